# Optimizing an MI355X kernel written in HIP

```python
import math
import jax
import jax.numpy as jnp
from jax import lax
import numpy as np

D_MODEL = 2048
BATCH = 4
SEQ = 2048
DEPTH = 4
DEC_BATCH = 8
DEC_SEQ = 1
PAST_LEN = 16384
PAGE_SIZE = 128

HEAD_DIM = 64
N_HEADS = D_MODEL // HEAD_DIM
N_ATT_HEADS = N_HEADS // 2
N_RWKV_HEADS = N_HEADS - N_ATT_HEADS
D_ATT = N_ATT_HEADS * HEAD_DIM
D_RWKV = N_RWKV_HEADS * HEAD_DIM
QKV_COLS = 3 * D_ATT + 3 * D_RWKV
BRANCHES = ((128, 1), (512, 4), (2048, 16))
W_MAX = max(w for w, _ in BRANCHES)
BAND = 128
NUM_BUCKETS = 32
MAX_DISTANCE = W_MAX
ATT_SCALE = HEAD_DIM ** -0.5
D_FF = -(-8 * D_MODEL // (3 * 256)) * 256
D_DECAY_LORA = 64
D_AAA_LORA = 64
D_MV_LORA = 32
D_GATE_LORA = 160
RMS_EPS = 1e-6
GN_EPS = 64e-5

kernel_name = 'hymba_dilated_attn_rwkv7_adaln_step'


def rmsnorm(x, g):
    xf = x.astype(jnp.float32)
    y = xf * lax.rsqrt(jnp.mean(xf * xf, axis=-1, keepdims=True) + RMS_EPS)
    return (y * g.astype(jnp.float32)).astype(x.dtype)


def modulate(h, shift, scale):
    return h * (1 + scale[:, None, :]) + shift[:, None, :]


def token_shift(t, prev):
    return jnp.concatenate([prev[:, None, :].astype(t.dtype), t[:, :-1]], axis=1)


def rel_bucket(dist):
    max_exact = NUM_BUCKETS // 2
    d = jnp.maximum(dist, 0)
    df = jnp.maximum(d, 1).astype(jnp.float32)
    large = max_exact + (jnp.log(df / max_exact) / math.log(MAX_DISTANCE / max_exact)
                         * (NUM_BUCKETS - max_exact)).astype(jnp.int32)
    return jnp.where(d < max_exact, d, jnp.minimum(large, NUM_BUCKETS - 1))


def dilated_branch_prompt(q, k, v, rel_bias, window, dil):
    B, S, H, E = q.shape
    L = S // dil
    nb = -(-L // BAND)
    Lp = nb * BAND
    wsub = window // dil

    def to_res(t):
        t = t.reshape(B, L, dil, H, E).transpose(0, 2, 1, 3, 4)
        t = jnp.pad(t, ((0, 0), (0, 0), (0, Lp - L), (0, 0), (0, 0)))
        return t.reshape(B, dil, nb, BAND, H, E)

    def with_prev(t):
        prev = jnp.pad(t, ((0, 0), (0, 0), (1, 0), (0, 0), (0, 0), (0, 0)))[:, :, :-1]
        return jnp.concatenate([prev, t], axis=3)

    qb = to_res(q)
    kb = with_prev(to_res(k))
    vb = with_prev(to_res(v))
    logits = jnp.einsum('brnqhe,brnkhe->brnhqk', qb, kb) * ATT_SCALE
    iq = jnp.arange(BAND)[:, None]
    jk = jnp.arange(2 * BAND)[None, :]
    dsub = BAND + iq - jk
    kpos = (jnp.arange(nb)[:, None, None] - 1) * BAND + jk[None]
    valid = (dsub >= 0) & (dsub <= wsub) & (kpos >= 0)
    bias = rel_bias[rel_bucket(dsub * dil)].astype(jnp.float32)
    logits = logits + jnp.moveaxis(bias, -1, 0)
    logits = jnp.where(valid[:, None], logits, -jnp.inf)
    lse = jax.nn.logsumexp(logits, axis=-1)
    p = jnp.exp(logits - lse[..., None])
    o = jnp.einsum('brnhqk,brnkhe->brnqhe', p, vb)

    def from_res(t):
        t = t.reshape((B, dil, Lp) + t.shape[4:])[:, :, :L]
        t = jnp.swapaxes(t, 1, 2)
        return t.reshape((B, S) + t.shape[3:])

    return from_res(o), from_res(jnp.swapaxes(lse, 3, 4))


def dilated_branch_sample(q, kc, vc, rel_bias, window, dil, wbuf):
    T = q.shape[1]
    m = jnp.arange(window // dil + 1)
    idx = wbuf + jnp.arange(T)[:, None] - dil * m[None, :]
    valid = idx >= 0
    idxc = jnp.maximum(idx, 0)
    kg = kc[:, idxc]
    vg = vc[:, idxc]
    logits = jnp.einsum('bthe,btmhe->bhtm', q, kg) * ATT_SCALE
    bias = rel_bias[rel_bucket(dil * m)].astype(jnp.float32)
    logits = logits + bias.T[None, :, None, :]
    logits = jnp.where(valid[None, None], logits, -jnp.inf)
    lse = jax.nn.logsumexp(logits, axis=-1)
    p = jnp.exp(logits - lse[..., None])
    o = jnp.einsum('bhtm,btmhe->bthe', p, vg)
    return o, jnp.swapaxes(lse, 1, 2)


def wkv_scan(S0, r, w, k, v, a, b):
    def step(S, inp):
        r_t, w_t, k_t, v_t, a_t, b_t = inp
        sa = jnp.einsum('bhij,bhj->bhi', S, a_t)
        S = S * w_t[:, :, None, :] + sa[..., None] * b_t[:, :, None, :] + v_t[..., None] * k_t[:, :, None, :]
        return S, jnp.einsum('bhij,bhj->bhi', S, r_t)
    xs = tuple(jnp.swapaxes(t, 0, 1) for t in (r, w, k, v, a, b))
    S, ys = lax.scan(step, S0, xs)
    return S, jnp.swapaxes(ys, 0, 1)


def trunk_layer(P, l, x, c, h_last, wkv0, k_buf, v_buf, v_first):
    B, T, _ = x.shape
    f32 = jnp.float32
    mod = jnp.dot(jax.nn.silu(c), P['ada_w'][l]) + P['ada_b'][l]
    sh1, sc1, gt1, sh2, sc2, gt2 = jnp.split(mod, 6, axis=-1)
    h = modulate(rmsnorm(x, P['norm1_g'][l]), sh1, sc1)
    w_in = P['w_in'][l]
    qa, ka, va, rkv0 = jnp.split(h @ w_in, [D_ATT, 2 * D_ATT, 3 * D_ATT], axis=-1)

    q = rmsnorm(qa.reshape(B, T, N_ATT_HEADS, HEAD_DIM), P['q_norm_g'][l]).astype(f32)
    k = rmsnorm(ka.reshape(B, T, N_ATT_HEADS, HEAD_DIM), P['k_norm_g'][l])
    v = va.reshape(B, T, N_ATT_HEADS, HEAD_DIM)
    if k_buf is None:
        res = [dilated_branch_prompt(q, k.astype(f32), v.astype(f32), P['rel_bias'], w, d)
               for (w, d) in BRANCHES]
        keep = min(W_MAX, T)
        new_k, new_v = k[:, T - keep:], v[:, T - keep:]
    else:
        kc = jnp.concatenate([k_buf.astype(f32), k.astype(f32)], axis=1)
        vc = jnp.concatenate([v_buf.astype(f32), v.astype(f32)], axis=1)
        res = [dilated_branch_sample(q, kc, vc, P['rel_bias'], w, d, k_buf.shape[1])
               for (w, d) in BRANCHES]
        new_k, new_v = k, v
    outs = jnp.stack([o for o, _ in res])
    lses = jnp.stack([s for _, s in res])
    alpha = jax.nn.softmax(lses, axis=0)
    att = jnp.einsum('nbth,nbthe->bthe', alpha, outs).reshape(B, T, D_ATT).astype(x.dtype)

    H, N = N_RWKV_HEADS, HEAD_DIM
    dh = token_shift(h, h_last) - h
    mu = P['mu_wag'][l]
    xw = h + dh * mu[0]
    xa = h + dh * mu[1]
    xg = h + dh * mu[2]
    rkv_prev = token_shift(rkv0, h_last @ w_in[:, 3 * D_ATT:])
    rkv = rkv0 + (rkv_prev - rkv0) * P['mu_rkv'][l].reshape(-1)
    r, kr, vr = jnp.split(rkv.astype(f32), 3, axis=-1)
    logw = -jax.nn.softplus(-(P['decay_w0'][l] + jnp.tanh(xw @ P['decay_w1'][l]) @ P['decay_w2'][l])) - 0.5
    decay = jnp.exp(-jnp.exp(logw.astype(f32)))
    if l == 0:
        v_first = vr
    else:
        xv = h + dh * P['vres_mu'][l - 1]
        vgate = jax.nn.sigmoid((P['vres_v0'][l - 1] + (xv @ P['vres_w1'][l - 1]) @ P['vres_w2'][l - 1]).astype(f32))
        vr = vr + (v_first - vr) * vgate
    a = jax.nn.sigmoid((P['aaa_a0'][l] + (xa @ P['aaa_w1'][l]) @ P['aaa_w2'][l]).astype(f32))
    g = (jax.nn.sigmoid(xg @ P['gate_w1'][l]) @ P['gate_w2'][l]).astype(f32)
    kk = (kr * P['k_k'][l]).reshape(B, T, H, N)
    kk = kk / jnp.maximum(jnp.sqrt(jnp.sum(kk * kk, axis=-1, keepdims=True)), 1e-12)
    kr = kr * (1 + (a - 1) * P['k_a'][l])
    rh = r.reshape(B, T, H, N)
    kh = kr.reshape(B, T, H, N)
    vh = vr.reshape(B, T, H, N)
    ah = a.reshape(B, T, H, N)
    wkv, y = wkv_scan(wkv0.astype(f32), rh, decay.reshape(B, T, H, N), kh, vh, -kk, kk * ah)
    y_mu = jnp.mean(y, axis=-1, keepdims=True)
    y_var = jnp.mean(jnp.square(y - y_mu), axis=-1, keepdims=True)
    y = (y - y_mu) * lax.rsqrt(y_var + GN_EPS)
    y = y * P['lnx_g'][l].reshape(H, N) + P['lnx_b'][l].reshape(H, N)
    y = y + jnp.sum(rh * kh * P['r_k'][l], axis=-1, keepdims=True) * vh
    rw = (y.reshape(B, T, D_RWKV) * g).astype(x.dtype)

    mix = jnp.concatenate([att, rw], axis=-1) @ P['w_out'][l]
    x = x + gt1[:, None, :] * mix

    h2 = modulate(rmsnorm(x, P['norm2_g'][l]), sh2, sc2)
    gate, up = jnp.split(h2 @ P['w_gu'][l], 2, axis=-1)
    x = x + gt2[:, None, :] * ((jax.nn.silu(gate) * up) @ P['w_down'][l])
    return x, v_first, new_k, new_v, wkv.astype(x.dtype), h[:, -1]


def setup_inputs(seed: int = 0) -> dict:
    key = jax.random.key(seed)
    ks = iter(jax.random.split(key, 48))

    def nrm(shape, scale):
        return jax.random.normal(next(ks), shape, jnp.float32) * scale

    def uni(shape, lo, hi):
        return jax.random.uniform(next(ks), shape, jnp.float32, lo, hi)

    wbuf = min(W_MAX, PAST_LEN)
    nv = DEPTH - 1
    d_in = D_MODEL ** -0.5
    return {
        'x_prompt': nrm((BATCH, SEQ, D_MODEL), 1.0),
        'x_sample': nrm((DEC_BATCH, DEC_SEQ, D_MODEL), 1.0),
        'c_prompt': nrm((BATCH, D_MODEL), 1.0),
        'c_sample': nrm((DEC_BATCH, D_MODEL), 1.0),
        'cache_k': nrm((DEPTH, DEC_BATCH, wbuf, N_ATT_HEADS, HEAD_DIM), 1.0),
        'cache_v': nrm((DEPTH, DEC_BATCH, wbuf, N_ATT_HEADS, HEAD_DIM), 1.0),
        'state_wkv': nrm((DEPTH, DEC_BATCH, N_RWKV_HEADS, HEAD_DIM, HEAD_DIM), 0.3),
        'state_shift': nrm((DEPTH, DEC_BATCH, D_MODEL), 1.0),
        'rel_bias': nrm((NUM_BUCKETS, N_ATT_HEADS), 0.5),
        'ada_w': nrm((DEPTH, D_MODEL, 6 * D_MODEL), 0.5 * d_in),
        'ada_b': nrm((DEPTH, 6 * D_MODEL), 0.02),
        'norm1_g': 1.0 + nrm((DEPTH, D_MODEL), 0.02),
        'norm2_g': 1.0 + nrm((DEPTH, D_MODEL), 0.02),
        'w_in': nrm((DEPTH, D_MODEL, QKV_COLS), d_in),
        'q_norm_g': 1.0 + nrm((DEPTH, HEAD_DIM), 0.02),
        'k_norm_g': 1.0 + nrm((DEPTH, HEAD_DIM), 0.02),
        'mu_wag': uni((DEPTH, 3, D_MODEL), 0.0, 1.0),
        'mu_rkv': uni((DEPTH, 3, D_RWKV), 0.0, 1.0),
        'decay_w0': uni((DEPTH, D_RWKV), -3.0, 0.0),
        'decay_w1': nrm((DEPTH, D_MODEL, D_DECAY_LORA), d_in),
        'decay_w2': nrm((DEPTH, D_DECAY_LORA, D_RWKV), 0.1 * D_DECAY_LORA ** -0.5),
        'aaa_a0': nrm((DEPTH, D_RWKV), 0.1),
        'aaa_w1': nrm((DEPTH, D_MODEL, D_AAA_LORA), d_in),
        'aaa_w2': nrm((DEPTH, D_AAA_LORA, D_RWKV), 0.1 * D_AAA_LORA ** -0.5),
        'gate_w1': nrm((DEPTH, D_MODEL, D_GATE_LORA), d_in),
        'gate_w2': nrm((DEPTH, D_GATE_LORA, D_RWKV), D_GATE_LORA ** -0.5),
        'vres_mu': uni((nv, D_MODEL), 0.0, 1.0),
        'vres_v0': 1.0 + nrm((nv, D_RWKV), 0.1),
        'vres_w1': nrm((nv, D_MODEL, D_MV_LORA), d_in),
        'vres_w2': nrm((nv, D_MV_LORA, D_RWKV), 0.1 * D_MV_LORA ** -0.5),
        'k_k': 0.85 + nrm((DEPTH, D_RWKV), 0.02),
        'k_a': 1.0 + nrm((DEPTH, D_RWKV), 0.02),
        'r_k': nrm((DEPTH, N_RWKV_HEADS, HEAD_DIM), 0.1),
        'lnx_g': 1.0 + nrm((DEPTH, D_RWKV), 0.02),
        'lnx_b': nrm((DEPTH, D_RWKV), 0.02),
        'w_out': nrm((DEPTH, D_MODEL, D_MODEL), d_in),
        'w_gu': nrm((DEPTH, D_MODEL, 2 * D_FF), d_in),
        'w_down': nrm((DEPTH, D_FF, D_MODEL), D_FF ** -0.5),
    }


def reference(x_prompt, x_sample, c_prompt, c_sample, cache_k, cache_v, state_wkv, state_shift,
              rel_bias, ada_w, ada_b, norm1_g, norm2_g, w_in, q_norm_g, k_norm_g, mu_wag, mu_rkv,
              decay_w0, decay_w1, decay_w2, aaa_a0, aaa_w1, aaa_w2, gate_w1, gate_w2,
              vres_mu, vres_v0, vres_w1, vres_w2, k_k, k_a, r_k, lnx_g, lnx_b, w_out, w_gu, w_down):
    P = dict(rel_bias=rel_bias, ada_w=ada_w, ada_b=ada_b, norm1_g=norm1_g, norm2_g=norm2_g,
             w_in=w_in, q_norm_g=q_norm_g, k_norm_g=k_norm_g, mu_wag=mu_wag, mu_rkv=mu_rkv,
             decay_w0=decay_w0, decay_w1=decay_w1, decay_w2=decay_w2,
             aaa_a0=aaa_a0, aaa_w1=aaa_w1, aaa_w2=aaa_w2, gate_w1=gate_w1, gate_w2=gate_w2,
             vres_mu=vres_mu, vres_v0=vres_v0, vres_w1=vres_w1, vres_w2=vres_w2,
             k_k=k_k, k_a=k_a, r_k=r_k, lnx_g=lnx_g, lnx_b=lnx_b,
             w_out=w_out, w_gu=w_gu, w_down=w_down)

    B = x_prompt.shape[0]
    h0 = jnp.zeros((B, D_MODEL), x_prompt.dtype)
    s0 = jnp.zeros((B, N_RWKV_HEADS, HEAD_DIM, HEAD_DIM), jnp.float32)
    xp, vf = x_prompt, None
    pk, pv, ps, ph = [], [], [], []
    for l in range(DEPTH):
        xp, vf, nk, nvv, ns, nh = trunk_layer(P, l, xp, c_prompt, h0, s0, None, None, vf)
        pk.append(nk)
        pv.append(nvv)
        ps.append(ns)
        ph.append(nh)

    xs, vf = x_sample, None
    sk, sv, ss, sh = [], [], [], []
    for l in range(DEPTH):
        xs, vf, nk, nvv, ns, nh = trunk_layer(P, l, xs, c_sample, state_shift[l], state_wkv[l],
                                              cache_k[l], cache_v[l], vf)
        sk.append(nk)
        sv.append(nvv)
        ss.append(ns)
        sh.append(nh)

    return (xp, xs, jnp.stack(pk), jnp.stack(pv), jnp.stack(ps), jnp.stack(ph),
            jnp.stack(sk), jnp.stack(sv), jnp.stack(ss), jnp.stack(sh))
```

```cpp
#include <hip/hip_runtime.h>
#include <cstdio>
#include <cstdint>
#include <cmath>
namespace pg8 {
#define PG8_LAS __attribute__((address_space(3)))
typedef unsigned short bf16_t;
typedef short bf16x8 __attribute__((ext_vector_type(8)));
typedef float f32x4 __attribute__((ext_vector_type(4)));
typedef unsigned u32x4 __attribute__((ext_vector_type(4)));
constexpr int BM = 256, BK = 64, HALF = 128, HTB = HALF * BK * 2  , STAGE_BYTES = 8 * HTB, NXCD = 8, WGM = 8;

__host__ __device__ __forceinline__ int lds_byte(int r, int c) { const int st = (r >> 4) * 2 + (c >> 5), rr = r & 15, cc = c & 31, ob = rr * 64 + cc * 2; return st * 1024 + (ob ^ (((ob >> 9) & 1) << 5)); }
__host__ __device__ __forceinline__ void stage_rc(int b, int& R, int& C) { const int st = b / 1024, sb = b % 1024, swz = sb ^ (((sb >> 9) & 1) << 5); R = (st >> 1) * 16 + swz / 64; C = (st & 1) * 32 + (swz % 64) / 2; }
__host__ __device__ __forceinline__ int perm32(int rho) { const int n = rho >> 4, i = rho & 15; return 8 * (i >> 2) + 4 * n + (i & 3); }

struct Unit { int pm, pn; };
struct Gemm { const bf16_t* A; const bf16_t* Bt; int M, N, K; };

struct StaticOrder {
    int nM, nN, nwg, G, c;
    __host__ __device__ void init(int M, int N, int G_, int c_) { nM = M / BM; nN = N / BM; nwg = nM * nN; G = G_; c = c_; }
    __host__ __device__ bool next(int i, Unit& u) const {
        const long L = (long)i * G + c; if (L >= nwg) return false;
        int wgid = (int)L; { const int q = nwg / NXCD, r = nwg % NXCD, xcd = wgid % NXCD, off = wgid / NXCD; wgid = (xcd < r ? xcd * (q + 1) : r * (q + 1) + (xcd - r) * q) + off; }
        const int nig = WGM * nN, gid = wgid / nig, fm = gid * WGM, gsz = (nM - fm) < WGM ? (nM - fm) : WGM;
        u.pm = fm + ((wgid % nig) % gsz); u.pn = (wgid % nig) / gsz; return true;
    }
    __device__ __forceinline__ void a_ready(const Unit&) const {}
    __device__ __forceinline__ void done(const Unit&) const {}
};

__device__ __forceinline__ unsigned cvt_pk_bf16(float lo, float hi) { unsigned r; asm volatile("v_cvt_pk_bf16_f32 %0, %1, %2" : "=v"(r) : "v"(lo), "v"(hi)); return r; }
typedef float f32x2 __attribute__((ext_vector_type(2)));
__device__ __forceinline__ f32x2 gelu_pk(f32x2 v) {
    const f32x2 av = __builtin_elementwise_abs(v), d = av * 0.2316418882f + 1.0f;
    f32x2 t; t.x = __builtin_amdgcn_rcpf(d.x); t.y = __builtin_amdgcn_rcpf(d.y);
    f32x2 q = t * 0.5307027145f + (-0.7265760135f); q = q * t + 0.7107068705f; q = q * t + (-0.142248368f); q = q * t + 0.127414796f; q = q * t;
    const f32x2 s = (v * v) * (-0.72134752044f);
    f32x2 e; e.x = __builtin_amdgcn_exp2f(s.x); e.y = __builtin_amdgcn_exp2f(s.y);
    const f32x2 m = v * (q * e), r = v - m;
    f32x2 o; o.x = v.x < 0.f ? m.x : r.x; o.y = v.y < 0.f ? m.y : r.y; return o;
}

template <int ACT  > struct EpiBf16 {
    static constexpr bool PERM = true, AFTER_DRAIN = false; static_assert(ACT == 0 || ACT == 1, "EpiBf16: ACT is 0 (none) or 1 (gelu_pk)");
    bf16_t* O; int ldc; const float* bias; int split_cols; size_t split_stride; float scale0;
    __device__ __forceinline__ void operator()(const f32x4 (&acc)[2][2][4][2], const Unit& u, int wr, int wc, int fr, int fq) const {
        const int row0 = u.pm * BM + wr * 64 + fr; int colt = u.pn * BM; bf16_t* base = O;
        float sc = 1.f; if (split_cols) { const int t = colt / split_cols; base += (size_t)t * split_stride; colt -= t * split_cols; if (t == 0) sc = scale0; }
        const int col0 = colt + wc * 32 + 8 * fq, bcol0 = u.pn * BM + wc * 32 + 8 * fq;
        f32x4 bv[2][2];
#pragma unroll
        for (int bj = 0; bj < 2; ++bj)
#pragma unroll
            for (int n = 0; n < 2; ++n) bv[bj][n] = bias ? *(const f32x4*)(bias + bcol0 + bj * HALF + 4 * n) : (f32x4){0.f, 0.f, 0.f, 0.f};
#pragma unroll
        for (int ai = 0; ai < 2; ++ai)
#pragma unroll
            for (int m = 0; m < 4; ++m) { bf16_t* rowp = base + (size_t)(row0 + ai * HALF + m * 16) * ldc + col0;
#pragma unroll
                for (int bj = 0; bj < 2; ++bj) { f32x4 v0 = acc[ai][bj][m][0] + bv[bj][0], v1 = acc[ai][bj][m][1] + bv[bj][1];
                    if (ACT == 1) { f32x2 a = gelu_pk((f32x2){v0[0], v0[1]}), b = gelu_pk((f32x2){v0[2], v0[3]}), c = gelu_pk((f32x2){v1[0], v1[1]}), d = gelu_pk((f32x2){v1[2], v1[3]});
                        v0 = (f32x4){a.x, a.y, b.x, b.y}; v1 = (f32x4){c.x, c.y, d.x, d.y}; }
                    v0 = v0 * sc; v1 = v1 * sc; u32x4 w; w.x = cvt_pk_bf16(v0[0], v0[1]); w.y = cvt_pk_bf16(v0[2], v0[3]); w.z = cvt_pk_bf16(v1[0], v1[1]); w.w = cvt_pk_bf16(v1[2], v1[3]);
                    *(u32x4*)(rowp + bj * HALF) = w; } }
    }
};


struct EpiF32 {
    static constexpr bool PERM = false, AFTER_DRAIN = false;
    float* O; int ldc;
    __device__ __forceinline__ void operator()(const f32x4 (&acc)[2][2][4][2], const Unit& u, int wr, int wc, int fr, int fq) const {
        const int col0 = u.pn * BM + wc * 32 + 4 * fq;
#pragma unroll
        for (int ai = 0; ai < 2; ++ai)
#pragma unroll
            for (int m = 0; m < 4; ++m) { float* rowp = O + (size_t)(u.pm * BM + ai * HALF + wr * 64 + m * 16 + fr) * ldc + col0;
#pragma unroll
                for (int bj = 0; bj < 2; ++bj)
#pragma unroll
                    for (int n = 0; n < 2; ++n) *(f32x4*)(rowp + bj * HALF + n * 16) = acc[ai][bj][m][n]; }
    }
};
struct EpiResid {
    static constexpr bool PERM = false, AFTER_DRAIN = false;
    const float* base_p; const float* base_s; float* out_p; float* out_s; const float* gate;
    __device__ __forceinline__ void operator()(const f32x4 (&acc)[2][2][4][2], const Unit& u, int wr, int wc, int fr, int fq) const {
        const int col0 = u.pn * BM + wc * 32 + 4 * fq;
        if (u.pm < 32) {
            const float* g = gate + (size_t)(u.pm >> 3) * 12288 + col0;
            f32x4 gv[2][2];
#pragma unroll
            for (int bj = 0; bj < 2; ++bj)
#pragma unroll
                for (int n = 0; n < 2; ++n) gv[bj][n] = *(const f32x4*)(g + bj * HALF + n * 16);
#pragma unroll
            for (int ai = 0; ai < 2; ++ai)
#pragma unroll
                for (int m = 0; m < 4; ++m) { const size_t off = (size_t)(u.pm * BM + ai * HALF + wr * 64 + m * 16 + fr) * 2048 + col0;
#pragma unroll
                    for (int bj = 0; bj < 2; ++bj)
#pragma unroll
                        for (int n = 0; n < 2; ++n) { const f32x4 bs = *(const f32x4*)(base_p + off + bj * HALF + n * 16);
                            *(f32x4*)(out_p + off + bj * HALF + n * 16) = bs + gv[bj][n] * acc[ai][bj][m][n]; } }
        } else if (wr == 0 && fr < 8) {
            const float* g = gate + (size_t)(4 + fr) * 12288 + col0; const size_t off = (size_t)fr * 2048 + col0;
#pragma unroll
            for (int bj = 0; bj < 2; ++bj)
#pragma unroll
                for (int n = 0; n < 2; ++n) { const f32x4 gv = *(const f32x4*)(g + bj * HALF + n * 16); const f32x4 bs = *(const f32x4*)(base_s + off + bj * HALF + n * 16);
                    *(f32x4*)(out_s + off + bj * HALF + n * 16) = bs + gv * acc[0][bj][0][n]; }
        }
    }
};
struct EpiSwiGLU {
    static constexpr bool PERM = true, AFTER_DRAIN = false;
    bf16_t* O; int ldc;
    __device__ __forceinline__ void operator()(const f32x4 (&acc)[2][2][4][2], const Unit& u, int wr, int wc, int fr, int fq) const {
        const int row0 = u.pm * BM + wr * 64 + fr, col0 = u.pn * HALF + wc * 32 + 8 * fq;
#pragma unroll
        for (int ai = 0; ai < 2; ++ai)
#pragma unroll
            for (int m = 0; m < 4; ++m) { bf16_t* rowp = O + (size_t)(row0 + ai * HALF + m * 16) * ldc + col0;
                float v[8];
#pragma unroll
                for (int n = 0; n < 2; ++n)
#pragma unroll
                    for (int e = 0; e < 4; ++e) { const float g = acc[ai][0][m][n][e], up = acc[ai][1][m][n][e]; v[4 * n + e] = g * __builtin_amdgcn_rcpf(1.0f + __expf(-g)) * up; }
                u32x4 w; w.x = cvt_pk_bf16(v[0], v[1]); w.y = cvt_pk_bf16(v[2], v[3]); w.z = cvt_pk_bf16(v[4], v[5]); w.w = cvt_pk_bf16(v[6], v[7]);
                *(u32x4*)rowp = w; }
    }
};
template <class Epi, class Sched, bool ALIGN_EPI = false, bool SP2 = false>
__device__ __forceinline__ void gemm_phase(PG8_LAS unsigned char* lds, const Gemm g, const Sched& S, const Epi& E) {
    int tid_ = threadIdx.x; asm volatile("" : "+v"(tid_));
    const int tid = tid_, wid = __builtin_amdgcn_readfirstlane(tid >> 6), lane = tid & 63, wr = wid >> 2, wc = wid & 3, fr = lane & 15, fq = lane >> 4;
    const int K = g.K, nt = K / BK;
    unsigned voffA[2], voffB[2];
#pragma unroll
    for (int i = 0; i < 2; ++i) { int R, C; stage_rc(tid * 16 + i * 8192, R, C); const int Rb = Epi::PERM ? ((R & ~31) + perm32(R & 31)) : R;
        voffA[i] = (unsigned)(R * K + C) * 2u; voffB[i] = (unsigned)(Rb * K + C) * 2u; }
    const size_t kstep = (size_t)(BK * 2);
    const size_t hstep = (size_t)HALF * K * 2;
    const size_t tstep = 2 * hstep;
    const unsigned ldsw = (unsigned)wid * 1024u;
    const int aoff = lds_byte(wr * 64 + fr, fq * 8), boff = lds_byte(wc * 32 + fr, fq * 8);
#define PG8_SA(b, h) (((b) * 2 + (h)) * HTB)
#define PG8_SB(b, h) ((4 + (b) * 2 + (h)) * HTB)
#define PG8_STAGE(bufoff, gbase, voff) do { _Pragma("unroll") for (int _i = 0; _i < 2; ++_i) \
        __builtin_amdgcn_global_load_lds((const unsigned*)((const char*)(gbase) + (voff)[_i]), (PG8_LAS unsigned*)(lds + (bufoff) + ldsw + _i * 8192), 16, 0, 0); } while (0)
#define PG8_LDA(dst, b, h) do { _Pragma("unroll") for (int m = 0; m < 4; ++m) _Pragma("unroll") for (int k = 0; k < 2; ++k) dst[m][k] = *(const PG8_LAS bf16x8*)(lds + PG8_SA(b, h) + aoff + m * 2048 + k * 1024); } while (0)
#define PG8_LDB(dst, b, h) do { _Pragma("unroll") for (int n = 0; n < 2; ++n) _Pragma("unroll") for (int k = 0; k < 2; ++k) dst[n][k] = *(const PG8_LAS bf16x8*)(lds + PG8_SB(b, h) + boff + n * 2048 + k * 1024); } while (0)
#define PG8_MMA(ai, bj, At, Bt) do { __builtin_amdgcn_s_setprio(1); _Pragma("unroll") for (int m = 0; m < 4; ++m) _Pragma("unroll") for (int n = 0; n < 2; ++n) _Pragma("unroll") for (int k = 0; k < 2; ++k) \
        acc[ai][bj][m][n] = __builtin_amdgcn_mfma_f32_16x16x32_bf16(Bt[n][k], At[m][k], acc[ai][bj][m][n], 0, 0, 0); __builtin_amdgcn_s_setprio(0); } while (0)
#define PG8_WAIT_V(n) asm volatile("s_waitcnt vmcnt(" #n ")" ::: "memory")
#define PG8_WAIT_L(n) asm volatile("s_waitcnt lgkmcnt(" #n ")" ::: "memory")
#define PG8_BAR __builtin_amdgcn_s_barrier()
#define PG8_SCHED __builtin_amdgcn_sched_barrier(0)
    Unit cur, nxt; int ui = 0;
    if (!S.next(0, cur)) return;
    f32x4 acc[2][2][4][2];
#pragma unroll
    for (int a = 0; a < 2; ++a)
#pragma unroll
        for (int b = 0; b < 2; ++b)
#pragma unroll
            for (int m = 0; m < 4; ++m)
#pragma unroll
                for (int n = 0; n < 2; ++n) acc[a][b][m][n] = (f32x4){0.f, 0.f, 0.f, 0.f};
    bf16x8 At[4][2], B0[2][2], B1[2][2];
    const char* cA = (const char*)g.A + (size_t)cur.pm * tstep; const char* cB = (const char*)g.Bt + (size_t)cur.pn * tstep;
    S.a_ready(cur);
    if constexpr (SP2) {
        PG8_STAGE(PG8_SB(0, 0), cB, voffB); PG8_STAGE(PG8_SB(0, 1), cB + hstep, voffB); PG8_STAGE(PG8_SA(0, 0), cA, voffA); PG8_STAGE(PG8_SA(0, 1), cA + hstep, voffA);
        if (wr == 1) PG8_BAR;
        PG8_WAIT_V(2); PG8_BAR;
        PG8_STAGE(PG8_SB(1, 0), cB + kstep, voffB); PG8_STAGE(PG8_SA(1, 0), cA + kstep, voffA); PG8_STAGE(PG8_SB(1, 1), cB + hstep + kstep, voffB);
        PG8_WAIT_V(6); PG8_BAR;
    } else {
        PG8_STAGE(PG8_SB(0, 0), cB, voffB); PG8_STAGE(PG8_SA(0, 0), cA, voffA); PG8_STAGE(PG8_SB(0, 1), cB + hstep, voffB); PG8_STAGE(PG8_SA(0, 1), cA + hstep, voffA);
        if (wr == 1) PG8_BAR;
        PG8_WAIT_V(4); PG8_BAR;
        PG8_STAGE(PG8_SB(1, 0), cB + kstep, voffB); PG8_STAGE(PG8_SA(1, 0), cA + kstep, voffA); PG8_STAGE(PG8_SB(1, 1), cB + hstep + kstep, voffB);
        PG8_WAIT_V(6); PG8_BAR;
    }
    for (;;) {
        const bool has_next = S.next(ui + 1, nxt);
        const char* nA = has_next ? (const char*)g.A + (size_t)nxt.pm * tstep : cA; const char* nB = has_next ? (const char*)g.Bt + (size_t)nxt.pn * tstep : cB;
        for (int t = 0; t < nt; t += 2) {
            const bool last = (t == nt - 2);
            const char* a1 = cA + (size_t)(t + 1) * kstep;
            const char* a2 = last ? nA : cA + (size_t)(t + 2) * kstep; const char* b2 = last ? nB : cB + (size_t)(t + 2) * kstep;
            const char* a3 = a2 + kstep; const char* b3 = b2 + kstep;
            if (last && has_next) S.a_ready(nxt);
            if constexpr (SP2) {
            PG8_LDB(B0, 0, 0); PG8_LDB(B1, 0, 1); PG8_SCHED; PG8_LDA(At, 0, 0); PG8_STAGE(PG8_SA(1, 1), a1 + hstep, voffA);
            PG8_WAIT_V(8); PG8_WAIT_L(0); PG8_BAR; PG8_MMA(0, 0, At, B0); PG8_MMA(0, 1, At, B1); PG8_BAR; PG8_SCHED;
            PG8_LDA(At, 0, 1); PG8_STAGE(PG8_SB(0, 0), b2, voffB); PG8_STAGE(PG8_SB(0, 1), b2 + hstep, voffB); PG8_STAGE(PG8_SA(0, 0), a2, voffA);
            PG8_WAIT_V(8); PG8_WAIT_L(0); PG8_BAR; PG8_MMA(1, 0, At, B0); PG8_MMA(1, 1, At, B1); PG8_BAR; PG8_SCHED;
            PG8_LDB(B0, 1, 0); PG8_LDB(B1, 1, 1); PG8_SCHED; PG8_LDA(At, 1, 0); PG8_STAGE(PG8_SA(0, 1), a2 + hstep, voffA);
            PG8_WAIT_V(8); PG8_WAIT_L(0); PG8_BAR; PG8_MMA(0, 0, At, B0); PG8_MMA(0, 1, At, B1); PG8_BAR; PG8_SCHED;
            PG8_LDA(At, 1, 1); PG8_STAGE(PG8_SB(1, 0), b3, voffB); PG8_STAGE(PG8_SB(1, 1), b3 + hstep, voffB); PG8_STAGE(PG8_SA(1, 0), a3, voffA);
            PG8_WAIT_V(8); PG8_WAIT_L(0); PG8_BAR; PG8_MMA(1, 0, At, B0); PG8_MMA(1, 1, At, B1); PG8_BAR; PG8_SCHED;
            } else {
            PG8_LDB(B0, 0, 0); PG8_SCHED; PG8_LDA(At, 0, 0); PG8_STAGE(PG8_SA(1, 1), a1 + hstep, voffA);
            PG8_WAIT_L(8); PG8_BAR; PG8_WAIT_L(0); PG8_MMA(0, 0, At, B0); PG8_BAR; PG8_SCHED;
            PG8_LDB(B1, 0, 1); PG8_STAGE(PG8_SB(0, 0), b2, voffB);
            PG8_BAR; PG8_WAIT_L(0); PG8_MMA(0, 1, At, B1); PG8_BAR;
            PG8_LDA(At, 0, 1); PG8_STAGE(PG8_SA(0, 0), a2, voffA);
            PG8_BAR; PG8_WAIT_L(0); PG8_MMA(1, 0, At, B0); PG8_BAR; PG8_SCHED;
            PG8_STAGE(PG8_SB(0, 1), b2 + hstep, voffB);
            PG8_WAIT_V(6); PG8_BAR; PG8_MMA(1, 1, At, B1); PG8_BAR;
            PG8_LDB(B0, 1, 0); PG8_SCHED; PG8_LDA(At, 1, 0); PG8_STAGE(PG8_SA(0, 1), a2 + hstep, voffA);
            PG8_WAIT_L(8); PG8_BAR; PG8_WAIT_L(0); PG8_MMA(0, 0, At, B0); PG8_BAR; PG8_SCHED;
            PG8_LDB(B1, 1, 1); PG8_STAGE(PG8_SB(1, 0), b3, voffB);
            PG8_BAR; PG8_WAIT_L(0); PG8_MMA(0, 1, At, B1); PG8_BAR;
            PG8_LDA(At, 1, 1); PG8_STAGE(PG8_SA(1, 0), a3, voffA);
            PG8_BAR; PG8_WAIT_L(0); PG8_MMA(1, 0, At, B0); PG8_BAR; PG8_SCHED;
            PG8_STAGE(PG8_SB(1, 1), b3 + hstep, voffB);
            PG8_WAIT_V(6); PG8_BAR; PG8_MMA(1, 1, At, B1); PG8_BAR;
            }
        }
        if constexpr (ALIGN_EPI) { if (wr == 0) PG8_BAR; }
        if constexpr (!Epi::AFTER_DRAIN) { E(acc, cur, wr, wc, fr, fq); S.done(cur); }
        if (!has_next) break;
#pragma unroll
        for (int a = 0; a < 2; ++a)
#pragma unroll
            for (int b = 0; b < 2; ++b)
#pragma unroll
                for (int m = 0; m < 4; ++m)
#pragma unroll
                    for (int n = 0; n < 2; ++n) acc[a][b][m][n] = (f32x4){0.f, 0.f, 0.f, 0.f};
        cur = nxt; cA = nA; cB = nB; ++ui;
        if constexpr (ALIGN_EPI) { if (wr == 1) PG8_BAR; }
    }
    PG8_WAIT_V(0);
    if constexpr (!ALIGN_EPI) { if (wr == 0) PG8_BAR; }
    PG8_BAR;
    if constexpr (Epi::AFTER_DRAIN) { E.fused(acc, cur, wr, wc, fr, fq, lds, wid, lane); S.done(cur); }
#undef PG8_SA
#undef PG8_SB
#undef PG8_STAGE
#undef PG8_LDA
#undef PG8_LDB
#undef PG8_MMA
#undef PG8_WAIT_V
#undef PG8_WAIT_L
#undef PG8_BAR
#undef PG8_SCHED
}
}
#define GAS __attribute__((address_space(1)))
#define LAS __attribute__((address_space(3)))
typedef unsigned short bf16;
typedef unsigned v4u __attribute__((ext_vector_type(4)));
typedef float f32x4 __attribute__((ext_vector_type(4)));
typedef short bf16x8 __attribute__((ext_vector_type(8)));
typedef GAS unsigned gu32;
typedef GAS unsigned long long gu64;
#define RLX_AGENT __ATOMIC_RELAXED, __HIP_MEMORY_SCOPE_AGENT
#define LDS_WAIT() asm volatile("s_waitcnt lgkmcnt(0)" ::: "memory")
#define VM_WAIT() asm volatile("s_waitcnt vmcnt(0)" ::: "memory")
__device__ __forceinline__ unsigned long long rt() { return __builtin_amdgcn_s_memrealtime(); }
__device__ __forceinline__ unsigned f2bf(float f) { unsigned u = __builtin_bit_cast(unsigned, f); return (u + 0x7fffu + ((u >> 16) & 1u)) >> 16; }
__device__ __forceinline__ unsigned pk2(float lo, float hi) { return f2bf(lo) | (f2bf(hi) << 16); }
#define XB_TMO      128
#define XB_XCNT(j)  (256  + 64 * (j))
#define XB_XSUB(j)  (1280 + 64 * (j))
#define XB_XGEN(j)  (2304 + 64 * (j))
#define XB_TOP      3328
#define XB_TOPGEN   3392
#define XCD_BAR_WORDS 3456
#define XB_SPIN_CAP (1u << 18)

__device__ __forceinline__ unsigned xb_ld(unsigned* p)              { return __hip_atomic_load(p, __ATOMIC_RELAXED, __HIP_MEMORY_SCOPE_AGENT); }
__device__ __forceinline__ unsigned xb_add(unsigned* p, unsigned v) { return __hip_atomic_fetch_add(p, v, __ATOMIC_RELAXED, __HIP_MEMORY_SCOPE_AGENT); }
__device__ __forceinline__ unsigned xb_xcc_id() { return (unsigned)__builtin_amdgcn_s_getreg((3 << 11) | 20) & 0xFu; }
#define XB_SPIN(cond, bar) do { unsigned _sp = 0; while (cond) { __builtin_amdgcn_s_sleep(1); \
    if ((++_sp & 255u) == 0u) { if (xb_ld(&(bar)[XB_TMO])) break; if (_sp > XB_SPIN_CAP) { atomicAdd(&(bar)[XB_TMO], 1u); break; } } } } while (0)

struct XcdBarrier {
    unsigned* bar; unsigned x;
    volatile LAS unsigned* st;
};

__device__ __forceinline__ XcdBarrier xcd_barrier_post(unsigned* bar, volatile LAS unsigned* st) {
    XcdBarrier b; b.bar = bar; b.x = xb_xcc_id(); b.st = st;
    if (threadIdx.x == 0) (void)xb_add(&bar[XB_XCNT(b.x)], 1u);
    return b;
}
__device__ __forceinline__ void xcd_barrier_complete(unsigned* bar, unsigned x, unsigned& nloc, unsigned& nx) {
    const unsigned G = gridDim.x * gridDim.y * gridDim.z;
    unsigned sum, cnt, mine, sp = 0u;
    for (;;) {
        sum = 0u; cnt = 0u; mine = 0u;
#pragma unroll
        for (unsigned j = 0; j < 16; ++j) { const unsigned c = xb_ld(&bar[XB_XCNT(j)]); sum += c; cnt += (c > 0u) ? 1u : 0u; mine = (j == x) ? c : mine; }
        if (sum == G) break;
        __builtin_amdgcn_s_sleep(1);
        if ((++sp & 255u) == 0u) { if (xb_ld(&bar[XB_TMO])) break; if (sp > XB_SPIN_CAP) { atomicAdd(&bar[XB_TMO], 1u); break; } }
    }
    nloc = mine > 0u ? mine : 1u; nx = cnt > 0u ? cnt : 1u;
}

__device__ __forceinline__ void xcd_barrier(const XcdBarrier& b) {
    asm volatile("s_waitcnt vmcnt(0)" ::: "memory");
    __syncthreads();
    if (threadIdx.x == 0) {
        unsigned* bar = b.bar;
        __builtin_amdgcn_s_waitcnt(0);
        unsigned nloc = b.st[0], nx = b.st[1];
        if (nloc == 0u) { xcd_barrier_complete(bar, b.x, nloc, nx); b.st[0] = nloc; b.st[1] = nx; }
        const unsigned old = xb_add(&bar[XB_XSUB(b.x)], 1u);
        const unsigned gen = old / nloc;
        if (old + 1u == (gen + 1u) * nloc) {
            __builtin_amdgcn_fence(__ATOMIC_RELEASE, "agent");
            asm volatile("s_waitcnt vmcnt(0)" ::: "memory");
            const unsigned og = xb_add(&bar[XB_TOP], 1u);
            const unsigned tg = og / nx;
            if (og + 1u == (tg + 1u) * nx) xb_add(&bar[XB_TOPGEN], 1u);
            else XB_SPIN(xb_ld(&bar[XB_TOPGEN]) == tg, bar);
            __builtin_amdgcn_fence(__ATOMIC_ACQUIRE, "agent");
            xb_add(&bar[XB_XGEN(b.x)], 1u);
            asm volatile("s_waitcnt vmcnt(0)" ::: "memory");
        } else {
            XB_SPIN(xb_ld(&bar[XB_XGEN(b.x)]) == gen, bar);
            __builtin_amdgcn_fence(__ATOMIC_ACQUIRE, "agent");
            asm volatile("s_waitcnt vmcnt(0)" ::: "memory");
        }
    }
    __syncthreads();
}

#ifndef MK_N_LAUNCHES
#define MK_N_LAUNCHES 1
#endif
constexpr int NWAVES = 8, NTHR = 512;
constexpr int DM = 2048, SEQ = 2048, PBATCH = 4, SBATCH = 8, DEPTH = 4, NHEADS = 16, HD = 64, DATT = 1024, DRW = 1024, FF = 5632;
constexpr int MP = PBATCH * SEQ;
constexpr int ROW_S = MP;
constexpr int ROW_SS = MP + 8;
constexpr int NROWS = MP + 8;
constexpr int MH = MP + 256;
constexpr int N1 = 6912;
constexpr int PC0 = 6144, PP0 = 6144 + 384;
constexpr int NLORA = 320;
constexpr int MODW = 6 * DM;
constexpr float RMS_EPS = 1e-6f, GN_EPS = 64e-5f, ATT_SCALE = 0.125f;

enum { I_XP = 0, I_XS, I_CP, I_CS, I_CK, I_CV, I_SWKV, I_SSH, I_RELB, I_ADAW, I_ADAB, I_N1G, I_N2G, I_WIN, I_QG, I_KG, I_MUWAG, I_MURKV,
       I_DW0, I_DW1, I_DW2, I_AA0, I_AW1, I_AW2, I_GW1, I_GW2, I_VMU, I_VV0, I_VW1, I_VW2, I_KK, I_KA, I_RK, I_LNG, I_LNB, I_WOUT, I_WGU, I_WDN, N_IN };
constexpr size_t O_YP = 0, O_YS = O_YP + (size_t)MP * DM, O_KP = O_YS + 8 * DM, O_VP = O_KP + (size_t)DEPTH * MP * DATT, O_WP = O_VP + (size_t)DEPTH * MP * DATT,
                 O_SP = O_WP + (size_t)DEPTH * PBATCH * 16 * 4096, O_KS = O_SP + (size_t)DEPTH * PBATCH * DM, O_VS = O_KS + (size_t)DEPTH * 8 * DATT, O_WS = O_VS + (size_t)DEPTH * 8 * DATT,
                 O_SS = O_WS + (size_t)DEPTH * 8 * 16 * 4096, O_END = O_SS + (size_t)DEPTH * 8 * DM;
static_assert(O_END == 87212032, "output size");

constexpr size_t MiB = 1u << 20;
constexpr size_t WS_CTL = 0, CTL_ZERO_BYTES = 1 * MiB;
constexpr size_t WS_MOD = 1 * MiB;
constexpr size_t WS_BT = 4 * MiB;
constexpr size_t WS_WIN = 8 * MiB;
constexpr size_t WS_WOUT = 116 * MiB;
constexpr size_t WS_WGU = 148 * MiB;
constexpr size_t WS_WDN = 324 * MiB;
constexpr size_t WS_HB = 412 * MiB;
constexpr size_t WS_G1O = 446 * MiB;
constexpr size_t WS_QB = 670 * MiB, WS_KB = 687 * MiB, WS_VB = 704 * MiB;
constexpr size_t WS_R = 722 * MiB, WS_W = 755 * MiB, WS_K = 788 * MiB, WS_V = 821 * MiB, WS_A = 854 * MiB, WS_B = 887 * MiB, WS_G = 920 * MiB, WS_VF = 953 * MiB;
constexpr size_t WS_Y = 986 * MiB;
constexpr size_t WS_OBR = 1019 * MiB;
constexpr size_t WS_LSE = 1067 * MiB;
constexpr size_t WS_MIX = 1069 * MiB;
constexpr size_t WS_XB = 1102 * MiB;
constexpr size_t WS_ACT = 1168 * MiB;
constexpr size_t WS_END = 1260 * MiB;
static_assert(WS_WIN + (size_t)DEPTH * N1 * DM * 2 <= WS_WOUT && WS_WGU + (size_t)DEPTH * 2 * FF * DM * 2 <= WS_WDN && WS_WDN + (size_t)DEPTH * DM * FF * 2 <= WS_HB, "ws map (weights)");
static_assert(WS_HB + (size_t)MH * DM * 2 <= WS_G1O && WS_G1O + (size_t)MH * N1 * 4 <= WS_QB && WS_QB + (size_t)MH * DATT * 2 <= WS_KB && WS_VB + (size_t)MH * DATT * 2 <= WS_R, "ws map (act 1)");
static_assert(WS_R + (size_t)NROWS * DRW * 4 <= WS_W && WS_Y + (size_t)NROWS * DRW * 4 <= WS_OBR && WS_OBR + (size_t)3 * MP * DATT * 2 <= WS_LSE && WS_LSE + (size_t)3 * MP * 16 * 4 <= WS_MIX, "ws map (act 2)");
static_assert(WS_MIX + (size_t)MH * DM * 2 <= WS_XB && WS_XB + (size_t)MH * DM * 4 <= WS_ACT && WS_ACT + (size_t)MH * FF * 2 <= WS_END, "ws map (act 3)");
constexpr int CW_BAR = 4096;

constexpr int RING_BYTES = 131072;
constexpr int LDSCTL_OFF = RING_BYTES, MISC_OFF = LDSCTL_OFF + 320;
constexpr int LDS_BYTES = 147456;

constexpr int PH_PER_LAYER = 9, N_PHASES = 1 + DEPTH * PH_PER_LAYER;

struct Args { const float* in[N_IN]; float* out; unsigned char* ws; int ph_lo, ph_hi; };
static_assert(sizeof(Args) == N_IN * 8 + 24, "Args has no padding");

__device__ __forceinline__ float wave_sum(float v) {
#pragma unroll
    for (int o = 1; o < 64; o <<= 1) v += __shfl_xor(v, o);
    return v;
}
__device__ __forceinline__ float wave_max(float v) {
#pragma unroll
    for (int o = 1; o < 64; o <<= 1) v = fmaxf(v, __shfl_xor(v, o));
    return v;
}
template <int CTRL> __device__ __forceinline__ float dpp_mov(float v) { return __builtin_bit_cast(float, __builtin_amdgcn_update_dpp(0, __builtin_bit_cast(int, v), CTRL, 0xf, 0xf, false)); }
__device__ __forceinline__ float row16_sum(float v) {
    v += dpp_mov<0xB1>(v);
    v += dpp_mov<0x4E>(v);
    v += dpp_mov<0x141>(v);
    v += dpp_mov<0x140>(v);
    return v;
}
__device__ __forceinline__ float bf2f(unsigned short b) { return __builtin_bit_cast(float, (unsigned)b << 16); }
__device__ __forceinline__ float sigmoidf_(float x) { return 1.0f / (1.0f + __expf(-x)); }

__device__ __forceinline__ void p0_transpose_item(const float* W, int N, int k0, int n0, bf16* WT, int ldt, int drow0, const float* mu, int smode, LAS float* scr, int lane) {
#pragma unroll 8
    for (int i = 0; i < 32; ++i) { const int kk = 2 * i + (lane >> 5); float v = W[(size_t)(k0 + kk) * N + n0 + (lane & 31)];
        if (smode) { const float m = mu[k0 + kk]; v *= (smode == 1) ? (1.0f - m) : m; }
        scr[kk * 33 + (lane & 31)] = v; }
    LDS_WAIT(); asm volatile("" ::: "memory");
    const int c = lane & 7;
#pragma unroll
    for (int j = 0; j < 4; ++j) { const int n = (lane >> 3) + 8 * j; const LAS float* s = scr + (8 * c) * 33 + n;
        v4u o; o.x = pk2(s[0 * 33], s[1 * 33]); o.y = pk2(s[2 * 33], s[3 * 33]); o.z = pk2(s[4 * 33], s[5 * 33]); o.w = pk2(s[6 * 33], s[7 * 33]);
        *(GAS v4u*)(WT + (size_t)(drow0 + n) * ldt + k0 + 8 * c) = o; }
    LDS_WAIT(); asm volatile("" ::: "memory");
}
__device__ __forceinline__ int rel_bucket(int d) {
    if (d < 16) return d;
    const int large = 16 + (int)(logf((float)d / 16.0f) / logf(128.0f) * 16.0f);
    return large < 31 ? large : 31;
}
__device__ __forceinline__ void p0_prologue(const Args& args, LAS unsigned char* lds, int vcu, int G) {
    int tid_ = threadIdx.x; asm volatile("" : "+v"(tid_)); const int tid = tid_, lane = tid & 63, wave = __builtin_amdgcn_readfirstlane(tid >> 6); const int gw = vcu * NWAVES + wave, NGW = G * NWAVES; (void)tid; (void)lane; (void)wave; (void)gw; (void)NGW;
    unsigned char* ws = args.ws;
    float* MOD = (float*)(ws + WS_MOD);
    for (int it = vcu; it < DEPTH * (MODW / 256); it += G) {
        const int l = it / (MODW / 256), c0 = (it % (MODW / 256)) * 256;
        LAS float* sl = (LAS float*)lds;
        __syncthreads();
        for (int i = tid; i < 12 * DM; i += NTHR) { const int bb = i / DM, k = i % DM; const float c = (bb < 4) ? args.in[I_CP][bb * DM + k] : args.in[I_CS][(bb - 4) * DM + k];
            sl[k * 12 + bb] = c / (1.0f + __expf(-c)); }
        __syncthreads();
        const float* Wl = args.in[I_ADAW] + (size_t)l * DM * MODW + c0 + 4 * lane;
        f32x4 acc[12];
#pragma unroll
        for (int bb = 0; bb < 12; ++bb) acc[bb] = (f32x4){0.f, 0.f, 0.f, 0.f};
        const int kb = wave * 256;
#pragma unroll 4
        for (int k = kb; k < kb + 256; ++k) {
            const f32x4 w = *(const f32x4*)(Wl + (size_t)k * MODW);
            const f32x4 s0 = *(const LAS f32x4*)(sl + k * 12), s1 = *(const LAS f32x4*)(sl + k * 12 + 4), s2 = *(const LAS f32x4*)(sl + k * 12 + 8);
            acc[0] += w * s0.x; acc[1] += w * s0.y; acc[2] += w * s0.z; acc[3] += w * s0.w;
            acc[4] += w * s1.x; acc[5] += w * s1.y; acc[6] += w * s1.z; acc[7] += w * s1.w;
            acc[8] += w * s2.x; acc[9] += w * s2.y; acc[10] += w * s2.z; acc[11] += w * s2.w;
        }
        __syncthreads();
        LAS float* part = (LAS float*)lds;
#pragma unroll
        for (int bb = 0; bb < 12; ++bb) *(LAS f32x4*)(part + (wave * 12 + bb) * 256 + 4 * lane) = acc[bb];
        __syncthreads();
        for (int i = tid; i < 12 * 256; i += NTHR) { const int bb = i / 256, c = i % 256; float s = args.in[I_ADAB][l * MODW + c0 + c];
#pragma unroll
            for (int w = 0; w < 8; ++w) s += part[(w * 12 + bb) * 256 + c];
            MOD[((size_t)l * 12 + bb) * MODW + c0 + c] = s; }
        __syncthreads();
    }
    if (vcu == G - 1) {
        float* BT = (float*)(ws + WS_BT);
        for (int i = tid; i < 3 * 129 * 16; i += NTHR) { const int h = i & 15, m = (i >> 4) % 129, br = (i >> 4) / 129; BT[i] = args.in[I_RELB][rel_bucket(m << (2 * br)) * 16 + h]; }
    }
    __syncthreads();
    LAS float* scr = (LAS float*)(lds + wave * 16384);
    constexpr int I_IN = (DM / 64) * (6144 / 32), I_LD = (DM / 64) * 2, I_LG = (DM / 64) * 5, I_LV = (DM / 64) * 1, I_OUT = (DM / 64) * (DM / 32), I_GU = (DM / 64) * (2 * FF / 32), I_DN = (FF / 64) * (DM / 32);
    constexpr int I_LAYER = I_IN + 2 * (2 * I_LD + I_LG + I_LV) + I_OUT + I_GU + I_DN;
    for (int it = gw; it < DEPTH * I_LAYER; it += NGW) {
        const int l = it / I_LAYER; int r = it % I_LAYER;
        bf16* WIN = (bf16*)(ws + WS_WIN) + (size_t)l * N1 * DM;
        if (r < I_IN) { const int nblk = 6144 / 32, kbk = r / nblk, nb = r % nblk;
            p0_transpose_item(args.in[I_WIN] + (size_t)l * DM * 6144, 6144, 64 * kbk, 32 * nb, WIN, DM, 32 * nb, nullptr, 0, scr, lane); continue; }
        r -= I_IN;
        constexpr int LH = 2 * I_LD + I_LG + I_LV;
        if (r < 2 * LH) {
            const int half = r / LH, base = half ? PP0 : PC0, sm = 1 + half; int q = r % LH;
            if (q < I_LD) { p0_transpose_item(args.in[I_DW1] + (size_t)l * DM * 64, 64, 64 * (q / 2), 32 * (q % 2), WIN, DM, base + 0 + 32 * (q % 2), args.in[I_MUWAG] + ((size_t)l * 3 + 0) * DM, sm, scr, lane); continue; }
            q -= I_LD;
            if (q < I_LD) { p0_transpose_item(args.in[I_AW1] + (size_t)l * DM * 64, 64, 64 * (q / 2), 32 * (q % 2), WIN, DM, base + 64 + 32 * (q % 2), args.in[I_MUWAG] + ((size_t)l * 3 + 1) * DM, sm, scr, lane); continue; }
            q -= I_LD;
            if (q < I_LG) { p0_transpose_item(args.in[I_GW1] + (size_t)l * DM * 160, 160, 64 * (q / 5), 32 * (q % 5), WIN, DM, base + 128 + 32 * (q % 5), args.in[I_MUWAG] + ((size_t)l * 3 + 2) * DM, sm, scr, lane); continue; }
            q -= I_LG;
            if (l > 0) p0_transpose_item(args.in[I_VW1] + (size_t)(l - 1) * DM * 32, 32, 64 * q, 0, WIN, DM, base + 288, args.in[I_VMU] + (size_t)(l - 1) * DM, sm, scr, lane);
            continue;
        }
        r -= 2 * LH;
        if (r < I_OUT) { const int nblk = DM / 32, kbk = r / nblk, nb = r % nblk;
            p0_transpose_item(args.in[I_WOUT] + (size_t)l * DM * DM, DM, 64 * kbk, 32 * nb, (bf16*)(ws + WS_WOUT) + (size_t)l * DM * DM, DM, 32 * nb, nullptr, 0, scr, lane); continue; }
        r -= I_OUT;
        if (r < I_GU) { const int nblk = 2 * FF / 32, kbk = r / nblk, nb = r % nblk, n0 = 32 * nb;
            const int nn = (n0 < FF) ? n0 : n0 - FF, drow = 256 * (nn / 128) + (nn % 128) + ((n0 < FF) ? 0 : 128);
            p0_transpose_item(args.in[I_WGU] + (size_t)l * DM * 2 * FF, 2 * FF, 64 * kbk, n0, (bf16*)(ws + WS_WGU) + (size_t)l * 2 * FF * DM, DM, drow, nullptr, 0, scr, lane); continue; }
        r -= I_GU;
        { const int nblk = DM / 32, kbk = r / nblk, nb = r % nblk;
            p0_transpose_item(args.in[I_WDN] + (size_t)l * FF * DM, DM, 64 * kbk, 32 * nb, (bf16*)(ws + WS_WDN) + (size_t)l * DM * FF, FF, 32 * nb, nullptr, 0, scr, lane); }
    }
}

__device__ __forceinline__ void norm_mod_row(const float* xrow, const float* g, const float* sh, const float* sc, bf16* hrow, float* frow, int lane) {
    const GAS f32x4* xr = (const GAS f32x4*)xrow + lane;
    f32x4 v[8]; float s = 0.f;
#pragma unroll
    for (int j = 0; j < 8; ++j) { v[j] = xr[64 * j]; s += (v[j].x * v[j].x + v[j].y * v[j].y) + (v[j].z * v[j].z + v[j].w * v[j].w); }
    const float rstd = 1.0f / sqrtf(wave_sum(s) * (1.0f / DM) + RMS_EPS);
    GAS unsigned long long* o8 = (GAS unsigned long long*)hrow + lane;
#pragma unroll
    for (int j = 0; j < 8; ++j) { const f32x4 g4 = ((const GAS f32x4*)g)[lane + 64 * j], sh4 = ((const GAS f32x4*)sh)[lane + 64 * j], sc4 = ((const GAS f32x4*)sc)[lane + 64 * j];
        const f32x4 h = (v[j] * rstd * g4) * (sc4 + 1.0f) + sh4;
        o8[64 * j] = (unsigned long long)pk2(h.x, h.y) | ((unsigned long long)pk2(h.z, h.w) << 32);
        if (frow) ((GAS f32x4*)frow)[lane + 64 * j] = h; }
}

template <int KLEN> __device__ __forceinline__ void lora_pass(const LAS float* Lk, const float* W2, float (&acc)[32][2]) {
    typedef float f32x2 __attribute__((ext_vector_type(2)));
#pragma unroll
    for (int r = 0; r < 32; ++r) { acc[r][0] = 0.f; acc[r][1] = 0.f; }
    for (int k = 0; k < KLEN; k += 4) {
        const f32x2 w0 = *(const f32x2*)(W2 + (size_t)(k + 0) * DRW), w1 = *(const f32x2*)(W2 + (size_t)(k + 1) * DRW), w2 = *(const f32x2*)(W2 + (size_t)(k + 2) * DRW), w3 = *(const f32x2*)(W2 + (size_t)(k + 3) * DRW);
#pragma unroll
        for (int r = 0; r < 32; ++r) { const f32x4 lv = *(const LAS f32x4*)(Lk + r * NLORA + k);
            acc[r][0] += lv.x * w0.x + lv.y * w1.x + lv.z * w2.x + lv.w * w3.x;
            acc[r][1] += lv.x * w0.y + lv.y * w1.y + lv.z * w2.y + lv.w * w3.y; }
    }
}
__device__ __forceinline__ void pw_phase(const Args& args, int l, LAS unsigned char* lds, int vcu, int G) {
    int tid_ = threadIdx.x; asm volatile("" : "+v"(tid_)); const int tid = tid_, lane = tid & 63, wave = __builtin_amdgcn_readfirstlane(tid >> 6); const int gw = vcu * NWAVES + wave, NGW = G * NWAVES; (void)tid; (void)lane; (void)wave; (void)gw; (void)NGW;
    typedef float f32x2 __attribute__((ext_vector_type(2)));
    unsigned char* ws = args.ws;
    const float* G1O = (const float*)(ws + WS_G1O);
    {
        bf16* QB = (bf16*)(ws + WS_QB); bf16* KB = (bf16*)(ws + WS_KB); bf16* VB = (bf16*)(ws + WS_VB);
        const int hh = lane >> 2, p = lane & 3, c0 = hh * 64 + p * 16;
        f32x4 qg[4], kg[4];
#pragma unroll
        for (int j = 0; j < 4; ++j) { qg[j] = *(const f32x4*)(args.in[I_QG] + l * 64 + p * 16 + 4 * j); kg[j] = *(const f32x4*)(args.in[I_KG] + l * 64 + p * 16 + 4 * j); }
        for (int m = gw; m < NROWS; m += NGW) {
            const float* src = G1O + (size_t)m * N1 + c0;
            float *ok, *ov;
            if (m < MP) { ok = args.out + O_KP + ((size_t)l * MP + m) * DATT + c0; ov = args.out + O_VP + ((size_t)l * MP + m) * DATT + c0; }
            else { ok = args.out + O_KS + ((size_t)l * 8 + (m - MP)) * DATT + c0; ov = args.out + O_VS + ((size_t)l * 8 + (m - MP)) * DATT + c0; }
            f32x4 v[4]; float ss; v4u o0, o1;
#pragma unroll
            for (int j = 0; j < 4; ++j) v[j] = *(const f32x4*)(src + 4 * j);
            ss = 0.f;
#pragma unroll
            for (int j = 0; j < 4; ++j) ss += (v[j].x * v[j].x + v[j].y * v[j].y) + (v[j].z * v[j].z + v[j].w * v[j].w);
            ss += __shfl_xor(ss, 1); ss += __shfl_xor(ss, 2);
            { const float rs = 1.0f / sqrtf(ss * (1.0f / 64.0f) + RMS_EPS);
#pragma unroll
              for (int j = 0; j < 4; ++j) v[j] = v[j] * rs * qg[j]; }
            o0.x = pk2(v[0].x, v[0].y); o0.y = pk2(v[0].z, v[0].w); o0.z = pk2(v[1].x, v[1].y); o0.w = pk2(v[1].z, v[1].w);
            o1.x = pk2(v[2].x, v[2].y); o1.y = pk2(v[2].z, v[2].w); o1.z = pk2(v[3].x, v[3].y); o1.w = pk2(v[3].z, v[3].w);
            *(v4u*)(QB + (size_t)m * DATT + c0) = o0; *(v4u*)(QB + (size_t)m * DATT + c0 + 8) = o1;
#pragma unroll
            for (int j = 0; j < 4; ++j) v[j] = *(const f32x4*)(src + 1024 + 4 * j);
            ss = 0.f;
#pragma unroll
            for (int j = 0; j < 4; ++j) ss += (v[j].x * v[j].x + v[j].y * v[j].y) + (v[j].z * v[j].z + v[j].w * v[j].w);
            ss += __shfl_xor(ss, 1); ss += __shfl_xor(ss, 2);
            { const float rs = 1.0f / sqrtf(ss * (1.0f / 64.0f) + RMS_EPS);
#pragma unroll
              for (int j = 0; j < 4; ++j) { v[j] = v[j] * rs * kg[j]; *(f32x4*)(ok + 4 * j) = v[j]; } }
            o0.x = pk2(v[0].x, v[0].y); o0.y = pk2(v[0].z, v[0].w); o0.z = pk2(v[1].x, v[1].y); o0.w = pk2(v[1].z, v[1].w);
            o1.x = pk2(v[2].x, v[2].y); o1.y = pk2(v[2].z, v[2].w); o1.z = pk2(v[3].x, v[3].y); o1.w = pk2(v[3].z, v[3].w);
            *(v4u*)(KB + (size_t)m * DATT + c0) = o0; *(v4u*)(KB + (size_t)m * DATT + c0 + 8) = o1;
#pragma unroll
            for (int j = 0; j < 4; ++j) { v[j] = *(const f32x4*)(src + 2048 + 4 * j); *(f32x4*)(ov + 4 * j) = v[j]; }
            o0.x = pk2(v[0].x, v[0].y); o0.y = pk2(v[0].z, v[0].w); o0.z = pk2(v[1].x, v[1].y); o0.w = pk2(v[1].z, v[1].w);
            o1.x = pk2(v[2].x, v[2].y); o1.y = pk2(v[2].z, v[2].w); o1.z = pk2(v[3].x, v[3].y); o1.w = pk2(v[3].z, v[3].w);
            *(v4u*)(VB + (size_t)m * DATT + c0) = o0; *(v4u*)(VB + (size_t)m * DATT + c0 + 8) = o1;
        }
    }
    float* Rr = (float*)(ws + WS_R); float* Ww = (float*)(ws + WS_W); float* Kk = (float*)(ws + WS_K); float* Vv = (float*)(ws + WS_V);
    float* Aa = (float*)(ws + WS_A); float* Bb = (float*)(ws + WS_B); float* Gg = (float*)(ws + WS_G); float* VF = (float*)(ws + WS_VF);
    LAS float* L = (LAS float*)lds;
    const int ch = 2 * tid;
    const float* mur = args.in[I_MURKV] + (size_t)l * 3 * DRW;
    for (int tile = vcu; tile < 257; tile += G) {
        const int m0 = tile < 256 ? tile * 32 : MP, nv = tile < 256 ? 32 : 8;
        __syncthreads();
        for (int i = tid; i < 32 * NLORA; i += NTHR) { const int r = i / NLORA, c = i % NLORA; float v = 0.f;
            if (r < nv) { const int m = m0 + r; const int pm = (m < MP) ? (((m & (SEQ - 1)) == 0) ? -1 : m - 1) : m + 8;
                v = G1O[(size_t)m * N1 + PC0 + c]; if (pm >= 0) v += G1O[(size_t)pm * N1 + PP0 + c];
                if (c < 64) v = tanhf(v); else if (c >= 128 && c < 288) v = sigmoidf_(v); }
            L[r * NLORA + c] = v; }
        __syncthreads();
        float acc[32][2];
#define PW_PREV(m) (((m) < MP) ? ((((m) & (SEQ - 1)) == 0) ? -1 : (m) - 1) : (m) + 8)
#define PW_LERP(dst, m, pm, col, mu2) do { const f32x2 x0_ = *(const f32x2*)(G1O + (size_t)(m) * N1 + (col)); f32x2 xp_ = (f32x2){0.f, 0.f}; if ((pm) >= 0) xp_ = *(const f32x2*)(G1O + (size_t)(pm) * N1 + (col)); dst = x0_ + (xp_ - x0_) * (mu2); } while (0)
        lora_pass<64>(L + 0, args.in[I_DW2] + (size_t)l * 64 * DRW + ch, acc);
        { const f32x2 w0 = *(const f32x2*)(args.in[I_DW0] + (size_t)l * DRW + ch);
#pragma unroll
          for (int r = 0; r < 32; ++r) if (r < nv) { const int m = m0 + r; f32x2 o;
#pragma unroll
              for (int e = 0; e < 2; ++e) { const float x = w0[e] + acc[r][e]; const float sp = (-x > 20.f) ? -x : log1pf(__expf(-x)); const float logw = -sp - 0.5f; o[e] = __expf(-__expf(logw)); }
              *(f32x2*)(Ww + (size_t)m * DRW + ch) = o; } }
        if (l > 0) lora_pass<32>(L + 288, args.in[I_VW2] + (size_t)(l - 1) * 32 * DRW + ch, acc);
        { const f32x2 mu2 = *(const f32x2*)(mur + 2 * DRW + ch); f32x2 v0 = (f32x2){0.f, 0.f}; if (l > 0) v0 = *(const f32x2*)(args.in[I_VV0] + (size_t)(l - 1) * DRW + ch);
#pragma unroll
          for (int r = 0; r < 32; ++r) if (r < nv) { const int m = m0 + r, pm = PW_PREV(m); f32x2 vr; PW_LERP(vr, m, pm, 3072 + 2048 + ch, mu2);
              if (l == 0) *(f32x2*)(VF + (size_t)m * DRW + ch) = vr;
              else { const f32x2 vf = *(const f32x2*)(VF + (size_t)m * DRW + ch); f32x2 vg; vg[0] = sigmoidf_(v0[0] + acc[r][0]); vg[1] = sigmoidf_(v0[1] + acc[r][1]); vr = vr + (vf - vr) * vg; }
              *(f32x2*)(Vv + (size_t)m * DRW + ch) = vr; } }
        lora_pass<160>(L + 128, args.in[I_GW2] + (size_t)l * 160 * DRW + ch, acc);
#pragma unroll
        for (int r = 0; r < 32; ++r) if (r < nv) { f32x2 o; o[0] = acc[r][0]; o[1] = acc[r][1]; *(f32x2*)(Gg + (size_t)(m0 + r) * DRW + ch) = o; }
        lora_pass<64>(L + 64, args.in[I_AW2] + (size_t)l * 64 * DRW + ch, acc);
        { const f32x2 a0 = *(const f32x2*)(args.in[I_AA0] + (size_t)l * DRW + ch), kk_ = *(const f32x2*)(args.in[I_KK] + (size_t)l * DRW + ch), ka_ = *(const f32x2*)(args.in[I_KA] + (size_t)l * DRW + ch);
          const f32x2 mu0 = *(const f32x2*)(mur + 0 * DRW + ch), mu1 = *(const f32x2*)(mur + 1 * DRW + ch);
#pragma unroll
          for (int r = 0; r < 32; ++r) if (r < nv) { const int m = m0 + r, pm = PW_PREV(m);
              f32x2 a; a[0] = sigmoidf_(a0[0] + acc[r][0]); a[1] = sigmoidf_(a0[1] + acc[r][1]);
              f32x2 kr, rr; PW_LERP(kr, m, pm, 3072 + 1024 + ch, mu1); PW_LERP(rr, m, pm, 3072 + ch, mu0);
              f32x2 kk = kr * kk_; float s = kk[0] * kk[0] + kk[1] * kk[1];
              s += __shfl_xor(s, 1); s += __shfl_xor(s, 2); s += __shfl_xor(s, 4); s += __shfl_xor(s, 8); s += __shfl_xor(s, 16);
              const float inv = 1.0f / fmaxf(sqrtf(s), 1e-12f); kk = kk * inv;
              *(f32x2*)(Kk + (size_t)m * DRW + ch) = kr * ((a - 1.0f) * ka_ + 1.0f);
              *(f32x2*)(Aa + (size_t)m * DRW + ch) = -kk; *(f32x2*)(Bb + (size_t)m * DRW + ch) = kk * a; *(f32x2*)(Rr + (size_t)m * DRW + ch) = rr; } }
#undef PW_PREV
#undef PW_LERP
    }
}

__device__ __forceinline__ void scan_units(const Args& args, int l, LAS unsigned char* lds, int vcu, int G) {
    int tid_ = threadIdx.x; asm volatile("" : "+v"(tid_)); const int tid = tid_, lane = tid & 63, wave = __builtin_amdgcn_readfirstlane(tid >> 6); const int gw = vcu * NWAVES + wave, NGW = G * NWAVES; (void)tid; (void)lane; (void)wave; (void)gw; (void)NGW;
    unsigned char* ws = args.ws;
    const float* Vv = (const float*)(ws + WS_V); float* Y = (float*)(ws + WS_Y);
    constexpr int TS = 32, STEPF = 336, BUFF = TS * STEPF;
    LAS float* ybuf = (LAS float*)lds + 2 * BUFF;
    for (int u = vcu; u < 256; u += G) {
        const int b = u >> 6, h = (u >> 2) & 15, rq = u & 3, mb = b * SEQ;
        const float* src[5]; int dst[5];
#pragma unroll
        for (int i = 0; i < 5; ++i) { const int idx = tid + NTHR * i, s = idx / 80, rem = idx % 80, vec = rem >> 4, q = rem & 15;
            const size_t ao = (vec == 0) ? WS_W : (vec == 1) ? WS_K : (vec == 2) ? WS_A : (vec == 3) ? WS_B : WS_R;
            src[i] = (const float*)(ws + ao) + (size_t)(mb + s) * DRW + h * 64 + q * 4; dst[i] = s * STEPF + vec * 64 + q * 4; }
        const float* srcv = Vv + (size_t)(mb + (tid >> 2)) * DRW + h * 64 + rq * 16 + (tid & 3) * 4; const int dstv = (tid >> 2) * STEPF + 320 + (tid & 3) * 4;
        f32x4 pre[6];
        float S0 = 0.f, S1 = 0.f, S2 = 0.f, S3 = 0.f;
        const int rl = 4 * wave + (lane >> 4), j4 = (lane & 15) * 4;
        __syncthreads();
#pragma unroll
        for (int i = 0; i < 5; ++i) pre[i] = *(const f32x4*)(src[i]);
        if (tid < 128) pre[5] = *(const f32x4*)srcv;
        { LAS float* bw = (LAS float*)lds;
#pragma unroll
          for (int i = 0; i < 5; ++i) *(LAS f32x4*)(bw + dst[i]) = pre[i];
          if (tid < 128) *(LAS f32x4*)(bw + dstv) = pre[5]; }
        __syncthreads();
        for (int c = 0; c < SEQ / TS; ++c) {
            const LAS float* bc = (const LAS float*)lds + (c & 1) * BUFF; LAS float* bn = (LAS float*)lds + ((c + 1) & 1) * BUFF; LAS float* yb = ybuf + (c & 1) * 512;
            if (c + 1 < SEQ / TS) {
#pragma unroll
                for (int i = 0; i < 5; ++i) pre[i] = *(const f32x4*)(src[i] + (size_t)(c + 1) * TS * DRW);
                if (tid < 128) pre[5] = *(const f32x4*)(srcv + (size_t)(c + 1) * TS * DRW);
            }
            if (wave < 4) {
#pragma unroll 4
                for (int s = 0; s < TS; ++s) { const LAS float* bs = bc + s * STEPF;
                    const f32x4 w4 = *(const LAS f32x4*)(bs + j4), k4 = *(const LAS f32x4*)(bs + 64 + j4), a4 = *(const LAS f32x4*)(bs + 128 + j4), b4 = *(const LAS f32x4*)(bs + 192 + j4), r4 = *(const LAS f32x4*)(bs + 256 + j4);
                    const float vi = bs[320 + rl];
                    float sa = (S0 * a4.x + S1 * a4.y) + (S2 * a4.z + S3 * a4.w); sa = row16_sum(sa);
                    S0 = S0 * w4.x + (sa * b4.x + vi * k4.x); S1 = S1 * w4.y + (sa * b4.y + vi * k4.y); S2 = S2 * w4.z + (sa * b4.z + vi * k4.z); S3 = S3 * w4.w + (sa * b4.w + vi * k4.w);
                    float yp = (S0 * r4.x + S1 * r4.y) + (S2 * r4.z + S3 * r4.w); yp = row16_sum(yp);
                    if ((lane & 15) == 0) yb[s * 16 + rl] = yp; }
            }
            if (c + 1 < SEQ / TS) {
#pragma unroll
                for (int i = 0; i < 5; ++i) *(LAS f32x4*)(bn + dst[i]) = pre[i];
                if (tid < 128) *(LAS f32x4*)(bn + dstv) = pre[5];
            }
            __syncthreads();
            Y[(size_t)(mb + c * TS + (tid >> 4)) * DRW + h * 64 + rq * 16 + (tid & 15)] = yb[tid];
        }
        if (wave < 4) { float* so = args.out + O_WP + ((((size_t)l * PBATCH + b) * 16 + h) * 64 + rq * 16 + rl) * 64 + j4; *(f32x4*)so = (f32x4){S0, S1, S2, S3}; }
    }
}
__device__ __forceinline__ void sample_wkv_units(const Args& args, int l, int vcu, int G) {
    int tid_ = threadIdx.x; asm volatile("" : "+v"(tid_)); const int tid = tid_, lane = tid & 63, wave = __builtin_amdgcn_readfirstlane(tid >> 6); const int gw = vcu * NWAVES + wave, NGW = G * NWAVES; (void)tid; (void)lane; (void)wave; (void)gw; (void)NGW;
    unsigned char* ws = args.ws;
    const float* Rr = (const float*)(ws + WS_R); const float* Ww = (const float*)(ws + WS_W); const float* Kk = (const float*)(ws + WS_K); const float* Vv = (const float*)(ws + WS_V);
    const float* Aa = (const float*)(ws + WS_A); const float* Bb = (const float*)(ws + WS_B); float* Y = (float*)(ws + WS_Y);
    for (int u = gw; u < 128; u += NGW) {
        const int b = u >> 4, h = u & 15; const size_t vo = (size_t)(MP + b) * DRW + h * 64;
        const float* Sp = args.in[I_SWKV] + ((((size_t)l * 8 + b) * 16 + h) * 64 + lane) * 64;
        float* So = args.out + O_WS + ((((size_t)l * 8 + b) * 16 + h) * 64 + lane) * 64;
        f32x4 S[16];
#pragma unroll
        for (int j = 0; j < 16; ++j) S[j] = *(const f32x4*)(Sp + 4 * j);
        float sa = 0.f;
#pragma unroll
        for (int j = 0; j < 16; ++j) { const f32x4 a4 = *(const f32x4*)(Aa + vo + 4 * j); sa += (S[j].x * a4.x + S[j].y * a4.y) + (S[j].z * a4.z + S[j].w * a4.w); }
        const float vi = Vv[vo + lane]; float y = 0.f;
#pragma unroll
        for (int j = 0; j < 16; ++j) { const f32x4 w4 = *(const f32x4*)(Ww + vo + 4 * j), k4 = *(const f32x4*)(Kk + vo + 4 * j), b4 = *(const f32x4*)(Bb + vo + 4 * j), r4 = *(const f32x4*)(Rr + vo + 4 * j);
            f32x4 s = S[j] * w4 + (b4 * sa + k4 * vi); y += (s.x * r4.x + s.y * r4.y) + (s.z * r4.z + s.w * r4.w); *(f32x4*)(So + 4 * j) = s; }
        Y[vo + lane] = y;
    }
}
typedef short v4i16_t __attribute__((ext_vector_type(4)));
typedef float f32x4v __attribute__((ext_vector_type(4)));
__device__ __forceinline__ void attn_units(const Args& args, int l, LAS unsigned char* lds, int vcu, int G) {
    int tid_ = threadIdx.x; asm volatile("" : "+v"(tid_)); const int tid = tid_, lane = tid & 63, wave = __builtin_amdgcn_readfirstlane(tid >> 6); const int gw = vcu * NWAVES + wave, NGW = G * NWAVES; (void)tid; (void)lane; (void)wave; (void)gw; (void)NGW;
    unsigned char* ws = args.ws;
    const bf16* QB = (const bf16*)(ws + WS_QB); const bf16* KB = (const bf16*)(ws + WS_KB); const bf16* VB = (const bf16*)(ws + WS_VB);
    bf16* OBR = (bf16*)(ws + WS_OBR); float* LSE = (float*)(ws + WS_LSE); const float* BT = (const float*)(ws + WS_BT);
    constexpr int KST = 144, VST = 160;
    LAS unsigned char* Kt = lds; LAS unsigned char* Vt = lds + 256 * KST; LAS float* btab = (LAS float*)(lds + 256 * KST + 256 * VST);
    const int q = lane & 15, g = lane >> 4;
    for (int u = vcu; u < PBATCH * NHEADS * 48; u += G) {
        const int rn = u & 15, br = (u >> 4) % 3, h = (u / 48) & 15, b = u / 768;
        const int dsh = 2 * br, dil = 1 << dsh, r = rn & (dil - 1), n = rn >> dsh;
        __syncthreads();
        for (int i = tid; i < 2048; i += NTHR) { const int row = i >> 3, chk = i & 7, sk = (n - 1) * 128 + row; v4u kv = (v4u){0u, 0u, 0u, 0u}, vv = (v4u){0u, 0u, 0u, 0u};
            if (sk >= 0) { const size_t go = ((size_t)(b * SEQ + sk * dil + r)) * DATT + h * 64 + chk * 8; kv = *(const v4u*)(KB + go); vv = *(const v4u*)(VB + go); }
            *(LAS v4u*)(Kt + row * KST + chk * 16) = kv; *(LAS v4u*)(Vt + row * VST + chk * 16) = vv; }
        if (tid < 129) btab[tid] = BT[(br * 129 + tid) * 16 + h];
        __syncthreads();
        const int iq = 16 * wave + q, mq = b * SEQ + (n * 128 + iq) * dil + r;
        const bf16x8 qf0 = *(const bf16x8*)(QB + (size_t)mq * DATT + h * 64 + 8 * g), qf1 = *(const bf16x8*)(QB + (size_t)mq * DATT + h * 64 + 32 + 8 * g);
        const int kb0 = wave >> 1;
        f32x4 sacc[10];
#pragma unroll
        for (int sb = 0; sb < 10; ++sb) { const int key0 = 32 * kb0 + 16 * sb;
            const bf16x8 a0 = *(const LAS bf16x8*)(Kt + (key0 + q) * KST + 16 * g), a1 = *(const LAS bf16x8*)(Kt + (key0 + q) * KST + 64 + 16 * g);
            f32x4 acc = (f32x4){0.f, 0.f, 0.f, 0.f};
            acc = __builtin_amdgcn_mfma_f32_16x16x32_bf16(a0, qf0, acc, 0, 0, 0); acc = __builtin_amdgcn_mfma_f32_16x16x32_bf16(a1, qf1, acc, 0, 0, 0); sacc[sb] = acc; }
        float mx = -INFINITY;
#pragma unroll
        for (int sb = 0; sb < 10; ++sb)
#pragma unroll
            for (int e = 0; e < 4; ++e) { const int jj = 32 * kb0 + 16 * sb + 4 * g + e, dsub = 128 + iq - jj, sk = (n - 1) * 128 + jj;
                const bool ok = (dsub >= 0) && (dsub <= 128) && (sk >= 0);
                const float s = ok ? sacc[sb][e] * ATT_SCALE + btab[ok ? dsub : 0] : -INFINITY; sacc[sb][e] = s; mx = fmaxf(mx, s); }
        mx = fmaxf(mx, __shfl_xor(mx, 16)); mx = fmaxf(mx, __shfl_xor(mx, 32));
        float sum = 0.f;
#pragma unroll
        for (int sb = 0; sb < 10; ++sb)
#pragma unroll
            for (int e = 0; e < 4; ++e) { const float p = __expf(sacc[sb][e] - mx); sacc[sb][e] = p; sum += p; }
        sum += __shfl_xor(sum, 16); sum += __shfl_xor(sum, 32);
        f32x4 o[4];
#pragma unroll
        for (int c = 0; c < 4; ++c) o[c] = (f32x4){0.f, 0.f, 0.f, 0.f};
#pragma unroll
        for (int kk = 0; kk < 5; ++kk) {
            v4u pw; pw.x = pk2(sacc[2 * kk][0], sacc[2 * kk][1]); pw.y = pk2(sacc[2 * kk][2], sacc[2 * kk][3]); pw.z = pk2(sacc[2 * kk + 1][0], sacc[2 * kk + 1][1]); pw.w = pk2(sacc[2 * kk + 1][2], sacc[2 * kk + 1][3]);
            const bf16x8 pb = __builtin_bit_cast(bf16x8, pw);
            const int R0 = 32 * (kb0 + kk) + 4 * g + (q >> 2);
#pragma unroll
            for (int c = 0; c < 4; ++c) {
                const v4i16_t lo = __builtin_amdgcn_ds_read_tr16_b64_v4i16((LAS v4i16_t*)(Vt + R0 * VST + (16 * c + 4 * (q & 3)) * 2));
                const v4i16_t hi = __builtin_amdgcn_ds_read_tr16_b64_v4i16((LAS v4i16_t*)(Vt + (R0 + 16) * VST + (16 * c + 4 * (q & 3)) * 2));
                const bf16x8 va = (bf16x8){lo[0], lo[1], lo[2], lo[3], hi[0], hi[1], hi[2], hi[3]};
                o[c] = __builtin_amdgcn_mfma_f32_16x16x32_bf16(va, pb, o[c], 0, 0, 0); }
        }
        const float inv = 1.0f / sum;
        bf16* op = OBR + ((size_t)br * MP + mq) * DATT + h * 64 + 4 * g;
#pragma unroll
        for (int c = 0; c < 4; ++c) { const unsigned long long w = (unsigned long long)pk2(o[c][0] * inv, o[c][1] * inv) | ((unsigned long long)pk2(o[c][2] * inv, o[c][3] * inv) << 32); *(unsigned long long*)(op + 16 * c) = w; }
        if (g == 0) LSE[((size_t)br * MP + mq) * 16 + h] = mx + __logf(sum);
    }
}
__device__ __forceinline__ void sample_attn_units(const Args& args, int l, LAS unsigned char* lds, int vcu, int G) {
    int tid_ = threadIdx.x; asm volatile("" : "+v"(tid_)); const int tid = tid_, lane = tid & 63, wave = __builtin_amdgcn_readfirstlane(tid >> 6); const int gw = vcu * NWAVES + wave, NGW = G * NWAVES; (void)tid; (void)lane; (void)wave; (void)gw; (void)NGW;
    unsigned char* ws = args.ws;
    const bf16* QB = (const bf16*)(ws + WS_QB); bf16* MIX = (bf16*)(ws + WS_MIX); const float* BT = (const float*)(ws + WS_BT);
    LAS float* pl = (LAS float*)(lds + 90112) + wave * 448;
    for (int u = gw; u < 128; u += NGW) {
        const int b = u >> 4, h = u & 15, m = MP + b;
        float qv[64];
#pragma unroll
        for (int j = 0; j < 8; ++j) { const v4u w = *(const v4u*)(QB + (size_t)m * DATT + h * 64 + 8 * j);
            qv[8 * j + 0] = bf2f((unsigned short)(w.x & 0xffff)); qv[8 * j + 1] = bf2f((unsigned short)(w.x >> 16)); qv[8 * j + 2] = bf2f((unsigned short)(w.y & 0xffff)); qv[8 * j + 3] = bf2f((unsigned short)(w.y >> 16));
            qv[8 * j + 4] = bf2f((unsigned short)(w.z & 0xffff)); qv[8 * j + 5] = bf2f((unsigned short)(w.z >> 16)); qv[8 * j + 6] = bf2f((unsigned short)(w.w & 0xffff)); qv[8 * j + 7] = bf2f((unsigned short)(w.w >> 16)); }
        const float* knew = args.out + O_KS + ((size_t)l * 8 + b) * DATT + h * 64; const float* vnew = args.out + O_VS + ((size_t)l * 8 + b) * DATT + h * 64;
        const float* kc = args.in[I_CK] + (((size_t)l * 8 + b) * 2048) * 1024 + h * 64; const float* vc = args.in[I_CV] + (((size_t)l * 8 + b) * 2048) * 1024 + h * 64;
        float mx = -INFINITY;
        for (int it = 0; it < 7; ++it) { const int kk = lane + 64 * it;
            if (kk < 387) { const int br = kk / 129, mm = kk % 129; const float* kp = (mm == 0) ? knew : kc + (size_t)(2048 - (mm << (2 * br))) * 1024;
                float d = 0.f;
#pragma unroll
                for (int j = 0; j < 16; ++j) { const f32x4 k4 = *(const f32x4*)(kp + 4 * j); d += (qv[4 * j] * k4.x + qv[4 * j + 1] * k4.y) + (qv[4 * j + 2] * k4.z + qv[4 * j + 3] * k4.w); }
                const float s = d * ATT_SCALE + BT[(br * 129 + mm) * 16 + h]; pl[kk] = s; mx = fmaxf(mx, s); } }
        mx = wave_max(mx);
        float sum = 0.f;
        for (int it = 0; it < 7; ++it) { const int kk = lane + 64 * it; if (kk < 387) { const float p = __expf(pl[kk] - mx); pl[kk] = p; sum += p; } }
        sum = wave_sum(sum);
        float o = 0.f;
        for (int kk = 0; kk < 387; ++kk) { const int br = kk / 129, mm = kk % 129; const float* vp = (mm == 0) ? vnew : vc + (size_t)(2048 - (mm << (2 * br))) * 1024; o += pl[kk] * vp[lane]; }
        ((unsigned short*)MIX)[(size_t)m * DM + h * 64 + lane] = (unsigned short)f2bf(o / sum);
    }
}

__device__ __forceinline__ void mx_phase(const Args& args, int l, int vcu, int G) {
    int tid_ = threadIdx.x; asm volatile("" : "+v"(tid_)); const int tid = tid_, lane = tid & 63, wave = __builtin_amdgcn_readfirstlane(tid >> 6); const int gw = vcu * NWAVES + wave, NGW = G * NWAVES; (void)tid; (void)lane; (void)wave; (void)gw; (void)NGW;
    unsigned char* ws = args.ws;
    const bf16* OBR = (const bf16*)(ws + WS_OBR); const float* LSE = (const float*)(ws + WS_LSE); bf16* MIX = (bf16*)(ws + WS_MIX);
    const float* Rr = (const float*)(ws + WS_R); const float* Kk = (const float*)(ws + WS_K); const float* Vv = (const float*)(ws + WS_V); const float* Gg = (const float*)(ws + WS_G); const float* Y = (const float*)(ws + WS_Y);
    const int hh = lane >> 2, p = lane & 3, c0 = hh * 64 + p * 16;
    f32x4 lng[4], lnb[4], rk[4];
#pragma unroll
    for (int j = 0; j < 4; ++j) { lng[j] = *(const f32x4*)(args.in[I_LNG] + (size_t)l * DRW + c0 + 4 * j); lnb[j] = *(const f32x4*)(args.in[I_LNB] + (size_t)l * DRW + c0 + 4 * j); rk[j] = *(const f32x4*)(args.in[I_RK] + (size_t)l * DRW + c0 + 4 * j); }
    for (int m = gw; m < NROWS; m += NGW) {
        if (m < MP) {
            const float l0 = LSE[((size_t)0 * MP + m) * 16 + hh], l1 = LSE[((size_t)1 * MP + m) * 16 + hh], l2 = LSE[((size_t)2 * MP + m) * 16 + hh];
            const float mx = fmaxf(l0, fmaxf(l1, l2)); float e0 = __expf(l0 - mx), e1 = __expf(l1 - mx), e2 = __expf(l2 - mx); const float inv = 1.0f / (e0 + e1 + e2); e0 *= inv; e1 *= inv; e2 *= inv;
            float acc[16];
#pragma unroll
            for (int i = 0; i < 16; ++i) acc[i] = 0.f;
#pragma unroll
            for (int br = 0; br < 3; ++br) { const float al = br == 0 ? e0 : br == 1 ? e1 : e2;
#pragma unroll
                for (int j = 0; j < 2; ++j) { const v4u w = *(const v4u*)(OBR + ((size_t)br * MP + m) * DATT + c0 + 8 * j);
                    acc[8 * j + 0] += al * bf2f((unsigned short)(w.x & 0xffff)); acc[8 * j + 1] += al * bf2f((unsigned short)(w.x >> 16)); acc[8 * j + 2] += al * bf2f((unsigned short)(w.y & 0xffff)); acc[8 * j + 3] += al * bf2f((unsigned short)(w.y >> 16));
                    acc[8 * j + 4] += al * bf2f((unsigned short)(w.z & 0xffff)); acc[8 * j + 5] += al * bf2f((unsigned short)(w.z >> 16)); acc[8 * j + 6] += al * bf2f((unsigned short)(w.w & 0xffff)); acc[8 * j + 7] += al * bf2f((unsigned short)(w.w >> 16)); } }
            v4u o0, o1; o0.x = pk2(acc[0], acc[1]); o0.y = pk2(acc[2], acc[3]); o0.z = pk2(acc[4], acc[5]); o0.w = pk2(acc[6], acc[7]); o1.x = pk2(acc[8], acc[9]); o1.y = pk2(acc[10], acc[11]); o1.z = pk2(acc[12], acc[13]); o1.w = pk2(acc[14], acc[15]);
            *(v4u*)(MIX + (size_t)m * DM + c0) = o0; *(v4u*)(MIX + (size_t)m * DM + c0 + 8) = o1;
        }
        const size_t ro = (size_t)m * DRW + c0;
        f32x4 y[4], rr[4], kk[4], vv[4], gg[4];
        float s = 0.f, bon = 0.f;
#pragma unroll
        for (int j = 0; j < 4; ++j) { y[j] = *(const f32x4*)(Y + ro + 4 * j); rr[j] = *(const f32x4*)(Rr + ro + 4 * j); kk[j] = *(const f32x4*)(Kk + ro + 4 * j); vv[j] = *(const f32x4*)(Vv + ro + 4 * j); gg[j] = *(const f32x4*)(Gg + ro + 4 * j);
            s += (y[j].x + y[j].y) + (y[j].z + y[j].w); const f32x4 t = rr[j] * kk[j] * rk[j]; bon += (t.x + t.y) + (t.z + t.w); }
        s += __shfl_xor(s, 1); s += __shfl_xor(s, 2); bon += __shfl_xor(bon, 1); bon += __shfl_xor(bon, 2);
        const float mean = s * (1.0f / 64.0f); float qq = 0.f;
#pragma unroll
        for (int j = 0; j < 4; ++j) { y[j] = y[j] - mean; qq += (y[j].x * y[j].x + y[j].y * y[j].y) + (y[j].z * y[j].z + y[j].w * y[j].w); }
        qq += __shfl_xor(qq, 1); qq += __shfl_xor(qq, 2);
        const float rstd = 1.0f / sqrtf(qq * (1.0f / 64.0f) + GN_EPS);
        v4u o0, o1; f32x4 z[4];
#pragma unroll
        for (int j = 0; j < 4; ++j) z[j] = ((y[j] * rstd) * lng[j] + lnb[j] + vv[j] * bon) * gg[j];
        o0.x = pk2(z[0].x, z[0].y); o0.y = pk2(z[0].z, z[0].w); o0.z = pk2(z[1].x, z[1].y); o0.w = pk2(z[1].z, z[1].w); o1.x = pk2(z[2].x, z[2].y); o1.y = pk2(z[2].z, z[2].w); o1.z = pk2(z[3].x, z[3].y); o1.w = pk2(z[3].z, z[3].w);
        *(v4u*)(MIX + (size_t)m * DM + DATT + c0) = o0; *(v4u*)(MIX + (size_t)m * DM + DATT + c0 + 8) = o1;
    }
}

__device__ __forceinline__ void n1_phase(const Args& args, int l, int vcu, int G, const float* Xp, const float* Xs, const float* modl, bf16* HB) {
    int tid_ = threadIdx.x; asm volatile("" : "+v"(tid_)); const int tid = tid_, lane = tid & 63, wave = __builtin_amdgcn_readfirstlane(tid >> 6); const int gw = vcu * NWAVES + wave, NGW = G * NWAVES; (void)tid; (void)lane; (void)wave; (void)gw; (void)NGW;
    for (int m = gw; m < NROWS + 8; m += NGW) {
        if (m < MP) { const int b = m >> 11, t = m & (SEQ - 1);
            norm_mod_row(Xp + (size_t)m * DM, args.in[I_N1G] + (size_t)l * DM, modl + (size_t)b * MODW, modl + (size_t)b * MODW + DM, HB + (size_t)m * DM,
                         (t == SEQ - 1) ? args.out + O_SP + ((size_t)l * PBATCH + b) * DM : nullptr, lane); }
        else if (m < NROWS) { const int b = m - MP;
            norm_mod_row(Xs + (size_t)b * DM, args.in[I_N1G] + (size_t)l * DM, modl + (size_t)(4 + b) * MODW, modl + (size_t)(4 + b) * MODW + DM, HB + (size_t)m * DM,
                         args.out + O_SS + ((size_t)l * 8 + b) * DM, lane); }
        else { const int b = m - NROWS; const float* s = args.in[I_SSH] + ((size_t)l * 8 + b) * DM; GAS unsigned long long* o8 = (GAS unsigned long long*)(HB + (size_t)m * DM) + lane;
#pragma unroll
            for (int j = 0; j < 8; ++j) { const f32x4 v = ((const GAS f32x4*)s)[lane + 64 * j]; o8[64 * j] = (unsigned long long)pk2(v.x, v.y) | ((unsigned long long)pk2(v.z, v.w) << 32); } }
    }
}
__device__ __forceinline__ void n2_phase(const Args& args, int l, int vcu, int G, const float* XB, const float* modl, bf16* HB) {
    int tid_ = threadIdx.x; asm volatile("" : "+v"(tid_)); const int tid = tid_, lane = tid & 63, wave = __builtin_amdgcn_readfirstlane(tid >> 6); const int gw = vcu * NWAVES + wave, NGW = G * NWAVES; (void)tid; (void)lane; (void)wave; (void)gw; (void)NGW;
    for (int m = gw; m < NROWS; m += NGW) { const int bb = (m < MP) ? (m >> 11) : 4 + (m - MP);
        norm_mod_row(XB + (size_t)m * DM, args.in[I_N2G] + (size_t)l * DM, modl + (size_t)bb * MODW + 3 * DM, modl + (size_t)bb * MODW + 4 * DM, HB + (size_t)m * DM, nullptr, lane); }
}

__global__ void __launch_bounds__(NTHR, 2) fwd(Args args) {
    extern __shared__ __attribute__((aligned(16))) unsigned char lds_raw[];
    LAS unsigned char* lds = (LAS unsigned char*)lds_raw;
    volatile LAS unsigned* MISC = (volatile LAS unsigned*)(lds + MISC_OFF);
    const int G = gridDim.x; const int bx = blockIdx.x; const int vcu = (G % 8 == 0) ? (bx % 8) * (G / 8) + bx / 8 : bx;
    unsigned char* ws = args.ws;
    for (int u = threadIdx.x; u < (LDS_BYTES - LDSCTL_OFF) / 4; u += NTHR) ((LAS unsigned*)(lds + LDSCTL_OFF))[u] = 0u;
    __syncthreads();
    const int lo = args.ph_lo, hi = args.ph_hi;
    XcdBarrier bar; bar.bar = (unsigned*)(ws + WS_CTL) + CW_BAR; bar.x = 0; bar.st = nullptr;
    if (hi - lo > 1) bar = xcd_barrier_post((unsigned*)(ws + WS_CTL) + CW_BAR, MISC + 8);
#define IN(k) (lo <= (k) && (k) < hi)
#define SEAM(k) do { if (IN(k) && IN((k) + 1)) xcd_barrier(bar); } while (0)

    if (IN(0)) { p0_prologue(args, lds, vcu, G); }
    SEAM(0);

    float* MOD = (float*)(ws + WS_MOD);
    bf16* HB = (bf16*)(ws + WS_HB); float* G1O = (float*)(ws + WS_G1O); bf16* MIX = (bf16*)(ws + WS_MIX); float* XB = (float*)(ws + WS_XB); bf16* ACT = (bf16*)(ws + WS_ACT);
    for (int l = 0; l < DEPTH; ++l) {
        const int pb = 1 + PH_PER_LAYER * l;
        const float* modl = MOD + (size_t)l * 12 * MODW;
        const float* Xp = (l == 0) ? args.in[I_XP] : XB; const float* Xs = (l == 0) ? args.in[I_XS] : XB + (size_t)MP * DM;
        if (IN(pb + 0)) { __syncthreads(); n1_phase(args, l, vcu, G, Xp, Xs, modl, HB); }
        SEAM(pb + 0);
        if (IN(pb + 1)) {
            __syncthreads();
            pg8::Gemm g{(const pg8::bf16_t*)HB, (const pg8::bf16_t*)(ws + WS_WIN) + (size_t)l * N1 * DM, MH, N1, DM}; pg8::StaticOrder S; S.init(MH, N1, G, bx);
            pg8::EpiF32 E{G1O, N1};
            pg8::gemm_phase<pg8::EpiF32, pg8::StaticOrder, true, true>(lds, g, S, E);
        }
        SEAM(pb + 1);
        if (IN(pb + 2)) { __syncthreads(); pw_phase(args, l, lds, vcu, G); }
        SEAM(pb + 2);
        if (IN(pb + 3)) {
            __syncthreads();
            scan_units(args, l, lds, vcu, G);
            sample_wkv_units(args, l, vcu, G);
            __syncthreads();
            attn_units(args, l, lds, vcu, G);
            __syncthreads();
            sample_attn_units(args, l, lds, vcu, G);
        }
        SEAM(pb + 3);
        if (IN(pb + 4)) { mx_phase(args, l, vcu, G); }
        SEAM(pb + 4);
        if (IN(pb + 5)) {
            __syncthreads();
            pg8::Gemm g{(const pg8::bf16_t*)MIX, (const pg8::bf16_t*)(ws + WS_WOUT) + (size_t)l * DM * DM, MH, DM, DM}; pg8::StaticOrder S; S.init(MH, DM, G, bx);
            pg8::EpiResid E{Xp, Xs, XB, XB + (size_t)MP * DM, modl + 2 * DM};
            pg8::gemm_phase<pg8::EpiResid, pg8::StaticOrder, true, true>(lds, g, S, E);
        }
        SEAM(pb + 5);
        if (IN(pb + 6)) { __syncthreads(); n2_phase(args, l, vcu, G, XB, modl, HB); }
        SEAM(pb + 6);
        if (IN(pb + 7)) {
            __syncthreads();
            pg8::Gemm g{(const pg8::bf16_t*)HB, (const pg8::bf16_t*)(ws + WS_WGU) + (size_t)l * 2 * FF * DM, MH, 2 * FF, DM}; pg8::StaticOrder S; S.init(MH, 2 * FF, G, bx);
            pg8::EpiSwiGLU E{(pg8::bf16_t*)ACT, FF};
            pg8::gemm_phase<pg8::EpiSwiGLU, pg8::StaticOrder, true, true>(lds, g, S, E);
        }
        SEAM(pb + 7);
        if (IN(pb + 8)) {
            __syncthreads();
            pg8::Gemm g{(const pg8::bf16_t*)ACT, (const pg8::bf16_t*)(ws + WS_WDN) + (size_t)l * DM * FF, MH, DM, FF}; pg8::StaticOrder S; S.init(MH, DM, G, bx);
            float* op = (l == DEPTH - 1) ? args.out + O_YP : XB; float* os = (l == DEPTH - 1) ? args.out + O_YS : XB + (size_t)MP * DM;
            pg8::EpiResid E{XB, XB + (size_t)MP * DM, op, os, modl + 5 * DM};
            pg8::gemm_phase<pg8::EpiResid, pg8::StaticOrder, true, true>(lds, g, S, E);
        }
        SEAM(pb + 8);
    }
#undef IN
#undef SEAM
}

extern "C" void kernel_launch(void* const* d_in, const int* in_sizes, int n_in, void* d_out, int out_size, void* d_ws, size_t ws_size, hipStream_t stream) {
    static int grid = 0;
    if (grid == 0) {
        if (n_in != N_IN || (size_t)out_size != O_END || ws_size < WS_END) { fprintf(stderr, "kernel_launch: unexpected shapes: n_in %d, out %d, ws %zu (need %zu)\n", n_in, out_size, ws_size, (size_t)WS_END); grid = -1; return; }
        int dev = 0, cus = 0;
        if (hipGetDevice(&dev) != hipSuccess || hipDeviceGetAttribute(&cus, hipDeviceAttributeMultiprocessorCount, dev) != hipSuccess) { grid = -1; return; }
        if (hipFuncSetAttribute((const void*)fwd, hipFuncAttributeMaxDynamicSharedMemorySize, LDS_BYTES) != hipSuccess) { fprintf(stderr, "kernel_launch: hipFuncSetAttribute failed\n"); grid = -1; return; }
        int per_cu = 0;
        if (hipOccupancyMaxActiveBlocksPerMultiprocessor(&per_cu, (const void*)fwd, NTHR, LDS_BYTES) != hipSuccess || per_cu < 1) fprintf(stderr, "kernel_launch: occupancy query says %d blocks per CU\n", per_cu);
        (void)hipGetLastError();
        grid = cus;
    }
    if (grid < 0) return;
    if (hipMemsetAsync((char*)d_ws + WS_CTL, 0, CTL_ZERO_BYTES, stream) != hipSuccess) return;
    Args a{};
    for (int i = 0; i < N_IN; ++i) a.in[i] = (const float*)d_in[i];
    a.out = (float*)d_out; a.ws = (unsigned char*)d_ws;
#if MK_N_LAUNCHES == 1
    a.ph_lo = 0; a.ph_hi = N_PHASES;
    hipLaunchKernelGGL(fwd, dim3(grid), dim3(NTHR), LDS_BYTES, stream, a);
#else
    for (int li = 0; li < N_PHASES; ++li) { a.ph_lo = li; a.ph_hi = li + 1; hipLaunchKernelGGL(fwd, dim3(grid), dim3(NTHR), LDS_BYTES, stream, a); }
#endif
}
```

```cpp
#include <hip/hip_runtime.h>
#include <cstdio>
#include <cstdint>
#include <cmath>
namespace pg8 {
#define PG8_LAS __attribute__((address_space(3)))
typedef unsigned short bf16_t;
typedef short bf16x8 __attribute__((ext_vector_type(8)));
typedef float f32x4 __attribute__((ext_vector_type(4)));
typedef unsigned u32x4 __attribute__((ext_vector_type(4)));
constexpr int BM = 256, BK = 64, HALF = 128, HTB = HALF * BK * 2  , STAGE_BYTES = 8 * HTB, NXCD = 8, WGM = 8;

__host__ __device__ __forceinline__ int lds_byte(int r, int c) { const int st = (r >> 4) * 2 + (c >> 5), rr = r & 15, cc = c & 31, ob = rr * 64 + cc * 2; return st * 1024 + (ob ^ (((ob >> 9) & 1) << 5)); }
__host__ __device__ __forceinline__ void stage_rc(int b, int& R, int& C) { const int st = b / 1024, sb = b % 1024, swz = sb ^ (((sb >> 9) & 1) << 5); R = (st >> 1) * 16 + swz / 64; C = (st & 1) * 32 + (swz % 64) / 2; }
__host__ __device__ __forceinline__ int perm32(int rho) { const int n = rho >> 4, i = rho & 15; return 8 * (i >> 2) + 4 * n + (i & 3); }

struct Unit { int pm, pn; };
struct Gemm { const bf16_t* A; const bf16_t* Bt; int M, N, K; };

struct StaticOrder {
    int nM, nN, nwg, G, c;
    __host__ __device__ void init(int M, int N, int G_, int c_) { nM = M / BM; nN = N / BM; nwg = nM * nN; G = G_; c = c_; }
    __host__ __device__ bool next(int i, Unit& u) const {
        const long L = (long)i * G + c; if (L >= nwg) return false;
        int wgid = (int)L; { const int q = nwg / NXCD, r = nwg % NXCD, xcd = wgid % NXCD, off = wgid / NXCD; wgid = (xcd < r ? xcd * (q + 1) : r * (q + 1) + (xcd - r) * q) + off; }
        const int nig = WGM * nN, gid = wgid / nig, fm = gid * WGM, gsz = (nM - fm) < WGM ? (nM - fm) : WGM;
        u.pm = fm + ((wgid % nig) % gsz); u.pn = (wgid % nig) / gsz; return true;
    }
    __device__ __forceinline__ void a_ready(const Unit&) const {}
    __device__ __forceinline__ void done(const Unit&) const {}
};

__device__ __forceinline__ unsigned cvt_pk_bf16(float lo, float hi) { unsigned r; asm volatile("v_cvt_pk_bf16_f32 %0, %1, %2" : "=v"(r) : "v"(lo), "v"(hi)); return r; }
typedef float f32x2 __attribute__((ext_vector_type(2)));
__device__ __forceinline__ f32x2 gelu_pk(f32x2 v) {
    const f32x2 av = __builtin_elementwise_abs(v), d = av * 0.2316418882f + 1.0f;
    f32x2 t; t.x = __builtin_amdgcn_rcpf(d.x); t.y = __builtin_amdgcn_rcpf(d.y);
    f32x2 q = t * 0.5307027145f + (-0.7265760135f); q = q * t + 0.7107068705f; q = q * t + (-0.142248368f); q = q * t + 0.127414796f; q = q * t;
    const f32x2 s = (v * v) * (-0.72134752044f);
    f32x2 e; e.x = __builtin_amdgcn_exp2f(s.x); e.y = __builtin_amdgcn_exp2f(s.y);
    const f32x2 m = v * (q * e), r = v - m;
    f32x2 o; o.x = v.x < 0.f ? m.x : r.x; o.y = v.y < 0.f ? m.y : r.y; return o;
}

template <int ACT  > struct EpiBf16 {
    static constexpr bool PERM = true, AFTER_DRAIN = false; static_assert(ACT == 0 || ACT == 1, "EpiBf16: ACT is 0 (none) or 1 (gelu_pk)");
    bf16_t* O; int ldc; const float* bias; int split_cols; size_t split_stride; float scale0;
    __device__ __forceinline__ void operator()(const f32x4 (&acc)[2][2][4][2], const Unit& u, int wr, int wc, int fr, int fq) const {
        const int row0 = u.pm * BM + wr * 64 + fr; int colt = u.pn * BM; bf16_t* base = O;
        float sc = 1.f; if (split_cols) { const int t = colt / split_cols; base += (size_t)t * split_stride; colt -= t * split_cols; if (t == 0) sc = scale0; }
        const int col0 = colt + wc * 32 + 8 * fq, bcol0 = u.pn * BM + wc * 32 + 8 * fq;
        f32x4 bv[2][2];
#pragma unroll
        for (int bj = 0; bj < 2; ++bj)
#pragma unroll
            for (int n = 0; n < 2; ++n) bv[bj][n] = bias ? *(const f32x4*)(bias + bcol0 + bj * HALF + 4 * n) : (f32x4){0.f, 0.f, 0.f, 0.f};
#pragma unroll
        for (int ai = 0; ai < 2; ++ai)
#pragma unroll
            for (int m = 0; m < 4; ++m) { bf16_t* rowp = base + (size_t)(row0 + ai * HALF + m * 16) * ldc + col0;
#pragma unroll
                for (int bj = 0; bj < 2; ++bj) { f32x4 v0 = acc[ai][bj][m][0] + bv[bj][0], v1 = acc[ai][bj][m][1] + bv[bj][1];
                    if (ACT == 1) { f32x2 a = gelu_pk((f32x2){v0[0], v0[1]}), b = gelu_pk((f32x2){v0[2], v0[3]}), c = gelu_pk((f32x2){v1[0], v1[1]}), d = gelu_pk((f32x2){v1[2], v1[3]});
                        v0 = (f32x4){a.x, a.y, b.x, b.y}; v1 = (f32x4){c.x, c.y, d.x, d.y}; }
                    v0 = v0 * sc; v1 = v1 * sc; u32x4 w; w.x = cvt_pk_bf16(v0[0], v0[1]); w.y = cvt_pk_bf16(v0[2], v0[3]); w.z = cvt_pk_bf16(v1[0], v1[1]); w.w = cvt_pk_bf16(v1[2], v1[3]);
                    *(u32x4*)(rowp + bj * HALF) = w; } }
    }
};


struct EpiF32 {
    static constexpr bool PERM = false, AFTER_DRAIN = false;
    float* O; int ldc;
    __device__ __forceinline__ void operator()(const f32x4 (&acc)[2][2][4][2], const Unit& u, int wr, int wc, int fr, int fq) const {
        const int col0 = u.pn * BM + wc * 32 + 4 * fq;
#pragma unroll
        for (int ai = 0; ai < 2; ++ai)
#pragma unroll
            for (int m = 0; m < 4; ++m) { float* rowp = O + (size_t)(u.pm * BM + ai * HALF + wr * 64 + m * 16 + fr) * ldc + col0;
#pragma unroll
                for (int bj = 0; bj < 2; ++bj)
#pragma unroll
                    for (int n = 0; n < 2; ++n) *(f32x4*)(rowp + bj * HALF + n * 16) = acc[ai][bj][m][n]; }
    }
};
struct EpiResid {
    static constexpr bool PERM = false, AFTER_DRAIN = false;
    const float* base_p; const float* base_s; float* out_p; float* out_s; const float* gate;
    __device__ __forceinline__ void operator()(const f32x4 (&acc)[2][2][4][2], const Unit& u, int wr, int wc, int fr, int fq) const {
        const int col0 = u.pn * BM + wc * 32 + 4 * fq;
        if (u.pm < 32) {
            const float* g = gate + (size_t)(u.pm >> 3) * 12288 + col0;
            f32x4 gv[2][2];
#pragma unroll
            for (int bj = 0; bj < 2; ++bj)
#pragma unroll
                for (int n = 0; n < 2; ++n) gv[bj][n] = *(const f32x4*)(g + bj * HALF + n * 16);
#pragma unroll
            for (int ai = 0; ai < 2; ++ai)
#pragma unroll
                for (int m = 0; m < 4; ++m) { const size_t off = (size_t)(u.pm * BM + ai * HALF + wr * 64 + m * 16 + fr) * 2048 + col0;
#pragma unroll
                    for (int bj = 0; bj < 2; ++bj)
#pragma unroll
                        for (int n = 0; n < 2; ++n) { const f32x4 bs = *(const f32x4*)(base_p + off + bj * HALF + n * 16);
                            *(f32x4*)(out_p + off + bj * HALF + n * 16) = bs + gv[bj][n] * acc[ai][bj][m][n]; } }
        } else if (wr == 0 && fr < 8) {
            const float* g = gate + (size_t)(4 + fr) * 12288 + col0; const size_t off = (size_t)fr * 2048 + col0;
#pragma unroll
            for (int bj = 0; bj < 2; ++bj)
#pragma unroll
                for (int n = 0; n < 2; ++n) { const f32x4 gv = *(const f32x4*)(g + bj * HALF + n * 16); const f32x4 bs = *(const f32x4*)(base_s + off + bj * HALF + n * 16);
                    *(f32x4*)(out_s + off + bj * HALF + n * 16) = bs + gv * acc[0][bj][0][n]; }
        }
    }
};
struct EpiSwiGLU {
    static constexpr bool PERM = true, AFTER_DRAIN = false;
    bf16_t* O; int ldc;
    __device__ __forceinline__ void operator()(const f32x4 (&acc)[2][2][4][2], const Unit& u, int wr, int wc, int fr, int fq) const {
        const int row0 = u.pm * BM + wr * 64 + fr, col0 = u.pn * HALF + wc * 32 + 8 * fq;
#pragma unroll
        for (int ai = 0; ai < 2; ++ai)
#pragma unroll
            for (int m = 0; m < 4; ++m) { bf16_t* rowp = O + (size_t)(row0 + ai * HALF + m * 16) * ldc + col0;
                float v[8];
#pragma unroll
                for (int n = 0; n < 2; ++n)
#pragma unroll
                    for (int e = 0; e < 4; ++e) { const float g = acc[ai][0][m][n][e], up = acc[ai][1][m][n][e]; v[4 * n + e] = g * __builtin_amdgcn_rcpf(1.0f + __expf(-g)) * up; }
                u32x4 w; w.x = cvt_pk_bf16(v[0], v[1]); w.y = cvt_pk_bf16(v[2], v[3]); w.z = cvt_pk_bf16(v[4], v[5]); w.w = cvt_pk_bf16(v[6], v[7]);
                *(u32x4*)rowp = w; }
    }
};
struct EpiG1 {
    static constexpr bool PERM = true, AFTER_DRAIN = false;
    bf16_t* QB; size_t qkv_stride; float *RKV, *P; float *okp, *oks; size_t kv_stride_p, kv_stride_s; const float *qg, *kg;
    __device__ __forceinline__ void operator()(const f32x4 (&acc)[2][2][4][2], const Unit& u, int wr, int wc, int fr, int fq) const {
        const int row0 = u.pm * BM + wr * 64 + fr;
        if (u.pn >= 24) {
            const int col0 = (u.pn - 24) * BM + wc * 32 + 8 * fq;
#pragma unroll
            for (int ai = 0; ai < 2; ++ai)
#pragma unroll
                for (int m = 0; m < 4; ++m) { float* rp = P + (size_t)(row0 + ai * HALF + m * 16) * 768 + col0;
#pragma unroll
                    for (int bj = 0; bj < 2; ++bj) { *(f32x4*)(rp + bj * HALF) = acc[ai][bj][m][0]; *(f32x4*)(rp + bj * HALF + 4) = acc[ai][bj][m][1]; } }
            return;
        }
        const int reg = u.pn >> 2, cb = (4 * (u.pn & 3) + wc) * 64 + 8 * fq;
        if (reg >= 3) {
            const int col0 = (reg - 3) * 1024 + cb;
#pragma unroll
            for (int ai = 0; ai < 2; ++ai)
#pragma unroll
                for (int m = 0; m < 4; ++m) { float* rp = RKV + (size_t)(row0 + ai * HALF + m * 16) * 3072 + col0;
#pragma unroll
                    for (int bj = 0; bj < 2; ++bj) { *(f32x4*)(rp + 32 * bj) = acc[ai][bj][m][0]; *(f32x4*)(rp + 32 * bj + 4) = acc[ai][bj][m][1]; } }
            return;
        }
        f32x4 gn[2][2];
#pragma unroll
        for (int bj = 0; bj < 2; ++bj)
#pragma unroll
            for (int n = 0; n < 2; ++n) { const f32x4 a = *(const f32x4*)(qg + 8 * fq + 32 * bj + 4 * n), b = *(const f32x4*)(kg + 8 * fq + 32 * bj + 4 * n); gn[bj][n] = (reg == 0) ? a : b; }
        bf16_t* dstb = QB + (size_t)reg * qkv_stride;
#pragma unroll
        for (int ai = 0; ai < 2; ++ai)
#pragma unroll
            for (int m = 0; m < 4; ++m) { const int row = row0 + ai * HALF + m * 16;
                f32x4 v[2][2];
#pragma unroll
                for (int bj = 0; bj < 2; ++bj)
#pragma unroll
                    for (int n = 0; n < 2; ++n) v[bj][n] = acc[ai][bj][m][n];
                if (reg < 2) { float ss = 0.f;
#pragma unroll
                    for (int bj = 0; bj < 2; ++bj)
#pragma unroll
                        for (int n = 0; n < 2; ++n) ss += (v[bj][n][0] * v[bj][n][0] + v[bj][n][1] * v[bj][n][1]) + (v[bj][n][2] * v[bj][n][2] + v[bj][n][3] * v[bj][n][3]);
                    ss += __shfl_xor(ss, 16); ss += __shfl_xor(ss, 32);
                    const float rs = 1.0f / sqrtf(ss * (1.0f / 64.0f) + 1e-6f);
#pragma unroll
                    for (int bj = 0; bj < 2; ++bj)
#pragma unroll
                        for (int n = 0; n < 2; ++n) v[bj][n] = v[bj][n] * rs * gn[bj][n]; }
                bf16_t* db = dstb + (size_t)row * 1024 + cb;
#pragma unroll
                for (int bj = 0; bj < 2; ++bj) { u32x4 w; w.x = cvt_pk_bf16(v[bj][0][0], v[bj][0][1]); w.y = cvt_pk_bf16(v[bj][0][2], v[bj][0][3]); w.z = cvt_pk_bf16(v[bj][1][0], v[bj][1][1]); w.w = cvt_pk_bf16(v[bj][1][2], v[bj][1][3]);
                    *(u32x4*)(db + 32 * bj) = w; }
                if (reg >= 1) { float* op = nullptr;
                    if (u.pm < 32) op = okp + (size_t)(reg - 1) * kv_stride_p + (size_t)row * 1024 + cb; else if (row - 32 * BM < 8) op = oks + (size_t)(reg - 1) * kv_stride_s + (size_t)(row - 32 * BM) * 1024 + cb;
                    if (op) {
#pragma unroll
                        for (int bj = 0; bj < 2; ++bj) { *(f32x4*)(op + 32 * bj) = v[bj][0]; *(f32x4*)(op + 32 * bj + 4) = v[bj][1]; } } }
            }
    }
};
template <class Epi, class Sched, bool ALIGN_EPI = false, bool SP2 = false>
__device__ __forceinline__ void gemm_phase(PG8_LAS unsigned char* lds, const Gemm g, const Sched& S, const Epi& E) {
    int tid_ = threadIdx.x; asm volatile("" : "+v"(tid_));
    const int tid = tid_, wid = __builtin_amdgcn_readfirstlane(tid >> 6), lane = tid & 63, wr = wid >> 2, wc = wid & 3, fr = lane & 15, fq = lane >> 4;
    const int K = g.K, nt = K / BK;
    unsigned voffA[2], voffB[2];
#pragma unroll
    for (int i = 0; i < 2; ++i) { int R, C; stage_rc(tid * 16 + i * 8192, R, C); const int Rb = Epi::PERM ? ((R & ~31) + perm32(R & 31)) : R;
        voffA[i] = (unsigned)(R * K + C) * 2u; voffB[i] = (unsigned)(Rb * K + C) * 2u; }
    const size_t kstep = (size_t)(BK * 2);
    const size_t hstep = (size_t)HALF * K * 2;
    const size_t tstep = 2 * hstep;
    const unsigned ldsw = (unsigned)wid * 1024u;
    const int aoff = lds_byte(wr * 64 + fr, fq * 8), boff = lds_byte(wc * 32 + fr, fq * 8);
#define PG8_SA(b, h) (((b) * 2 + (h)) * HTB)
#define PG8_SB(b, h) ((4 + (b) * 2 + (h)) * HTB)
#define PG8_STAGE(bufoff, gbase, voff) do { _Pragma("unroll") for (int _i = 0; _i < 2; ++_i) \
        __builtin_amdgcn_global_load_lds((const unsigned*)((const char*)(gbase) + (voff)[_i]), (PG8_LAS unsigned*)(lds + (bufoff) + ldsw + _i * 8192), 16, 0, 0); } while (0)
#define PG8_LDA(dst, b, h) do { _Pragma("unroll") for (int m = 0; m < 4; ++m) _Pragma("unroll") for (int k = 0; k < 2; ++k) dst[m][k] = *(const PG8_LAS bf16x8*)(lds + PG8_SA(b, h) + aoff + m * 2048 + k * 1024); } while (0)
#define PG8_LDB(dst, b, h) do { _Pragma("unroll") for (int n = 0; n < 2; ++n) _Pragma("unroll") for (int k = 0; k < 2; ++k) dst[n][k] = *(const PG8_LAS bf16x8*)(lds + PG8_SB(b, h) + boff + n * 2048 + k * 1024); } while (0)
#define PG8_MMA(ai, bj, At, Bt) do { __builtin_amdgcn_s_setprio(1); _Pragma("unroll") for (int m = 0; m < 4; ++m) _Pragma("unroll") for (int n = 0; n < 2; ++n) _Pragma("unroll") for (int k = 0; k < 2; ++k) \
        acc[ai][bj][m][n] = __builtin_amdgcn_mfma_f32_16x16x32_bf16(Bt[n][k], At[m][k], acc[ai][bj][m][n], 0, 0, 0); __builtin_amdgcn_s_setprio(0); } while (0)
#define PG8_WAIT_V(n) asm volatile("s_waitcnt vmcnt(" #n ")" ::: "memory")
#define PG8_WAIT_L(n) asm volatile("s_waitcnt lgkmcnt(" #n ")" ::: "memory")
#define PG8_BAR __builtin_amdgcn_s_barrier()
#define PG8_SCHED __builtin_amdgcn_sched_barrier(0)
    Unit cur, nxt; int ui = 0;
    if (!S.next(0, cur)) return;
    f32x4 acc[2][2][4][2];
#pragma unroll
    for (int a = 0; a < 2; ++a)
#pragma unroll
        for (int b = 0; b < 2; ++b)
#pragma unroll
            for (int m = 0; m < 4; ++m)
#pragma unroll
                for (int n = 0; n < 2; ++n) acc[a][b][m][n] = (f32x4){0.f, 0.f, 0.f, 0.f};
    bf16x8 At[4][2], B0[2][2], B1[2][2];
    const char* cA = (const char*)g.A + (size_t)cur.pm * tstep; const char* cB = (const char*)g.Bt + (size_t)cur.pn * tstep;
    S.a_ready(cur);
    if constexpr (SP2) {
        PG8_STAGE(PG8_SB(0, 0), cB, voffB); PG8_STAGE(PG8_SB(0, 1), cB + hstep, voffB); PG8_STAGE(PG8_SA(0, 0), cA, voffA); PG8_STAGE(PG8_SA(0, 1), cA + hstep, voffA);
        if (wr == 1) PG8_BAR;
        PG8_WAIT_V(2); PG8_BAR;
        PG8_STAGE(PG8_SB(1, 0), cB + kstep, voffB); PG8_STAGE(PG8_SA(1, 0), cA + kstep, voffA); PG8_STAGE(PG8_SB(1, 1), cB + hstep + kstep, voffB);
        PG8_WAIT_V(6); PG8_BAR;
    } else {
        PG8_STAGE(PG8_SB(0, 0), cB, voffB); PG8_STAGE(PG8_SA(0, 0), cA, voffA); PG8_STAGE(PG8_SB(0, 1), cB + hstep, voffB); PG8_STAGE(PG8_SA(0, 1), cA + hstep, voffA);
        if (wr == 1) PG8_BAR;
        PG8_WAIT_V(4); PG8_BAR;
        PG8_STAGE(PG8_SB(1, 0), cB + kstep, voffB); PG8_STAGE(PG8_SA(1, 0), cA + kstep, voffA); PG8_STAGE(PG8_SB(1, 1), cB + hstep + kstep, voffB);
        PG8_WAIT_V(6); PG8_BAR;
    }
    for (;;) {
        const bool has_next = S.next(ui + 1, nxt);
        const char* nA = has_next ? (const char*)g.A + (size_t)nxt.pm * tstep : cA; const char* nB = has_next ? (const char*)g.Bt + (size_t)nxt.pn * tstep : cB;
        for (int t = 0; t < nt; t += 2) {
            const bool last = (t == nt - 2);
            const char* a1 = cA + (size_t)(t + 1) * kstep;
            const char* a2 = last ? nA : cA + (size_t)(t + 2) * kstep; const char* b2 = last ? nB : cB + (size_t)(t + 2) * kstep;
            const char* a3 = a2 + kstep; const char* b3 = b2 + kstep;
            if (last && has_next) S.a_ready(nxt);
            if constexpr (SP2) {
            PG8_LDB(B0, 0, 0); PG8_LDB(B1, 0, 1); PG8_SCHED; PG8_LDA(At, 0, 0); PG8_STAGE(PG8_SA(1, 1), a1 + hstep, voffA);
            PG8_WAIT_V(8); PG8_WAIT_L(0); PG8_BAR; PG8_MMA(0, 0, At, B0); PG8_MMA(0, 1, At, B1); PG8_BAR; PG8_SCHED;
            PG8_LDA(At, 0, 1); PG8_STAGE(PG8_SB(0, 0), b2, voffB); PG8_STAGE(PG8_SB(0, 1), b2 + hstep, voffB); PG8_STAGE(PG8_SA(0, 0), a2, voffA);
            PG8_WAIT_V(8); PG8_WAIT_L(0); PG8_BAR; PG8_MMA(1, 0, At, B0); PG8_MMA(1, 1, At, B1); PG8_BAR; PG8_SCHED;
            PG8_LDB(B0, 1, 0); PG8_LDB(B1, 1, 1); PG8_SCHED; PG8_LDA(At, 1, 0); PG8_STAGE(PG8_SA(0, 1), a2 + hstep, voffA);
            PG8_WAIT_V(8); PG8_WAIT_L(0); PG8_BAR; PG8_MMA(0, 0, At, B0); PG8_MMA(0, 1, At, B1); PG8_BAR; PG8_SCHED;
            PG8_LDA(At, 1, 1); PG8_STAGE(PG8_SB(1, 0), b3, voffB); PG8_STAGE(PG8_SB(1, 1), b3 + hstep, voffB); PG8_STAGE(PG8_SA(1, 0), a3, voffA);
            PG8_WAIT_V(8); PG8_WAIT_L(0); PG8_BAR; PG8_MMA(1, 0, At, B0); PG8_MMA(1, 1, At, B1); PG8_BAR; PG8_SCHED;
            } else {
            PG8_LDB(B0, 0, 0); PG8_SCHED; PG8_LDA(At, 0, 0); PG8_STAGE(PG8_SA(1, 1), a1 + hstep, voffA);
            PG8_WAIT_L(8); PG8_BAR; PG8_WAIT_L(0); PG8_MMA(0, 0, At, B0); PG8_BAR; PG8_SCHED;
            PG8_LDB(B1, 0, 1); PG8_STAGE(PG8_SB(0, 0), b2, voffB);
            PG8_BAR; PG8_WAIT_L(0); PG8_MMA(0, 1, At, B1); PG8_BAR;
            PG8_LDA(At, 0, 1); PG8_STAGE(PG8_SA(0, 0), a2, voffA);
            PG8_BAR; PG8_WAIT_L(0); PG8_MMA(1, 0, At, B0); PG8_BAR; PG8_SCHED;
            PG8_STAGE(PG8_SB(0, 1), b2 + hstep, voffB);
            PG8_WAIT_V(6); PG8_BAR; PG8_MMA(1, 1, At, B1); PG8_BAR;
            PG8_LDB(B0, 1, 0); PG8_SCHED; PG8_LDA(At, 1, 0); PG8_STAGE(PG8_SA(0, 1), a2 + hstep, voffA);
            PG8_WAIT_L(8); PG8_BAR; PG8_WAIT_L(0); PG8_MMA(0, 0, At, B0); PG8_BAR; PG8_SCHED;
            PG8_LDB(B1, 1, 1); PG8_STAGE(PG8_SB(1, 0), b3, voffB);
            PG8_BAR; PG8_WAIT_L(0); PG8_MMA(0, 1, At, B1); PG8_BAR;
            PG8_LDA(At, 1, 1); PG8_STAGE(PG8_SA(1, 0), a3, voffA);
            PG8_BAR; PG8_WAIT_L(0); PG8_MMA(1, 0, At, B0); PG8_BAR; PG8_SCHED;
            PG8_STAGE(PG8_SB(1, 1), b3 + hstep, voffB);
            PG8_WAIT_V(6); PG8_BAR; PG8_MMA(1, 1, At, B1); PG8_BAR;
            }
        }
        if constexpr (ALIGN_EPI) { if (wr == 0) PG8_BAR; }
        if constexpr (!Epi::AFTER_DRAIN) { E(acc, cur, wr, wc, fr, fq); S.done(cur); }
        if (!has_next) break;
#pragma unroll
        for (int a = 0; a < 2; ++a)
#pragma unroll
            for (int b = 0; b < 2; ++b)
#pragma unroll
                for (int m = 0; m < 4; ++m)
#pragma unroll
                    for (int n = 0; n < 2; ++n) acc[a][b][m][n] = (f32x4){0.f, 0.f, 0.f, 0.f};
        cur = nxt; cA = nA; cB = nB; ++ui;
        if constexpr (ALIGN_EPI) { if (wr == 1) PG8_BAR; }
    }
    PG8_WAIT_V(0);
    if constexpr (!ALIGN_EPI) { if (wr == 0) PG8_BAR; }
    PG8_BAR;
    if constexpr (Epi::AFTER_DRAIN) { E.fused(acc, cur, wr, wc, fr, fq, lds, wid, lane); S.done(cur); }
#undef PG8_SA
#undef PG8_SB
#undef PG8_STAGE
#undef PG8_LDA
#undef PG8_LDB
#undef PG8_MMA
#undef PG8_WAIT_V
#undef PG8_WAIT_L
#undef PG8_BAR
#undef PG8_SCHED
}
}
#define GAS __attribute__((address_space(1)))
#define LAS __attribute__((address_space(3)))
typedef unsigned short bf16;
typedef unsigned v4u __attribute__((ext_vector_type(4)));
typedef float f32x4 __attribute__((ext_vector_type(4)));
typedef short bf16x8 __attribute__((ext_vector_type(8)));
typedef GAS unsigned gu32;
typedef GAS unsigned long long gu64;
#define RLX_AGENT __ATOMIC_RELAXED, __HIP_MEMORY_SCOPE_AGENT
#define LDS_WAIT() asm volatile("s_waitcnt lgkmcnt(0)" ::: "memory")
#define VM_WAIT() asm volatile("s_waitcnt vmcnt(0)" ::: "memory")
__device__ __forceinline__ unsigned long long rt() { return __builtin_amdgcn_s_memrealtime(); }
__device__ __forceinline__ unsigned f2bf(float f) { unsigned u = __builtin_bit_cast(unsigned, f); return (u + 0x7fffu + ((u >> 16) & 1u)) >> 16; }
__device__ __forceinline__ unsigned pk2(float lo, float hi) { return f2bf(lo) | (f2bf(hi) << 16); }
#define XB_TMO      128
#define XB_XCNT(j)  (256  + 64 * (j))
#define XB_XSUB(j)  (1280 + 64 * (j))
#define XB_XGEN(j)  (2304 + 64 * (j))
#define XB_TOP      3328
#define XB_TOPGEN   3392
#define XCD_BAR_WORDS 3456
#define XB_SPIN_CAP (1u << 18)

__device__ __forceinline__ unsigned xb_ld(unsigned* p)              { return __hip_atomic_load(p, __ATOMIC_RELAXED, __HIP_MEMORY_SCOPE_AGENT); }
__device__ __forceinline__ unsigned xb_add(unsigned* p, unsigned v) { return __hip_atomic_fetch_add(p, v, __ATOMIC_RELAXED, __HIP_MEMORY_SCOPE_AGENT); }
__device__ __forceinline__ unsigned xb_xcc_id() { return (unsigned)__builtin_amdgcn_s_getreg((3 << 11) | 20) & 0xFu; }
#define XB_SPIN(cond, bar) do { unsigned _sp = 0; while (cond) { __builtin_amdgcn_s_sleep(1); \
    if ((++_sp & 255u) == 0u) { if (xb_ld(&(bar)[XB_TMO])) break; if (_sp > XB_SPIN_CAP) { atomicAdd(&(bar)[XB_TMO], 1u); break; } } } } while (0)

struct XcdBarrier {
    unsigned* bar; unsigned x;
    volatile LAS unsigned* st;
};

__device__ __forceinline__ XcdBarrier xcd_barrier_post(unsigned* bar, volatile LAS unsigned* st) {
    XcdBarrier b; b.bar = bar; b.x = xb_xcc_id(); b.st = st;
    if (threadIdx.x == 0) (void)xb_add(&bar[XB_XCNT(b.x)], 1u);
    return b;
}
__device__ __forceinline__ void xcd_barrier_complete(unsigned* bar, unsigned x, unsigned& nloc, unsigned& nx) {
    const unsigned G = gridDim.x * gridDim.y * gridDim.z;
    unsigned sum, cnt, mine, sp = 0u;
    for (;;) {
        sum = 0u; cnt = 0u; mine = 0u;
#pragma unroll
        for (unsigned j = 0; j < 16; ++j) { const unsigned c = xb_ld(&bar[XB_XCNT(j)]); sum += c; cnt += (c > 0u) ? 1u : 0u; mine = (j == x) ? c : mine; }
        if (sum == G) break;
        __builtin_amdgcn_s_sleep(1);
        if ((++sp & 255u) == 0u) { if (xb_ld(&bar[XB_TMO])) break; if (sp > XB_SPIN_CAP) { atomicAdd(&bar[XB_TMO], 1u); break; } }
    }
    nloc = mine > 0u ? mine : 1u; nx = cnt > 0u ? cnt : 1u;
}

__device__ __forceinline__ void xcd_barrier(const XcdBarrier& b) {
    asm volatile("s_waitcnt vmcnt(0)" ::: "memory");
    __syncthreads();
    if (threadIdx.x == 0) {
        unsigned* bar = b.bar;
        __builtin_amdgcn_s_waitcnt(0);
        unsigned nloc = b.st[0], nx = b.st[1];
        if (nloc == 0u) { xcd_barrier_complete(bar, b.x, nloc, nx); b.st[0] = nloc; b.st[1] = nx; }
        const unsigned old = xb_add(&bar[XB_XSUB(b.x)], 1u);
        const unsigned gen = old / nloc;
        if (old + 1u == (gen + 1u) * nloc) {
            __builtin_amdgcn_fence(__ATOMIC_RELEASE, "agent");
            asm volatile("s_waitcnt vmcnt(0)" ::: "memory");
            const unsigned og = xb_add(&bar[XB_TOP], 1u);
            const unsigned tg = og / nx;
            if (og + 1u == (tg + 1u) * nx) xb_add(&bar[XB_TOPGEN], 1u);
            else XB_SPIN(xb_ld(&bar[XB_TOPGEN]) == tg, bar);
            __builtin_amdgcn_fence(__ATOMIC_ACQUIRE, "agent");
            xb_add(&bar[XB_XGEN(b.x)], 1u);
            asm volatile("s_waitcnt vmcnt(0)" ::: "memory");
        } else {
            XB_SPIN(xb_ld(&bar[XB_XGEN(b.x)]) == gen, bar);
            __builtin_amdgcn_fence(__ATOMIC_ACQUIRE, "agent");
            asm volatile("s_waitcnt vmcnt(0)" ::: "memory");
        }
    }
    __syncthreads();
}

#ifndef MK_N_LAUNCHES
#define MK_N_LAUNCHES 1
#endif
#ifndef REP_P0
#define REP_P0 1
#endif
#ifndef REP_N1
#define REP_N1 1
#endif
#ifndef REP_PW
#define REP_PW 1
#endif
#ifndef REP_SCAN
#define REP_SCAN 1
#endif
#ifndef REP_ATT
#define REP_ATT 1
#endif
#ifndef REP_SATT
#define REP_SATT 1
#endif
#ifndef REP_MX
#define REP_MX 1
#endif
#ifndef REP_N2
#define REP_N2 1
#endif
#ifndef REP_PWL
#define REP_PWL 1
#endif
#ifndef REP_PWM
#define REP_PWM 1
#endif
#ifndef REP_PWR
#define REP_PWR 1
#endif
constexpr int NWAVES = 8, NTHR = 512;
constexpr int DM = 2048, SEQ = 2048, PBATCH = 4, SBATCH = 8, DEPTH = 4, NHEADS = 16, HD = 64, DATT = 1024, DRW = 1024, FF = 5632;
constexpr int MP = PBATCH * SEQ;
constexpr int ROW_S = MP;
constexpr int ROW_SS = MP + 8;
constexpr int NROWS = MP + 8;
constexpr int MH = MP + 256;
constexpr int N1 = 6912;
constexpr int PC0 = 6144, PP0 = 6144 + 384;
constexpr int NLORA = 320;
constexpr int MODW = 6 * DM;
constexpr float RMS_EPS = 1e-6f, GN_EPS = 64e-5f, ATT_SCALE = 0.125f;

enum { I_XP = 0, I_XS, I_CP, I_CS, I_CK, I_CV, I_SWKV, I_SSH, I_RELB, I_ADAW, I_ADAB, I_N1G, I_N2G, I_WIN, I_QG, I_KG, I_MUWAG, I_MURKV,
       I_DW0, I_DW1, I_DW2, I_AA0, I_AW1, I_AW2, I_GW1, I_GW2, I_VMU, I_VV0, I_VW1, I_VW2, I_KK, I_KA, I_RK, I_LNG, I_LNB, I_WOUT, I_WGU, I_WDN, N_IN };
constexpr size_t O_YP = 0, O_YS = O_YP + (size_t)MP * DM, O_KP = O_YS + 8 * DM, O_VP = O_KP + (size_t)DEPTH * MP * DATT, O_WP = O_VP + (size_t)DEPTH * MP * DATT,
                 O_SP = O_WP + (size_t)DEPTH * PBATCH * 16 * 4096, O_KS = O_SP + (size_t)DEPTH * PBATCH * DM, O_VS = O_KS + (size_t)DEPTH * 8 * DATT, O_WS = O_VS + (size_t)DEPTH * 8 * DATT,
                 O_SS = O_WS + (size_t)DEPTH * 8 * 16 * 4096, O_END = O_SS + (size_t)DEPTH * 8 * DM;
static_assert(O_END == 87212032, "output size");

constexpr size_t MiB = 1u << 20;
constexpr size_t WS_CTL = 0, CTL_ZERO_BYTES = 1 * MiB;
constexpr size_t WS_MOD = 1 * MiB;
constexpr size_t WS_BT = 4 * MiB;
constexpr size_t WS_WIN = 8 * MiB;
constexpr size_t WS_WOUT = 116 * MiB;
constexpr size_t WS_WGU = 148 * MiB;
constexpr size_t WS_WDN = 324 * MiB;
constexpr size_t WS_HB = 412 * MiB;
constexpr size_t WS_W2T = 5 * MiB;
constexpr size_t WS_RKV = 446 * MiB;
constexpr size_t WS_P = 546 * MiB;
constexpr size_t WS_QB = 670 * MiB, WS_KB = 687 * MiB, WS_VB = 704 * MiB;
constexpr size_t WS_R = 722 * MiB, WS_W = 755 * MiB, WS_K = 788 * MiB, WS_V = 821 * MiB, WS_A = 854 * MiB, WS_B = 887 * MiB, WS_G = 920 * MiB, WS_VF = 953 * MiB;
constexpr size_t WS_Y = 986 * MiB;
constexpr size_t WS_OBR = 1019 * MiB;
constexpr size_t WS_LSE = 1067 * MiB;
constexpr size_t WS_MIX = 1069 * MiB;
constexpr size_t WS_XB = 1102 * MiB;
constexpr size_t WS_ACT = 1168 * MiB;
constexpr size_t WS_END = 1260 * MiB;
static_assert(WS_WIN + (size_t)DEPTH * N1 * DM * 2 <= WS_WOUT && WS_WGU + (size_t)DEPTH * 2 * FF * DM * 2 <= WS_WDN && WS_WDN + (size_t)DEPTH * DM * FF * 2 <= WS_HB, "ws map (weights)");
static_assert(WS_VB - WS_KB == WS_KB - WS_QB, "q | k | v bf16 buffers are equally spaced");
static_assert(WS_HB + (size_t)MH * DM * 2 <= WS_RKV && WS_RKV + (size_t)MH * 3072 * 4 <= WS_P && WS_P + (size_t)MH * 768 * 4 <= WS_QB && WS_W2T + (size_t)DEPTH * 1024 * 320 * 2 <= WS_WIN && WS_QB + (size_t)MH * DATT * 2 <= WS_KB && WS_VB + (size_t)MH * DATT * 2 <= WS_R, "ws map (act 1)");
static_assert(WS_R + (size_t)NROWS * DRW * 4 <= WS_W && WS_Y + (size_t)NROWS * DRW * 4 <= WS_OBR && WS_OBR + (size_t)3 * MP * DATT * 2 <= WS_LSE && WS_LSE + (size_t)3 * MP * 16 * 4 <= WS_MIX, "ws map (act 2)");
static_assert(WS_MIX + (size_t)MH * DM * 2 <= WS_XB && WS_XB + (size_t)MH * DM * 4 <= WS_ACT && WS_ACT + (size_t)MH * FF * 2 <= WS_END, "ws map (act 3)");
constexpr int CW_BAR = 4096;

constexpr int RING_BYTES = 131072;
constexpr int LDSCTL_OFF = RING_BYTES, MISC_OFF = LDSCTL_OFF + 320;
constexpr int LDS_BYTES = 147456;

constexpr int PH_PER_LAYER = 9, N_PHASES = 1 + DEPTH * PH_PER_LAYER;

struct Args { const float* in[N_IN]; float* out; unsigned char* ws; int ph_lo, ph_hi; };
static_assert(sizeof(Args) == N_IN * 8 + 24, "Args has no padding");

__device__ __forceinline__ float wave_sum(float v) {
#pragma unroll
    for (int o = 1; o < 64; o <<= 1) v += __shfl_xor(v, o);
    return v;
}
__device__ __forceinline__ float wave_max(float v) {
#pragma unroll
    for (int o = 1; o < 64; o <<= 1) v = fmaxf(v, __shfl_xor(v, o));
    return v;
}
template <int CTRL> __device__ __forceinline__ float dpp_mov(float v) { return __builtin_bit_cast(float, __builtin_amdgcn_update_dpp(0, __builtin_bit_cast(int, v), CTRL, 0xf, 0xf, false)); }
__device__ __forceinline__ float row16_sum(float v) {
    v += dpp_mov<0xB1>(v);
    v += dpp_mov<0x4E>(v);
    v += dpp_mov<0x141>(v);
    v += dpp_mov<0x140>(v);
    return v;
}
__device__ __forceinline__ float bf2f(unsigned short b) { return __builtin_bit_cast(float, (unsigned)b << 16); }
__device__ __forceinline__ float sigmoidf_(float x) { return 1.0f / (1.0f + __expf(-x)); }

__device__ __forceinline__ void p0_transpose_item(const float* W, int N, int k0, int n0, bf16* WT, int ldt, int drow0, const float* mu, int smode, LAS float* scr, int lane, int kdst = -1, int krows = 64) {
    if (kdst < 0) kdst = k0;
#pragma unroll 8
    for (int i = 0; i < 32; ++i) { const int kk = 2 * i + (lane >> 5); float v = 0.f;
        if (kk < krows) { v = W[(size_t)(k0 + kk) * N + n0 + (lane & 31)];
            if (smode) { const float m = mu[k0 + kk]; v *= (smode == 1) ? (1.0f - m) : m; } }
        scr[kk * 33 + (lane & 31)] = v; }
    LDS_WAIT(); asm volatile("" ::: "memory");
    const int c = lane & 7;
    if (8 * c < krows) {
#pragma unroll
        for (int j = 0; j < 4; ++j) { const int n = (lane >> 3) + 8 * j; const LAS float* s = scr + (8 * c) * 33 + n;
            v4u o; o.x = pk2(s[0 * 33], s[1 * 33]); o.y = pk2(s[2 * 33], s[3 * 33]); o.z = pk2(s[4 * 33], s[5 * 33]); o.w = pk2(s[6 * 33], s[7 * 33]);
            *(GAS v4u*)(WT + (size_t)(drow0 + n) * ldt + kdst + 8 * c) = o; }
    }
    LDS_WAIT(); asm volatile("" ::: "memory");
}
__device__ __forceinline__ int rel_bucket(int d) {
    if (d < 16) return d;
    const int large = 16 + (int)(logf((float)d / 16.0f) / logf(128.0f) * 16.0f);
    return large < 31 ? large : 31;
}
__device__ __forceinline__ void p0_prologue(const Args& args, LAS unsigned char* lds, int vcu, int G) {
    int tid_ = threadIdx.x; asm volatile("" : "+v"(tid_)); const int tid = tid_, lane = tid & 63, wave = __builtin_amdgcn_readfirstlane(tid >> 6); const int gw = vcu * NWAVES + wave, NGW = G * NWAVES; (void)tid; (void)lane; (void)wave; (void)gw; (void)NGW;
    unsigned char* ws = args.ws;
    float* MOD = (float*)(ws + WS_MOD);
    for (int it = vcu; it < DEPTH * (MODW / 256); it += G) {
        const int l = it / (MODW / 256), c0 = (it % (MODW / 256)) * 256;
        LAS float* sl = (LAS float*)lds;
        __syncthreads();
        for (int i = tid; i < 12 * DM; i += NTHR) { const int bb = i / DM, k = i % DM; const float c = (bb < 4) ? args.in[I_CP][bb * DM + k] : args.in[I_CS][(bb - 4) * DM + k];
            sl[k * 12 + bb] = c / (1.0f + __expf(-c)); }
        __syncthreads();
        const float* Wl = args.in[I_ADAW] + (size_t)l * DM * MODW + c0 + 4 * lane;
        f32x4 acc[12];
#pragma unroll
        for (int bb = 0; bb < 12; ++bb) acc[bb] = (f32x4){0.f, 0.f, 0.f, 0.f};
        const int kb = wave * 256;
#pragma unroll 4
        for (int k = kb; k < kb + 256; ++k) {
            const f32x4 w = *(const f32x4*)(Wl + (size_t)k * MODW);
            const f32x4 s0 = *(const LAS f32x4*)(sl + k * 12), s1 = *(const LAS f32x4*)(sl + k * 12 + 4), s2 = *(const LAS f32x4*)(sl + k * 12 + 8);
            acc[0] += w * s0.x; acc[1] += w * s0.y; acc[2] += w * s0.z; acc[3] += w * s0.w;
            acc[4] += w * s1.x; acc[5] += w * s1.y; acc[6] += w * s1.z; acc[7] += w * s1.w;
            acc[8] += w * s2.x; acc[9] += w * s2.y; acc[10] += w * s2.z; acc[11] += w * s2.w;
        }
        __syncthreads();
        LAS float* part = (LAS float*)lds;
#pragma unroll
        for (int bb = 0; bb < 12; ++bb) *(LAS f32x4*)(part + (wave * 12 + bb) * 256 + 4 * lane) = acc[bb];
        __syncthreads();
        for (int i = tid; i < 12 * 256; i += NTHR) { const int bb = i / 256, c = i % 256; float s = args.in[I_ADAB][l * MODW + c0 + c];
#pragma unroll
            for (int w = 0; w < 8; ++w) s += part[(w * 12 + bb) * 256 + c];
            MOD[((size_t)l * 12 + bb) * MODW + c0 + c] = s; }
        __syncthreads();
    }
    if (vcu == G - 1) {
        float* BT = (float*)(ws + WS_BT);
        for (int i = tid; i < 3 * 129 * 16; i += NTHR) { const int h = i & 15, m = (i >> 4) % 129, br = (i >> 4) / 129; BT[i] = args.in[I_RELB][rel_bucket(m << (2 * br)) * 16 + h]; }
    }
    __syncthreads();
    LAS float* scr = (LAS float*)(lds + wave * 16384);
    constexpr int I_IN = (DM / 64) * (6144 / 32), I_LD = (DM / 64) * 2, I_LG = (DM / 64) * 5, I_LV = (DM / 64) * 1, I_OUT = (DM / 64) * (DM / 32), I_GU = (DM / 64) * (2 * FF / 32), I_DN = (FF / 64) * (DM / 32);
    constexpr int I_W2 = 32 * 6;
    constexpr int I_LAYER = I_IN + 2 * (2 * I_LD + I_LG + I_LV) + I_W2 + I_OUT + I_GU + I_DN;
    for (int it = gw; it < DEPTH * I_LAYER; it += NGW) {
        const int l = it / I_LAYER; int r = it % I_LAYER;
        bf16* WIN = (bf16*)(ws + WS_WIN) + (size_t)l * N1 * DM;
        if (r < I_IN) { const int nblk = 6144 / 32, kbk = r / nblk, nb = r % nblk;
            const int n0 = 32 * nb, drow = 256 * (n0 / 256) + 128 * ((n0 % 64) / 32) + 32 * ((n0 % 256) / 64);
            p0_transpose_item(args.in[I_WIN] + (size_t)l * DM * 6144, 6144, 64 * kbk, n0, WIN, DM, drow, nullptr, 0, scr, lane); continue; }
        r -= I_IN;
        constexpr int LH = 2 * I_LD + I_LG + I_LV;
        if (r < 2 * LH) {
            const int half = r / LH, base = half ? PP0 : PC0, sm = 1 + half; int q = r % LH;
            if (q < I_LD) { p0_transpose_item(args.in[I_DW1] + (size_t)l * DM * 64, 64, 64 * (q / 2), 32 * (q % 2), WIN, DM, base + 0 + 32 * (q % 2), args.in[I_MUWAG] + ((size_t)l * 3 + 0) * DM, sm, scr, lane); continue; }
            q -= I_LD;
            if (q < I_LD) { p0_transpose_item(args.in[I_AW1] + (size_t)l * DM * 64, 64, 64 * (q / 2), 32 * (q % 2), WIN, DM, base + 64 + 32 * (q % 2), args.in[I_MUWAG] + ((size_t)l * 3 + 1) * DM, sm, scr, lane); continue; }
            q -= I_LD;
            if (q < I_LG) { p0_transpose_item(args.in[I_GW1] + (size_t)l * DM * 160, 160, 64 * (q / 5), 32 * (q % 5), WIN, DM, base + 128 + 32 * (q % 5), args.in[I_MUWAG] + ((size_t)l * 3 + 2) * DM, sm, scr, lane); continue; }
            q -= I_LG;
            if (l > 0) p0_transpose_item(args.in[I_VW1] + (size_t)(l - 1) * DM * 32, 32, 64 * q, 0, WIN, DM, base + 288, args.in[I_VMU] + (size_t)(l - 1) * DM, sm, scr, lane);
            continue;
        }
        r -= 2 * LH;
        if (r < I_W2) { const int kb = r / 32, n0 = 32 * (r % 32); bf16* W2T = (bf16*)(ws + WS_W2T) + (size_t)l * 1024 * NLORA;
            if (kb == 0) p0_transpose_item(args.in[I_DW2] + (size_t)l * 64 * DRW, DRW, 0, n0, W2T, NLORA, n0, nullptr, 0, scr, lane, 0, 64);
            else if (kb == 1) p0_transpose_item(args.in[I_AW2] + (size_t)l * 64 * DRW, DRW, 0, n0, W2T, NLORA, n0, nullptr, 0, scr, lane, 64, 64);
            else if (kb < 5) p0_transpose_item(args.in[I_GW2] + (size_t)l * 160 * DRW, DRW, 64 * (kb - 2), n0, W2T, NLORA, n0, nullptr, 0, scr, lane, 128 + 64 * (kb - 2), (kb == 4) ? 32 : 64);
            else if (l > 0) p0_transpose_item(args.in[I_VW2] + (size_t)(l - 1) * 32 * DRW, DRW, 0, n0, W2T, NLORA, n0, nullptr, 0, scr, lane, 288, 32);
            continue; }
        r -= I_W2;
        if (r < I_OUT) { const int nblk = DM / 32, kbk = r / nblk, nb = r % nblk;
            p0_transpose_item(args.in[I_WOUT] + (size_t)l * DM * DM, DM, 64 * kbk, 32 * nb, (bf16*)(ws + WS_WOUT) + (size_t)l * DM * DM, DM, 32 * nb, nullptr, 0, scr, lane); continue; }
        r -= I_OUT;
        if (r < I_GU) { const int nblk = 2 * FF / 32, kbk = r / nblk, nb = r % nblk, n0 = 32 * nb;
            const int nn = (n0 < FF) ? n0 : n0 - FF, drow = 256 * (nn / 128) + (nn % 128) + ((n0 < FF) ? 0 : 128);
            p0_transpose_item(args.in[I_WGU] + (size_t)l * DM * 2 * FF, 2 * FF, 64 * kbk, n0, (bf16*)(ws + WS_WGU) + (size_t)l * 2 * FF * DM, DM, drow, nullptr, 0, scr, lane); continue; }
        r -= I_GU;
        { const int nblk = DM / 32, kbk = r / nblk, nb = r % nblk;
            p0_transpose_item(args.in[I_WDN] + (size_t)l * FF * DM, DM, 64 * kbk, 32 * nb, (bf16*)(ws + WS_WDN) + (size_t)l * DM * FF, FF, 32 * nb, nullptr, 0, scr, lane); }
    }
}

__device__ __forceinline__ void norm_mod_row(const float* xrow, const float* g, const float* sh, const float* sc, bf16* hrow, float* frow, int lane) {
    const GAS f32x4* xr = (const GAS f32x4*)xrow + lane;
    f32x4 v[8]; float s = 0.f;
#pragma unroll
    for (int j = 0; j < 8; ++j) { v[j] = xr[64 * j]; s += (v[j].x * v[j].x + v[j].y * v[j].y) + (v[j].z * v[j].z + v[j].w * v[j].w); }
    const float rstd = 1.0f / sqrtf(wave_sum(s) * (1.0f / DM) + RMS_EPS);
    GAS unsigned long long* o8 = (GAS unsigned long long*)hrow + lane;
#pragma unroll
    for (int j = 0; j < 8; ++j) { const f32x4 g4 = ((const GAS f32x4*)g)[lane + 64 * j], sh4 = ((const GAS f32x4*)sh)[lane + 64 * j], sc4 = ((const GAS f32x4*)sc)[lane + 64 * j];
        const f32x4 h = (v[j] * rstd * g4) * (sc4 + 1.0f) + sh4;
        o8[64 * j] = (unsigned long long)pk2(h.x, h.y) | ((unsigned long long)pk2(h.z, h.w) << 32);
        if (frow) ((GAS f32x4*)frow)[lane + 64 * j] = h; }
}

__device__ __forceinline__ void pw_phase(const Args& args, int l, LAS unsigned char* lds, int vcu, int G) {
    int tid_ = threadIdx.x; asm volatile("" : "+v"(tid_)); const int tid = tid_, lane = tid & 63, wave = __builtin_amdgcn_readfirstlane(tid >> 6);
    typedef float f32x16 __attribute__((ext_vector_type(16)));
    unsigned char* ws = args.ws;
    const float* RKV = (const float*)(ws + WS_RKV); const float* P = (const float*)(ws + WS_P); const bf16* W2T = (const bf16*)(ws + WS_W2T) + (size_t)l * 1024 * NLORA;
    float* Rr = (float*)(ws + WS_R); float* Ww = (float*)(ws + WS_W); float* Kk = (float*)(ws + WS_K); float* Vv = (float*)(ws + WS_V);
    float* Aa = (float*)(ws + WS_A); float* Bb = (float*)(ws + WS_B); float* Gg = (float*)(ws + WS_G); float* VF = (float*)(ws + WS_VF);
    constexpr int LST = 328, SST = 68;
    LAS unsigned short* L = (LAS unsigned short*)lds;
    LAS float* Sw = (LAS float*)(lds + 21504) + wave * (32 * SST);
    const int r32 = lane & 31, hf = lane >> 5, rs = lane >> 4, c4 = (lane & 15) * 4;
    const float* mur = args.in[I_MURKV] + (size_t)l * 3 * DRW;
    for (int tile = vcu; tile < 257; tile += G) {
        const int m0 = tile < 256 ? tile * 32 : MP, nv = tile < 256 ? 32 : 8;
        __syncthreads();
        for (int repl = 0; repl < REP_PWL; ++repl)
#pragma unroll 4
        for (int i = tid; i < 32 * NLORA; i += NTHR) { const int r = i / NLORA, c = i % NLORA; const int m = m0 + ((r < nv) ? r : nv - 1);
            const int pm = (m < MP) ? (((m & (SEQ - 1)) == 0) ? -1 : m - 1) : m + 8;
            const float v = P[(size_t)m * 768 + c] + ((pm >= 0) ? 1.f : 0.f) * P[(size_t)((pm >= 0) ? pm : m) * 768 + 384 + c];
            const float e2 = __expf(2.0f * v), th = 1.0f - 2.0f / (1.0f + e2), sg = 1.0f / (1.0f + __expf(-v));
            L[r * LST + c] = (unsigned short)f2bf((c < 64) ? th : ((c >= 128 && c < 288) ? sg : v)); }
        __syncthreads();
        const bf16* w2a = W2T + (size_t)(128 * wave + r32) * NLORA + 8 * hf; const LAS unsigned short* lb = L + r32 * LST + 8 * hf;
        f32x16 acc[4];
#define PW_MM(koff, nks, CH) do { for (int repm = 0; repm < REP_PWM; ++repm) { _Pragma("unroll") for (int nt = 0; nt < 4; ++nt) acc[nt] = (f32x16){0.f}; \
        _Pragma("unroll 1") for (int kp = 0; kp < (nks); kp += (CH)) { bf16x8 bl[CH], aw[CH][4]; \
            _Pragma("unroll") for (int k2 = 0; k2 < (CH); ++k2) { bl[k2] = *(const LAS bf16x8*)(lb + (koff) + 16 * (kp + k2)); \
                _Pragma("unroll") for (int nt = 0; nt < 4; ++nt) aw[k2][nt] = *(const bf16x8*)(w2a + (size_t)(32 * nt) * NLORA + (koff) + 16 * (kp + k2)); } \
            _Pragma("unroll") for (int k2 = 0; k2 < (CH); ++k2) _Pragma("unroll") for (int nt = 0; nt < 4; ++nt) acc[nt] = __builtin_amdgcn_mfma_f32_32x32x16_bf16(aw[k2][nt], bl[k2], acc[nt], 0, 0, 0); } } } while (0)
#define PW_STAGE(hp) do { _Pragma("unroll") for (int n2 = 0; n2 < 2; ++n2) _Pragma("unroll") for (int g = 0; g < 4; ++g) \
            *(LAS f32x4*)(Sw + r32 * SST + 32 * n2 + 8 * g + 4 * hf) = (f32x4){acc[2 * (hp) + n2][4 * g], acc[2 * (hp) + n2][4 * g + 1], acc[2 * (hp) + n2][4 * g + 2], acc[2 * (hp) + n2][4 * g + 3]}; } while (0)
#define PW_AV(it) (*(const LAS f32x4*)(Sw + (4 * (it) + rs) * SST + c4))
        const unsigned vo1_ = (unsigned)(rs * DRW + c4), vo3_ = (unsigned)(rs * 3072 + c4);
#define PW_LOCAL_OFFS unsigned vo1 = vo1_, vo3 = vo3_; asm volatile("" : "+v"(vo1), "+v"(vo3)); (void)vo3;
        const int pd = (tile < 256) ? -1 : 8;
        const float pm0 = (tile < 256 && (m0 & (SEQ - 1)) == 0 && rs == 0) ? 0.f : 1.f;
        PW_MM(0, 4, 4);
#pragma unroll
        for (int hp = 0; hp < 2; ++hp) { PW_LOCAL_OFFS const int chu = 128 * wave + 64 * hp; const f32x4 w0 = *(const f32x4*)(args.in[I_DW0] + (size_t)l * DRW + chu + c4);
            PW_STAGE(hp);
#pragma unroll
            for (int it = 0; it < 8; ++it) { const f32x4 x = w0 + PW_AV(it); f32x4 o;
#pragma unroll
                for (int e = 0; e < 4; ++e) { const float sp = fmaxf(-x[e], 0.f) + __logf(1.0f + __expf(-fabsf(x[e]))); o[e] = __expf(-__expf(-sp - 0.5f)); }
                *(f32x4*)(Ww + (size_t)(m0 + 4 * it) * DRW + chu + vo1) = o; } }
        if (l > 0) PW_MM(288, 2, 2);
#pragma unroll
        for (int hp = 0; hp < 2; ++hp) { PW_LOCAL_OFFS const int chu = 128 * wave + 64 * hp; const f32x4 mu2 = *(const f32x4*)(mur + 2 * DRW + chu + c4); f32x4 v0 = (f32x4){0.f, 0.f, 0.f, 0.f};
            if (l > 0) v0 = *(const f32x4*)(args.in[I_VV0] + (size_t)(l - 1) * DRW + chu + c4);
            PW_STAGE(hp);
#pragma unroll
            for (int half = 0; half < 2; ++half) {
                f32x4 x0[4], xp[4], vf[4];
#pragma unroll
                for (int i = 0; i < 4; ++i) { const int it = 4 * half + i; const float* a_ = RKV + (size_t)(m0 + 4 * it) * 3072 + 2048 + chu; const float* b_ = RKV + ((size_t)(m0 + 4 * it) + pd) * 3072 + 2048 + chu;
                    x0[i] = *(const f32x4*)(a_ + vo3); xp[i] = *(const f32x4*)(b_ + vo3) * ((it == 0) ? pm0 : 1.f);
                    vf[i] = (l > 0) ? *(const f32x4*)(VF + (size_t)(m0 + 4 * it) * DRW + chu + vo1) : (f32x4){0.f, 0.f, 0.f, 0.f}; }
#pragma unroll
                for (int i = 0; i < 4; ++i) { const int it = 4 * half + i; f32x4 vr = x0[i] + (xp[i] - x0[i]) * mu2;
                    if (l > 0) { const f32x4 x = v0 + PW_AV(it); f32x4 vg;
#pragma unroll
                        for (int e = 0; e < 4; ++e) vg[e] = sigmoidf_(x[e]);
                        vr = vr + (vf[i] - vr) * vg; }
                    else *(f32x4*)(VF + (size_t)(m0 + 4 * it) * DRW + chu + vo1) = vr;
                    *(f32x4*)(Vv + (size_t)(m0 + 4 * it) * DRW + chu + vo1) = vr; }
            } }
        PW_MM(128, 10, 2);
#pragma unroll
        for (int hp = 0; hp < 2; ++hp) { PW_LOCAL_OFFS const int chu = 128 * wave + 64 * hp;
            PW_STAGE(hp);
#pragma unroll
            for (int it = 0; it < 8; ++it) *(f32x4*)(Gg + (size_t)(m0 + 4 * it) * DRW + chu + vo1) = PW_AV(it); }
        PW_MM(64, 4, 4);
#pragma unroll
        for (int hp = 0; hp < 2; ++hp) { PW_LOCAL_OFFS const int chu = 128 * wave + 64 * hp;
            const f32x4 a0 = *(const f32x4*)(args.in[I_AA0] + (size_t)l * DRW + chu + c4), kk4 = *(const f32x4*)(args.in[I_KK] + (size_t)l * DRW + chu + c4), ka4 = *(const f32x4*)(args.in[I_KA] + (size_t)l * DRW + chu + c4);
            const f32x4 mu0 = *(const f32x4*)(mur + chu + c4), mu1 = *(const f32x4*)(mur + DRW + chu + c4);
            PW_STAGE(hp);
#pragma unroll
            for (int qt = 0; qt < 4; ++qt) {
                f32x4 k0[2], kp[2], r0[2], rp[2];
#pragma unroll
                for (int i = 0; i < 2; ++i) { const int it = 2 * qt + i; const float pmask = (it == 0) ? pm0 : 1.f;
                    const float* a_ = RKV + (size_t)(m0 + 4 * it) * 3072 + chu; const float* b_ = RKV + ((size_t)(m0 + 4 * it) + pd) * 3072 + chu;
                    k0[i] = *(const f32x4*)(a_ + 1024 + vo3); kp[i] = *(const f32x4*)(b_ + 1024 + vo3) * pmask; r0[i] = *(const f32x4*)(a_ + vo3); rp[i] = *(const f32x4*)(b_ + vo3) * pmask; }
#pragma unroll
                for (int i = 0; i < 2; ++i) { const int it = 2 * qt + i; const size_t ou = (size_t)(m0 + 4 * it) * DRW + chu;
                    const f32x4 x = a0 + PW_AV(it); f32x4 a;
#pragma unroll
                    for (int e = 0; e < 4; ++e) a[e] = sigmoidf_(x[e]);
                    const f32x4 kr = k0[i] + (kp[i] - k0[i]) * mu1; f32x4 q = kr * kk4;
                    const float s = row16_sum((q[0] * q[0] + q[1] * q[1]) + (q[2] * q[2] + q[3] * q[3]));
                    q = q * (1.0f / fmaxf(sqrtf(s), 1e-12f));
                    *(f32x4*)(Kk + ou + vo1) = kr * ((a - 1.0f) * ka4 + 1.0f); *(f32x4*)(Aa + ou + vo1) = -q; *(f32x4*)(Bb + ou + vo1) = q * a; *(f32x4*)(Rr + ou + vo1) = r0[i] + (rp[i] - r0[i]) * mu0; }
            } }
#undef PW_MM
#undef PW_STAGE
#undef PW_AV
#undef PW_LOCAL_OFFS
    }
}

constexpr int MST = 144, MSLOT = 64 * MST;
__device__ __forceinline__ bf16x8 mfr_row(const LAS unsigned char* M, int row, int k0, int g) { return *(const LAS bf16x8*)(M + row * MST + (k0 + 8 * g) * 2); }
__device__ __forceinline__ bf16x8 mfr_tr(const LAS unsigned char* M, int k0, int col0, int g, int q) {
    typedef short v4i16 __attribute__((ext_vector_type(4)));
    const LAS unsigned char* p = M + (k0 + 8 * g + (q >> 2)) * MST + (col0 + 4 * (q & 3)) * 2;
    const v4i16 lo = __builtin_amdgcn_ds_read_tr16_b64_v4i16((LAS v4i16*)p), hi = __builtin_amdgcn_ds_read_tr16_b64_v4i16((LAS v4i16*)(p + 4 * MST));
    return (bf16x8){lo[0], lo[1], lo[2], lo[3], hi[0], hi[1], hi[2], hi[3]};
}
#define MFMA16(a, b, c) __builtin_amdgcn_mfma_f32_16x16x32_bf16((a), (b), (c), 0, 0, 0)
__device__ __forceinline__ f32x4 mm_nn(const LAS unsigned char* X, const LAS unsigned char* Y, int ti, int tj, int q, int g, f32x4 c) {
    c = MFMA16(mfr_row(X, 16 * ti + q, 0, g), mfr_tr(Y, 0, 16 * tj, g, q), c); return MFMA16(mfr_row(X, 16 * ti + q, 32, g), mfr_tr(Y, 32, 16 * tj, g, q), c); }
__device__ __forceinline__ f32x4 mm_nt(const LAS unsigned char* X, const LAS unsigned char* Yt, int ti, int tj, int q, int g, f32x4 c) {
    c = MFMA16(mfr_row(X, 16 * ti + q, 0, g), mfr_row(Yt, 16 * tj + q, 0, g), c); return MFMA16(mfr_row(X, 16 * ti + q, 32, g), mfr_row(Yt, 16 * tj + q, 32, g), c); }
__device__ __forceinline__ f32x4 mm_tn(const LAS unsigned char* Xt, const LAS unsigned char* Y, int ti, int tj, int q, int g, f32x4 c) {
    c = MFMA16(mfr_tr(Xt, 0, 16 * ti, g, q), mfr_tr(Y, 0, 16 * tj, g, q), c); return MFMA16(mfr_tr(Xt, 32, 16 * ti, g, q), mfr_tr(Y, 32, 16 * tj, g, q), c); }
typedef float f32x2_t __attribute__((ext_vector_type(2))); typedef __bf16 bf16x2_t __attribute__((ext_vector_type(2)));
__device__ __forceinline__ unsigned cvtpk(float lo, float hi) { f32x2_t v = {lo, hi}; bf16x2_t b = __builtin_convertvector(v, bf16x2_t); return __builtin_bit_cast(unsigned, b); }
__device__ __forceinline__ void mst_tile_t(LAS unsigned char* M, int ti, int tj, int q, int g, f32x4 c) {
    *(LAS unsigned long long*)(M + (16 * tj + q) * MST + (16 * ti + 4 * g) * 2) = (unsigned long long)cvtpk(c[0], c[1]) | ((unsigned long long)cvtpk(c[2], c[3]) << 32);
}
#define SC_BAR() do { asm volatile("s_waitcnt lgkmcnt(0)" ::: "memory"); __builtin_amdgcn_s_barrier(); asm volatile("" ::: "memory"); } while (0)
__device__ __forceinline__ void scan_units(const Args& args, int l, LAS unsigned char* lds, int vcu, int G) {
    int tid_ = threadIdx.x; asm volatile("" : "+v"(tid_)); const int tid = tid_, lane = tid & 63, wave = __builtin_amdgcn_readfirstlane(tid >> 6);
    unsigned char* ws = args.ws;
    const float* Rr = (const float*)(ws + WS_R); const float* Ww = (const float*)(ws + WS_W); const float* Kk = (const float*)(ws + WS_K); const float* Vv = (const float*)(ws + WS_V);
    const float* Aa = (const float*)(ws + WS_A); const float* Bb = (const float*)(ws + WS_B); float* Y = (float*)(ws + WS_Y);
    LAS unsigned char* iA = lds + 0 * MSLOT; LAS unsigned char* iR = lds + 1 * MSLOT; LAS unsigned char* iB = lds + 2 * MSLOT; LAS unsigned char* iK = lds + 3 * MSLOT;
    LAS unsigned char* iBh = lds + 4 * MSLOT; LAS unsigned char* iKh = lds + 5 * MSLOT; LAS unsigned char* iV = lds + 6 * MSLOT; LAS unsigned char* iS = lds + 7 * MSLOT;
    LAS unsigned char* iAak = lds + 8 * MSLOT; LAS unsigned char* iArb = lds + 9 * MSLOT; LAS unsigned char* iArk = lds + 10 * MSLOT; LAS unsigned char* iQa = lds + 11 * MSLOT;
    LAS unsigned char* iTa = lds + 12 * MSLOT; LAS unsigned char* iTb = lds + 13 * MSLOT;
    LAS unsigned char* iQb = iB; LAS unsigned char* iRHS = iK; LAS unsigned char* iU = iQa;
    LAS float* wtot = (LAS float*)(lds + LDSCTL_OFF + 1024); LAS float* sDC = wtot + 8 * 64;
    static_assert(14 * MSLOT <= RING_BYTES && LDSCTL_OFF + 1024 + 9 * 64 * 4 <= LDS_BYTES, "scan LDS map");
    const int q = lane & 15, g = lane >> 4, ti = wave >> 1, tj0 = 2 * (wave & 1);
    constexpr int C = 64, NCH = SEQ / C;
    for (int u = vcu; u < PBATCH * 16; u += G) {
        const int b = u >> 4, h = u & 15;
        const size_t base0 = (size_t)(b * SEQ + 8 * wave) * DRW + h * 64 + lane;
        float rw[8], rk[8], ra[8], rb[8], rr[8], rv[8];
#pragma unroll
        for (int i = 0; i < 8; ++i) { const size_t o = base0 + (size_t)i * DRW; rw[i] = Ww[o]; rk[i] = Kk[o]; ra[i] = Aa[o]; rb[i] = Bb[o]; rr[i] = Rr[o]; rv[i] = Vv[o]; }
        f32x4 Sreg[2], Treg[2];
#pragma unroll
        for (int t2 = 0; t2 < 2; ++t2) Sreg[t2] = (f32x4){0.f, 0.f, 0.f, 0.f};
        __syncthreads();
        for (int i = tid; i < 64 * 36; i += NTHR) ((LAS unsigned*)iS)[i] = 0u;
        for (int c = 0; c < NCH; ++c) {
            float p[8]; p[0] = rw[0];
#pragma unroll
            for (int i = 1; i < 8; ++i) p[i] = p[i - 1] * rw[i];
            wtot[wave * 64 + lane] = p[7];
            SC_BAR();
            float pre = 1.f, dc = 1.f;
#pragma unroll
            for (int w2 = 0; w2 < 8; ++w2) { const float x = wtot[w2 * 64 + lane]; dc *= x; if (w2 < wave) pre *= x; }
            if (wave == 0) sDC[lane] = dc;
            { float xa[8], xr[8], xb[8], xk[8], xbh[8], xkh[8];
#pragma unroll
              for (int i = 0; i < 8; ++i) { const float Dt = pre * p[i], Dm = (i == 0) ? pre : pre * p[i - 1], inv = __builtin_amdgcn_rcpf(Dt), sc = dc * inv;
                  xa[i] = ra[i] * Dm; xr[i] = rr[i] * Dt; xb[i] = rb[i] * inv; xk[i] = rk[i] * inv; xbh[i] = rb[i] * sc; xkh[i] = rk[i] * sc; }
              const int o = lane * MST + 16 * wave;
#define SC_W8(img, x) *(LAS v4u*)((img) + o) = (v4u){cvtpk(x[0], x[1]), cvtpk(x[2], x[3]), cvtpk(x[4], x[5]), cvtpk(x[6], x[7])}
              SC_W8(iA, xa); SC_W8(iR, xr); SC_W8(iB, xb); SC_W8(iK, xk); SC_W8(iBh, xbh); SC_W8(iKh, xkh); SC_W8(iV, rv);
#undef SC_W8
            }
            if (c + 1 < NCH) {
#pragma unroll
                for (int i = 0; i < 8; ++i) { const size_t o = base0 + (size_t)((c + 1) * C + i) * DRW; rw[i] = Ww[o]; rk[i] = Kk[o]; ra[i] = Aa[o]; rb[i] = Bb[o]; rr[i] = Rr[o]; rv[i] = Vv[o]; }
            }
            SC_BAR();
#define FR_ROW2(dst, M, row) do { dst[0] = mfr_row(M, (row), 0, g); dst[1] = mfr_row(M, (row), 32, g); } while (0)
#define FR_TR2(dst, M, col0) do { dst[0] = mfr_tr(M, 0, (col0), g, q); dst[1] = mfr_tr(M, 32, (col0), g, q); } while (0)
#define MM2(c, a, b) MFMA16(a[1], b[1], MFMA16(a[0], b[0], (c)))
            const f32x4 z4 = (f32x4){0.f, 0.f, 0.f, 0.f};
            { bf16x8 aA[2], aR[2], bB[2][2], bK[2][2];
              FR_TR2(aA, iA, 16 * ti); FR_TR2(aR, iR, 16 * ti);
#pragma unroll
              for (int t2 = 0; t2 < 2; ++t2) { FR_TR2(bB[t2], iB, 16 * (tj0 + t2)); FR_TR2(bK[t2], iK, 16 * (tj0 + t2)); }
#pragma unroll
              for (int t2 = 0; t2 < 2; ++t2) { const int tj = tj0 + t2;
                f32x4 aab = MM2(z4, aA, bB[t2]), aak = MM2(z4, aA, bK[t2]), arb = MM2(z4, aR, bB[t2]), ark = MM2(z4, aR, bK[t2]);
#pragma unroll
                for (int e = 0; e < 4; ++e) { const int t = 16 * ti + 4 * g + e, s = 16 * tj + q; if (!(s < t)) { aab[e] = 0.f; aak[e] = 0.f; } if (!(s <= t)) { arb[e] = 0.f; ark[e] = 0.f; } }
                mst_tile_t(iQa, ti, tj, q, g, aab); mst_tile_t(iAak, ti, tj, q, g, aak); mst_tile_t(iArb, ti, tj, q, g, arb); mst_tile_t(iArk, ti, tj, q, g, ark);
#pragma unroll
                for (int e = 0; e < 4; ++e) if (16 * ti + 4 * g + e == 16 * tj + q) aab[e] += 1.0f;
                Treg[t2] = aab; mst_tile_t(iTa, ti, tj, q, g, aab); } }
            SC_BAR();
            { bf16x8 aQ[2], bQ[2][2], aA[2], bS[2][2], aK[2], bV[2][2];
              FR_TR2(aQ, iQa, 16 * ti); FR_TR2(aA, iA, 16 * ti); FR_TR2(aK, iAak, 16 * ti);
#pragma unroll
              for (int t2 = 0; t2 < 2; ++t2) { FR_ROW2(bQ[t2], iQa, 16 * (tj0 + t2) + q); FR_ROW2(bS[t2], iS, 16 * (tj0 + t2) + q); FR_ROW2(bV[t2], iV, 16 * (tj0 + t2) + q); }
#pragma unroll
              for (int t2 = 0; t2 < 2; ++t2) { const int tj = tj0 + t2;
                mst_tile_t(iQb, ti, tj, q, g, MM2(z4, aQ, bQ[t2])); mst_tile_t(iRHS, ti, tj, q, g, MM2(MM2(z4, aA, bS[t2]), aK, bV[t2])); } }
            SC_BAR();
#define SC_LEVEL(Qin, Qout, Tin, Tout, doq) do { bf16x8 aQ[2], bQ[2][2], aT[2]; FR_TR2(aQ, Qin, 16 * ti); FR_TR2(aT, Tin, 16 * ti); \
                _Pragma("unroll") for (int t2 = 0; t2 < 2; ++t2) FR_ROW2(bQ[t2], Qin, 16 * (tj0 + t2) + q); \
                _Pragma("unroll") for (int t2 = 0; t2 < 2; ++t2) { const int tj = tj0 + t2; \
                    if (doq) mst_tile_t(Qout, ti, tj, q, g, MM2(z4, aQ, bQ[t2])); \
                    Treg[t2] = MM2(Treg[t2], aT, bQ[t2]); mst_tile_t(Tout, ti, tj, q, g, Treg[t2]); } SC_BAR(); } while (0)
            SC_LEVEL(iQb, iQa, iTa, iTb, true);
            SC_LEVEL(iQa, iQb, iTb, iTa, true);
            SC_LEVEL(iQb, iQa, iTa, iTb, true);
            SC_LEVEL(iQa, iQb, iTb, iTa, true);
            SC_LEVEL(iQb, iQa, iTa, iTb, false);
#undef SC_LEVEL
            { bf16x8 aT[2], bR[2][2]; FR_TR2(aT, iTb, 16 * ti);
#pragma unroll
              for (int t2 = 0; t2 < 2; ++t2) FR_ROW2(bR[t2], iRHS, 16 * (tj0 + t2) + q);
#pragma unroll
              for (int t2 = 0; t2 < 2; ++t2) mst_tile_t(iU, ti, tj0 + t2, q, g, MM2(z4, aT, bR[t2])); }
            SC_BAR();
            { bf16x8 aRt[2], aArb[2], aArk[2], aBh[2], aKh[2], bS[2][2], bU[2][2], bV[2][2];
              FR_TR2(aRt, iR, 16 * ti); FR_TR2(aArb, iArb, 16 * ti); FR_TR2(aArk, iArk, 16 * ti); FR_ROW2(aBh, iBh, 16 * ti + q); FR_ROW2(aKh, iKh, 16 * ti + q);
#pragma unroll
              for (int t2 = 0; t2 < 2; ++t2) { FR_ROW2(bS[t2], iS, 16 * (tj0 + t2) + q); FR_ROW2(bU[t2], iU, 16 * (tj0 + t2) + q); FR_ROW2(bV[t2], iV, 16 * (tj0 + t2) + q); }
              const f32x4 dcv = *(const LAS f32x4*)(sDC + 16 * ti + 4 * g);
#pragma unroll
              for (int t2 = 0; t2 < 2; ++t2) { const int tj = tj0 + t2;
                const f32x4 y = MM2(MM2(MM2(z4, aRt, bS[t2]), aArb, bU[t2]), aArk, bV[t2]);
                float* yp = Y + (size_t)(b * SEQ + c * C + 16 * ti + 4 * g) * DRW + h * 64 + 16 * tj + q;
#pragma unroll
                for (int e = 0; e < 4; ++e) yp[(size_t)e * DRW] = y[e];
                Sreg[t2] = MM2(MM2(Sreg[t2] * dcv, aBh, bU[t2]), aKh, bV[t2]); } }
            SC_BAR();
#undef FR_ROW2
#undef FR_TR2
#undef MM2
#pragma unroll
            for (int t2 = 0; t2 < 2; ++t2) mst_tile_t(iS, ti, tj0 + t2, q, g, Sreg[t2]);
        }
#pragma unroll
        for (int t2 = 0; t2 < 2; ++t2) { const int tj = tj0 + t2;
            *(f32x4*)(args.out + O_WP + ((((size_t)l * PBATCH + b) * 16 + h) * 64 + 16 * tj + q) * 64 + 16 * ti + 4 * g) = Sreg[t2]; }
        __syncthreads();
    }
}
#undef SC_BAR
__device__ __forceinline__ void sample_wkv_units(const Args& args, int l, int vcu, int G) {
    int tid_ = threadIdx.x; asm volatile("" : "+v"(tid_)); const int tid = tid_, lane = tid & 63, wave = __builtin_amdgcn_readfirstlane(tid >> 6); const int gw = vcu * NWAVES + wave, NGW = G * NWAVES; (void)tid; (void)lane; (void)wave; (void)gw; (void)NGW;
    unsigned char* ws = args.ws;
    const float* Rr = (const float*)(ws + WS_R); const float* Ww = (const float*)(ws + WS_W); const float* Kk = (const float*)(ws + WS_K); const float* Vv = (const float*)(ws + WS_V);
    const float* Aa = (const float*)(ws + WS_A); const float* Bb = (const float*)(ws + WS_B); float* Y = (float*)(ws + WS_Y);
    for (int u = gw; u < 128; u += NGW) {
        const int b = u >> 4, h = u & 15; const size_t vo = (size_t)(MP + b) * DRW + h * 64;
        const float* Sp = args.in[I_SWKV] + ((((size_t)l * 8 + b) * 16 + h) * 64 + lane) * 64;
        float* So = args.out + O_WS + ((((size_t)l * 8 + b) * 16 + h) * 64 + lane) * 64;
        f32x4 S[16];
#pragma unroll
        for (int j = 0; j < 16; ++j) S[j] = *(const f32x4*)(Sp + 4 * j);
        float sa = 0.f;
#pragma unroll
        for (int j = 0; j < 16; ++j) { const f32x4 a4 = *(const f32x4*)(Aa + vo + 4 * j); sa += (S[j].x * a4.x + S[j].y * a4.y) + (S[j].z * a4.z + S[j].w * a4.w); }
        const float vi = Vv[vo + lane]; float y = 0.f;
#pragma unroll
        for (int j = 0; j < 16; ++j) { const f32x4 w4 = *(const f32x4*)(Ww + vo + 4 * j), k4 = *(const f32x4*)(Kk + vo + 4 * j), b4 = *(const f32x4*)(Bb + vo + 4 * j), r4 = *(const f32x4*)(Rr + vo + 4 * j);
            f32x4 s = S[j] * w4 + (b4 * sa + k4 * vi); y += (s.x * r4.x + s.y * r4.y) + (s.z * r4.z + s.w * r4.w); *(f32x4*)(So + 4 * j) = s; }
        Y[vo + lane] = y;
    }
}
typedef short v4i16_t __attribute__((ext_vector_type(4)));
typedef float f32x4v __attribute__((ext_vector_type(4)));
__device__ __forceinline__ void attn_units(const Args& args, int l, LAS unsigned char* lds, int vcu, int G) {
    int tid_ = threadIdx.x; asm volatile("" : "+v"(tid_)); const int tid = tid_, lane = tid & 63, wave = __builtin_amdgcn_readfirstlane(tid >> 6); const int gw = vcu * NWAVES + wave, NGW = G * NWAVES; (void)tid; (void)lane; (void)wave; (void)gw; (void)NGW;
    unsigned char* ws = args.ws;
    const bf16* QB = (const bf16*)(ws + WS_QB); const bf16* KB = (const bf16*)(ws + WS_KB); const bf16* VB = (const bf16*)(ws + WS_VB);
    bf16* OBR = (bf16*)(ws + WS_OBR); float* LSE = (float*)(ws + WS_LSE); const float* BT = (const float*)(ws + WS_BT);
    constexpr int KST = 144, VST = 160;
    LAS unsigned char* Kt = lds; LAS unsigned char* Vt = lds + 256 * KST; LAS float* btab = (LAS float*)(lds + 256 * KST + 256 * VST);
    const int q = lane & 15, g = lane >> 4;
    constexpr int NA_S = 0, NA_O = 16; static_assert(64 * NA_S + 192 * NA_O == PBATCH * NHEADS * 48, "attention unit deal");
    const bool deal = (G == 256); const int ufirst = deal ? ((vcu < 64) ? vcu * NA_S : 64 * NA_S + (vcu - 64) * NA_O) : vcu, ucnt = deal ? ((vcu < 64) ? NA_S : NA_O) : (PBATCH * NHEADS * 48 - vcu + G - 1) / G, ustep = deal ? 1 : G;
    for (int ui = 0; ui < ucnt; ++ui) { const int u = ufirst + ui * ustep;
        const int rn = u & 15, br = (u >> 4) % 3, h = (u / 48) & 15, b = u / 768;
        const int dsh = 2 * br, dil = 1 << dsh, r = rn & (dil - 1), n = rn >> dsh;
        __syncthreads();
        for (int i = tid; i < 2048; i += NTHR) { const int row = i >> 3, chk = i & 7, sk = (n - 1) * 128 + row; v4u kv = (v4u){0u, 0u, 0u, 0u}, vv = (v4u){0u, 0u, 0u, 0u};
            if (sk >= 0) { const size_t go = ((size_t)(b * SEQ + sk * dil + r)) * DATT + h * 64 + chk * 8; kv = *(const v4u*)(KB + go); vv = *(const v4u*)(VB + go); }
            *(LAS v4u*)(Kt + row * KST + chk * 16) = kv; *(LAS v4u*)(Vt + row * VST + chk * 16) = vv; }
        if (tid < 129) btab[tid] = BT[(br * 129 + tid) * 16 + h];
        __syncthreads();
        const int iq = 16 * wave + q, mq = b * SEQ + (n * 128 + iq) * dil + r;
        const bf16x8 qf0 = *(const bf16x8*)(QB + (size_t)mq * DATT + h * 64 + 8 * g), qf1 = *(const bf16x8*)(QB + (size_t)mq * DATT + h * 64 + 32 + 8 * g);
        const int kb0 = wave >> 1;
        f32x4 sacc[10];
#pragma unroll
        for (int sb = 0; sb < 10; ++sb) { const int key0 = 32 * kb0 + 16 * sb;
            const bf16x8 a0 = *(const LAS bf16x8*)(Kt + (key0 + q) * KST + 16 * g), a1 = *(const LAS bf16x8*)(Kt + (key0 + q) * KST + 64 + 16 * g);
            f32x4 acc = (f32x4){0.f, 0.f, 0.f, 0.f};
            acc = __builtin_amdgcn_mfma_f32_16x16x32_bf16(a0, qf0, acc, 0, 0, 0); acc = __builtin_amdgcn_mfma_f32_16x16x32_bf16(a1, qf1, acc, 0, 0, 0); sacc[sb] = acc; }
        float mx = -INFINITY;
#pragma unroll
        for (int sb = 0; sb < 10; ++sb)
#pragma unroll
            for (int e = 0; e < 4; ++e) { const int jj = 32 * kb0 + 16 * sb + 4 * g + e, dsub = 128 + iq - jj, sk = (n - 1) * 128 + jj;
                const bool ok = (dsub >= 0) && (dsub <= 128) && (sk >= 0);
                const float s = ok ? sacc[sb][e] * ATT_SCALE + btab[ok ? dsub : 0] : -INFINITY; sacc[sb][e] = s; mx = fmaxf(mx, s); }
        mx = fmaxf(mx, __shfl_xor(mx, 16)); mx = fmaxf(mx, __shfl_xor(mx, 32));
        float sum = 0.f;
#pragma unroll
        for (int sb = 0; sb < 10; ++sb)
#pragma unroll
            for (int e = 0; e < 4; ++e) { const float p = __expf(sacc[sb][e] - mx); sacc[sb][e] = p; sum += p; }
        sum += __shfl_xor(sum, 16); sum += __shfl_xor(sum, 32);
        f32x4 o[4];
#pragma unroll
        for (int c = 0; c < 4; ++c) o[c] = (f32x4){0.f, 0.f, 0.f, 0.f};
#pragma unroll
        for (int kk = 0; kk < 5; ++kk) {
            v4u pw; pw.x = pk2(sacc[2 * kk][0], sacc[2 * kk][1]); pw.y = pk2(sacc[2 * kk][2], sacc[2 * kk][3]); pw.z = pk2(sacc[2 * kk + 1][0], sacc[2 * kk + 1][1]); pw.w = pk2(sacc[2 * kk + 1][2], sacc[2 * kk + 1][3]);
            const bf16x8 pb = __builtin_bit_cast(bf16x8, pw);
            const int R0 = 32 * (kb0 + kk) + 4 * g + (q >> 2);
#pragma unroll
            for (int c = 0; c < 4; ++c) {
                const v4i16_t lo = __builtin_amdgcn_ds_read_tr16_b64_v4i16((LAS v4i16_t*)(Vt + R0 * VST + (16 * c + 4 * (q & 3)) * 2));
                const v4i16_t hi = __builtin_amdgcn_ds_read_tr16_b64_v4i16((LAS v4i16_t*)(Vt + (R0 + 16) * VST + (16 * c + 4 * (q & 3)) * 2));
                const bf16x8 va = (bf16x8){lo[0], lo[1], lo[2], lo[3], hi[0], hi[1], hi[2], hi[3]};
                o[c] = __builtin_amdgcn_mfma_f32_16x16x32_bf16(va, pb, o[c], 0, 0, 0); }
        }
        const float inv = 1.0f / sum;
        bf16* op = OBR + ((size_t)br * MP + mq) * DATT + h * 64 + 4 * g;
#pragma unroll
        for (int c = 0; c < 4; ++c) { const unsigned long long w = (unsigned long long)pk2(o[c][0] * inv, o[c][1] * inv) | ((unsigned long long)pk2(o[c][2] * inv, o[c][3] * inv) << 32); *(unsigned long long*)(op + 16 * c) = w; }
        if (g == 0) LSE[((size_t)br * MP + mq) * 16 + h] = mx + __logf(sum);
    }
}
__device__ __forceinline__ void sample_attn_units(const Args& args, int l, LAS unsigned char* lds, int vcu, int G) {
    int tid_ = threadIdx.x; asm volatile("" : "+v"(tid_)); const int tid = tid_, lane = tid & 63, wave = __builtin_amdgcn_readfirstlane(tid >> 6); const int gw = vcu * NWAVES + wave, NGW = G * NWAVES; (void)tid; (void)lane; (void)wave; (void)gw; (void)NGW;
    unsigned char* ws = args.ws;
    const bf16* QB = (const bf16*)(ws + WS_QB); bf16* MIX = (bf16*)(ws + WS_MIX); const float* BT = (const float*)(ws + WS_BT);
    LAS float* pl = (LAS float*)(lds + 90112) + wave * 448;
    for (int u = gw; u < 128; u += NGW) {
        const int b = u >> 4, h = u & 15, m = MP + b;
        float qv[64];
#pragma unroll
        for (int j = 0; j < 8; ++j) { const v4u w = *(const v4u*)(QB + (size_t)m * DATT + h * 64 + 8 * j);
            qv[8 * j + 0] = bf2f((unsigned short)(w.x & 0xffff)); qv[8 * j + 1] = bf2f((unsigned short)(w.x >> 16)); qv[8 * j + 2] = bf2f((unsigned short)(w.y & 0xffff)); qv[8 * j + 3] = bf2f((unsigned short)(w.y >> 16));
            qv[8 * j + 4] = bf2f((unsigned short)(w.z & 0xffff)); qv[8 * j + 5] = bf2f((unsigned short)(w.z >> 16)); qv[8 * j + 6] = bf2f((unsigned short)(w.w & 0xffff)); qv[8 * j + 7] = bf2f((unsigned short)(w.w >> 16)); }
        const float* knew = args.out + O_KS + ((size_t)l * 8 + b) * DATT + h * 64; const float* vnew = args.out + O_VS + ((size_t)l * 8 + b) * DATT + h * 64;
        const float* kc = args.in[I_CK] + (((size_t)l * 8 + b) * 2048) * 1024 + h * 64; const float* vc = args.in[I_CV] + (((size_t)l * 8 + b) * 2048) * 1024 + h * 64;
        float mx = -INFINITY;
        for (int it = 0; it < 7; ++it) { const int kk = lane + 64 * it;
            if (kk < 387) { const int br = kk / 129, mm = kk % 129; const float* kp = (mm == 0) ? knew : kc + (size_t)(2048 - (mm << (2 * br))) * 1024;
                float d = 0.f;
#pragma unroll
                for (int j = 0; j < 16; ++j) { const f32x4 k4 = *(const f32x4*)(kp + 4 * j); d += (qv[4 * j] * k4.x + qv[4 * j + 1] * k4.y) + (qv[4 * j + 2] * k4.z + qv[4 * j + 3] * k4.w); }
                const float s = d * ATT_SCALE + BT[(br * 129 + mm) * 16 + h]; pl[kk] = s; mx = fmaxf(mx, s); } }
        mx = wave_max(mx);
        float sum = 0.f;
        for (int it = 0; it < 7; ++it) { const int kk = lane + 64 * it; if (kk < 387) { const float p = __expf(pl[kk] - mx); pl[kk] = p; sum += p; } }
        sum = wave_sum(sum);
        f32x4 o4 = (f32x4){0.f, 0.f, 0.f, 0.f}; const int kg = lane >> 4, dq = lane & 15;
#pragma unroll 8
        for (int i = 0; i < 97; ++i) { const int kk = kg + 4 * i; if (kk < 387) { const int br = kk / 129, mm = kk % 129; const float* vp = (mm == 0) ? vnew : vc + (size_t)(2048 - (mm << (2 * br))) * 1024;
            o4 += *(const f32x4*)(vp + 4 * dq) * pl[kk]; } }
#pragma unroll
        for (int e = 0; e < 4; ++e) { o4[e] += __shfl_xor(o4[e], 16); o4[e] += __shfl_xor(o4[e], 32); }
        if (kg == 0) { const float inv = 1.0f / sum; *(unsigned long long*)(MIX + (size_t)m * DM + h * 64 + 4 * dq) = (unsigned long long)pk2(o4.x * inv, o4.y * inv) | ((unsigned long long)pk2(o4.z * inv, o4.w * inv) << 32); }
    }
}

__device__ __forceinline__ void mx_phase(const Args& args, int l, int vcu, int G) {
    int tid_ = threadIdx.x; asm volatile("" : "+v"(tid_)); const int tid = tid_, lane = tid & 63, wave = __builtin_amdgcn_readfirstlane(tid >> 6); const int gw = vcu * NWAVES + wave, NGW = G * NWAVES; (void)tid; (void)lane; (void)wave; (void)gw; (void)NGW;
    unsigned char* ws = args.ws;
    const bf16* OBR = (const bf16*)(ws + WS_OBR); const float* LSE = (const float*)(ws + WS_LSE); bf16* MIX = (bf16*)(ws + WS_MIX);
    const float* Rr = (const float*)(ws + WS_R); const float* Kk = (const float*)(ws + WS_K); const float* Vv = (const float*)(ws + WS_V); const float* Gg = (const float*)(ws + WS_G); const float* Y = (const float*)(ws + WS_Y);
    const int hh = lane >> 2, p = lane & 3, c0 = hh * 64 + p * 16;
    f32x4 lng[4], lnb[4], rk[4];
#pragma unroll
    for (int j = 0; j < 4; ++j) { lng[j] = *(const f32x4*)(args.in[I_LNG] + (size_t)l * DRW + c0 + 4 * j); lnb[j] = *(const f32x4*)(args.in[I_LNB] + (size_t)l * DRW + c0 + 4 * j); rk[j] = *(const f32x4*)(args.in[I_RK] + (size_t)l * DRW + c0 + 4 * j); }
    for (int m = gw; m < NROWS; m += NGW) {
        if (m < MP) {
            const float l0 = LSE[((size_t)0 * MP + m) * 16 + hh], l1 = LSE[((size_t)1 * MP + m) * 16 + hh], l2 = LSE[((size_t)2 * MP + m) * 16 + hh];
            const float mx = fmaxf(l0, fmaxf(l1, l2)); float e0 = __expf(l0 - mx), e1 = __expf(l1 - mx), e2 = __expf(l2 - mx); const float inv = 1.0f / (e0 + e1 + e2); e0 *= inv; e1 *= inv; e2 *= inv;
            float acc[16];
#pragma unroll
            for (int i = 0; i < 16; ++i) acc[i] = 0.f;
#pragma unroll
            for (int br = 0; br < 3; ++br) { const float al = br == 0 ? e0 : br == 1 ? e1 : e2;
#pragma unroll
                for (int j = 0; j < 2; ++j) { const v4u w = *(const v4u*)(OBR + ((size_t)br * MP + m) * DATT + c0 + 8 * j);
                    acc[8 * j + 0] += al * bf2f((unsigned short)(w.x & 0xffff)); acc[8 * j + 1] += al * bf2f((unsigned short)(w.x >> 16)); acc[8 * j + 2] += al * bf2f((unsigned short)(w.y & 0xffff)); acc[8 * j + 3] += al * bf2f((unsigned short)(w.y >> 16));
                    acc[8 * j + 4] += al * bf2f((unsigned short)(w.z & 0xffff)); acc[8 * j + 5] += al * bf2f((unsigned short)(w.z >> 16)); acc[8 * j + 6] += al * bf2f((unsigned short)(w.w & 0xffff)); acc[8 * j + 7] += al * bf2f((unsigned short)(w.w >> 16)); } }
            v4u o0, o1; o0.x = pk2(acc[0], acc[1]); o0.y = pk2(acc[2], acc[3]); o0.z = pk2(acc[4], acc[5]); o0.w = pk2(acc[6], acc[7]); o1.x = pk2(acc[8], acc[9]); o1.y = pk2(acc[10], acc[11]); o1.z = pk2(acc[12], acc[13]); o1.w = pk2(acc[14], acc[15]);
            *(v4u*)(MIX + (size_t)m * DM + c0) = o0; *(v4u*)(MIX + (size_t)m * DM + c0 + 8) = o1;
        }
        const size_t ro = (size_t)m * DRW + c0;
        f32x4 y[4], rr[4], kk[4], vv[4], gg[4];
        float s = 0.f, bon = 0.f;
#pragma unroll
        for (int j = 0; j < 4; ++j) { y[j] = *(const f32x4*)(Y + ro + 4 * j); rr[j] = *(const f32x4*)(Rr + ro + 4 * j); kk[j] = *(const f32x4*)(Kk + ro + 4 * j); vv[j] = *(const f32x4*)(Vv + ro + 4 * j); gg[j] = *(const f32x4*)(Gg + ro + 4 * j);
            s += (y[j].x + y[j].y) + (y[j].z + y[j].w); const f32x4 t = rr[j] * kk[j] * rk[j]; bon += (t.x + t.y) + (t.z + t.w); }
        s += __shfl_xor(s, 1); s += __shfl_xor(s, 2); bon += __shfl_xor(bon, 1); bon += __shfl_xor(bon, 2);
        const float mean = s * (1.0f / 64.0f); float qq = 0.f;
#pragma unroll
        for (int j = 0; j < 4; ++j) { y[j] = y[j] - mean; qq += (y[j].x * y[j].x + y[j].y * y[j].y) + (y[j].z * y[j].z + y[j].w * y[j].w); }
        qq += __shfl_xor(qq, 1); qq += __shfl_xor(qq, 2);
        const float rstd = 1.0f / sqrtf(qq * (1.0f / 64.0f) + GN_EPS);
        v4u o0, o1; f32x4 z[4];
#pragma unroll
        for (int j = 0; j < 4; ++j) z[j] = ((y[j] * rstd) * lng[j] + lnb[j] + vv[j] * bon) * gg[j];
        o0.x = pk2(z[0].x, z[0].y); o0.y = pk2(z[0].z, z[0].w); o0.z = pk2(z[1].x, z[1].y); o0.w = pk2(z[1].z, z[1].w); o1.x = pk2(z[2].x, z[2].y); o1.y = pk2(z[2].z, z[2].w); o1.z = pk2(z[3].x, z[3].y); o1.w = pk2(z[3].z, z[3].w);
        *(v4u*)(MIX + (size_t)m * DM + DATT + c0) = o0; *(v4u*)(MIX + (size_t)m * DM + DATT + c0 + 8) = o1;
    }
}

template <int K> __device__ __forceinline__ void sample_proj(const bf16* A, const bf16* Bt, const float* base_s, float* out_s, const float* gate, LAS unsigned char* lds, int vcu, int G) {
    int tid_ = threadIdx.x; asm volatile("" : "+v"(tid_)); const int tid = tid_, lane = tid & 63, wave = __builtin_amdgcn_readfirstlane(tid >> 6);
    constexpr int KW = K / 8, NS = KW / 32; static_assert(KW % 32 == 0, "K split");
    LAS float* part = (LAS float*)lds;
    const int c = lane & 15, g = lane >> 4;
    for (int cg = vcu; cg < DM / 8; cg += G) {
        const int n0 = 8 * cg;
        const bf16* ap = A + (size_t)(MP + (c & 7)) * K + wave * KW + 8 * g; const bf16* bp = Bt + (size_t)(n0 + (c & 7)) * K + wave * KW + 8 * g;
        bf16x8 af[NS], bfr[NS];
#pragma unroll
        for (int s = 0; s < NS; ++s) { af[s] = *(const bf16x8*)(ap + 32 * s); bfr[s] = *(const bf16x8*)(bp + 32 * s); }
        f32x4 acc = (f32x4){0.f, 0.f, 0.f, 0.f};
#pragma unroll
        for (int s = 0; s < NS; ++s) acc = __builtin_amdgcn_mfma_f32_16x16x32_bf16(af[s], bfr[s], acc, 0, 0, 0);
        __syncthreads();
        if (g < 2 && c < 8) {
#pragma unroll
            for (int e = 0; e < 4; ++e) part[(wave * 8 + 4 * g + e) * 8 + c] = acc[e]; }
        __syncthreads();
        if (tid < 64) { const int r = tid >> 3, cc = tid & 7; float s = 0.f;
#pragma unroll
            for (int w = 0; w < 8; ++w) s += part[(w * 8 + r) * 8 + cc];
            const size_t o = (size_t)r * DM + n0 + cc; out_s[o] = base_s[o] + gate[(size_t)(4 + r) * MODW + n0 + cc] * s; }
    }
    __syncthreads();
}

__device__ __forceinline__ void n1_phase(const Args& args, int l, int vcu, int G, const float* Xp, const float* Xs, const float* modl, bf16* HB) {
    int tid_ = threadIdx.x; asm volatile("" : "+v"(tid_)); const int tid = tid_, lane = tid & 63, wave = __builtin_amdgcn_readfirstlane(tid >> 6); const int gw = vcu * NWAVES + wave, NGW = G * NWAVES; (void)tid; (void)lane; (void)wave; (void)gw; (void)NGW;
    for (int m = gw; m < NROWS + 8; m += NGW) {
        if (m < MP) { const int b = m >> 11, t = m & (SEQ - 1);
            norm_mod_row(Xp + (size_t)m * DM, args.in[I_N1G] + (size_t)l * DM, modl + (size_t)b * MODW, modl + (size_t)b * MODW + DM, HB + (size_t)m * DM,
                         (t == SEQ - 1) ? args.out + O_SP + ((size_t)l * PBATCH + b) * DM : nullptr, lane); }
        else if (m < NROWS) { const int b = m - MP;
            norm_mod_row(Xs + (size_t)b * DM, args.in[I_N1G] + (size_t)l * DM, modl + (size_t)(4 + b) * MODW, modl + (size_t)(4 + b) * MODW + DM, HB + (size_t)m * DM,
                         args.out + O_SS + ((size_t)l * 8 + b) * DM, lane); }
        else { const int b = m - NROWS; const float* s = args.in[I_SSH] + ((size_t)l * 8 + b) * DM; GAS unsigned long long* o8 = (GAS unsigned long long*)(HB + (size_t)m * DM) + lane;
#pragma unroll
            for (int j = 0; j < 8; ++j) { const f32x4 v = ((const GAS f32x4*)s)[lane + 64 * j]; o8[64 * j] = (unsigned long long)pk2(v.x, v.y) | ((unsigned long long)pk2(v.z, v.w) << 32); } }
    }
}
__device__ __forceinline__ void n2_phase(const Args& args, int l, int vcu, int G, const float* XB, const float* modl, bf16* HB) {
    int tid_ = threadIdx.x; asm volatile("" : "+v"(tid_)); const int tid = tid_, lane = tid & 63, wave = __builtin_amdgcn_readfirstlane(tid >> 6); const int gw = vcu * NWAVES + wave, NGW = G * NWAVES; (void)tid; (void)lane; (void)wave; (void)gw; (void)NGW;
    for (int m = gw; m < NROWS; m += NGW) { const int bb = (m < MP) ? (m >> 11) : 4 + (m - MP);
        norm_mod_row(XB + (size_t)m * DM, args.in[I_N2G] + (size_t)l * DM, modl + (size_t)bb * MODW + 3 * DM, modl + (size_t)bb * MODW + 4 * DM, HB + (size_t)m * DM, nullptr, lane); }
}

__global__ void __launch_bounds__(NTHR, 2) fwd(Args args) {
    extern __shared__ __attribute__((aligned(16))) unsigned char lds_raw[];
    LAS unsigned char* lds = (LAS unsigned char*)lds_raw;
    volatile LAS unsigned* MISC = (volatile LAS unsigned*)(lds + MISC_OFF);
    const int G = gridDim.x; const int bx = blockIdx.x; const int vcu = (G % 8 == 0) ? (bx % 8) * (G / 8) + bx / 8 : bx;
    unsigned char* ws = args.ws;
    for (int u = threadIdx.x; u < (LDS_BYTES - LDSCTL_OFF) / 4; u += NTHR) ((LAS unsigned*)(lds + LDSCTL_OFF))[u] = 0u;
    __syncthreads();
    const int lo = args.ph_lo, hi = args.ph_hi;
    XcdBarrier bar; bar.bar = (unsigned*)(ws + WS_CTL) + CW_BAR; bar.x = 0; bar.st = nullptr;
    if (hi - lo > 1) bar = xcd_barrier_post((unsigned*)(ws + WS_CTL) + CW_BAR, MISC + 8);
#define IN(k) (lo <= (k) && (k) < hi)
#define SEAM(k) do { if (IN(k) && IN((k) + 1)) xcd_barrier(bar); } while (0)

    if (IN(0)) { for (int rep = 0; rep < REP_P0; ++rep) { __syncthreads(); p0_prologue(args, lds, vcu, G); } }
    SEAM(0);

    float* MOD = (float*)(ws + WS_MOD);
    bf16* HB = (bf16*)(ws + WS_HB); bf16* MIX = (bf16*)(ws + WS_MIX); float* XB = (float*)(ws + WS_XB); bf16* ACT = (bf16*)(ws + WS_ACT);
    for (int l = 0; l < DEPTH; ++l) {
        const int pb = 1 + PH_PER_LAYER * l;
        const float* modl = MOD + (size_t)l * 12 * MODW;
        const float* Xp = (l == 0) ? args.in[I_XP] : XB; const float* Xs = (l == 0) ? args.in[I_XS] : XB + (size_t)MP * DM;
        if (IN(pb + 0)) { for (int rep = 0; rep < REP_N1; ++rep) { __syncthreads(); n1_phase(args, l, vcu, G, Xp, Xs, modl, HB); } }
        SEAM(pb + 0);
        if (IN(pb + 1)) {
            __syncthreads();
            pg8::Gemm g{(const pg8::bf16_t*)HB, (const pg8::bf16_t*)(ws + WS_WIN) + (size_t)l * N1 * DM, MH, N1, DM}; pg8::StaticOrder S; S.init(MH, N1, G, bx);
            pg8::EpiG1 E{(pg8::bf16_t*)(ws + WS_QB), (size_t)(WS_KB - WS_QB) / 2, (float*)(ws + WS_RKV), (float*)(ws + WS_P),
                         args.out + O_KP + (size_t)l * MP * DATT, args.out + O_KS + (size_t)l * 8 * DATT, (size_t)(O_VP - O_KP), (size_t)(O_VS - O_KS), args.in[I_QG] + l * 64, args.in[I_KG] + l * 64};
            pg8::gemm_phase<pg8::EpiG1, pg8::StaticOrder, true, true>(lds, g, S, E);
        }
        SEAM(pb + 1);
        if (IN(pb + 2)) { for (int rep = 0; rep < REP_PW; ++rep) { __syncthreads(); pw_phase(args, l, lds, vcu, G); } }
        SEAM(pb + 2);
        if (IN(pb + 3)) {
            __syncthreads();
            for (int rep = 0; rep < REP_SCAN; ++rep) { __syncthreads(); scan_units(args, l, lds, vcu, G); }
            sample_wkv_units(args, l, vcu, G);
            __syncthreads();
            for (int rep = 0; rep < REP_ATT; ++rep) { __syncthreads(); attn_units(args, l, lds, vcu, G); }
            __syncthreads();
            for (int rep = 0; rep < REP_SATT; ++rep) { __syncthreads(); sample_attn_units(args, l, lds, vcu, G); }
        }
        SEAM(pb + 3);
        if (IN(pb + 4)) { for (int rep = 0; rep < REP_MX; ++rep) mx_phase(args, l, vcu, G); }
        SEAM(pb + 4);
        if (IN(pb + 5)) {
            __syncthreads();
            sample_proj<DM>(MIX, (const bf16*)(ws + WS_WOUT) + (size_t)l * DM * DM, Xs, XB + (size_t)MP * DM, modl + 2 * DM, lds, vcu, G);
            pg8::Gemm g{(const pg8::bf16_t*)MIX, (const pg8::bf16_t*)(ws + WS_WOUT) + (size_t)l * DM * DM, MP, DM, DM}; pg8::StaticOrder S; S.init(MP, DM, G, bx);
            pg8::EpiResid E{Xp, Xs, XB, XB + (size_t)MP * DM, modl + 2 * DM};
            pg8::gemm_phase<pg8::EpiResid, pg8::StaticOrder, true, true>(lds, g, S, E);
        }
        SEAM(pb + 5);
        if (IN(pb + 6)) { for (int rep = 0; rep < REP_N2; ++rep) { __syncthreads(); n2_phase(args, l, vcu, G, XB, modl, HB); } }
        SEAM(pb + 6);
        if (IN(pb + 7)) {
            __syncthreads();
            pg8::Gemm g{(const pg8::bf16_t*)HB, (const pg8::bf16_t*)(ws + WS_WGU) + (size_t)l * 2 * FF * DM, MH, 2 * FF, DM}; pg8::StaticOrder S; S.init(MH, 2 * FF, G, bx);
            pg8::EpiSwiGLU E{(pg8::bf16_t*)ACT, FF};
            pg8::gemm_phase<pg8::EpiSwiGLU, pg8::StaticOrder, true, true>(lds, g, S, E);
        }
        SEAM(pb + 7);
        if (IN(pb + 8)) {
            __syncthreads();
            float* op = (l == DEPTH - 1) ? args.out + O_YP : XB; float* os = (l == DEPTH - 1) ? args.out + O_YS : XB + (size_t)MP * DM;
            sample_proj<FF>(ACT, (const bf16*)(ws + WS_WDN) + (size_t)l * DM * FF, XB + (size_t)MP * DM, os, modl + 5 * DM, lds, vcu, G);
            pg8::Gemm g{(const pg8::bf16_t*)ACT, (const pg8::bf16_t*)(ws + WS_WDN) + (size_t)l * DM * FF, MP, DM, FF}; pg8::StaticOrder S; S.init(MP, DM, G, bx);
            pg8::EpiResid E{XB, XB + (size_t)MP * DM, op, os, modl + 5 * DM};
            pg8::gemm_phase<pg8::EpiResid, pg8::StaticOrder, true, true>(lds, g, S, E);
        }
        SEAM(pb + 8);
    }
#undef IN
#undef SEAM
}

extern "C" void kernel_launch(void* const* d_in, const int* in_sizes, int n_in, void* d_out, int out_size, void* d_ws, size_t ws_size, hipStream_t stream) {
    static int grid = 0;
    if (grid == 0) {
        if (n_in != N_IN || (size_t)out_size != O_END || ws_size < WS_END) { fprintf(stderr, "kernel_launch: unexpected shapes: n_in %d, out %d, ws %zu (need %zu)\n", n_in, out_size, ws_size, (size_t)WS_END); grid = -1; return; }
        int dev = 0, cus = 0;
        if (hipGetDevice(&dev) != hipSuccess || hipDeviceGetAttribute(&cus, hipDeviceAttributeMultiprocessorCount, dev) != hipSuccess) { grid = -1; return; }
        if (hipFuncSetAttribute((const void*)fwd, hipFuncAttributeMaxDynamicSharedMemorySize, LDS_BYTES) != hipSuccess) { fprintf(stderr, "kernel_launch: hipFuncSetAttribute failed\n"); grid = -1; return; }
        int per_cu = 0;
        if (hipOccupancyMaxActiveBlocksPerMultiprocessor(&per_cu, (const void*)fwd, NTHR, LDS_BYTES) != hipSuccess || per_cu < 1) fprintf(stderr, "kernel_launch: occupancy query says %d blocks per CU\n", per_cu);
        (void)hipGetLastError();
        grid = cus;
    }
    if (grid < 0) return;
    if (hipMemsetAsync((char*)d_ws + WS_CTL, 0, CTL_ZERO_BYTES, stream) != hipSuccess) return;
    Args a{};
    for (int i = 0; i < N_IN; ++i) a.in[i] = (const float*)d_in[i];
    a.out = (float*)d_out; a.ws = (unsigned char*)d_ws;
#if MK_N_LAUNCHES == 1
    a.ph_lo = 0; a.ph_hi = N_PHASES;
    hipLaunchKernelGGL(fwd, dim3(grid), dim3(NTHR), LDS_BYTES, stream, a);
#else
    for (int li = 0; li < N_PHASES; ++li) { a.ph_lo = li; a.ph_hi = li + 1; hipLaunchKernelGGL(fwd, dim3(grid), dim3(NTHR), LDS_BYTES, stream, a); }
#endif
}
```

```cpp
#include <hip/hip_runtime.h>
#include <cstdio>
#include <cstdint>
#include <cmath>
namespace pg8 {
#define PG8_LAS __attribute__((address_space(3)))
typedef unsigned short bf16_t;
typedef short bf16x8 __attribute__((ext_vector_type(8)));
typedef float f32x4 __attribute__((ext_vector_type(4)));
typedef unsigned u32x4 __attribute__((ext_vector_type(4)));
constexpr int BM = 256, BK = 64, HALF = 128, HTB = HALF * BK * 2  , STAGE_BYTES = 8 * HTB, NXCD = 8, WGM = 8;

__host__ __device__ __forceinline__ int lds_byte(int r, int c) { const int st = (r >> 4) * 2 + (c >> 5), rr = r & 15, cc = c & 31, ob = rr * 64 + cc * 2; return st * 1024 + (ob ^ (((ob >> 9) & 1) << 5)); }
__host__ __device__ __forceinline__ void stage_rc(int b, int& R, int& C) { const int st = b / 1024, sb = b % 1024, swz = sb ^ (((sb >> 9) & 1) << 5); R = (st >> 1) * 16 + swz / 64; C = (st & 1) * 32 + (swz % 64) / 2; }
__host__ __device__ __forceinline__ int perm32(int rho) { const int n = rho >> 4, i = rho & 15; return 8 * (i >> 2) + 4 * n + (i & 3); }

struct Unit { int pm, pn; };
struct Gemm { const bf16_t* A; const bf16_t* Bt; int M, N, K; };

struct StaticOrder {
    int nM, nN, nwg, G, c;
    __host__ __device__ void init(int M, int N, int G_, int c_) { nM = M / BM; nN = N / BM; nwg = nM * nN; G = G_; c = c_; }
    __host__ __device__ bool next(int i, Unit& u) const {
        const long L = (long)i * G + c; if (L >= nwg) return false;
        int wgid = (int)L; { const int q = nwg / NXCD, r = nwg % NXCD, xcd = wgid % NXCD, off = wgid / NXCD; wgid = (xcd < r ? xcd * (q + 1) : r * (q + 1) + (xcd - r) * q) + off; }
        const int nig = WGM * nN, gid = wgid / nig, fm = gid * WGM, gsz = (nM - fm) < WGM ? (nM - fm) : WGM;
        u.pm = fm + ((wgid % nig) % gsz); u.pn = (wgid % nig) / gsz; return true;
    }
    __device__ __forceinline__ void a_ready(const Unit&) const {}
    __device__ __forceinline__ void done(const Unit&) const {}
};

__device__ __forceinline__ unsigned cvt_pk_bf16(float lo, float hi) { unsigned r; asm volatile("v_cvt_pk_bf16_f32 %0, %1, %2" : "=v"(r) : "v"(lo), "v"(hi)); return r; }
typedef float f32x2 __attribute__((ext_vector_type(2)));
__device__ __forceinline__ f32x2 gelu_pk(f32x2 v) {
    const f32x2 av = __builtin_elementwise_abs(v), d = av * 0.2316418882f + 1.0f;
    f32x2 t; t.x = __builtin_amdgcn_rcpf(d.x); t.y = __builtin_amdgcn_rcpf(d.y);
    f32x2 q = t * 0.5307027145f + (-0.7265760135f); q = q * t + 0.7107068705f; q = q * t + (-0.142248368f); q = q * t + 0.127414796f; q = q * t;
    const f32x2 s = (v * v) * (-0.72134752044f);
    f32x2 e; e.x = __builtin_amdgcn_exp2f(s.x); e.y = __builtin_amdgcn_exp2f(s.y);
    const f32x2 m = v * (q * e), r = v - m;
    f32x2 o; o.x = v.x < 0.f ? m.x : r.x; o.y = v.y < 0.f ? m.y : r.y; return o;
}

template <int ACT  > struct EpiBf16 {
    static constexpr bool PERM = true, AFTER_DRAIN = false; static_assert(ACT == 0 || ACT == 1, "EpiBf16: ACT is 0 (none) or 1 (gelu_pk)");
    bf16_t* O; int ldc; const float* bias; int split_cols; size_t split_stride; float scale0;
    __device__ __forceinline__ void operator()(const f32x4 (&acc)[2][2][4][2], const Unit& u, int wr, int wc, int fr, int fq) const {
        const int row0 = u.pm * BM + wr * 64 + fr; int colt = u.pn * BM; bf16_t* base = O;
        float sc = 1.f; if (split_cols) { const int t = colt / split_cols; base += (size_t)t * split_stride; colt -= t * split_cols; if (t == 0) sc = scale0; }
        const int col0 = colt + wc * 32 + 8 * fq, bcol0 = u.pn * BM + wc * 32 + 8 * fq;
        f32x4 bv[2][2];
#pragma unroll
        for (int bj = 0; bj < 2; ++bj)
#pragma unroll
            for (int n = 0; n < 2; ++n) bv[bj][n] = bias ? *(const f32x4*)(bias + bcol0 + bj * HALF + 4 * n) : (f32x4){0.f, 0.f, 0.f, 0.f};
#pragma unroll
        for (int ai = 0; ai < 2; ++ai)
#pragma unroll
            for (int m = 0; m < 4; ++m) { bf16_t* rowp = base + (size_t)(row0 + ai * HALF + m * 16) * ldc + col0;
#pragma unroll
                for (int bj = 0; bj < 2; ++bj) { f32x4 v0 = acc[ai][bj][m][0] + bv[bj][0], v1 = acc[ai][bj][m][1] + bv[bj][1];
                    if (ACT == 1) { f32x2 a = gelu_pk((f32x2){v0[0], v0[1]}), b = gelu_pk((f32x2){v0[2], v0[3]}), c = gelu_pk((f32x2){v1[0], v1[1]}), d = gelu_pk((f32x2){v1[2], v1[3]});
                        v0 = (f32x4){a.x, a.y, b.x, b.y}; v1 = (f32x4){c.x, c.y, d.x, d.y}; }
                    v0 = v0 * sc; v1 = v1 * sc; u32x4 w; w.x = cvt_pk_bf16(v0[0], v0[1]); w.y = cvt_pk_bf16(v0[2], v0[3]); w.z = cvt_pk_bf16(v1[0], v1[1]); w.w = cvt_pk_bf16(v1[2], v1[3]);
                    *(u32x4*)(rowp + bj * HALF) = w; } }
    }
};


struct EpiF32 {
    static constexpr bool PERM = false, AFTER_DRAIN = false;
    float* O; int ldc;
    __device__ __forceinline__ void operator()(const f32x4 (&acc)[2][2][4][2], const Unit& u, int wr, int wc, int fr, int fq) const {
        const int col0 = u.pn * BM + wc * 32 + 4 * fq;
#pragma unroll
        for (int ai = 0; ai < 2; ++ai)
#pragma unroll
            for (int m = 0; m < 4; ++m) { float* rowp = O + (size_t)(u.pm * BM + ai * HALF + wr * 64 + m * 16 + fr) * ldc + col0;
#pragma unroll
                for (int bj = 0; bj < 2; ++bj)
#pragma unroll
                    for (int n = 0; n < 2; ++n) *(f32x4*)(rowp + bj * HALF + n * 16) = acc[ai][bj][m][n]; }
    }
};
struct EpiResid {
    static constexpr bool PERM = false, AFTER_DRAIN = false;
    const float* base_p; const float* base_s; float* out_p; float* out_s; const float* gate;
    __device__ __forceinline__ void operator()(const f32x4 (&acc)[2][2][4][2], const Unit& u, int wr, int wc, int fr, int fq) const {
        const int col0 = u.pn * BM + wc * 32 + 4 * fq;
        if (u.pm < 32) {
            const float* g = gate + (size_t)(u.pm >> 3) * 12288 + col0;
            f32x4 gv[2][2];
#pragma unroll
            for (int bj = 0; bj < 2; ++bj)
#pragma unroll
                for (int n = 0; n < 2; ++n) gv[bj][n] = *(const f32x4*)(g + bj * HALF + n * 16);
#pragma unroll
            for (int ai = 0; ai < 2; ++ai)
#pragma unroll
                for (int m = 0; m < 4; ++m) { const size_t off = (size_t)(u.pm * BM + ai * HALF + wr * 64 + m * 16 + fr) * 2048 + col0;
#pragma unroll
                    for (int bj = 0; bj < 2; ++bj)
#pragma unroll
                        for (int n = 0; n < 2; ++n) { const f32x4 bs = *(const f32x4*)(base_p + off + bj * HALF + n * 16);
                            *(f32x4*)(out_p + off + bj * HALF + n * 16) = bs + gv[bj][n] * acc[ai][bj][m][n]; } }
        } else if (wr == 0 && fr < 8) {
            const float* g = gate + (size_t)(4 + fr) * 12288 + col0; const size_t off = (size_t)fr * 2048 + col0;
#pragma unroll
            for (int bj = 0; bj < 2; ++bj)
#pragma unroll
                for (int n = 0; n < 2; ++n) { const f32x4 gv = *(const f32x4*)(g + bj * HALF + n * 16); const f32x4 bs = *(const f32x4*)(base_s + off + bj * HALF + n * 16);
                    *(f32x4*)(out_s + off + bj * HALF + n * 16) = bs + gv * acc[0][bj][0][n]; }
        }
    }
};
struct EpiSwiGLU {
    static constexpr bool PERM = true, AFTER_DRAIN = false;
    bf16_t* O; int ldc;
    __device__ __forceinline__ void operator()(const f32x4 (&acc)[2][2][4][2], const Unit& u, int wr, int wc, int fr, int fq) const {
        const int row0 = u.pm * BM + wr * 64 + fr, col0 = u.pn * HALF + wc * 32 + 8 * fq;
#pragma unroll
        for (int ai = 0; ai < 2; ++ai)
#pragma unroll
            for (int m = 0; m < 4; ++m) { bf16_t* rowp = O + (size_t)(row0 + ai * HALF + m * 16) * ldc + col0;
                float v[8];
#pragma unroll
                for (int n = 0; n < 2; ++n)
#pragma unroll
                    for (int e = 0; e < 4; ++e) { const float g = acc[ai][0][m][n][e], up = acc[ai][1][m][n][e]; v[4 * n + e] = g * __builtin_amdgcn_rcpf(1.0f + __expf(-g)) * up; }
                u32x4 w; w.x = cvt_pk_bf16(v[0], v[1]); w.y = cvt_pk_bf16(v[2], v[3]); w.z = cvt_pk_bf16(v[4], v[5]); w.w = cvt_pk_bf16(v[6], v[7]);
                *(u32x4*)rowp = w; }
    }
};
struct EpiG1 {
    static constexpr bool PERM = true, AFTER_DRAIN = false;
    bf16_t* QB; size_t qkv_stride; bf16_t* RKV; float* P; float *okp, *oks; size_t kv_stride_p, kv_stride_s; const float *qg, *kg;
    __device__ __forceinline__ void operator()(const f32x4 (&acc)[2][2][4][2], const Unit& u, int wr, int wc, int fr, int fq) const {
        const int row0 = u.pm * BM + wr * 64 + fr;
        if (u.pn >= 24) {
            const int col0 = (u.pn - 24) * BM + wc * 32 + 8 * fq;
#pragma unroll
            for (int ai = 0; ai < 2; ++ai)
#pragma unroll
                for (int m = 0; m < 4; ++m) { float* rp = P + (size_t)(row0 + ai * HALF + m * 16) * 768 + col0;
#pragma unroll
                    for (int bj = 0; bj < 2; ++bj) { *(f32x4*)(rp + bj * HALF) = acc[ai][bj][m][0]; *(f32x4*)(rp + bj * HALF + 4) = acc[ai][bj][m][1]; } }
            return;
        }
        const int reg = u.pn >> 2, cb = (4 * (u.pn & 3) + wc) * 64 + 8 * fq;
        if (reg >= 3) {
            const int col0 = (reg - 3) * 1024 + cb;
#pragma unroll
            for (int ai = 0; ai < 2; ++ai)
#pragma unroll
                for (int m = 0; m < 4; ++m) { bf16_t* rp = RKV + (size_t)(row0 + ai * HALF + m * 16) * 3072 + col0;
#pragma unroll
                    for (int bj = 0; bj < 2; ++bj) { u32x4 w; w.x = cvt_pk_bf16(acc[ai][bj][m][0][0], acc[ai][bj][m][0][1]); w.y = cvt_pk_bf16(acc[ai][bj][m][0][2], acc[ai][bj][m][0][3]); w.z = cvt_pk_bf16(acc[ai][bj][m][1][0], acc[ai][bj][m][1][1]); w.w = cvt_pk_bf16(acc[ai][bj][m][1][2], acc[ai][bj][m][1][3]);
                        *(u32x4*)(rp + 32 * bj) = w; } }
            return;
        }
        f32x4 gn[2][2];
#pragma unroll
        for (int bj = 0; bj < 2; ++bj)
#pragma unroll
            for (int n = 0; n < 2; ++n) { const f32x4 a = *(const f32x4*)(qg + 8 * fq + 32 * bj + 4 * n), b = *(const f32x4*)(kg + 8 * fq + 32 * bj + 4 * n); gn[bj][n] = (reg == 0) ? a : b; }
        bf16_t* dstb = QB + (size_t)reg * qkv_stride;
#pragma unroll
        for (int ai = 0; ai < 2; ++ai)
#pragma unroll
            for (int m = 0; m < 4; ++m) { const int row = row0 + ai * HALF + m * 16;
                f32x4 v[2][2];
#pragma unroll
                for (int bj = 0; bj < 2; ++bj)
#pragma unroll
                    for (int n = 0; n < 2; ++n) v[bj][n] = acc[ai][bj][m][n];
                if (reg < 2) { float ss = 0.f;
#pragma unroll
                    for (int bj = 0; bj < 2; ++bj)
#pragma unroll
                        for (int n = 0; n < 2; ++n) ss += (v[bj][n][0] * v[bj][n][0] + v[bj][n][1] * v[bj][n][1]) + (v[bj][n][2] * v[bj][n][2] + v[bj][n][3] * v[bj][n][3]);
                    ss += __shfl_xor(ss, 16); ss += __shfl_xor(ss, 32);
                    const float rs = 1.0f / sqrtf(ss * (1.0f / 64.0f) + 1e-6f);
#pragma unroll
                    for (int bj = 0; bj < 2; ++bj)
#pragma unroll
                        for (int n = 0; n < 2; ++n) v[bj][n] = v[bj][n] * rs * gn[bj][n]; }
                bf16_t* db = dstb + (size_t)row * 1024 + cb;
#pragma unroll
                for (int bj = 0; bj < 2; ++bj) { u32x4 w; w.x = cvt_pk_bf16(v[bj][0][0], v[bj][0][1]); w.y = cvt_pk_bf16(v[bj][0][2], v[bj][0][3]); w.z = cvt_pk_bf16(v[bj][1][0], v[bj][1][1]); w.w = cvt_pk_bf16(v[bj][1][2], v[bj][1][3]);
                    *(u32x4*)(db + 32 * bj) = w; }
                if (reg >= 1) { float* op = nullptr;
                    if (u.pm < 32) op = okp + (size_t)(reg - 1) * kv_stride_p + (size_t)row * 1024 + cb; else if (row - 32 * BM < 8) op = oks + (size_t)(reg - 1) * kv_stride_s + (size_t)(row - 32 * BM) * 1024 + cb;
                    if (op) {
#pragma unroll
                        for (int bj = 0; bj < 2; ++bj) { *(f32x4*)(op + 32 * bj) = v[bj][0]; *(f32x4*)(op + 32 * bj + 4) = v[bj][1]; } } }
            }
    }
};
template <class Epi, class Sched, bool ALIGN_EPI = false, bool SP2 = false>
__device__ __forceinline__ void gemm_phase(PG8_LAS unsigned char* lds, const Gemm g, const Sched& S, const Epi& E) {
    int tid_ = threadIdx.x; asm volatile("" : "+v"(tid_));
    const int tid = tid_, wid = __builtin_amdgcn_readfirstlane(tid >> 6), lane = tid & 63, wr = wid >> 2, wc = wid & 3, fr = lane & 15, fq = lane >> 4;
    const int K = g.K, nt = K / BK;
    unsigned voffA[2], voffB[2];
#pragma unroll
    for (int i = 0; i < 2; ++i) { int R, C; stage_rc(tid * 16 + i * 8192, R, C); const int Rb = Epi::PERM ? ((R & ~31) + perm32(R & 31)) : R;
        voffA[i] = (unsigned)(R * K + C) * 2u; voffB[i] = (unsigned)(Rb * K + C) * 2u; }
    const size_t kstep = (size_t)(BK * 2);
    const size_t hstep = (size_t)HALF * K * 2;
    const size_t tstep = 2 * hstep;
    const unsigned ldsw = (unsigned)wid * 1024u;
    const int aoff = lds_byte(wr * 64 + fr, fq * 8), boff = lds_byte(wc * 32 + fr, fq * 8);
#define PG8_SA(b, h) (((b) * 2 + (h)) * HTB)
#define PG8_SB(b, h) ((4 + (b) * 2 + (h)) * HTB)
#define PG8_STAGE(bufoff, gbase, voff) do { _Pragma("unroll") for (int _i = 0; _i < 2; ++_i) \
        __builtin_amdgcn_global_load_lds((const unsigned*)((const char*)(gbase) + (voff)[_i]), (PG8_LAS unsigned*)(lds + (bufoff) + ldsw + _i * 8192), 16, 0, 0); } while (0)
#define PG8_LDA(dst, b, h) do { _Pragma("unroll") for (int m = 0; m < 4; ++m) _Pragma("unroll") for (int k = 0; k < 2; ++k) dst[m][k] = *(const PG8_LAS bf16x8*)(lds + PG8_SA(b, h) + aoff + m * 2048 + k * 1024); } while (0)
#define PG8_LDB(dst, b, h) do { _Pragma("unroll") for (int n = 0; n < 2; ++n) _Pragma("unroll") for (int k = 0; k < 2; ++k) dst[n][k] = *(const PG8_LAS bf16x8*)(lds + PG8_SB(b, h) + boff + n * 2048 + k * 1024); } while (0)
#define PG8_MMA(ai, bj, At, Bt) do { __builtin_amdgcn_s_setprio(1); _Pragma("unroll") for (int m = 0; m < 4; ++m) _Pragma("unroll") for (int n = 0; n < 2; ++n) _Pragma("unroll") for (int k = 0; k < 2; ++k) \
        acc[ai][bj][m][n] = __builtin_amdgcn_mfma_f32_16x16x32_bf16(Bt[n][k], At[m][k], acc[ai][bj][m][n], 0, 0, 0); __builtin_amdgcn_s_setprio(0); } while (0)
#define PG8_WAIT_V(n) asm volatile("s_waitcnt vmcnt(" #n ")" ::: "memory")
#define PG8_WAIT_L(n) asm volatile("s_waitcnt lgkmcnt(" #n ")" ::: "memory")
#define PG8_BAR __builtin_amdgcn_s_barrier()
#define PG8_SCHED __builtin_amdgcn_sched_barrier(0)
    Unit cur, nxt; int ui = 0;
    if (!S.next(0, cur)) return;
    f32x4 acc[2][2][4][2];
#pragma unroll
    for (int a = 0; a < 2; ++a)
#pragma unroll
        for (int b = 0; b < 2; ++b)
#pragma unroll
            for (int m = 0; m < 4; ++m)
#pragma unroll
                for (int n = 0; n < 2; ++n) acc[a][b][m][n] = (f32x4){0.f, 0.f, 0.f, 0.f};
    bf16x8 At[4][2], B0[2][2], B1[2][2];
    const char* cA = (const char*)g.A + (size_t)cur.pm * tstep; const char* cB = (const char*)g.Bt + (size_t)cur.pn * tstep;
    S.a_ready(cur);
    if constexpr (SP2) {
        PG8_STAGE(PG8_SB(0, 0), cB, voffB); PG8_STAGE(PG8_SB(0, 1), cB + hstep, voffB); PG8_STAGE(PG8_SA(0, 0), cA, voffA); PG8_STAGE(PG8_SA(0, 1), cA + hstep, voffA);
        if (wr == 1) PG8_BAR;
        PG8_WAIT_V(2); PG8_BAR;
        PG8_STAGE(PG8_SB(1, 0), cB + kstep, voffB); PG8_STAGE(PG8_SA(1, 0), cA + kstep, voffA); PG8_STAGE(PG8_SB(1, 1), cB + hstep + kstep, voffB);
        PG8_WAIT_V(6); PG8_BAR;
    } else {
        PG8_STAGE(PG8_SB(0, 0), cB, voffB); PG8_STAGE(PG8_SA(0, 0), cA, voffA); PG8_STAGE(PG8_SB(0, 1), cB + hstep, voffB); PG8_STAGE(PG8_SA(0, 1), cA + hstep, voffA);
        if (wr == 1) PG8_BAR;
        PG8_WAIT_V(4); PG8_BAR;
        PG8_STAGE(PG8_SB(1, 0), cB + kstep, voffB); PG8_STAGE(PG8_SA(1, 0), cA + kstep, voffA); PG8_STAGE(PG8_SB(1, 1), cB + hstep + kstep, voffB);
        PG8_WAIT_V(6); PG8_BAR;
    }
    for (;;) {
        const bool has_next = S.next(ui + 1, nxt);
        const char* nA = has_next ? (const char*)g.A + (size_t)nxt.pm * tstep : cA; const char* nB = has_next ? (const char*)g.Bt + (size_t)nxt.pn * tstep : cB;
        for (int t = 0; t < nt; t += 2) {
            const bool last = (t == nt - 2);
            const char* a1 = cA + (size_t)(t + 1) * kstep;
            const char* a2 = last ? nA : cA + (size_t)(t + 2) * kstep; const char* b2 = last ? nB : cB + (size_t)(t + 2) * kstep;
            const char* a3 = a2 + kstep; const char* b3 = b2 + kstep;
            if (last && has_next) S.a_ready(nxt);
            if constexpr (SP2) {
            PG8_LDB(B0, 0, 0); PG8_LDB(B1, 0, 1); PG8_SCHED; PG8_LDA(At, 0, 0); PG8_STAGE(PG8_SA(1, 1), a1 + hstep, voffA);
            PG8_WAIT_V(8); PG8_WAIT_L(0); PG8_BAR; PG8_MMA(0, 0, At, B0); PG8_MMA(0, 1, At, B1); PG8_BAR; PG8_SCHED;
            PG8_LDA(At, 0, 1); PG8_STAGE(PG8_SB(0, 0), b2, voffB); PG8_STAGE(PG8_SB(0, 1), b2 + hstep, voffB); PG8_STAGE(PG8_SA(0, 0), a2, voffA);
            PG8_WAIT_V(8); PG8_WAIT_L(0); PG8_BAR; PG8_MMA(1, 0, At, B0); PG8_MMA(1, 1, At, B1); PG8_BAR; PG8_SCHED;
            PG8_LDB(B0, 1, 0); PG8_LDB(B1, 1, 1); PG8_SCHED; PG8_LDA(At, 1, 0); PG8_STAGE(PG8_SA(0, 1), a2 + hstep, voffA);
            PG8_WAIT_V(8); PG8_WAIT_L(0); PG8_BAR; PG8_MMA(0, 0, At, B0); PG8_MMA(0, 1, At, B1); PG8_BAR; PG8_SCHED;
            PG8_LDA(At, 1, 1); PG8_STAGE(PG8_SB(1, 0), b3, voffB); PG8_STAGE(PG8_SB(1, 1), b3 + hstep, voffB); PG8_STAGE(PG8_SA(1, 0), a3, voffA);
            PG8_WAIT_V(8); PG8_WAIT_L(0); PG8_BAR; PG8_MMA(1, 0, At, B0); PG8_MMA(1, 1, At, B1); PG8_BAR; PG8_SCHED;
            } else {
            PG8_LDB(B0, 0, 0); PG8_SCHED; PG8_LDA(At, 0, 0); PG8_STAGE(PG8_SA(1, 1), a1 + hstep, voffA);
            PG8_WAIT_L(8); PG8_BAR; PG8_WAIT_L(0); PG8_MMA(0, 0, At, B0); PG8_BAR; PG8_SCHED;
            PG8_LDB(B1, 0, 1); PG8_STAGE(PG8_SB(0, 0), b2, voffB);
            PG8_BAR; PG8_WAIT_L(0); PG8_MMA(0, 1, At, B1); PG8_BAR;
            PG8_LDA(At, 0, 1); PG8_STAGE(PG8_SA(0, 0), a2, voffA);
            PG8_BAR; PG8_WAIT_L(0); PG8_MMA(1, 0, At, B0); PG8_BAR; PG8_SCHED;
            PG8_STAGE(PG8_SB(0, 1), b2 + hstep, voffB);
            PG8_WAIT_V(6); PG8_BAR; PG8_MMA(1, 1, At, B1); PG8_BAR;
            PG8_LDB(B0, 1, 0); PG8_SCHED; PG8_LDA(At, 1, 0); PG8_STAGE(PG8_SA(0, 1), a2 + hstep, voffA);
            PG8_WAIT_L(8); PG8_BAR; PG8_WAIT_L(0); PG8_MMA(0, 0, At, B0); PG8_BAR; PG8_SCHED;
            PG8_LDB(B1, 1, 1); PG8_STAGE(PG8_SB(1, 0), b3, voffB);
            PG8_BAR; PG8_WAIT_L(0); PG8_MMA(0, 1, At, B1); PG8_BAR;
            PG8_LDA(At, 1, 1); PG8_STAGE(PG8_SA(1, 0), a3, voffA);
            PG8_BAR; PG8_WAIT_L(0); PG8_MMA(1, 0, At, B0); PG8_BAR; PG8_SCHED;
            PG8_STAGE(PG8_SB(1, 1), b3 + hstep, voffB);
            PG8_WAIT_V(6); PG8_BAR; PG8_MMA(1, 1, At, B1); PG8_BAR;
            }
        }
        if constexpr (ALIGN_EPI) { if (wr == 0) PG8_BAR; }
        if constexpr (!Epi::AFTER_DRAIN) { E(acc, cur, wr, wc, fr, fq); S.done(cur); }
        if (!has_next) break;
#pragma unroll
        for (int a = 0; a < 2; ++a)
#pragma unroll
            for (int b = 0; b < 2; ++b)
#pragma unroll
                for (int m = 0; m < 4; ++m)
#pragma unroll
                    for (int n = 0; n < 2; ++n) acc[a][b][m][n] = (f32x4){0.f, 0.f, 0.f, 0.f};
        cur = nxt; cA = nA; cB = nB; ++ui;
        if constexpr (ALIGN_EPI) { if (wr == 1) PG8_BAR; }
    }
    PG8_WAIT_V(0);
    if constexpr (!ALIGN_EPI) { if (wr == 0) PG8_BAR; }
    PG8_BAR;
    if constexpr (Epi::AFTER_DRAIN) { E.fused(acc, cur, wr, wc, fr, fq, lds, wid, lane); S.done(cur); }
#undef PG8_SA
#undef PG8_SB
#undef PG8_STAGE
#undef PG8_LDA
#undef PG8_LDB
#undef PG8_MMA
#undef PG8_WAIT_V
#undef PG8_WAIT_L
#undef PG8_BAR
#undef PG8_SCHED
}
}
#define GAS __attribute__((address_space(1)))
#define LAS __attribute__((address_space(3)))
typedef unsigned short bf16;
typedef unsigned v4u __attribute__((ext_vector_type(4)));
typedef float f32x4 __attribute__((ext_vector_type(4)));
typedef short bf16x8 __attribute__((ext_vector_type(8)));
typedef GAS unsigned gu32;
typedef GAS unsigned long long gu64;
#define RLX_AGENT __ATOMIC_RELAXED, __HIP_MEMORY_SCOPE_AGENT
#define LDS_WAIT() asm volatile("s_waitcnt lgkmcnt(0)" ::: "memory")
#define VM_WAIT() asm volatile("s_waitcnt vmcnt(0)" ::: "memory")
__device__ __forceinline__ unsigned long long rt() { return __builtin_amdgcn_s_memrealtime(); }
__device__ __forceinline__ unsigned f2bf(float f) { unsigned u = __builtin_bit_cast(unsigned, f); return (u + 0x7fffu + ((u >> 16) & 1u)) >> 16; }
__device__ __forceinline__ unsigned pk2(float lo, float hi) { return f2bf(lo) | (f2bf(hi) << 16); }
#define XB_TMO      128
#define XB_XCNT(j)  (256  + 64 * (j))
#define XB_XSUB(j)  (1280 + 64 * (j))
#define XB_XGEN(j)  (2304 + 64 * (j))
#define XB_TOP      3328
#define XB_TOPGEN   3392
#define XCD_BAR_WORDS 3456
#define XB_SPIN_CAP (1u << 18)

__device__ __forceinline__ unsigned xb_ld(unsigned* p)              { return __hip_atomic_load(p, __ATOMIC_RELAXED, __HIP_MEMORY_SCOPE_AGENT); }
__device__ __forceinline__ unsigned xb_add(unsigned* p, unsigned v) { return __hip_atomic_fetch_add(p, v, __ATOMIC_RELAXED, __HIP_MEMORY_SCOPE_AGENT); }
__device__ __forceinline__ unsigned xb_xcc_id() { return (unsigned)__builtin_amdgcn_s_getreg((3 << 11) | 20) & 0xFu; }
#define XB_SPIN(cond, bar) do { unsigned _sp = 0; while (cond) { __builtin_amdgcn_s_sleep(1); \
    if ((++_sp & 255u) == 0u) { if (xb_ld(&(bar)[XB_TMO])) break; if (_sp > XB_SPIN_CAP) { atomicAdd(&(bar)[XB_TMO], 1u); break; } } } } while (0)

struct XcdBarrier {
    unsigned* bar; unsigned x;
    volatile LAS unsigned* st;
};

__device__ __forceinline__ XcdBarrier xcd_barrier_post(unsigned* bar, volatile LAS unsigned* st) {
    XcdBarrier b; b.bar = bar; b.x = xb_xcc_id(); b.st = st;
    if (threadIdx.x == 0) (void)xb_add(&bar[XB_XCNT(b.x)], 1u);
    return b;
}
__device__ __forceinline__ void xcd_barrier_complete(unsigned* bar, unsigned x, unsigned& nloc, unsigned& nx) {
    const unsigned G = gridDim.x * gridDim.y * gridDim.z;
    unsigned sum, cnt, mine, sp = 0u;
    for (;;) {
        sum = 0u; cnt = 0u; mine = 0u;
#pragma unroll
        for (unsigned j = 0; j < 16; ++j) { const unsigned c = xb_ld(&bar[XB_XCNT(j)]); sum += c; cnt += (c > 0u) ? 1u : 0u; mine = (j == x) ? c : mine; }
        if (sum == G) break;
        __builtin_amdgcn_s_sleep(1);
        if ((++sp & 255u) == 0u) { if (xb_ld(&bar[XB_TMO])) break; if (sp > XB_SPIN_CAP) { atomicAdd(&bar[XB_TMO], 1u); break; } }
    }
    nloc = mine > 0u ? mine : 1u; nx = cnt > 0u ? cnt : 1u;
}

__device__ __forceinline__ void xcd_barrier(const XcdBarrier& b) {
    asm volatile("s_waitcnt vmcnt(0)" ::: "memory");
    __syncthreads();
    if (threadIdx.x == 0) {
        unsigned* bar = b.bar;
        __builtin_amdgcn_s_waitcnt(0);
        unsigned nloc = b.st[0], nx = b.st[1];
        if (nloc == 0u) { xcd_barrier_complete(bar, b.x, nloc, nx); b.st[0] = nloc; b.st[1] = nx; }
        const unsigned old = xb_add(&bar[XB_XSUB(b.x)], 1u);
        const unsigned gen = old / nloc;
        if (old + 1u == (gen + 1u) * nloc) {
            __builtin_amdgcn_fence(__ATOMIC_RELEASE, "agent");
            asm volatile("s_waitcnt vmcnt(0)" ::: "memory");
            const unsigned og = xb_add(&bar[XB_TOP], 1u);
            const unsigned tg = og / nx;
            if (og + 1u == (tg + 1u) * nx) xb_add(&bar[XB_TOPGEN], 1u);
            else XB_SPIN(xb_ld(&bar[XB_TOPGEN]) == tg, bar);
            __builtin_amdgcn_fence(__ATOMIC_ACQUIRE, "agent");
            xb_add(&bar[XB_XGEN(b.x)], 1u);
            asm volatile("s_waitcnt vmcnt(0)" ::: "memory");
        } else {
            XB_SPIN(xb_ld(&bar[XB_XGEN(b.x)]) == gen, bar);
            __builtin_amdgcn_fence(__ATOMIC_ACQUIRE, "agent");
            asm volatile("s_waitcnt vmcnt(0)" ::: "memory");
        }
    }
    __syncthreads();
}

#ifndef MK_N_LAUNCHES
#define MK_N_LAUNCHES 1
#endif
#ifndef REP_P0
#define REP_P0 1
#endif
#ifndef REP_N1
#define REP_N1 1
#endif
#ifndef REP_PW
#define REP_PW 1
#endif
#ifndef REP_SCAN
#define REP_SCAN 1
#endif
#ifndef REP_ATT
#define REP_ATT 1
#endif
#ifndef REP_SATT
#define REP_SATT 1
#endif
#ifndef REP_MX
#define REP_MX 1
#endif
#ifndef REP_N2
#define REP_N2 1
#endif
#ifndef REP_G3
#define REP_G3 1
#endif
#ifndef REP_PWL
#define REP_PWL 1
#endif
#ifndef REP_PWM
#define REP_PWM 1
#endif
#ifndef REP_PWR
#define REP_PWR 1
#endif
constexpr int NWAVES = 8, NTHR = 512;
constexpr int DM = 2048, SEQ = 2048, PBATCH = 4, SBATCH = 8, DEPTH = 4, NHEADS = 16, HD = 64, DATT = 1024, DRW = 1024, FF = 5632;
constexpr int MP = PBATCH * SEQ;
constexpr int ROW_S = MP;
constexpr int ROW_SS = MP + 8;
constexpr int NROWS = MP + 8;
constexpr int MH = MP + 256;
constexpr int N1 = 6912;
constexpr int PC0 = 6144, PP0 = 6144 + 384;
constexpr int NLORA = 320;
constexpr int MODW = 6 * DM;
constexpr float RMS_EPS = 1e-6f, GN_EPS = 64e-5f, ATT_SCALE = 0.125f;

enum { I_XP = 0, I_XS, I_CP, I_CS, I_CK, I_CV, I_SWKV, I_SSH, I_RELB, I_ADAW, I_ADAB, I_N1G, I_N2G, I_WIN, I_QG, I_KG, I_MUWAG, I_MURKV,
       I_DW0, I_DW1, I_DW2, I_AA0, I_AW1, I_AW2, I_GW1, I_GW2, I_VMU, I_VV0, I_VW1, I_VW2, I_KK, I_KA, I_RK, I_LNG, I_LNB, I_WOUT, I_WGU, I_WDN, N_IN };
constexpr size_t O_YP = 0, O_YS = O_YP + (size_t)MP * DM, O_KP = O_YS + 8 * DM, O_VP = O_KP + (size_t)DEPTH * MP * DATT, O_WP = O_VP + (size_t)DEPTH * MP * DATT,
                 O_SP = O_WP + (size_t)DEPTH * PBATCH * 16 * 4096, O_KS = O_SP + (size_t)DEPTH * PBATCH * DM, O_VS = O_KS + (size_t)DEPTH * 8 * DATT, O_WS = O_VS + (size_t)DEPTH * 8 * DATT,
                 O_SS = O_WS + (size_t)DEPTH * 8 * 16 * 4096, O_END = O_SS + (size_t)DEPTH * 8 * DM;
static_assert(O_END == 87212032, "output size");

constexpr size_t MiB = 1u << 20;
constexpr size_t WS_CTL = 0, CTL_ZERO_BYTES = 1 * MiB;
constexpr size_t WS_MOD = 1 * MiB;
constexpr size_t WS_BT = 4 * MiB;
constexpr size_t WS_WIN = 8 * MiB;
constexpr size_t WS_WOUT = 116 * MiB;
constexpr size_t WS_WGU = 148 * MiB;
constexpr size_t WS_WDN = 324 * MiB;
constexpr size_t WS_HB = 412 * MiB;
constexpr size_t WS_W2T = 5 * MiB;
constexpr size_t WS_RKV = 446 * MiB;
constexpr size_t WS_P = 546 * MiB;
constexpr size_t WS_QB = 670 * MiB, WS_KB = 687 * MiB, WS_VB = 704 * MiB;
constexpr size_t WS_R = 722 * MiB, WS_W = 755 * MiB, WS_K = 788 * MiB, WS_V = 821 * MiB, WS_A = 854 * MiB, WS_B = 887 * MiB, WS_G = 920 * MiB, WS_VF = 953 * MiB;
constexpr size_t WS_Y = 986 * MiB;
constexpr size_t WS_OBR = 1019 * MiB;
constexpr size_t WS_LSE = 1067 * MiB;
constexpr size_t WS_MIX = 1069 * MiB;
constexpr size_t WS_XB = 1102 * MiB;
constexpr size_t WS_ACT = 1168 * MiB;
constexpr size_t WS_END = 1260 * MiB;
static_assert(WS_WIN + (size_t)DEPTH * N1 * DM * 2 <= WS_WOUT && WS_WGU + (size_t)DEPTH * 2 * FF * DM * 2 <= WS_WDN && WS_WDN + (size_t)DEPTH * DM * FF * 2 <= WS_HB, "ws map (weights)");
static_assert(WS_VB - WS_KB == WS_KB - WS_QB, "q | k | v bf16 buffers are equally spaced");
static_assert(WS_HB + (size_t)MH * DM * 2 <= WS_RKV && WS_RKV + (size_t)MH * 3072 * 4 <= WS_P && WS_P + (size_t)MH * 768 * 4 <= WS_QB && WS_W2T + (size_t)DEPTH * 1024 * 320 * 2 <= WS_WIN && WS_QB + (size_t)MH * DATT * 2 <= WS_KB && WS_VB + (size_t)MH * DATT * 2 <= WS_R, "ws map (act 1)");
static_assert(WS_R + (size_t)NROWS * DRW * 4 <= WS_W && WS_Y + (size_t)NROWS * DRW * 4 <= WS_OBR && WS_OBR + (size_t)3 * MP * DATT * 2 <= WS_LSE && WS_LSE + (size_t)3 * MP * 16 * 4 <= WS_MIX, "ws map (act 2)");
static_assert(WS_MIX + (size_t)MH * DM * 2 <= WS_XB && WS_XB + (size_t)MH * DM * 4 <= WS_ACT && WS_ACT + (size_t)MH * FF * 2 <= WS_END, "ws map (act 3)");
constexpr int CW_BAR = 4096;

constexpr int RING_BYTES = 131072;
constexpr int LDSCTL_OFF = RING_BYTES, MISC_OFF = LDSCTL_OFF + 320;
constexpr int LDS_BYTES = 147456;

constexpr int PH_PER_LAYER = 9, N_PHASES = 1 + DEPTH * PH_PER_LAYER;

struct Args { const float* in[N_IN]; float* out; unsigned char* ws; int ph_lo, ph_hi; };
static_assert(sizeof(Args) == N_IN * 8 + 24, "Args has no padding");

__device__ __forceinline__ float wave_sum(float v) {
#pragma unroll
    for (int o = 1; o < 64; o <<= 1) v += __shfl_xor(v, o);
    return v;
}
__device__ __forceinline__ float wave_max(float v) {
#pragma unroll
    for (int o = 1; o < 64; o <<= 1) v = fmaxf(v, __shfl_xor(v, o));
    return v;
}
template <int CTRL> __device__ __forceinline__ float dpp_mov(float v) { return __builtin_bit_cast(float, __builtin_amdgcn_update_dpp(0, __builtin_bit_cast(int, v), CTRL, 0xf, 0xf, false)); }
__device__ __forceinline__ float row16_sum(float v) {
    v += dpp_mov<0xB1>(v);
    v += dpp_mov<0x4E>(v);
    v += dpp_mov<0x141>(v);
    v += dpp_mov<0x140>(v);
    return v;
}
__device__ __forceinline__ float bf2f(unsigned short b) { return __builtin_bit_cast(float, (unsigned)b << 16); }
__device__ __forceinline__ f32x4 ld4bf(const bf16* p) { const unsigned long long w = *(const unsigned long long*)p; return (f32x4){__builtin_bit_cast(float, (unsigned)w << 16), __builtin_bit_cast(float, (unsigned)w & 0xffff0000u), __builtin_bit_cast(float, (unsigned)(w >> 32) << 16), __builtin_bit_cast(float, (unsigned)(w >> 32) & 0xffff0000u)}; }
__device__ __forceinline__ void st4bf(bf16* p, f32x4 v) { *(unsigned long long*)p = (unsigned long long)pk2(v[0], v[1]) | ((unsigned long long)pk2(v[2], v[3]) << 32); }
__device__ __forceinline__ float sigmoidf_(float x) { return 1.0f / (1.0f + __expf(-x)); }

__device__ __forceinline__ void p0_transpose_item(const float* W, int N, int k0, int n0, bf16* WT, int ldt, int drow0, const float* mu, int smode, LAS float* scr, int lane, int kdst = -1, int krows = 64) {
    if (kdst < 0) kdst = k0;
#pragma unroll 8
    for (int i = 0; i < 32; ++i) { const int kk = 2 * i + (lane >> 5); float v = 0.f;
        if (kk < krows) { v = W[(size_t)(k0 + kk) * N + n0 + (lane & 31)];
            if (smode) { const float m = mu[k0 + kk]; v *= (smode == 1) ? (1.0f - m) : m; } }
        scr[kk * 33 + (lane & 31)] = v; }
    LDS_WAIT(); asm volatile("" ::: "memory");
    const int c = lane & 7;
    if (8 * c < krows) {
#pragma unroll
        for (int j = 0; j < 4; ++j) { const int n = (lane >> 3) + 8 * j; const LAS float* s = scr + (8 * c) * 33 + n;
            v4u o; o.x = pk2(s[0 * 33], s[1 * 33]); o.y = pk2(s[2 * 33], s[3 * 33]); o.z = pk2(s[4 * 33], s[5 * 33]); o.w = pk2(s[6 * 33], s[7 * 33]);
            *(GAS v4u*)(WT + (size_t)(drow0 + n) * ldt + kdst + 8 * c) = o; }
    }
    LDS_WAIT(); asm volatile("" ::: "memory");
}
__device__ __forceinline__ int rel_bucket(int d) {
    if (d < 16) return d;
    const int large = 16 + (int)(logf((float)d / 16.0f) / logf(128.0f) * 16.0f);
    return large < 31 ? large : 31;
}
constexpr int I_IN = (DM / 64) * (6144 / 32), I_LD = (DM / 64) * 2, I_LG = (DM / 64) * 5, I_LV = (DM / 64) * 1, I_OUT = (DM / 64) * (DM / 32), I_GU = (DM / 64) * (2 * FF / 32), I_DN = (FF / 64) * (DM / 32);
constexpr int I_W2 = 32 * 6;
constexpr int I_LAYER = I_IN + 2 * (2 * I_LD + I_LG + I_LV) + I_W2 + I_OUT + I_GU + I_DN;
constexpr int CONV_BATCH = 32, N_CONV_BATCHES = (I_LAYER + CONV_BATCH - 1) / CONV_BATCH, N_MOD_ITEMS = MODW / 256, N_PREP_ITEMS = N_MOD_ITEMS + N_CONV_BATCHES;
constexpr int TAIL_PULLS = 0;
constexpr int CW_Q = 8192;
__device__ __forceinline__ void mod_block_item(const Args& args, int l, int c0, LAS unsigned char* lds, int tid, int lane, int wave) {
    unsigned char* ws = args.ws; float* MOD = (float*)(ws + WS_MOD);
        LAS float* sl = (LAS float*)lds;
        __syncthreads();
        for (int i = tid; i < 12 * DM; i += NTHR) { const int bb = i / DM, k = i % DM; const float c = (bb < 4) ? args.in[I_CP][bb * DM + k] : args.in[I_CS][(bb - 4) * DM + k];
            sl[k * 12 + bb] = c / (1.0f + __expf(-c)); }
        __syncthreads();
        const float* Wl = args.in[I_ADAW] + (size_t)l * DM * MODW + c0 + 4 * lane;
        f32x4 acc[12];
#pragma unroll
        for (int bb = 0; bb < 12; ++bb) acc[bb] = (f32x4){0.f, 0.f, 0.f, 0.f};
        const int kb = wave * 256;
#pragma unroll 4
        for (int k = kb; k < kb + 256; ++k) {
            const f32x4 w = *(const f32x4*)(Wl + (size_t)k * MODW);
            const f32x4 s0 = *(const LAS f32x4*)(sl + k * 12), s1 = *(const LAS f32x4*)(sl + k * 12 + 4), s2 = *(const LAS f32x4*)(sl + k * 12 + 8);
            acc[0] += w * s0.x; acc[1] += w * s0.y; acc[2] += w * s0.z; acc[3] += w * s0.w;
            acc[4] += w * s1.x; acc[5] += w * s1.y; acc[6] += w * s1.z; acc[7] += w * s1.w;
            acc[8] += w * s2.x; acc[9] += w * s2.y; acc[10] += w * s2.z; acc[11] += w * s2.w;
        }
        __syncthreads();
        LAS float* part = (LAS float*)lds;
#pragma unroll
        for (int bb = 0; bb < 12; ++bb) *(LAS f32x4*)(part + (wave * 12 + bb) * 256 + 4 * lane) = acc[bb];
        __syncthreads();
        for (int i = tid; i < 12 * 256; i += NTHR) { const int bb = i / 256, c = i % 256; float s = args.in[I_ADAB][l * MODW + c0 + c];
#pragma unroll
            for (int w = 0; w < 8; ++w) s += part[(w * 12 + bb) * 256 + c];
            MOD[((size_t)l * 12 + bb) * MODW + c0 + c] = s; }
        __syncthreads();
}
__device__ __forceinline__ void conv_wave_item(const Args& args, int l, int r, LAS float* scr, int lane) {
    unsigned char* ws = args.ws;
        bf16* WIN = (bf16*)(ws + WS_WIN) + (size_t)l * N1 * DM;
        if (r < I_IN) { const int nblk = 6144 / 32, kbk = r / nblk, nb = r % nblk;
            const int n0 = 32 * nb, drow = 256 * (n0 / 256) + 128 * ((n0 % 64) / 32) + 32 * ((n0 % 256) / 64);
            p0_transpose_item(args.in[I_WIN] + (size_t)l * DM * 6144, 6144, 64 * kbk, n0, WIN, DM, drow, nullptr, 0, scr, lane); return; }
        r -= I_IN;
        constexpr int LH = 2 * I_LD + I_LG + I_LV;
        if (r < 2 * LH) {
            const int half = r / LH, base = half ? PP0 : PC0, sm = 1 + half; int q = r % LH;
            if (q < I_LD) { p0_transpose_item(args.in[I_DW1] + (size_t)l * DM * 64, 64, 64 * (q / 2), 32 * (q % 2), WIN, DM, base + 0 + 32 * (q % 2), args.in[I_MUWAG] + ((size_t)l * 3 + 0) * DM, sm, scr, lane); return; }
            q -= I_LD;
            if (q < I_LD) { p0_transpose_item(args.in[I_AW1] + (size_t)l * DM * 64, 64, 64 * (q / 2), 32 * (q % 2), WIN, DM, base + 64 + 32 * (q % 2), args.in[I_MUWAG] + ((size_t)l * 3 + 1) * DM, sm, scr, lane); return; }
            q -= I_LD;
            if (q < I_LG) { p0_transpose_item(args.in[I_GW1] + (size_t)l * DM * 160, 160, 64 * (q / 5), 32 * (q % 5), WIN, DM, base + 128 + 32 * (q % 5), args.in[I_MUWAG] + ((size_t)l * 3 + 2) * DM, sm, scr, lane); return; }
            q -= I_LG;
            if (l > 0) p0_transpose_item(args.in[I_VW1] + (size_t)(l - 1) * DM * 32, 32, 64 * q, 0, WIN, DM, base + 288, args.in[I_VMU] + (size_t)(l - 1) * DM, sm, scr, lane);
            return;
        }
        r -= 2 * LH;
        if (r < I_W2) { const int kb = r / 32, n0 = 32 * (r % 32); bf16* W2T = (bf16*)(ws + WS_W2T) + (size_t)l * 1024 * NLORA;
            if (kb == 0) p0_transpose_item(args.in[I_DW2] + (size_t)l * 64 * DRW, DRW, 0, n0, W2T, NLORA, n0, nullptr, 0, scr, lane, 0, 64);
            else if (kb == 1) p0_transpose_item(args.in[I_AW2] + (size_t)l * 64 * DRW, DRW, 0, n0, W2T, NLORA, n0, nullptr, 0, scr, lane, 64, 64);
            else if (kb < 5) p0_transpose_item(args.in[I_GW2] + (size_t)l * 160 * DRW, DRW, 64 * (kb - 2), n0, W2T, NLORA, n0, nullptr, 0, scr, lane, 128 + 64 * (kb - 2), (kb == 4) ? 32 : 64);
            else if (l > 0) p0_transpose_item(args.in[I_VW2] + (size_t)(l - 1) * 32 * DRW, DRW, 0, n0, W2T, NLORA, n0, nullptr, 0, scr, lane, 288, 32);
            return; }
        r -= I_W2;
        if (r < I_OUT) { const int nblk = DM / 32, kbk = r / nblk, nb = r % nblk;
            p0_transpose_item(args.in[I_WOUT] + (size_t)l * DM * DM, DM, 64 * kbk, 32 * nb, (bf16*)(ws + WS_WOUT) + (size_t)l * DM * DM, DM, 32 * nb, nullptr, 0, scr, lane); return; }
        r -= I_OUT;
        if (r < I_GU) { const int nblk = 2 * FF / 32, kbk = r / nblk, nb = r % nblk, n0 = 32 * nb;
            const int nn = (n0 < FF) ? n0 : n0 - FF, drow = 256 * (nn / 128) + (nn % 128) + ((n0 < FF) ? 0 : 128);
            p0_transpose_item(args.in[I_WGU] + (size_t)l * DM * 2 * FF, 2 * FF, 64 * kbk, n0, (bf16*)(ws + WS_WGU) + (size_t)l * 2 * FF * DM, DM, drow, nullptr, 0, scr, lane); return; }
        r -= I_GU;
        { const int nblk = DM / 32, kbk = r / nblk, nb = r % nblk;
            p0_transpose_item(args.in[I_WDN] + (size_t)l * FF * DM, DM, 64 * kbk, 32 * nb, (bf16*)(ws + WS_WDN) + (size_t)l * DM * FF, FF, 32 * nb, nullptr, 0, scr, lane); }
}
__device__ __forceinline__ void prep_item(const Args& args, int l, int item, LAS unsigned char* lds, int tid, int lane, int wave) {
    if (item < N_MOD_ITEMS) { mod_block_item(args, l, item * 256, lds, tid, lane, wave); return; }
    __syncthreads();
    LAS float* scr = (LAS float*)(lds + wave * 16384); const int r0 = (item - N_MOD_ITEMS) * CONV_BATCH + wave * (CONV_BATCH / NWAVES);
#pragma unroll 1
    for (int k = 0; k < CONV_BATCH / NWAVES; ++k) if (r0 + k < I_LAYER) conv_wave_item(args, l, r0 + k, scr, lane);
}
__device__ __forceinline__ void prep_layer_all(const Args& args, int l, LAS unsigned char* lds, int vcu, int G) {
    int tid_ = threadIdx.x; asm volatile("" : "+v"(tid_)); const int tid = tid_, lane = tid & 63, wave = __builtin_amdgcn_readfirstlane(tid >> 6);
#pragma unroll 1
    for (int it = vcu; it < N_PREP_ITEMS; it += G) prep_item(args, l, it, lds, tid, lane, wave);
    __syncthreads();
}
__device__ __forceinline__ void prep_layer_pull(const Args& args, int l, int kind, int max_items, LAS unsigned char* lds, volatile LAS unsigned* bcast) {
    int tid_ = threadIdx.x; asm volatile("" : "+v"(tid_)); const int tid = tid_, lane = tid & 63, wave = __builtin_amdgcn_readfirstlane(tid >> 6);
    unsigned* ctr = (unsigned*)(args.ws + WS_CTL) + CW_Q + 64 * (4 * kind + l); const int n_items = kind ? N_MOD_ITEMS : N_CONV_BATCHES;
#pragma unroll 1
    for (int k = 0; k < max_items; ++k) {
        __syncthreads();
        if (tid == 0) *bcast = __hip_atomic_fetch_add(ctr, 1u, __ATOMIC_RELAXED, __HIP_MEMORY_SCOPE_AGENT);
        __syncthreads();
        const int item = (int)*bcast;
        if (item >= n_items) break;
        prep_item(args, l, kind ? item : N_MOD_ITEMS + item, lds, tid, lane, wave);
    }
    __syncthreads();
}
__device__ __forceinline__ void p0_prologue(const Args& args, LAS unsigned char* lds, int vcu, int G) {
    if (vcu == G - 1) {
        float* BT = (float*)(args.ws + WS_BT);
        for (int i = threadIdx.x; i < 3 * 129 * 16; i += NTHR) { const int h = i & 15, m = (i >> 4) % 129, br = (i >> 4) / 129; BT[i] = args.in[I_RELB][rel_bucket(m << (2 * br)) * 16 + h]; }
    }
    prep_layer_all(args, 0, lds, vcu, G);
}

__device__ __forceinline__ void norm_mod_row(const float* xrow, const float* g, const float* sh, const float* sc, bf16* hrow, float* frow, int lane) {
    const GAS f32x4* xr = (const GAS f32x4*)xrow + lane;
    f32x4 v[8]; float s = 0.f;
#pragma unroll
    for (int j = 0; j < 8; ++j) { v[j] = xr[64 * j]; s += (v[j].x * v[j].x + v[j].y * v[j].y) + (v[j].z * v[j].z + v[j].w * v[j].w); }
    const float rstd = 1.0f / sqrtf(wave_sum(s) * (1.0f / DM) + RMS_EPS);
    GAS unsigned long long* o8 = (GAS unsigned long long*)hrow + lane;
#pragma unroll
    for (int j = 0; j < 8; ++j) { const f32x4 g4 = ((const GAS f32x4*)g)[lane + 64 * j], sh4 = ((const GAS f32x4*)sh)[lane + 64 * j], sc4 = ((const GAS f32x4*)sc)[lane + 64 * j];
        const f32x4 h = (v[j] * rstd * g4) * (sc4 + 1.0f) + sh4;
        o8[64 * j] = (unsigned long long)pk2(h.x, h.y) | ((unsigned long long)pk2(h.z, h.w) << 32);
        if (frow) ((GAS f32x4*)frow)[lane + 64 * j] = h; }
}

__device__ __forceinline__ void pw_phase(const Args& args, int l, LAS unsigned char* lds, int vcu, int G) {
    int tid_ = threadIdx.x; asm volatile("" : "+v"(tid_)); const int tid = tid_, lane = tid & 63, wave = __builtin_amdgcn_readfirstlane(tid >> 6);
    typedef float f32x16 __attribute__((ext_vector_type(16)));
    unsigned char* ws = args.ws;
    const bf16* RKV = (const bf16*)(ws + WS_RKV); const float* P = (const float*)(ws + WS_P); const bf16* W2T = (const bf16*)(ws + WS_W2T) + (size_t)l * 1024 * NLORA;
    bf16* Rr = (bf16*)(ws + WS_R); float* Ww = (float*)(ws + WS_W); bf16* Kk = (bf16*)(ws + WS_K); bf16* Vv = (bf16*)(ws + WS_V);
    bf16* Aa = (bf16*)(ws + WS_A); bf16* Bb = (bf16*)(ws + WS_B); bf16* Gg = (bf16*)(ws + WS_G); float* VF = (float*)(ws + WS_VF);
    constexpr int LST = 328, SST = 68;
    LAS unsigned short* L = (LAS unsigned short*)lds;
    LAS float* Sw = (LAS float*)(lds + 21504) + wave * (32 * SST);
    const int r32 = lane & 31, hf = lane >> 5, rs = lane >> 4, c4 = (lane & 15) * 4;
    const float* mur = args.in[I_MURKV] + (size_t)l * 3 * DRW;
    for (int tile = vcu; tile < 257; tile += G) {
        const int m0 = tile < 256 ? tile * 32 : MP, nv = tile < 256 ? 32 : 8;
        __syncthreads();
        for (int repl = 0; repl < REP_PWL; ++repl)
#pragma unroll 4
        for (int i = tid; i < 32 * NLORA; i += NTHR) { const int r = i / NLORA, c = i % NLORA; const int m = m0 + ((r < nv) ? r : nv - 1);
            const int pm = (m < MP) ? (((m & (SEQ - 1)) == 0) ? -1 : m - 1) : m + 8;
            const float v = P[(size_t)m * 768 + c] + ((pm >= 0) ? 1.f : 0.f) * P[(size_t)((pm >= 0) ? pm : m) * 768 + 384 + c];
            const float e2 = __expf(2.0f * v), th = 1.0f - 2.0f / (1.0f + e2), sg = 1.0f / (1.0f + __expf(-v));
            L[r * LST + c] = (unsigned short)f2bf((c < 64) ? th : ((c >= 128 && c < 288) ? sg : v)); }
        __syncthreads();
        const bf16* w2a = W2T + (size_t)(128 * wave + r32) * NLORA + 8 * hf; const LAS unsigned short* lb = L + r32 * LST + 8 * hf;
        f32x16 acc[4];
#define PW_MM(koff, nks, CH) do { for (int repm = 0; repm < REP_PWM; ++repm) { _Pragma("unroll") for (int nt = 0; nt < 4; ++nt) acc[nt] = (f32x16){0.f}; \
        _Pragma("unroll 1") for (int kp = 0; kp < (nks); kp += (CH)) { bf16x8 bl[CH], aw[CH][4]; \
            _Pragma("unroll") for (int k2 = 0; k2 < (CH); ++k2) { bl[k2] = *(const LAS bf16x8*)(lb + (koff) + 16 * (kp + k2)); \
                _Pragma("unroll") for (int nt = 0; nt < 4; ++nt) aw[k2][nt] = *(const bf16x8*)(w2a + (size_t)(32 * nt) * NLORA + (koff) + 16 * (kp + k2)); } \
            _Pragma("unroll") for (int k2 = 0; k2 < (CH); ++k2) _Pragma("unroll") for (int nt = 0; nt < 4; ++nt) acc[nt] = __builtin_amdgcn_mfma_f32_32x32x16_bf16(aw[k2][nt], bl[k2], acc[nt], 0, 0, 0); } } } while (0)
#define PW_STAGE(hp) do { _Pragma("unroll") for (int n2 = 0; n2 < 2; ++n2) _Pragma("unroll") for (int g = 0; g < 4; ++g) \
            *(LAS f32x4*)(Sw + r32 * SST + 32 * n2 + 8 * g + 4 * hf) = (f32x4){acc[2 * (hp) + n2][4 * g], acc[2 * (hp) + n2][4 * g + 1], acc[2 * (hp) + n2][4 * g + 2], acc[2 * (hp) + n2][4 * g + 3]}; } while (0)
#define PW_AV(it) (*(const LAS f32x4*)(Sw + (4 * (it) + rs) * SST + c4))
        const unsigned vo1_ = (unsigned)(rs * DRW + c4), vo3_ = (unsigned)(rs * 3072 + c4);
#define PW_LOCAL_OFFS unsigned vo1 = vo1_, vo3 = vo3_; asm volatile("" : "+v"(vo1), "+v"(vo3)); (void)vo3;
        const int pd = (tile < 256) ? -1 : 8;
        const float pm0 = (tile < 256 && (m0 & (SEQ - 1)) == 0 && rs == 0) ? 0.f : 1.f;
        PW_MM(0, 4, 4);
#pragma unroll
        for (int hp = 0; hp < 2; ++hp) { PW_LOCAL_OFFS const int chu = 128 * wave + 64 * hp; const f32x4 w0 = *(const f32x4*)(args.in[I_DW0] + (size_t)l * DRW + chu + c4);
            PW_STAGE(hp);
#pragma unroll
            for (int it = 0; it < 8; ++it) { const f32x4 x = w0 + PW_AV(it); f32x4 o;
#pragma unroll
                for (int e = 0; e < 4; ++e) { const float sp = fmaxf(-x[e], 0.f) + __logf(1.0f + __expf(-fabsf(x[e]))); o[e] = __expf(-__expf(-sp - 0.5f)); }
                *(f32x4*)(Ww + (size_t)(m0 + 4 * it) * DRW + chu + vo1) = o; } }
        if (l > 0) PW_MM(288, 2, 2);
#pragma unroll
        for (int hp = 0; hp < 2; ++hp) { PW_LOCAL_OFFS const int chu = 128 * wave + 64 * hp; const f32x4 mu2 = *(const f32x4*)(mur + 2 * DRW + chu + c4); f32x4 v0 = (f32x4){0.f, 0.f, 0.f, 0.f};
            if (l > 0) v0 = *(const f32x4*)(args.in[I_VV0] + (size_t)(l - 1) * DRW + chu + c4);
            PW_STAGE(hp);
#pragma unroll
            for (int half = 0; half < 2; ++half) {
                f32x4 x0[4], xp[4], vf[4];
#pragma unroll
                for (int i = 0; i < 4; ++i) { const int it = 4 * half + i; const bf16* a_ = RKV + (size_t)(m0 + 4 * it) * 3072 + 2048 + chu; const bf16* b_ = RKV + ((size_t)(m0 + 4 * it) + pd) * 3072 + 2048 + chu;
                    x0[i] = ld4bf(a_ + vo3); xp[i] = ld4bf(b_ + vo3) * ((it == 0) ? pm0 : 1.f);
                    vf[i] = (l > 0) ? *(const f32x4*)(VF + (size_t)(m0 + 4 * it) * DRW + chu + vo1) : (f32x4){0.f, 0.f, 0.f, 0.f}; }
#pragma unroll
                for (int i = 0; i < 4; ++i) { const int it = 4 * half + i; f32x4 vr = x0[i] + (xp[i] - x0[i]) * mu2;
                    if (l > 0) { const f32x4 x = v0 + PW_AV(it); f32x4 vg;
#pragma unroll
                        for (int e = 0; e < 4; ++e) vg[e] = sigmoidf_(x[e]);
                        vr = vr + (vf[i] - vr) * vg; }
                    else *(f32x4*)(VF + (size_t)(m0 + 4 * it) * DRW + chu + vo1) = vr;
                    st4bf(Vv + (size_t)(m0 + 4 * it) * DRW + chu + vo1, vr); }
            } }
        PW_MM(128, 10, 2);
#pragma unroll
        for (int hp = 0; hp < 2; ++hp) { PW_LOCAL_OFFS const int chu = 128 * wave + 64 * hp;
            PW_STAGE(hp);
#pragma unroll
            for (int it = 0; it < 8; ++it) st4bf(Gg + (size_t)(m0 + 4 * it) * DRW + chu + vo1, PW_AV(it)); }
        PW_MM(64, 4, 4);
#pragma unroll
        for (int hp = 0; hp < 2; ++hp) { PW_LOCAL_OFFS const int chu = 128 * wave + 64 * hp;
            const f32x4 a0 = *(const f32x4*)(args.in[I_AA0] + (size_t)l * DRW + chu + c4), kk4 = *(const f32x4*)(args.in[I_KK] + (size_t)l * DRW + chu + c4), ka4 = *(const f32x4*)(args.in[I_KA] + (size_t)l * DRW + chu + c4);
            const f32x4 mu0 = *(const f32x4*)(mur + chu + c4), mu1 = *(const f32x4*)(mur + DRW + chu + c4);
            PW_STAGE(hp);
#pragma unroll
            for (int qt = 0; qt < 4; ++qt) {
                f32x4 k0[2], kp[2], r0[2], rp[2];
#pragma unroll
                for (int i = 0; i < 2; ++i) { const int it = 2 * qt + i; const float pmask = (it == 0) ? pm0 : 1.f;
                    const bf16* a_ = RKV + (size_t)(m0 + 4 * it) * 3072 + chu; const bf16* b_ = RKV + ((size_t)(m0 + 4 * it) + pd) * 3072 + chu;
                    k0[i] = ld4bf(a_ + 1024 + vo3); kp[i] = ld4bf(b_ + 1024 + vo3) * pmask; r0[i] = ld4bf(a_ + vo3); rp[i] = ld4bf(b_ + vo3) * pmask; }
#pragma unroll
                for (int i = 0; i < 2; ++i) { const int it = 2 * qt + i; const size_t ou = (size_t)(m0 + 4 * it) * DRW + chu;
                    const f32x4 x = a0 + PW_AV(it); f32x4 a;
#pragma unroll
                    for (int e = 0; e < 4; ++e) a[e] = sigmoidf_(x[e]);
                    const f32x4 kr = k0[i] + (kp[i] - k0[i]) * mu1; f32x4 q = kr * kk4;
                    const float s = row16_sum((q[0] * q[0] + q[1] * q[1]) + (q[2] * q[2] + q[3] * q[3]));
                    q = q * (1.0f / fmaxf(sqrtf(s), 1e-12f));
                    st4bf(Kk + ou + vo1, kr * ((a - 1.0f) * ka4 + 1.0f)); st4bf(Aa + ou + vo1, -q); st4bf(Bb + ou + vo1, q * a); st4bf(Rr + ou + vo1, r0[i] + (rp[i] - r0[i]) * mu0); }
            } }
#undef PW_MM
#undef PW_STAGE
#undef PW_AV
#undef PW_LOCAL_OFFS
    }
}

constexpr int MST = 144, MSLOT = 64 * MST;
__device__ __forceinline__ bf16x8 mfr_row(const LAS unsigned char* M, int row, int k0, int g) { return *(const LAS bf16x8*)(M + row * MST + (k0 + 8 * g) * 2); }
__device__ __forceinline__ bf16x8 mfr_tr(const LAS unsigned char* M, int k0, int col0, int g, int q) {
    typedef short v4i16 __attribute__((ext_vector_type(4)));
    const LAS unsigned char* p = M + (k0 + 8 * g + (q >> 2)) * MST + (col0 + 4 * (q & 3)) * 2;
    const v4i16 lo = __builtin_amdgcn_ds_read_tr16_b64_v4i16((LAS v4i16*)p), hi = __builtin_amdgcn_ds_read_tr16_b64_v4i16((LAS v4i16*)(p + 4 * MST));
    return (bf16x8){lo[0], lo[1], lo[2], lo[3], hi[0], hi[1], hi[2], hi[3]};
}
#define MFMA16(a, b, c) __builtin_amdgcn_mfma_f32_16x16x32_bf16((a), (b), (c), 0, 0, 0)
__device__ __forceinline__ f32x4 mm_nn(const LAS unsigned char* X, const LAS unsigned char* Y, int ti, int tj, int q, int g, f32x4 c) {
    c = MFMA16(mfr_row(X, 16 * ti + q, 0, g), mfr_tr(Y, 0, 16 * tj, g, q), c); return MFMA16(mfr_row(X, 16 * ti + q, 32, g), mfr_tr(Y, 32, 16 * tj, g, q), c); }
__device__ __forceinline__ f32x4 mm_nt(const LAS unsigned char* X, const LAS unsigned char* Yt, int ti, int tj, int q, int g, f32x4 c) {
    c = MFMA16(mfr_row(X, 16 * ti + q, 0, g), mfr_row(Yt, 16 * tj + q, 0, g), c); return MFMA16(mfr_row(X, 16 * ti + q, 32, g), mfr_row(Yt, 16 * tj + q, 32, g), c); }
__device__ __forceinline__ f32x4 mm_tn(const LAS unsigned char* Xt, const LAS unsigned char* Y, int ti, int tj, int q, int g, f32x4 c) {
    c = MFMA16(mfr_tr(Xt, 0, 16 * ti, g, q), mfr_tr(Y, 0, 16 * tj, g, q), c); return MFMA16(mfr_tr(Xt, 32, 16 * ti, g, q), mfr_tr(Y, 32, 16 * tj, g, q), c); }
typedef float f32x2_t __attribute__((ext_vector_type(2))); typedef __bf16 bf16x2_t __attribute__((ext_vector_type(2)));
__device__ __forceinline__ unsigned cvtpk(float lo, float hi) { f32x2_t v = {lo, hi}; bf16x2_t b = __builtin_convertvector(v, bf16x2_t); return __builtin_bit_cast(unsigned, b); }
__device__ __forceinline__ void mst_tile_t(LAS unsigned char* M, int ti, int tj, int q, int g, f32x4 c) {
    *(LAS unsigned long long*)(M + (16 * tj + q) * MST + (16 * ti + 4 * g) * 2) = (unsigned long long)cvtpk(c[0], c[1]) | ((unsigned long long)cvtpk(c[2], c[3]) << 32);
}
#define SC_BAR() do { asm volatile("s_waitcnt lgkmcnt(0)" ::: "memory"); __builtin_amdgcn_s_barrier(); asm volatile("" ::: "memory"); } while (0)
__device__ __forceinline__ void scan_units(const Args& args, int l, LAS unsigned char* lds, int vcu, int G) {
    int tid_ = threadIdx.x; asm volatile("" : "+v"(tid_)); const int tid = tid_, lane = tid & 63, wave = __builtin_amdgcn_readfirstlane(tid >> 6);
    unsigned char* ws = args.ws;
    const unsigned short* Rr = (const unsigned short*)(ws + WS_R); const float* Ww = (const float*)(ws + WS_W); const unsigned short* Kk = (const unsigned short*)(ws + WS_K); const unsigned short* Vv = (const unsigned short*)(ws + WS_V);
    const unsigned short* Aa = (const unsigned short*)(ws + WS_A); const unsigned short* Bb = (const unsigned short*)(ws + WS_B); float* Y = (float*)(ws + WS_Y);
    LAS unsigned char* iA = lds + 0 * MSLOT; LAS unsigned char* iR = lds + 1 * MSLOT; LAS unsigned char* iB = lds + 2 * MSLOT; LAS unsigned char* iK = lds + 3 * MSLOT;
    LAS unsigned char* iBh = lds + 4 * MSLOT; LAS unsigned char* iKh = lds + 5 * MSLOT; LAS unsigned char* iV = lds + 6 * MSLOT; LAS unsigned char* iS = lds + 7 * MSLOT;
    LAS unsigned char* iAak = lds + 8 * MSLOT; LAS unsigned char* iArb = lds + 9 * MSLOT; LAS unsigned char* iArk = lds + 10 * MSLOT; LAS unsigned char* iQa = lds + 11 * MSLOT;
    LAS unsigned char* iTa = lds + 12 * MSLOT; LAS unsigned char* iTb = lds + 13 * MSLOT;
    LAS unsigned char* iQb = iB; LAS unsigned char* iRHS = iK; LAS unsigned char* iU = iQa;
    LAS float* wtot = (LAS float*)(lds + LDSCTL_OFF + 1024); LAS float* sDC = wtot + 8 * 64;
    static_assert(14 * MSLOT <= RING_BYTES && LDSCTL_OFF + 1024 + 9 * 64 * 4 <= LDS_BYTES, "scan LDS map");
    const int q = lane & 15, g = lane >> 4, ti = wave >> 1, tj0 = 2 * (wave & 1);
    constexpr int C = 64, NCH = SEQ / C;
    for (int u = vcu; u < PBATCH * 16; u += G) {
        const int b = u >> 4, h = u & 15;
        const int hw = lane >> 5, jp = lane & 31;
        const size_t base0 = (size_t)(b * SEQ + 8 * wave + 4 * hw) * DRW + h * 64 + 2 * jp;
        typedef float f32x2v __attribute__((ext_vector_type(2)));
        f32x2v rw[4]; unsigned rk[4], ra[4], rb[4], rr[4], rv[4];
#define SC_LOAD(cc) do { _Pragma("unroll") for (int i = 0; i < 4; ++i) { const size_t o = base0 + (size_t)((cc) * C + i) * DRW; rw[i] = *(const f32x2v*)(Ww + o); \
            rk[i] = *(const unsigned*)(Kk + o); ra[i] = *(const unsigned*)(Aa + o); rb[i] = *(const unsigned*)(Bb + o); rr[i] = *(const unsigned*)(Rr + o); rv[i] = *(const unsigned*)(Vv + o); } } while (0)
#define BLO(U) __builtin_bit_cast(float, (U) << 16)
#define BHI(U) __builtin_bit_cast(float, (U) & 0xffff0000u)
        SC_LOAD(0);
        f32x4 Sreg[2], Treg[2];
#pragma unroll
        for (int t2 = 0; t2 < 2; ++t2) Sreg[t2] = (f32x4){0.f, 0.f, 0.f, 0.f};
        __syncthreads();
        for (int i = tid; i < 64 * 36; i += NTHR) ((LAS unsigned*)iS)[i] = 0u;
        for (int c = 0; c < NCH; ++c) {
            f32x2v p[4]; p[0] = rw[0];
#pragma unroll
            for (int i = 1; i < 4; ++i) p[i] = p[i - 1] * rw[i];
            f32x2v lo; lo.x = __shfl(p[3].x, jp); lo.y = __shfl(p[3].y, jp);
            if (hw) {
#pragma unroll
                for (int i = 0; i < 4; ++i) p[i] = p[i] * lo;
                *(LAS f32x2v*)(wtot + wave * 64 + 2 * jp) = p[3]; }
            SC_BAR();
            f32x2v pre = (f32x2v){1.f, 1.f}, dc = (f32x2v){1.f, 1.f};
#pragma unroll
            for (int w2 = 0; w2 < 8; ++w2) { const f32x2v x = *(const LAS f32x2v*)(wtot + w2 * 64 + 2 * jp); dc = dc * x; if (w2 < wave) pre = pre * x; }
            if (wave == 0 && hw == 0) *(LAS f32x2v*)(sDC + 2 * jp) = dc;
            { const f32x2v d0 = hw ? pre * lo : pre;
              f32x2v xa[4], xr[4], xb[4], xk[4], xbh[4], xkh[4], xv[4];
#pragma unroll
              for (int i = 0; i < 4; ++i) { const f32x2v Dt = pre * p[i], Dm = (i == 0) ? d0 : pre * p[i - 1]; f32x2v inv; inv.x = __builtin_amdgcn_rcpf(Dt.x); inv.y = __builtin_amdgcn_rcpf(Dt.y); const f32x2v sc = dc * inv;
                  const f32x2v a2 = (f32x2v){BLO(ra[i]), BHI(ra[i])}, r2 = (f32x2v){BLO(rr[i]), BHI(rr[i])}, b2 = (f32x2v){BLO(rb[i]), BHI(rb[i])}, k2 = (f32x2v){BLO(rk[i]), BHI(rk[i])};
                  xa[i] = a2 * Dm; xr[i] = r2 * Dt; xb[i] = b2 * inv; xk[i] = k2 * inv; xbh[i] = b2 * sc; xkh[i] = k2 * sc; xv[i] = (f32x2v){BLO(rv[i]), BHI(rv[i])}; }
              const int o0 = (2 * jp) * MST + (8 * wave + 4 * hw) * 2, o1 = o0 + MST;
#define SC_W4(img, ARR) do { *(LAS unsigned long long*)((img) + o0) = (unsigned long long)cvtpk(ARR[0].x, ARR[1].x) | ((unsigned long long)cvtpk(ARR[2].x, ARR[3].x) << 32); \
                           *(LAS unsigned long long*)((img) + o1) = (unsigned long long)cvtpk(ARR[0].y, ARR[1].y) | ((unsigned long long)cvtpk(ARR[2].y, ARR[3].y) << 32); } while (0)
              SC_W4(iA, xa); SC_W4(iR, xr); SC_W4(iB, xb); SC_W4(iK, xk); SC_W4(iBh, xbh); SC_W4(iKh, xkh); SC_W4(iV, xv);
#undef SC_W4
            }
            if (c + 1 < NCH) SC_LOAD(c + 1);
            SC_BAR();
#define FR_ROW2(dst, M, row) do { dst[0] = mfr_row(M, (row), 0, g); dst[1] = mfr_row(M, (row), 32, g); } while (0)
#define FR_TR2(dst, M, col0) do { dst[0] = mfr_tr(M, 0, (col0), g, q); dst[1] = mfr_tr(M, 32, (col0), g, q); } while (0)
#define MM2(c, a, b) MFMA16(a[1], b[1], MFMA16(a[0], b[0], (c)))
            const f32x4 z4 = (f32x4){0.f, 0.f, 0.f, 0.f};
            { bf16x8 aA[2], aR[2], bB[2][2], bK[2][2];
              FR_TR2(aA, iA, 16 * ti); FR_TR2(aR, iR, 16 * ti);
#pragma unroll
              for (int t2 = 0; t2 < 2; ++t2) { FR_TR2(bB[t2], iB, 16 * (tj0 + t2)); FR_TR2(bK[t2], iK, 16 * (tj0 + t2)); }
#pragma unroll
              for (int t2 = 0; t2 < 2; ++t2) { const int tj = tj0 + t2;
                f32x4 aab = MM2(z4, aA, bB[t2]), aak = MM2(z4, aA, bK[t2]), arb = MM2(z4, aR, bB[t2]), ark = MM2(z4, aR, bK[t2]);
#pragma unroll
                for (int e = 0; e < 4; ++e) { const int t = 16 * ti + 4 * g + e, s = 16 * tj + q; if (!(s < t)) { aab[e] = 0.f; aak[e] = 0.f; } if (!(s <= t)) { arb[e] = 0.f; ark[e] = 0.f; } }
                mst_tile_t(iQa, ti, tj, q, g, aab); mst_tile_t(iAak, ti, tj, q, g, aak); mst_tile_t(iArb, ti, tj, q, g, arb); mst_tile_t(iArk, ti, tj, q, g, ark);
#pragma unroll
                for (int e = 0; e < 4; ++e) if (16 * ti + 4 * g + e == 16 * tj + q) aab[e] += 1.0f;
                Treg[t2] = aab; mst_tile_t(iTa, ti, tj, q, g, aab); } }
            SC_BAR();
            { bf16x8 aQ[2], bQ[2][2], aA[2], bS[2][2], aK[2], bV[2][2];
              FR_TR2(aQ, iQa, 16 * ti); FR_TR2(aA, iA, 16 * ti); FR_TR2(aK, iAak, 16 * ti);
#pragma unroll
              for (int t2 = 0; t2 < 2; ++t2) { FR_ROW2(bQ[t2], iQa, 16 * (tj0 + t2) + q); FR_ROW2(bS[t2], iS, 16 * (tj0 + t2) + q); FR_ROW2(bV[t2], iV, 16 * (tj0 + t2) + q); }
#pragma unroll
              for (int t2 = 0; t2 < 2; ++t2) { const int tj = tj0 + t2;
                mst_tile_t(iQb, ti, tj, q, g, MM2(z4, aQ, bQ[t2])); mst_tile_t(iRHS, ti, tj, q, g, MM2(MM2(z4, aA, bS[t2]), aK, bV[t2])); } }
            SC_BAR();
#define SC_LEVEL(Qin, Qout, Tin, Tout, doq) do { bf16x8 aQ[2], bQ[2][2], aT[2]; FR_TR2(aQ, Qin, 16 * ti); FR_TR2(aT, Tin, 16 * ti); \
                _Pragma("unroll") for (int t2 = 0; t2 < 2; ++t2) FR_ROW2(bQ[t2], Qin, 16 * (tj0 + t2) + q); \
                _Pragma("unroll") for (int t2 = 0; t2 < 2; ++t2) { const int tj = tj0 + t2; \
                    if (doq) mst_tile_t(Qout, ti, tj, q, g, MM2(z4, aQ, bQ[t2])); \
                    Treg[t2] = MM2(Treg[t2], aT, bQ[t2]); mst_tile_t(Tout, ti, tj, q, g, Treg[t2]); } SC_BAR(); } while (0)
            SC_LEVEL(iQb, iQa, iTa, iTb, true);
            SC_LEVEL(iQa, iQb, iTb, iTa, true);
            SC_LEVEL(iQb, iQa, iTa, iTb, true);
            SC_LEVEL(iQa, iQb, iTb, iTa, true);
            SC_LEVEL(iQb, iQa, iTa, iTb, false);
#undef SC_LEVEL
            { bf16x8 aT[2], bR[2][2]; FR_TR2(aT, iTb, 16 * ti);
#pragma unroll
              for (int t2 = 0; t2 < 2; ++t2) FR_ROW2(bR[t2], iRHS, 16 * (tj0 + t2) + q);
#pragma unroll
              for (int t2 = 0; t2 < 2; ++t2) mst_tile_t(iU, ti, tj0 + t2, q, g, MM2(z4, aT, bR[t2])); }
            SC_BAR();
            { bf16x8 aRt[2], aArb[2], aArk[2], aBh[2], aKh[2], bS[2][2], bU[2][2], bV[2][2];
              FR_TR2(aRt, iR, 16 * ti); FR_TR2(aArb, iArb, 16 * ti); FR_TR2(aArk, iArk, 16 * ti); FR_ROW2(aBh, iBh, 16 * ti + q); FR_ROW2(aKh, iKh, 16 * ti + q);
#pragma unroll
              for (int t2 = 0; t2 < 2; ++t2) { FR_ROW2(bS[t2], iS, 16 * (tj0 + t2) + q); FR_ROW2(bU[t2], iU, 16 * (tj0 + t2) + q); FR_ROW2(bV[t2], iV, 16 * (tj0 + t2) + q); }
              const f32x4 dcv = *(const LAS f32x4*)(sDC + 16 * ti + 4 * g);
#pragma unroll
              for (int t2 = 0; t2 < 2; ++t2) { const int tj = tj0 + t2;
                const f32x4 y = MM2(MM2(MM2(z4, aRt, bS[t2]), aArb, bU[t2]), aArk, bV[t2]);
                float* yp = Y + (size_t)(b * SEQ + c * C + 16 * ti + 4 * g) * DRW + h * 64 + 16 * tj + q;
#pragma unroll
                for (int e = 0; e < 4; ++e) yp[(size_t)e * DRW] = y[e];
                Sreg[t2] = MM2(MM2(Sreg[t2] * dcv, aBh, bU[t2]), aKh, bV[t2]); } }
            SC_BAR();
#undef FR_ROW2
#undef FR_TR2
#undef MM2
#pragma unroll
            for (int t2 = 0; t2 < 2; ++t2) mst_tile_t(iS, ti, tj0 + t2, q, g, Sreg[t2]);
        }
#pragma unroll
        for (int t2 = 0; t2 < 2; ++t2) { const int tj = tj0 + t2;
            *(f32x4*)(args.out + O_WP + ((((size_t)l * PBATCH + b) * 16 + h) * 64 + 16 * tj + q) * 64 + 16 * ti + 4 * g) = Sreg[t2]; }
        __syncthreads();
    }
#undef SC_LOAD
#undef BLO
#undef BHI
}
#undef SC_BAR
__device__ __forceinline__ void sample_wkv_units(const Args& args, int l, int vcu, int G) {
    int tid_ = threadIdx.x; asm volatile("" : "+v"(tid_)); const int tid = tid_, lane = tid & 63, wave = __builtin_amdgcn_readfirstlane(tid >> 6); const int gw = vcu * NWAVES + wave, NGW = G * NWAVES; (void)tid; (void)lane; (void)wave; (void)gw; (void)NGW;
    unsigned char* ws = args.ws;
    const bf16* Rr = (const bf16*)(ws + WS_R); const float* Ww = (const float*)(ws + WS_W); const bf16* Kk = (const bf16*)(ws + WS_K); const bf16* Vv = (const bf16*)(ws + WS_V);
    const bf16* Aa = (const bf16*)(ws + WS_A); const bf16* Bb = (const bf16*)(ws + WS_B); float* Y = (float*)(ws + WS_Y);
    for (int u = gw; u < 128; u += NGW) {
        const int b = u >> 4, h = u & 15; const size_t vo = (size_t)(MP + b) * DRW + h * 64;
        const float* Sp = args.in[I_SWKV] + ((((size_t)l * 8 + b) * 16 + h) * 64 + lane) * 64;
        float* So = args.out + O_WS + ((((size_t)l * 8 + b) * 16 + h) * 64 + lane) * 64;
        f32x4 S[16];
#pragma unroll
        for (int j = 0; j < 16; ++j) S[j] = *(const f32x4*)(Sp + 4 * j);
        float sa = 0.f;
#pragma unroll
        for (int j = 0; j < 16; ++j) { const f32x4 a4 = ld4bf(Aa + vo + 4 * j); sa += (S[j].x * a4.x + S[j].y * a4.y) + (S[j].z * a4.z + S[j].w * a4.w); }
        const float vi = bf2f(Vv[vo + lane]); float y = 0.f;
#pragma unroll
        for (int j = 0; j < 16; ++j) { const f32x4 w4 = *(const f32x4*)(Ww + vo + 4 * j), k4 = ld4bf(Kk + vo + 4 * j), b4 = ld4bf(Bb + vo + 4 * j), r4 = ld4bf(Rr + vo + 4 * j);
            f32x4 s = S[j] * w4 + (b4 * sa + k4 * vi); y += (s.x * r4.x + s.y * r4.y) + (s.z * r4.z + s.w * r4.w); *(f32x4*)(So + 4 * j) = s; }
        Y[vo + lane] = y;
    }
}
typedef short v4i16_t __attribute__((ext_vector_type(4)));
typedef float f32x4v __attribute__((ext_vector_type(4)));
__device__ __forceinline__ void attn_units(const Args& args, int l, LAS unsigned char* lds, int vcu, int G) {
    int tid_ = threadIdx.x; asm volatile("" : "+v"(tid_)); const int tid = tid_, lane = tid & 63, wave = __builtin_amdgcn_readfirstlane(tid >> 6); const int gw = vcu * NWAVES + wave, NGW = G * NWAVES; (void)tid; (void)lane; (void)wave; (void)gw; (void)NGW;
    unsigned char* ws = args.ws;
    const bf16* QB = (const bf16*)(ws + WS_QB); const bf16* KB = (const bf16*)(ws + WS_KB); const bf16* VB = (const bf16*)(ws + WS_VB);
    bf16* OBR = (bf16*)(ws + WS_OBR); float* LSE = (float*)(ws + WS_LSE); const float* BT = (const float*)(ws + WS_BT);
    constexpr int KST = 144, VST = 160;
    LAS unsigned char* Kt = lds; LAS unsigned char* Vt = lds + 256 * KST; LAS float* btab = (LAS float*)(lds + 256 * KST + 256 * VST);
    const int q = lane & 15, g = lane >> 4;
    constexpr int NA_S = 0, NA_O = 16; static_assert(64 * NA_S + 192 * NA_O == PBATCH * NHEADS * 48, "attention unit deal");
    const bool deal = (G == 256); const int ufirst = deal ? ((vcu < 64) ? vcu * NA_S : 64 * NA_S + (vcu - 64) * NA_O) : vcu, ucnt = deal ? ((vcu < 64) ? NA_S : NA_O) : (PBATCH * NHEADS * 48 - vcu + G - 1) / G, ustep = deal ? 1 : G;
    for (int ui = 0; ui < ucnt; ++ui) { const int u = ufirst + ui * ustep;
        const int rn = u & 15, br = (u >> 4) % 3, h = (u / 48) & 15, b = u / 768;
        const int dsh = 2 * br, dil = 1 << dsh, r = rn & (dil - 1), n = rn >> dsh;
        __syncthreads();
        for (int i = tid; i < 2048; i += NTHR) { const int row = i >> 3, chk = i & 7, sk = (n - 1) * 128 + row; v4u kv = (v4u){0u, 0u, 0u, 0u}, vv = (v4u){0u, 0u, 0u, 0u};
            if (sk >= 0) { const size_t go = ((size_t)(b * SEQ + sk * dil + r)) * DATT + h * 64 + chk * 8; kv = *(const v4u*)(KB + go); vv = *(const v4u*)(VB + go); }
            *(LAS v4u*)(Kt + row * KST + chk * 16) = kv; *(LAS v4u*)(Vt + row * VST + chk * 16) = vv; }
        if (tid < 129) btab[tid] = BT[(br * 129 + tid) * 16 + h];
        __syncthreads();
        const int iq = 16 * wave + q, mq = b * SEQ + (n * 128 + iq) * dil + r;
        const bf16x8 qf0 = *(const bf16x8*)(QB + (size_t)mq * DATT + h * 64 + 8 * g), qf1 = *(const bf16x8*)(QB + (size_t)mq * DATT + h * 64 + 32 + 8 * g);
        const int kb0 = wave >> 1;
        f32x4 sacc[10];
#pragma unroll
        for (int sb = 0; sb < 10; ++sb) { const int key0 = 32 * kb0 + 16 * sb;
            const bf16x8 a0 = *(const LAS bf16x8*)(Kt + (key0 + q) * KST + 16 * g), a1 = *(const LAS bf16x8*)(Kt + (key0 + q) * KST + 64 + 16 * g);
            f32x4 acc = (f32x4){0.f, 0.f, 0.f, 0.f};
            acc = __builtin_amdgcn_mfma_f32_16x16x32_bf16(a0, qf0, acc, 0, 0, 0); acc = __builtin_amdgcn_mfma_f32_16x16x32_bf16(a1, qf1, acc, 0, 0, 0); sacc[sb] = acc; }
        float mx = -INFINITY;
#pragma unroll
        for (int sb = 0; sb < 10; ++sb)
#pragma unroll
            for (int e = 0; e < 4; ++e) { const int jj = 32 * kb0 + 16 * sb + 4 * g + e, dsub = 128 + iq - jj, sk = (n - 1) * 128 + jj;
                const bool ok = (dsub >= 0) && (dsub <= 128) && (sk >= 0);
                const float s = ok ? sacc[sb][e] * ATT_SCALE + btab[ok ? dsub : 0] : -INFINITY; sacc[sb][e] = s; mx = fmaxf(mx, s); }
        mx = fmaxf(mx, __shfl_xor(mx, 16)); mx = fmaxf(mx, __shfl_xor(mx, 32));
        float sum = 0.f;
#pragma unroll
        for (int sb = 0; sb < 10; ++sb)
#pragma unroll
            for (int e = 0; e < 4; ++e) { const float p = __expf(sacc[sb][e] - mx); sacc[sb][e] = p; sum += p; }
        sum += __shfl_xor(sum, 16); sum += __shfl_xor(sum, 32);
        f32x4 o[4];
#pragma unroll
        for (int c = 0; c < 4; ++c) o[c] = (f32x4){0.f, 0.f, 0.f, 0.f};
#pragma unroll
        for (int kk = 0; kk < 5; ++kk) {
            v4u pw; pw.x = pk2(sacc[2 * kk][0], sacc[2 * kk][1]); pw.y = pk2(sacc[2 * kk][2], sacc[2 * kk][3]); pw.z = pk2(sacc[2 * kk + 1][0], sacc[2 * kk + 1][1]); pw.w = pk2(sacc[2 * kk + 1][2], sacc[2 * kk + 1][3]);
            const bf16x8 pb = __builtin_bit_cast(bf16x8, pw);
            const int R0 = 32 * (kb0 + kk) + 4 * g + (q >> 2);
#pragma unroll
            for (int c = 0; c < 4; ++c) {
                const v4i16_t lo = __builtin_amdgcn_ds_read_tr16_b64_v4i16((LAS v4i16_t*)(Vt + R0 * VST + (16 * c + 4 * (q & 3)) * 2));
                const v4i16_t hi = __builtin_amdgcn_ds_read_tr16_b64_v4i16((LAS v4i16_t*)(Vt + (R0 + 16) * VST + (16 * c + 4 * (q & 3)) * 2));
                const bf16x8 va = (bf16x8){lo[0], lo[1], lo[2], lo[3], hi[0], hi[1], hi[2], hi[3]};
                o[c] = __builtin_amdgcn_mfma_f32_16x16x32_bf16(va, pb, o[c], 0, 0, 0); }
        }
        const float inv = 1.0f / sum;
        bf16* op = OBR + ((size_t)br * MP + mq) * DATT + h * 64 + 4 * g;
#pragma unroll
        for (int c = 0; c < 4; ++c) { const unsigned long long w = (unsigned long long)pk2(o[c][0] * inv, o[c][1] * inv) | ((unsigned long long)pk2(o[c][2] * inv, o[c][3] * inv) << 32); *(unsigned long long*)(op + 16 * c) = w; }
        if (g == 0) LSE[((size_t)br * MP + mq) * 16 + h] = mx + __logf(sum);
    }
}
__device__ __forceinline__ void sample_attn_units(const Args& args, int l, LAS unsigned char* lds, int vcu, int G) {
    int tid_ = threadIdx.x; asm volatile("" : "+v"(tid_)); const int tid = tid_, lane = tid & 63, wave = __builtin_amdgcn_readfirstlane(tid >> 6); const int gw = vcu * NWAVES + wave, NGW = G * NWAVES; (void)tid; (void)lane; (void)wave; (void)gw; (void)NGW;
    unsigned char* ws = args.ws;
    const bf16* QB = (const bf16*)(ws + WS_QB); bf16* MIX = (bf16*)(ws + WS_MIX); const float* BT = (const float*)(ws + WS_BT);
    LAS float* pl = (LAS float*)(lds + 90112) + wave * 448;
    for (int u = gw; u < 128; u += NGW) {
        const int b = u >> 4, h = u & 15, m = MP + b;
        float qv[64];
#pragma unroll
        for (int j = 0; j < 8; ++j) { const v4u w = *(const v4u*)(QB + (size_t)m * DATT + h * 64 + 8 * j);
            qv[8 * j + 0] = bf2f((unsigned short)(w.x & 0xffff)); qv[8 * j + 1] = bf2f((unsigned short)(w.x >> 16)); qv[8 * j + 2] = bf2f((unsigned short)(w.y & 0xffff)); qv[8 * j + 3] = bf2f((unsigned short)(w.y >> 16));
            qv[8 * j + 4] = bf2f((unsigned short)(w.z & 0xffff)); qv[8 * j + 5] = bf2f((unsigned short)(w.z >> 16)); qv[8 * j + 6] = bf2f((unsigned short)(w.w & 0xffff)); qv[8 * j + 7] = bf2f((unsigned short)(w.w >> 16)); }
        const float* knew = args.out + O_KS + ((size_t)l * 8 + b) * DATT + h * 64; const float* vnew = args.out + O_VS + ((size_t)l * 8 + b) * DATT + h * 64;
        const float* kc = args.in[I_CK] + (((size_t)l * 8 + b) * 2048) * 1024 + h * 64; const float* vc = args.in[I_CV] + (((size_t)l * 8 + b) * 2048) * 1024 + h * 64;
        float mx = -INFINITY;
        for (int it = 0; it < 7; ++it) { const int kk = lane + 64 * it;
            if (kk < 387) { const int br = kk / 129, mm = kk % 129; const float* kp = (mm == 0) ? knew : kc + (size_t)(2048 - (mm << (2 * br))) * 1024;
                float d = 0.f;
#pragma unroll
                for (int j = 0; j < 16; ++j) { const f32x4 k4 = *(const f32x4*)(kp + 4 * j); d += (qv[4 * j] * k4.x + qv[4 * j + 1] * k4.y) + (qv[4 * j + 2] * k4.z + qv[4 * j + 3] * k4.w); }
                const float s = d * ATT_SCALE + BT[(br * 129 + mm) * 16 + h]; pl[kk] = s; mx = fmaxf(mx, s); } }
        mx = wave_max(mx);
        float sum = 0.f;
        for (int it = 0; it < 7; ++it) { const int kk = lane + 64 * it; if (kk < 387) { const float p = __expf(pl[kk] - mx); pl[kk] = p; sum += p; } }
        sum = wave_sum(sum);
        f32x4 o4 = (f32x4){0.f, 0.f, 0.f, 0.f}; const int kg = lane >> 4, dq = lane & 15;
#pragma unroll 8
        for (int i = 0; i < 97; ++i) { const int kk = kg + 4 * i; if (kk < 387) { const int br = kk / 129, mm = kk % 129; const float* vp = (mm == 0) ? vnew : vc + (size_t)(2048 - (mm << (2 * br))) * 1024;
            o4 += *(const f32x4*)(vp + 4 * dq) * pl[kk]; } }
#pragma unroll
        for (int e = 0; e < 4; ++e) { o4[e] += __shfl_xor(o4[e], 16); o4[e] += __shfl_xor(o4[e], 32); }
        if (kg == 0) { const float inv = 1.0f / sum; *(unsigned long long*)(MIX + (size_t)m * DM + h * 64 + 4 * dq) = (unsigned long long)pk2(o4.x * inv, o4.y * inv) | ((unsigned long long)pk2(o4.z * inv, o4.w * inv) << 32); }
    }
}

__device__ __forceinline__ void mx_phase(const Args& args, int l, int vcu, int G) {
    int tid_ = threadIdx.x; asm volatile("" : "+v"(tid_)); const int tid = tid_, lane = tid & 63, wave = __builtin_amdgcn_readfirstlane(tid >> 6); const int gw = vcu * NWAVES + wave, NGW = G * NWAVES; (void)tid; (void)lane; (void)wave; (void)gw; (void)NGW;
    unsigned char* ws = args.ws;
    const bf16* OBR = (const bf16*)(ws + WS_OBR); const float* LSE = (const float*)(ws + WS_LSE); bf16* MIX = (bf16*)(ws + WS_MIX);
    const bf16* Rr = (const bf16*)(ws + WS_R); const bf16* Kk = (const bf16*)(ws + WS_K); const bf16* Vv = (const bf16*)(ws + WS_V); const bf16* Gg = (const bf16*)(ws + WS_G); const float* Y = (const float*)(ws + WS_Y);
    const int hh = lane >> 2, p = lane & 3, c0 = hh * 64 + p * 16;
    f32x4 lng[4], lnb[4], rk[4];
#pragma unroll
    for (int j = 0; j < 4; ++j) { lng[j] = *(const f32x4*)(args.in[I_LNG] + (size_t)l * DRW + c0 + 4 * j); lnb[j] = *(const f32x4*)(args.in[I_LNB] + (size_t)l * DRW + c0 + 4 * j); rk[j] = *(const f32x4*)(args.in[I_RK] + (size_t)l * DRW + c0 + 4 * j); }
    for (int m = gw; m < NROWS; m += NGW) {
        if (m < MP) {
            const float l0 = LSE[((size_t)0 * MP + m) * 16 + hh], l1 = LSE[((size_t)1 * MP + m) * 16 + hh], l2 = LSE[((size_t)2 * MP + m) * 16 + hh];
            const float mx = fmaxf(l0, fmaxf(l1, l2)); float e0 = __expf(l0 - mx), e1 = __expf(l1 - mx), e2 = __expf(l2 - mx); const float inv = 1.0f / (e0 + e1 + e2); e0 *= inv; e1 *= inv; e2 *= inv;
            float acc[16];
#pragma unroll
            for (int i = 0; i < 16; ++i) acc[i] = 0.f;
#pragma unroll
            for (int br = 0; br < 3; ++br) { const float al = br == 0 ? e0 : br == 1 ? e1 : e2;
#pragma unroll
                for (int j = 0; j < 2; ++j) { const v4u w = *(const v4u*)(OBR + ((size_t)br * MP + m) * DATT + c0 + 8 * j);
                    acc[8 * j + 0] += al * bf2f((unsigned short)(w.x & 0xffff)); acc[8 * j + 1] += al * bf2f((unsigned short)(w.x >> 16)); acc[8 * j + 2] += al * bf2f((unsigned short)(w.y & 0xffff)); acc[8 * j + 3] += al * bf2f((unsigned short)(w.y >> 16));
                    acc[8 * j + 4] += al * bf2f((unsigned short)(w.z & 0xffff)); acc[8 * j + 5] += al * bf2f((unsigned short)(w.z >> 16)); acc[8 * j + 6] += al * bf2f((unsigned short)(w.w & 0xffff)); acc[8 * j + 7] += al * bf2f((unsigned short)(w.w >> 16)); } }
            v4u o0, o1; o0.x = pk2(acc[0], acc[1]); o0.y = pk2(acc[2], acc[3]); o0.z = pk2(acc[4], acc[5]); o0.w = pk2(acc[6], acc[7]); o1.x = pk2(acc[8], acc[9]); o1.y = pk2(acc[10], acc[11]); o1.z = pk2(acc[12], acc[13]); o1.w = pk2(acc[14], acc[15]);
            *(v4u*)(MIX + (size_t)m * DM + c0) = o0; *(v4u*)(MIX + (size_t)m * DM + c0 + 8) = o1;
        }
        const size_t ro = (size_t)m * DRW + c0;
        f32x4 y[4], rr[4], kk[4], vv[4], gg[4];
        float s = 0.f, bon = 0.f;
#pragma unroll
        for (int j = 0; j < 4; ++j) { y[j] = *(const f32x4*)(Y + ro + 4 * j); rr[j] = ld4bf(Rr + ro + 4 * j); kk[j] = ld4bf(Kk + ro + 4 * j); vv[j] = ld4bf(Vv + ro + 4 * j); gg[j] = ld4bf(Gg + ro + 4 * j);
            s += (y[j].x + y[j].y) + (y[j].z + y[j].w); const f32x4 t = rr[j] * kk[j] * rk[j]; bon += (t.x + t.y) + (t.z + t.w); }
        s += __shfl_xor(s, 1); s += __shfl_xor(s, 2); bon += __shfl_xor(bon, 1); bon += __shfl_xor(bon, 2);
        const float mean = s * (1.0f / 64.0f); float qq = 0.f;
#pragma unroll
        for (int j = 0; j < 4; ++j) { y[j] = y[j] - mean; qq += (y[j].x * y[j].x + y[j].y * y[j].y) + (y[j].z * y[j].z + y[j].w * y[j].w); }
        qq += __shfl_xor(qq, 1); qq += __shfl_xor(qq, 2);
        const float rstd = 1.0f / sqrtf(qq * (1.0f / 64.0f) + GN_EPS);
        v4u o0, o1; f32x4 z[4];
#pragma unroll
        for (int j = 0; j < 4; ++j) z[j] = ((y[j] * rstd) * lng[j] + lnb[j] + vv[j] * bon) * gg[j];
        o0.x = pk2(z[0].x, z[0].y); o0.y = pk2(z[0].z, z[0].w); o0.z = pk2(z[1].x, z[1].y); o0.w = pk2(z[1].z, z[1].w); o1.x = pk2(z[2].x, z[2].y); o1.y = pk2(z[2].z, z[2].w); o1.z = pk2(z[3].x, z[3].y); o1.w = pk2(z[3].z, z[3].w);
        *(v4u*)(MIX + (size_t)m * DM + DATT + c0) = o0; *(v4u*)(MIX + (size_t)m * DM + DATT + c0 + 8) = o1;
    }
}

template <int K> __device__ __forceinline__ void sample_proj(const bf16* A, const bf16* Bt, const float* base_s, float* out_s, const float* gate, LAS unsigned char* lds, int vcu, int G) {
    int tid_ = threadIdx.x; asm volatile("" : "+v"(tid_)); const int tid = tid_, lane = tid & 63, wave = __builtin_amdgcn_readfirstlane(tid >> 6);
    constexpr int KW = K / 8, NS = KW / 32; static_assert(KW % 32 == 0, "K split");
    LAS float* part = (LAS float*)lds;
    const int c = lane & 15, g = lane >> 4;
    for (int cg = vcu; cg < DM / 8; cg += G) {
        const int n0 = 8 * cg;
        const bf16* ap = A + (size_t)(MP + (c & 7)) * K + wave * KW + 8 * g; const bf16* bp = Bt + (size_t)(n0 + (c & 7)) * K + wave * KW + 8 * g;
        bf16x8 af[NS], bfr[NS];
#pragma unroll
        for (int s = 0; s < NS; ++s) { af[s] = *(const bf16x8*)(ap + 32 * s); bfr[s] = *(const bf16x8*)(bp + 32 * s); }
        f32x4 acc = (f32x4){0.f, 0.f, 0.f, 0.f};
#pragma unroll
        for (int s = 0; s < NS; ++s) acc = __builtin_amdgcn_mfma_f32_16x16x32_bf16(af[s], bfr[s], acc, 0, 0, 0);
        __syncthreads();
        if (g < 2 && c < 8) {
#pragma unroll
            for (int e = 0; e < 4; ++e) part[(wave * 8 + 4 * g + e) * 8 + c] = acc[e]; }
        __syncthreads();
        if (tid < 64) { const int r = tid >> 3, cc = tid & 7; float s = 0.f;
#pragma unroll
            for (int w = 0; w < 8; ++w) s += part[(w * 8 + r) * 8 + cc];
            const size_t o = (size_t)r * DM + n0 + cc; out_s[o] = base_s[o] + gate[(size_t)(4 + r) * MODW + n0 + cc] * s; }
    }
    __syncthreads();
}

__device__ __forceinline__ void n1_phase(const Args& args, int l, int vcu, int G, const float* Xp, const float* Xs, const float* modl, bf16* HB) {
    int tid_ = threadIdx.x; asm volatile("" : "+v"(tid_)); const int tid = tid_, lane = tid & 63, wave = __builtin_amdgcn_readfirstlane(tid >> 6); const int gw = vcu * NWAVES + wave, NGW = G * NWAVES; (void)tid; (void)lane; (void)wave; (void)gw; (void)NGW;
    for (int m = gw; m < NROWS + 8; m += NGW) {
        if (m < MP) { const int b = m >> 11, t = m & (SEQ - 1);
            norm_mod_row(Xp + (size_t)m * DM, args.in[I_N1G] + (size_t)l * DM, modl + (size_t)b * MODW, modl + (size_t)b * MODW + DM, HB + (size_t)m * DM,
                         (t == SEQ - 1) ? args.out + O_SP + ((size_t)l * PBATCH + b) * DM : nullptr, lane); }
        else if (m < NROWS) { const int b = m - MP;
            norm_mod_row(Xs + (size_t)b * DM, args.in[I_N1G] + (size_t)l * DM, modl + (size_t)(4 + b) * MODW, modl + (size_t)(4 + b) * MODW + DM, HB + (size_t)m * DM,
                         args.out + O_SS + ((size_t)l * 8 + b) * DM, lane); }
        else { const int b = m - NROWS; const float* s = args.in[I_SSH] + ((size_t)l * 8 + b) * DM; GAS unsigned long long* o8 = (GAS unsigned long long*)(HB + (size_t)m * DM) + lane;
#pragma unroll
            for (int j = 0; j < 8; ++j) { const f32x4 v = ((const GAS f32x4*)s)[lane + 64 * j]; o8[64 * j] = (unsigned long long)pk2(v.x, v.y) | ((unsigned long long)pk2(v.z, v.w) << 32); } }
    }
}
__device__ __forceinline__ void n2_phase(const Args& args, int l, int vcu, int G, const float* XB, const float* modl, bf16* HB) {
    int tid_ = threadIdx.x; asm volatile("" : "+v"(tid_)); const int tid = tid_, lane = tid & 63, wave = __builtin_amdgcn_readfirstlane(tid >> 6); const int gw = vcu * NWAVES + wave, NGW = G * NWAVES; (void)tid; (void)lane; (void)wave; (void)gw; (void)NGW;
    for (int m = gw; m < NROWS; m += NGW) { const int bb = (m < MP) ? (m >> 11) : 4 + (m - MP);
        norm_mod_row(XB + (size_t)m * DM, args.in[I_N2G] + (size_t)l * DM, modl + (size_t)bb * MODW + 3 * DM, modl + (size_t)bb * MODW + 4 * DM, HB + (size_t)m * DM, nullptr, lane); }
}

__global__ void __launch_bounds__(NTHR, 2) fwd(Args args) {
    extern __shared__ __attribute__((aligned(16))) unsigned char lds_raw[];
    LAS unsigned char* lds = (LAS unsigned char*)lds_raw;
    volatile LAS unsigned* MISC = (volatile LAS unsigned*)(lds + MISC_OFF);
    const int G = gridDim.x; const int bx = blockIdx.x; const int vcu = (G % 8 == 0) ? (bx % 8) * (G / 8) + bx / 8 : bx;
    unsigned char* ws = args.ws;
    for (int u = threadIdx.x; u < (LDS_BYTES - LDSCTL_OFF) / 4; u += NTHR) ((LAS unsigned*)(lds + LDSCTL_OFF))[u] = 0u;
    __syncthreads();
    const int lo = args.ph_lo, hi = args.ph_hi;
    XcdBarrier bar; bar.bar = (unsigned*)(ws + WS_CTL) + CW_BAR; bar.x = 0; bar.st = nullptr;
    if (hi - lo > 1) bar = xcd_barrier_post((unsigned*)(ws + WS_CTL) + CW_BAR, MISC + 8);
#define IN(k) (lo <= (k) && (k) < hi)
#define SEAM(k) do { if (IN(k) && IN((k) + 1)) xcd_barrier(bar); } while (0)

    if (IN(0)) { for (int rep = 0; rep < REP_P0; ++rep) { __syncthreads(); p0_prologue(args, lds, vcu, G); } }
    SEAM(0);

    float* MOD = (float*)(ws + WS_MOD);
    bf16* HB = (bf16*)(ws + WS_HB); bf16* MIX = (bf16*)(ws + WS_MIX); float* XB = (float*)(ws + WS_XB); bf16* ACT = (bf16*)(ws + WS_ACT);
    for (int l = 0; l < DEPTH; ++l) {
        const int pb = 1 + PH_PER_LAYER * l;
        const float* modl = MOD + (size_t)l * 12 * MODW;
        const float* Xp = (l == 0) ? args.in[I_XP] : XB; const float* Xs = (l == 0) ? args.in[I_XS] : XB + (size_t)MP * DM;
        if (IN(pb + 0)) { for (int rep = 0; rep < REP_N1; ++rep) { __syncthreads(); n1_phase(args, l, vcu, G, Xp, Xs, modl, HB); } }
        SEAM(pb + 0);
        if (IN(pb + 1)) {
            __syncthreads();
            pg8::Gemm g{(const pg8::bf16_t*)HB, (const pg8::bf16_t*)(ws + WS_WIN) + (size_t)l * N1 * DM, MH, N1, DM}; pg8::StaticOrder S; S.init(MH, N1, G, bx);
            pg8::EpiG1 E{(pg8::bf16_t*)(ws + WS_QB), (size_t)(WS_KB - WS_QB) / 2, (pg8::bf16_t*)(ws + WS_RKV), (float*)(ws + WS_P),
                         args.out + O_KP + (size_t)l * MP * DATT, args.out + O_KS + (size_t)l * 8 * DATT, (size_t)(O_VP - O_KP), (size_t)(O_VS - O_KS), args.in[I_QG] + l * 64, args.in[I_KG] + l * 64};
            pg8::gemm_phase<pg8::EpiG1, pg8::StaticOrder, true, true>(lds, g, S, E);
            if (l + 1 < DEPTH && bx >= (MH / 256) * (N1 / 256) % G && G == 256) prep_layer_pull(args, l + 1, 0, TAIL_PULLS, lds, MISC + 16);
        }
        SEAM(pb + 1);
        if (IN(pb + 2)) { for (int rep = 0; rep < REP_PW; ++rep) { __syncthreads(); pw_phase(args, l, lds, vcu, G); } }
        SEAM(pb + 2);
        if (IN(pb + 3)) {
            __syncthreads();
            for (int rep = 0; rep < REP_SCAN; ++rep) { __syncthreads(); scan_units(args, l, lds, vcu, G); }
            sample_wkv_units(args, l, vcu, G);
            __syncthreads();
            for (int rep = 0; rep < REP_ATT; ++rep) { __syncthreads(); attn_units(args, l, lds, vcu, G); }
            __syncthreads();
            for (int rep = 0; rep < REP_SATT; ++rep) { __syncthreads(); sample_attn_units(args, l, lds, vcu, G); }
            if (l + 1 < DEPTH) { prep_layer_pull(args, l + 1, 1, 1 << 30, lds, MISC + 16); prep_layer_pull(args, l + 1, 0, 1 << 30, lds, MISC + 16); }
        }
        SEAM(pb + 3);
        if (IN(pb + 4)) { for (int rep = 0; rep < REP_MX; ++rep) mx_phase(args, l, vcu, G); }
        SEAM(pb + 4);
        if (IN(pb + 5)) {
            __syncthreads();
            sample_proj<DM>(MIX, (const bf16*)(ws + WS_WOUT) + (size_t)l * DM * DM, Xs, XB + (size_t)MP * DM, modl + 2 * DM, lds, vcu, G);
            pg8::Gemm g{(const pg8::bf16_t*)MIX, (const pg8::bf16_t*)(ws + WS_WOUT) + (size_t)l * DM * DM, MP, DM, DM}; pg8::StaticOrder S; S.init(MP, DM, G, bx);
            pg8::EpiResid E{Xp, Xs, XB, XB + (size_t)MP * DM, modl + 2 * DM};
            pg8::gemm_phase<pg8::EpiResid, pg8::StaticOrder, true, true>(lds, g, S, E);
        }
        SEAM(pb + 5);
        if (IN(pb + 6)) { for (int rep = 0; rep < REP_N2; ++rep) { __syncthreads(); n2_phase(args, l, vcu, G, XB, modl, HB); } }
        SEAM(pb + 6);
        if (IN(pb + 7)) {
            __syncthreads();
            pg8::Gemm g{(const pg8::bf16_t*)HB, (const pg8::bf16_t*)(ws + WS_WGU) + (size_t)l * 2 * FF * DM, MH, 2 * FF, DM}; pg8::StaticOrder S; S.init(MH, 2 * FF, G, bx);
            pg8::EpiSwiGLU E{(pg8::bf16_t*)ACT, FF};
            for (int rep = 0; rep < REP_G3; ++rep) pg8::gemm_phase<pg8::EpiSwiGLU, pg8::StaticOrder, true, true>(lds, g, S, E);
            if (l + 1 < DEPTH && bx >= (MH / 256) * (2 * FF / 256) % G && G == 256) prep_layer_pull(args, l + 1, 0, TAIL_PULLS, lds, MISC + 16);
        }
        SEAM(pb + 7);
        if (IN(pb + 8)) {
            __syncthreads();
            float* op = (l == DEPTH - 1) ? args.out + O_YP : XB; float* os = (l == DEPTH - 1) ? args.out + O_YS : XB + (size_t)MP * DM;
            sample_proj<FF>(ACT, (const bf16*)(ws + WS_WDN) + (size_t)l * DM * FF, XB + (size_t)MP * DM, os, modl + 5 * DM, lds, vcu, G);
            pg8::Gemm g{(const pg8::bf16_t*)ACT, (const pg8::bf16_t*)(ws + WS_WDN) + (size_t)l * DM * FF, MP, DM, FF}; pg8::StaticOrder S; S.init(MP, DM, G, bx);
            pg8::EpiResid E{XB, XB + (size_t)MP * DM, op, os, modl + 5 * DM};
            pg8::gemm_phase<pg8::EpiResid, pg8::StaticOrder, true, true>(lds, g, S, E);
        }
        SEAM(pb + 8);
    }
#undef IN
#undef SEAM
}

extern "C" void kernel_launch(void* const* d_in, const int* in_sizes, int n_in, void* d_out, int out_size, void* d_ws, size_t ws_size, hipStream_t stream) {
    static int grid = 0;
    if (grid == 0) {
        if (n_in != N_IN || (size_t)out_size != O_END || ws_size < WS_END) { fprintf(stderr, "kernel_launch: unexpected shapes: n_in %d, out %d, ws %zu (need %zu)\n", n_in, out_size, ws_size, (size_t)WS_END); grid = -1; return; }
        int dev = 0, cus = 0;
        if (hipGetDevice(&dev) != hipSuccess || hipDeviceGetAttribute(&cus, hipDeviceAttributeMultiprocessorCount, dev) != hipSuccess) { grid = -1; return; }
        if (hipFuncSetAttribute((const void*)fwd, hipFuncAttributeMaxDynamicSharedMemorySize, LDS_BYTES) != hipSuccess) { fprintf(stderr, "kernel_launch: hipFuncSetAttribute failed\n"); grid = -1; return; }
        int per_cu = 0;
        if (hipOccupancyMaxActiveBlocksPerMultiprocessor(&per_cu, (const void*)fwd, NTHR, LDS_BYTES) != hipSuccess || per_cu < 1) fprintf(stderr, "kernel_launch: occupancy query says %d blocks per CU\n", per_cu);
        (void)hipGetLastError();
        grid = cus;
    }
    if (grid < 0) return;
    if (hipMemsetAsync((char*)d_ws + WS_CTL, 0, CTL_ZERO_BYTES, stream) != hipSuccess) return;
    Args a{};
    for (int i = 0; i < N_IN; ++i) a.in[i] = (const float*)d_in[i];
    a.out = (float*)d_out; a.ws = (unsigned char*)d_ws;
#if MK_N_LAUNCHES == 1
    a.ph_lo = 0; a.ph_hi = N_PHASES;
    hipLaunchKernelGGL(fwd, dim3(grid), dim3(NTHR), LDS_BYTES, stream, a);
#else
    for (int li = 0; li < N_PHASES; ++li) { a.ph_lo = li; a.ph_hi = li + 1; hipLaunchKernelGGL(fwd, dim3(grid), dim3(NTHR), LDS_BYTES, stream, a); }
#endif
}
```

```cpp
#include <hip/hip_runtime.h>
#include <cstdio>
#include <cstdint>
#include <cmath>
namespace pg8 {
#define PG8_LAS __attribute__((address_space(3)))
typedef unsigned short bf16_t;
typedef short bf16x8 __attribute__((ext_vector_type(8)));
typedef float f32x4 __attribute__((ext_vector_type(4)));
typedef unsigned u32x4 __attribute__((ext_vector_type(4)));
constexpr int BM = 256, BK = 64, HALF = 128, HTB = HALF * BK * 2  , STAGE_BYTES = 8 * HTB, NXCD = 8, WGM = 8;

__host__ __device__ __forceinline__ int lds_byte(int r, int c) { const int st = (r >> 4) * 2 + (c >> 5), rr = r & 15, cc = c & 31, ob = rr * 64 + cc * 2; return st * 1024 + (ob ^ (((ob >> 9) & 1) << 5)); }
__host__ __device__ __forceinline__ void stage_rc(int b, int& R, int& C) { const int st = b / 1024, sb = b % 1024, swz = sb ^ (((sb >> 9) & 1) << 5); R = (st >> 1) * 16 + swz / 64; C = (st & 1) * 32 + (swz % 64) / 2; }
__host__ __device__ __forceinline__ int perm32(int rho) { const int n = rho >> 4, i = rho & 15; return 8 * (i >> 2) + 4 * n + (i & 3); }

struct Unit { int pm, pn; };
struct Gemm { const bf16_t* A; const bf16_t* Bt; int M, N, K; };

struct StaticOrder {
    int nM, nN, nwg, G, c;
    __host__ __device__ void init(int M, int N, int G_, int c_) { nM = M / BM; nN = N / BM; nwg = nM * nN; G = G_; c = c_; }
    __host__ __device__ bool next(int i, Unit& u) const {
        const long L = (long)i * G + c; if (L >= nwg) return false;
        int wgid = (int)L; { const int q = nwg / NXCD, r = nwg % NXCD, xcd = wgid % NXCD, off = wgid / NXCD; wgid = (xcd < r ? xcd * (q + 1) : r * (q + 1) + (xcd - r) * q) + off; }
        const int nig = WGM * nN, gid = wgid / nig, fm = gid * WGM, gsz = (nM - fm) < WGM ? (nM - fm) : WGM;
        u.pm = fm + ((wgid % nig) % gsz); u.pn = (wgid % nig) / gsz; return true;
    }
    __device__ __forceinline__ void a_ready(const Unit&) const {}
    __device__ __forceinline__ void done(const Unit&) const {}
};

__device__ __forceinline__ unsigned cvt_pk_bf16(float lo, float hi) { unsigned r; asm volatile("v_cvt_pk_bf16_f32 %0, %1, %2" : "=v"(r) : "v"(lo), "v"(hi)); return r; }
typedef float f32x2 __attribute__((ext_vector_type(2)));
__device__ __forceinline__ f32x2 gelu_pk(f32x2 v) {
    const f32x2 av = __builtin_elementwise_abs(v), d = av * 0.2316418882f + 1.0f;
    f32x2 t; t.x = __builtin_amdgcn_rcpf(d.x); t.y = __builtin_amdgcn_rcpf(d.y);
    f32x2 q = t * 0.5307027145f + (-0.7265760135f); q = q * t + 0.7107068705f; q = q * t + (-0.142248368f); q = q * t + 0.127414796f; q = q * t;
    const f32x2 s = (v * v) * (-0.72134752044f);
    f32x2 e; e.x = __builtin_amdgcn_exp2f(s.x); e.y = __builtin_amdgcn_exp2f(s.y);
    const f32x2 m = v * (q * e), r = v - m;
    f32x2 o; o.x = v.x < 0.f ? m.x : r.x; o.y = v.y < 0.f ? m.y : r.y; return o;
}

template <int ACT  > struct EpiBf16 {
    static constexpr bool PERM = true, AFTER_DRAIN = false; static_assert(ACT == 0 || ACT == 1, "EpiBf16: ACT is 0 (none) or 1 (gelu_pk)");
    bf16_t* O; int ldc; const float* bias; int split_cols; size_t split_stride; float scale0;
    __device__ __forceinline__ void operator()(const f32x4 (&acc)[2][2][4][2], const Unit& u, int wr, int wc, int fr, int fq) const {
        const int row0 = u.pm * BM + wr * 64 + fr; int colt = u.pn * BM; bf16_t* base = O;
        float sc = 1.f; if (split_cols) { const int t = colt / split_cols; base += (size_t)t * split_stride; colt -= t * split_cols; if (t == 0) sc = scale0; }
        const int col0 = colt + wc * 32 + 8 * fq, bcol0 = u.pn * BM + wc * 32 + 8 * fq;
        f32x4 bv[2][2];
#pragma unroll
        for (int bj = 0; bj < 2; ++bj)
#pragma unroll
            for (int n = 0; n < 2; ++n) bv[bj][n] = bias ? *(const f32x4*)(bias + bcol0 + bj * HALF + 4 * n) : (f32x4){0.f, 0.f, 0.f, 0.f};
#pragma unroll
        for (int ai = 0; ai < 2; ++ai)
#pragma unroll
            for (int m = 0; m < 4; ++m) { bf16_t* rowp = base + (size_t)(row0 + ai * HALF + m * 16) * ldc + col0;
#pragma unroll
                for (int bj = 0; bj < 2; ++bj) { f32x4 v0 = acc[ai][bj][m][0] + bv[bj][0], v1 = acc[ai][bj][m][1] + bv[bj][1];
                    if (ACT == 1) { f32x2 a = gelu_pk((f32x2){v0[0], v0[1]}), b = gelu_pk((f32x2){v0[2], v0[3]}), c = gelu_pk((f32x2){v1[0], v1[1]}), d = gelu_pk((f32x2){v1[2], v1[3]});
                        v0 = (f32x4){a.x, a.y, b.x, b.y}; v1 = (f32x4){c.x, c.y, d.x, d.y}; }
                    v0 = v0 * sc; v1 = v1 * sc; u32x4 w; w.x = cvt_pk_bf16(v0[0], v0[1]); w.y = cvt_pk_bf16(v0[2], v0[3]); w.z = cvt_pk_bf16(v1[0], v1[1]); w.w = cvt_pk_bf16(v1[2], v1[3]);
                    *(u32x4*)(rowp + bj * HALF) = w; } }
    }
};


struct EpiF32 {
    static constexpr bool PERM = false, AFTER_DRAIN = false;
    float* O; int ldc;
    __device__ __forceinline__ void operator()(const f32x4 (&acc)[2][2][4][2], const Unit& u, int wr, int wc, int fr, int fq) const {
        const int col0 = u.pn * BM + wc * 32 + 4 * fq;
#pragma unroll
        for (int ai = 0; ai < 2; ++ai)
#pragma unroll
            for (int m = 0; m < 4; ++m) { float* rowp = O + (size_t)(u.pm * BM + ai * HALF + wr * 64 + m * 16 + fr) * ldc + col0;
#pragma unroll
                for (int bj = 0; bj < 2; ++bj)
#pragma unroll
                    for (int n = 0; n < 2; ++n) *(f32x4*)(rowp + bj * HALF + n * 16) = acc[ai][bj][m][n]; }
    }
};
struct EpiResid {
    static constexpr bool PERM = false, AFTER_DRAIN = false;
    const float* base_p; const float* base_s; float* out_p; float* out_s; const float* gate;
    __device__ __forceinline__ void operator()(const f32x4 (&acc)[2][2][4][2], const Unit& u, int wr, int wc, int fr, int fq) const {
        const int col0 = u.pn * BM + wc * 32 + 4 * fq;
        if (u.pm < 32) {
            const float* g = gate + (size_t)(u.pm >> 3) * 12288 + col0;
            f32x4 gv[2][2];
#pragma unroll
            for (int bj = 0; bj < 2; ++bj)
#pragma unroll
                for (int n = 0; n < 2; ++n) gv[bj][n] = *(const f32x4*)(g + bj * HALF + n * 16);
#pragma unroll
            for (int ai = 0; ai < 2; ++ai) { f32x4 bs[4][2][2];
#pragma unroll
                for (int m = 0; m < 4; ++m) { const size_t off = (size_t)(u.pm * BM + ai * HALF + wr * 64 + m * 16 + fr) * 2048 + col0;
#pragma unroll
                    for (int bj = 0; bj < 2; ++bj)
#pragma unroll
                        for (int n = 0; n < 2; ++n) bs[m][bj][n] = *(const f32x4*)(base_p + off + bj * HALF + n * 16); }
#pragma unroll
                for (int m = 0; m < 4; ++m) { const size_t off = (size_t)(u.pm * BM + ai * HALF + wr * 64 + m * 16 + fr) * 2048 + col0;
#pragma unroll
                    for (int bj = 0; bj < 2; ++bj)
#pragma unroll
                        for (int n = 0; n < 2; ++n) *(f32x4*)(out_p + off + bj * HALF + n * 16) = bs[m][bj][n] + gv[bj][n] * acc[ai][bj][m][n]; } }
        } else if (wr == 0 && fr < 8) {
            const float* g = gate + (size_t)(4 + fr) * 12288 + col0; const size_t off = (size_t)fr * 2048 + col0;
#pragma unroll
            for (int bj = 0; bj < 2; ++bj)
#pragma unroll
                for (int n = 0; n < 2; ++n) { const f32x4 gv = *(const f32x4*)(g + bj * HALF + n * 16); const f32x4 bs = *(const f32x4*)(base_s + off + bj * HALF + n * 16);
                    *(f32x4*)(out_s + off + bj * HALF + n * 16) = bs + gv * acc[0][bj][0][n]; }
        }
    }
};
struct EpiSwiGLU {
    static constexpr bool PERM = true, AFTER_DRAIN = false;
    bf16_t* O; int ldc;
    __device__ __forceinline__ void operator()(const f32x4 (&acc)[2][2][4][2], const Unit& u, int wr, int wc, int fr, int fq) const {
        const int row0 = u.pm * BM + wr * 64 + fr, col0 = u.pn * HALF + wc * 32 + 8 * fq;
#pragma unroll
        for (int ai = 0; ai < 2; ++ai)
#pragma unroll
            for (int m = 0; m < 4; ++m) { bf16_t* rowp = O + (size_t)(row0 + ai * HALF + m * 16) * ldc + col0;
                float v[8];
#pragma unroll
                for (int n = 0; n < 2; ++n)
#pragma unroll
                    for (int e = 0; e < 4; ++e) { const float g = acc[ai][0][m][n][e], up = acc[ai][1][m][n][e]; v[4 * n + e] = g * __builtin_amdgcn_rcpf(1.0f + __expf(-g)) * up; }
                u32x4 w; w.x = cvt_pk_bf16(v[0], v[1]); w.y = cvt_pk_bf16(v[2], v[3]); w.z = cvt_pk_bf16(v[4], v[5]); w.w = cvt_pk_bf16(v[6], v[7]);
                *(u32x4*)rowp = w; }
    }
};
struct EpiG1 {
    static constexpr bool PERM = true, AFTER_DRAIN = false;
    bf16_t* QB; size_t qkv_stride; bf16_t* RKV; float* P; float *okp, *oks; size_t kv_stride_p, kv_stride_s; const float *qg, *kg;
    __device__ __forceinline__ void operator()(const f32x4 (&acc)[2][2][4][2], const Unit& u, int wr, int wc, int fr, int fq) const {
        const int row0 = u.pm * BM + wr * 64 + fr;
        if (u.pn >= 24) {
            const int col0 = (u.pn - 24) * BM + wc * 32 + 8 * fq;
#pragma unroll
            for (int ai = 0; ai < 2; ++ai)
#pragma unroll
                for (int m = 0; m < 4; ++m) { float* rp = P + (size_t)(row0 + ai * HALF + m * 16) * 768 + col0;
#pragma unroll
                    for (int bj = 0; bj < 2; ++bj) { *(f32x4*)(rp + bj * HALF) = acc[ai][bj][m][0]; *(f32x4*)(rp + bj * HALF + 4) = acc[ai][bj][m][1]; } }
            return;
        }
        const int reg = u.pn >> 2, cb = (4 * (u.pn & 3) + wc) * 64 + 8 * fq;
        if (reg >= 3) {
            const int col0 = (reg - 3) * 1024 + cb;
#pragma unroll
            for (int ai = 0; ai < 2; ++ai)
#pragma unroll
                for (int m = 0; m < 4; ++m) { bf16_t* rp = RKV + (size_t)(row0 + ai * HALF + m * 16) * 3072 + col0;
#pragma unroll
                    for (int bj = 0; bj < 2; ++bj) { u32x4 w; w.x = cvt_pk_bf16(acc[ai][bj][m][0][0], acc[ai][bj][m][0][1]); w.y = cvt_pk_bf16(acc[ai][bj][m][0][2], acc[ai][bj][m][0][3]); w.z = cvt_pk_bf16(acc[ai][bj][m][1][0], acc[ai][bj][m][1][1]); w.w = cvt_pk_bf16(acc[ai][bj][m][1][2], acc[ai][bj][m][1][3]);
                        *(u32x4*)(rp + 32 * bj) = w; } }
            return;
        }
        f32x4 gn[2][2];
#pragma unroll
        for (int bj = 0; bj < 2; ++bj)
#pragma unroll
            for (int n = 0; n < 2; ++n) { const f32x4 a = *(const f32x4*)(qg + 8 * fq + 32 * bj + 4 * n), b = *(const f32x4*)(kg + 8 * fq + 32 * bj + 4 * n); gn[bj][n] = (reg == 0) ? a : b; }
        bf16_t* dstb = QB + (size_t)reg * qkv_stride;
#pragma unroll
        for (int ai = 0; ai < 2; ++ai)
#pragma unroll
            for (int m = 0; m < 4; ++m) { const int row = row0 + ai * HALF + m * 16;
                f32x4 v[2][2];
#pragma unroll
                for (int bj = 0; bj < 2; ++bj)
#pragma unroll
                    for (int n = 0; n < 2; ++n) v[bj][n] = acc[ai][bj][m][n];
                if (reg < 2) { float ss = 0.f;
#pragma unroll
                    for (int bj = 0; bj < 2; ++bj)
#pragma unroll
                        for (int n = 0; n < 2; ++n) ss += (v[bj][n][0] * v[bj][n][0] + v[bj][n][1] * v[bj][n][1]) + (v[bj][n][2] * v[bj][n][2] + v[bj][n][3] * v[bj][n][3]);
                    ss += __shfl_xor(ss, 16); ss += __shfl_xor(ss, 32);
                    const float rs = 1.0f / sqrtf(ss * (1.0f / 64.0f) + 1e-6f);
#pragma unroll
                    for (int bj = 0; bj < 2; ++bj)
#pragma unroll
                        for (int n = 0; n < 2; ++n) v[bj][n] = v[bj][n] * rs * gn[bj][n]; }
                bf16_t* db = dstb + (size_t)row * 1024 + cb;
#pragma unroll
                for (int bj = 0; bj < 2; ++bj) { u32x4 w; w.x = cvt_pk_bf16(v[bj][0][0], v[bj][0][1]); w.y = cvt_pk_bf16(v[bj][0][2], v[bj][0][3]); w.z = cvt_pk_bf16(v[bj][1][0], v[bj][1][1]); w.w = cvt_pk_bf16(v[bj][1][2], v[bj][1][3]);
                    *(u32x4*)(db + 32 * bj) = w; }
                if (reg >= 1) { float* op = nullptr;
                    if (u.pm < 32) op = okp + (size_t)(reg - 1) * kv_stride_p + (size_t)row * 1024 + cb; else if (row - 32 * BM < 8) op = oks + (size_t)(reg - 1) * kv_stride_s + (size_t)(row - 32 * BM) * 1024 + cb;
                    if (op) {
#pragma unroll
                        for (int bj = 0; bj < 2; ++bj) { *(f32x4*)(op + 32 * bj) = v[bj][0]; *(f32x4*)(op + 32 * bj + 4) = v[bj][1]; } } }
            }
    }
};
template <class Epi, class Sched, bool ALIGN_EPI = false, bool SP2 = false>
__device__ __forceinline__ void gemm_phase(PG8_LAS unsigned char* lds, const Gemm g, const Sched& S, const Epi& E) {
    int tid_ = threadIdx.x; asm volatile("" : "+v"(tid_));
    const int tid = tid_, wid = __builtin_amdgcn_readfirstlane(tid >> 6), lane = tid & 63, wr = wid >> 2, wc = wid & 3, fr = lane & 15, fq = lane >> 4;
    const int K = g.K, nt = K / BK;
    unsigned voffA[2], voffB[2];
#pragma unroll
    for (int i = 0; i < 2; ++i) { int R, C; stage_rc(tid * 16 + i * 8192, R, C); const int Rb = Epi::PERM ? ((R & ~31) + perm32(R & 31)) : R;
        voffA[i] = (unsigned)(R * K + C) * 2u; voffB[i] = (unsigned)(Rb * K + C) * 2u; }
    const size_t kstep = (size_t)(BK * 2);
    const size_t hstep = (size_t)HALF * K * 2;
    const size_t tstep = 2 * hstep;
    const unsigned ldsw = (unsigned)wid * 1024u;
    const int aoff = lds_byte(wr * 64 + fr, fq * 8), boff = lds_byte(wc * 32 + fr, fq * 8);
#define PG8_SA(b, h) (((b) * 2 + (h)) * HTB)
#define PG8_SB(b, h) ((4 + (b) * 2 + (h)) * HTB)
#define PG8_STAGE(bufoff, gbase, voff) do { _Pragma("unroll") for (int _i = 0; _i < 2; ++_i) \
        __builtin_amdgcn_global_load_lds((const unsigned*)((const char*)(gbase) + (voff)[_i]), (PG8_LAS unsigned*)(lds + (bufoff) + ldsw + _i * 8192), 16, 0, 0); } while (0)
#define PG8_LDA(dst, b, h) do { _Pragma("unroll") for (int m = 0; m < 4; ++m) _Pragma("unroll") for (int k = 0; k < 2; ++k) dst[m][k] = *(const PG8_LAS bf16x8*)(lds + PG8_SA(b, h) + aoff + m * 2048 + k * 1024); } while (0)
#define PG8_LDB(dst, b, h) do { _Pragma("unroll") for (int n = 0; n < 2; ++n) _Pragma("unroll") for (int k = 0; k < 2; ++k) dst[n][k] = *(const PG8_LAS bf16x8*)(lds + PG8_SB(b, h) + boff + n * 2048 + k * 1024); } while (0)
#define PG8_MMA(ai, bj, At, Bt) do { __builtin_amdgcn_s_setprio(1); _Pragma("unroll") for (int m = 0; m < 4; ++m) _Pragma("unroll") for (int n = 0; n < 2; ++n) _Pragma("unroll") for (int k = 0; k < 2; ++k) \
        acc[ai][bj][m][n] = __builtin_amdgcn_mfma_f32_16x16x32_bf16(Bt[n][k], At[m][k], acc[ai][bj][m][n], 0, 0, 0); __builtin_amdgcn_s_setprio(0); } while (0)
#define PG8_WAIT_V(n) asm volatile("s_waitcnt vmcnt(" #n ")" ::: "memory")
#define PG8_WAIT_L(n) asm volatile("s_waitcnt lgkmcnt(" #n ")" ::: "memory")
#define PG8_BAR __builtin_amdgcn_s_barrier()
#define PG8_SCHED __builtin_amdgcn_sched_barrier(0)
    Unit cur, nxt; int ui = 0;
    if (!S.next(0, cur)) return;
    f32x4 acc[2][2][4][2];
#pragma unroll
    for (int a = 0; a < 2; ++a)
#pragma unroll
        for (int b = 0; b < 2; ++b)
#pragma unroll
            for (int m = 0; m < 4; ++m)
#pragma unroll
                for (int n = 0; n < 2; ++n) acc[a][b][m][n] = (f32x4){0.f, 0.f, 0.f, 0.f};
    bf16x8 At[4][2], B0[2][2], B1[2][2];
    const char* cA = (const char*)g.A + (size_t)cur.pm * tstep; const char* cB = (const char*)g.Bt + (size_t)cur.pn * tstep;
    S.a_ready(cur);
    if constexpr (SP2) {
        PG8_STAGE(PG8_SB(0, 0), cB, voffB); PG8_STAGE(PG8_SB(0, 1), cB + hstep, voffB); PG8_STAGE(PG8_SA(0, 0), cA, voffA); PG8_STAGE(PG8_SA(0, 1), cA + hstep, voffA);
        if (wr == 1) PG8_BAR;
        PG8_WAIT_V(2); PG8_BAR;
        PG8_STAGE(PG8_SB(1, 0), cB + kstep, voffB); PG8_STAGE(PG8_SA(1, 0), cA + kstep, voffA); PG8_STAGE(PG8_SB(1, 1), cB + hstep + kstep, voffB);
        PG8_WAIT_V(6); PG8_BAR;
    } else {
        PG8_STAGE(PG8_SB(0, 0), cB, voffB); PG8_STAGE(PG8_SA(0, 0), cA, voffA); PG8_STAGE(PG8_SB(0, 1), cB + hstep, voffB); PG8_STAGE(PG8_SA(0, 1), cA + hstep, voffA);
        if (wr == 1) PG8_BAR;
        PG8_WAIT_V(4); PG8_BAR;
        PG8_STAGE(PG8_SB(1, 0), cB + kstep, voffB); PG8_STAGE(PG8_SA(1, 0), cA + kstep, voffA); PG8_STAGE(PG8_SB(1, 1), cB + hstep + kstep, voffB);
        PG8_WAIT_V(6); PG8_BAR;
    }
    for (;;) {
        const bool has_next = S.next(ui + 1, nxt);
        const char* nA = has_next ? (const char*)g.A + (size_t)nxt.pm * tstep : cA; const char* nB = has_next ? (const char*)g.Bt + (size_t)nxt.pn * tstep : cB;
        for (int t = 0; t < nt; t += 2) {
            const bool last = (t == nt - 2);
            const char* a1 = cA + (size_t)(t + 1) * kstep;
            const char* a2 = last ? nA : cA + (size_t)(t + 2) * kstep; const char* b2 = last ? nB : cB + (size_t)(t + 2) * kstep;
            const char* a3 = a2 + kstep; const char* b3 = b2 + kstep;
            if (last && has_next) S.a_ready(nxt);
            if constexpr (SP2) {
            PG8_LDB(B0, 0, 0); PG8_LDB(B1, 0, 1); PG8_SCHED; PG8_LDA(At, 0, 0); PG8_STAGE(PG8_SA(1, 1), a1 + hstep, voffA);
            PG8_WAIT_V(8); PG8_WAIT_L(0); PG8_BAR; PG8_MMA(0, 0, At, B0); PG8_MMA(0, 1, At, B1); PG8_BAR; PG8_SCHED;
            PG8_LDA(At, 0, 1); PG8_STAGE(PG8_SB(0, 0), b2, voffB); PG8_STAGE(PG8_SB(0, 1), b2 + hstep, voffB); PG8_STAGE(PG8_SA(0, 0), a2, voffA);
            PG8_WAIT_V(8); PG8_WAIT_L(0); PG8_BAR; PG8_MMA(1, 0, At, B0); PG8_MMA(1, 1, At, B1); PG8_BAR; PG8_SCHED;
            PG8_LDB(B0, 1, 0); PG8_LDB(B1, 1, 1); PG8_SCHED; PG8_LDA(At, 1, 0); PG8_STAGE(PG8_SA(0, 1), a2 + hstep, voffA);
            PG8_WAIT_V(8); PG8_WAIT_L(0); PG8_BAR; PG8_MMA(0, 0, At, B0); PG8_MMA(0, 1, At, B1); PG8_BAR; PG8_SCHED;
            PG8_LDA(At, 1, 1); PG8_STAGE(PG8_SB(1, 0), b3, voffB); PG8_STAGE(PG8_SB(1, 1), b3 + hstep, voffB); PG8_STAGE(PG8_SA(1, 0), a3, voffA);
            PG8_WAIT_V(8); PG8_WAIT_L(0); PG8_BAR; PG8_MMA(1, 0, At, B0); PG8_MMA(1, 1, At, B1); PG8_BAR; PG8_SCHED;
            } else {
            PG8_LDB(B0, 0, 0); PG8_SCHED; PG8_LDA(At, 0, 0); PG8_STAGE(PG8_SA(1, 1), a1 + hstep, voffA);
            PG8_WAIT_L(8); PG8_BAR; PG8_WAIT_L(0); PG8_MMA(0, 0, At, B0); PG8_BAR; PG8_SCHED;
            PG8_LDB(B1, 0, 1); PG8_STAGE(PG8_SB(0, 0), b2, voffB);
            PG8_BAR; PG8_WAIT_L(0); PG8_MMA(0, 1, At, B1); PG8_BAR;
            PG8_LDA(At, 0, 1); PG8_STAGE(PG8_SA(0, 0), a2, voffA);
            PG8_BAR; PG8_WAIT_L(0); PG8_MMA(1, 0, At, B0); PG8_BAR; PG8_SCHED;
            PG8_STAGE(PG8_SB(0, 1), b2 + hstep, voffB);
            PG8_WAIT_V(6); PG8_BAR; PG8_MMA(1, 1, At, B1); PG8_BAR;
            PG8_LDB(B0, 1, 0); PG8_SCHED; PG8_LDA(At, 1, 0); PG8_STAGE(PG8_SA(0, 1), a2 + hstep, voffA);
            PG8_WAIT_L(8); PG8_BAR; PG8_WAIT_L(0); PG8_MMA(0, 0, At, B0); PG8_BAR; PG8_SCHED;
            PG8_LDB(B1, 1, 1); PG8_STAGE(PG8_SB(1, 0), b3, voffB);
            PG8_BAR; PG8_WAIT_L(0); PG8_MMA(0, 1, At, B1); PG8_BAR;
            PG8_LDA(At, 1, 1); PG8_STAGE(PG8_SA(1, 0), a3, voffA);
            PG8_BAR; PG8_WAIT_L(0); PG8_MMA(1, 0, At, B0); PG8_BAR; PG8_SCHED;
            PG8_STAGE(PG8_SB(1, 1), b3 + hstep, voffB);
            PG8_WAIT_V(6); PG8_BAR; PG8_MMA(1, 1, At, B1); PG8_BAR;
            }
        }
        if constexpr (ALIGN_EPI) { if (wr == 0) PG8_BAR; }
        if constexpr (!Epi::AFTER_DRAIN) { E(acc, cur, wr, wc, fr, fq); S.done(cur); }
        if (!has_next) break;
#pragma unroll
        for (int a = 0; a < 2; ++a)
#pragma unroll
            for (int b = 0; b < 2; ++b)
#pragma unroll
                for (int m = 0; m < 4; ++m)
#pragma unroll
                    for (int n = 0; n < 2; ++n) acc[a][b][m][n] = (f32x4){0.f, 0.f, 0.f, 0.f};
        cur = nxt; cA = nA; cB = nB; ++ui;
        if constexpr (ALIGN_EPI) { if (wr == 1) PG8_BAR; }
    }
    PG8_WAIT_V(0);
    if constexpr (!ALIGN_EPI) { if (wr == 0) PG8_BAR; }
    PG8_BAR;
    if constexpr (Epi::AFTER_DRAIN) { E.fused(acc, cur, wr, wc, fr, fq, lds, wid, lane); S.done(cur); }
#undef PG8_SA
#undef PG8_SB
#undef PG8_STAGE
#undef PG8_LDA
#undef PG8_LDB
#undef PG8_MMA
#undef PG8_WAIT_V
#undef PG8_WAIT_L
#undef PG8_BAR
#undef PG8_SCHED
}
}
#define GAS __attribute__((address_space(1)))
#define LAS __attribute__((address_space(3)))
typedef unsigned short bf16;
typedef unsigned v4u __attribute__((ext_vector_type(4)));
typedef float f32x4 __attribute__((ext_vector_type(4)));
typedef short bf16x8 __attribute__((ext_vector_type(8)));
typedef GAS unsigned gu32;
typedef GAS unsigned long long gu64;
#define RLX_AGENT __ATOMIC_RELAXED, __HIP_MEMORY_SCOPE_AGENT
#define LDS_WAIT() asm volatile("s_waitcnt lgkmcnt(0)" ::: "memory")
#define VM_WAIT() asm volatile("s_waitcnt vmcnt(0)" ::: "memory")
__device__ __forceinline__ unsigned long long rt() { return __builtin_amdgcn_s_memrealtime(); }
__device__ __forceinline__ unsigned f2bf(float f) { unsigned u = __builtin_bit_cast(unsigned, f); return (u + 0x7fffu + ((u >> 16) & 1u)) >> 16; }
__device__ __forceinline__ unsigned pk2(float lo, float hi) { return f2bf(lo) | (f2bf(hi) << 16); }
#define XB_TMO      128
#define XB_XCNT(j)  (256  + 64 * (j))
#define XB_XSUB(j)  (1280 + 64 * (j))
#define XB_XGEN(j)  (2304 + 64 * (j))
#define XB_TOP      3328
#define XB_TOPGEN   3392
#define XCD_BAR_WORDS 3456
#define XB_SPIN_CAP (1u << 18)

__device__ __forceinline__ unsigned xb_ld(unsigned* p)              { return __hip_atomic_load(p, __ATOMIC_RELAXED, __HIP_MEMORY_SCOPE_AGENT); }
__device__ __forceinline__ unsigned xb_add(unsigned* p, unsigned v) { return __hip_atomic_fetch_add(p, v, __ATOMIC_RELAXED, __HIP_MEMORY_SCOPE_AGENT); }
__device__ __forceinline__ unsigned xb_xcc_id() { return (unsigned)__builtin_amdgcn_s_getreg((3 << 11) | 20) & 0xFu; }
#define XB_SPIN(cond, bar) do { unsigned _sp = 0; while (cond) { __builtin_amdgcn_s_sleep(1); \
    if ((++_sp & 255u) == 0u) { if (xb_ld(&(bar)[XB_TMO])) break; if (_sp > XB_SPIN_CAP) { atomicAdd(&(bar)[XB_TMO], 1u); break; } } } } while (0)

struct XcdBarrier {
    unsigned* bar; unsigned x;
    volatile LAS unsigned* st;
};

__device__ __forceinline__ XcdBarrier xcd_barrier_post(unsigned* bar, volatile LAS unsigned* st) {
    XcdBarrier b; b.bar = bar; b.x = xb_xcc_id(); b.st = st;
    if (threadIdx.x == 0) (void)xb_add(&bar[XB_XCNT(b.x)], 1u);
    return b;
}
__device__ __forceinline__ void xcd_barrier_complete(unsigned* bar, unsigned x, unsigned& nloc, unsigned& nx) {
    const unsigned G = gridDim.x * gridDim.y * gridDim.z;
    unsigned sum, cnt, mine, sp = 0u;
    for (;;) {
        sum = 0u; cnt = 0u; mine = 0u;
#pragma unroll
        for (unsigned j = 0; j < 16; ++j) { const unsigned c = xb_ld(&bar[XB_XCNT(j)]); sum += c; cnt += (c > 0u) ? 1u : 0u; mine = (j == x) ? c : mine; }
        if (sum == G) break;
        __builtin_amdgcn_s_sleep(1);
        if ((++sp & 255u) == 0u) { if (xb_ld(&bar[XB_TMO])) break; if (sp > XB_SPIN_CAP) { atomicAdd(&bar[XB_TMO], 1u); break; } }
    }
    nloc = mine > 0u ? mine : 1u; nx = cnt > 0u ? cnt : 1u;
}

__device__ __forceinline__ void xcd_barrier(const XcdBarrier& b) {
    asm volatile("s_waitcnt vmcnt(0)" ::: "memory");
    __syncthreads();
    if (threadIdx.x == 0) {
        unsigned* bar = b.bar;
        __builtin_amdgcn_s_waitcnt(0);
        unsigned nloc = b.st[0], nx = b.st[1];
        if (nloc == 0u) { xcd_barrier_complete(bar, b.x, nloc, nx); b.st[0] = nloc; b.st[1] = nx; }
        const unsigned old = xb_add(&bar[XB_XSUB(b.x)], 1u);
        const unsigned gen = old / nloc;
        if (old + 1u == (gen + 1u) * nloc) {
            __builtin_amdgcn_fence(__ATOMIC_RELEASE, "agent");
            asm volatile("s_waitcnt vmcnt(0)" ::: "memory");
            const unsigned og = xb_add(&bar[XB_TOP], 1u);
            const unsigned tg = og / nx;
            if (og + 1u == (tg + 1u) * nx) xb_add(&bar[XB_TOPGEN], 1u);
            else XB_SPIN(xb_ld(&bar[XB_TOPGEN]) == tg, bar);
            __builtin_amdgcn_fence(__ATOMIC_ACQUIRE, "agent");
            xb_add(&bar[XB_XGEN(b.x)], 1u);
            asm volatile("s_waitcnt vmcnt(0)" ::: "memory");
        } else {
            XB_SPIN(xb_ld(&bar[XB_XGEN(b.x)]) == gen, bar);
            __builtin_amdgcn_fence(__ATOMIC_ACQUIRE, "agent");
            asm volatile("s_waitcnt vmcnt(0)" ::: "memory");
        }
    }
    __syncthreads();
}

#ifndef MK_N_LAUNCHES
#define MK_N_LAUNCHES 1
#endif
#ifndef REP_P0
#define REP_P0 1
#endif
#ifndef REP_N1
#define REP_N1 1
#endif
#ifndef REP_PW
#define REP_PW 1
#endif
#ifndef REP_SCAN
#define REP_SCAN 1
#endif
#ifndef REP_ATT
#define REP_ATT 1
#endif
#ifndef REP_SATT
#define REP_SATT 1
#endif
#ifndef REP_MX
#define REP_MX 1
#endif
#ifndef REP_N2
#define REP_N2 1
#endif
#ifndef REP_G3
#define REP_G3 1
#endif
#ifndef REP_BAR
#define REP_BAR 1
#endif
#ifndef REP_G1
#define REP_G1 1
#endif
#ifndef REP_PWL
#define REP_PWL 1
#endif
#ifndef REP_PWM
#define REP_PWM 1
#endif
#ifndef REP_PWR
#define REP_PWR 1
#endif
constexpr int NWAVES = 8, NTHR = 512;
constexpr int DM = 2048, SEQ = 2048, PBATCH = 4, SBATCH = 8, DEPTH = 4, NHEADS = 16, HD = 64, DATT = 1024, DRW = 1024, FF = 5632;
constexpr int MP = PBATCH * SEQ;
constexpr int ROW_S = MP;
constexpr int ROW_SS = MP + 8;
constexpr int NROWS = MP + 8;
constexpr int MH = MP + 256;
constexpr int N1 = 6912;
constexpr int PC0 = 6144, PP0 = 6144 + 384;
constexpr int NLORA = 320;
constexpr int MODW = 6 * DM;
constexpr float RMS_EPS = 1e-6f, GN_EPS = 64e-5f, ATT_SCALE = 0.125f;

enum { I_XP = 0, I_XS, I_CP, I_CS, I_CK, I_CV, I_SWKV, I_SSH, I_RELB, I_ADAW, I_ADAB, I_N1G, I_N2G, I_WIN, I_QG, I_KG, I_MUWAG, I_MURKV,
       I_DW0, I_DW1, I_DW2, I_AA0, I_AW1, I_AW2, I_GW1, I_GW2, I_VMU, I_VV0, I_VW1, I_VW2, I_KK, I_KA, I_RK, I_LNG, I_LNB, I_WOUT, I_WGU, I_WDN, N_IN };
constexpr size_t O_YP = 0, O_YS = O_YP + (size_t)MP * DM, O_KP = O_YS + 8 * DM, O_VP = O_KP + (size_t)DEPTH * MP * DATT, O_WP = O_VP + (size_t)DEPTH * MP * DATT,
                 O_SP = O_WP + (size_t)DEPTH * PBATCH * 16 * 4096, O_KS = O_SP + (size_t)DEPTH * PBATCH * DM, O_VS = O_KS + (size_t)DEPTH * 8 * DATT, O_WS = O_VS + (size_t)DEPTH * 8 * DATT,
                 O_SS = O_WS + (size_t)DEPTH * 8 * 16 * 4096, O_END = O_SS + (size_t)DEPTH * 8 * DM;
static_assert(O_END == 87212032, "output size");

constexpr size_t MiB = 1u << 20;
constexpr size_t WS_CTL = 0, CTL_ZERO_BYTES = 1 * MiB;
constexpr size_t WS_MOD = 1 * MiB;
constexpr size_t WS_BT = 4 * MiB;
constexpr size_t WS_WIN = 8 * MiB;
constexpr size_t WS_WOUT = 116 * MiB;
constexpr size_t WS_WGU = 148 * MiB;
constexpr size_t WS_WDN = 324 * MiB;
constexpr size_t WS_HB = 412 * MiB;
constexpr size_t WS_W2T = 5 * MiB;
constexpr size_t WS_RKV = 446 * MiB;
constexpr size_t WS_P = 546 * MiB;
constexpr size_t WS_QB = 670 * MiB, WS_KB = 687 * MiB, WS_VB = 704 * MiB;
constexpr size_t WS_R = 722 * MiB, WS_W = 755 * MiB, WS_K = 788 * MiB, WS_V = 821 * MiB, WS_A = 854 * MiB, WS_B = 887 * MiB, WS_G = 920 * MiB, WS_VF = 953 * MiB;
constexpr size_t WS_Y = 986 * MiB;
constexpr size_t WS_OBR = 1019 * MiB;
constexpr size_t WS_LSE = 1067 * MiB;
constexpr size_t WS_MIX = 1069 * MiB;
constexpr size_t WS_XB = 1102 * MiB;
constexpr size_t WS_ACT = 1168 * MiB;
constexpr size_t WS_END = 1260 * MiB;
static_assert(WS_WIN + (size_t)DEPTH * N1 * DM * 2 <= WS_WOUT && WS_WGU + (size_t)DEPTH * 2 * FF * DM * 2 <= WS_WDN && WS_WDN + (size_t)DEPTH * DM * FF * 2 <= WS_HB, "ws map (weights)");
static_assert(WS_VB - WS_KB == WS_KB - WS_QB, "q | k | v bf16 buffers are equally spaced");
static_assert(WS_HB + (size_t)MH * DM * 2 <= WS_RKV && WS_RKV + (size_t)MH * 3072 * 4 <= WS_P && WS_P + (size_t)MH * 768 * 4 <= WS_QB && WS_W2T + (size_t)DEPTH * 1024 * 320 * 2 <= WS_WIN && WS_QB + (size_t)MH * DATT * 2 <= WS_KB && WS_VB + (size_t)MH * DATT * 2 <= WS_R, "ws map (act 1)");
static_assert(WS_R + (size_t)NROWS * DRW * 4 <= WS_W && WS_Y + (size_t)NROWS * DRW * 4 <= WS_OBR && WS_OBR + (size_t)3 * MP * DATT * 2 <= WS_LSE && WS_LSE + (size_t)3 * MP * 16 * 4 <= WS_MIX, "ws map (act 2)");
static_assert(WS_MIX + (size_t)MH * DM * 2 <= WS_XB && WS_XB + (size_t)MH * DM * 4 <= WS_ACT && WS_ACT + (size_t)MH * FF * 2 <= WS_END, "ws map (act 3)");
constexpr int CW_BAR = 4096;

constexpr int RING_BYTES = 131072;
constexpr int LDSCTL_OFF = RING_BYTES, MISC_OFF = LDSCTL_OFF + 320;
constexpr int LDS_BYTES = 147456;

constexpr int PH_PER_LAYER = 9, N_PHASES = 1 + DEPTH * PH_PER_LAYER;

struct Args { const float* in[N_IN]; float* out; unsigned char* ws; int ph_lo, ph_hi; };
static_assert(sizeof(Args) == N_IN * 8 + 24, "Args has no padding");

__device__ __forceinline__ float wave_sum(float v) {
#pragma unroll
    for (int o = 1; o < 64; o <<= 1) v += __shfl_xor(v, o);
    return v;
}
__device__ __forceinline__ float wave_max(float v) {
#pragma unroll
    for (int o = 1; o < 64; o <<= 1) v = fmaxf(v, __shfl_xor(v, o));
    return v;
}
template <int CTRL> __device__ __forceinline__ float dpp_mov(float v) { return __builtin_bit_cast(float, __builtin_amdgcn_update_dpp(0, __builtin_bit_cast(int, v), CTRL, 0xf, 0xf, false)); }
__device__ __forceinline__ float row16_sum(float v) {
    v += dpp_mov<0xB1>(v);
    v += dpp_mov<0x4E>(v);
    v += dpp_mov<0x141>(v);
    v += dpp_mov<0x140>(v);
    return v;
}
__device__ __forceinline__ float bf2f(unsigned short b) { return __builtin_bit_cast(float, (unsigned)b << 16); }
__device__ __forceinline__ f32x4 ld4bf(const bf16* p) { const unsigned long long w = *(const unsigned long long*)p; return (f32x4){__builtin_bit_cast(float, (unsigned)w << 16), __builtin_bit_cast(float, (unsigned)w & 0xffff0000u), __builtin_bit_cast(float, (unsigned)(w >> 32) << 16), __builtin_bit_cast(float, (unsigned)(w >> 32) & 0xffff0000u)}; }
__device__ __forceinline__ f32x4 up4bf(unsigned long long w) { return (f32x4){__builtin_bit_cast(float, (unsigned)w << 16), __builtin_bit_cast(float, (unsigned)w & 0xffff0000u), __builtin_bit_cast(float, (unsigned)(w >> 32) << 16), __builtin_bit_cast(float, (unsigned)(w >> 32) & 0xffff0000u)}; }
__device__ __forceinline__ void st4bf(bf16* p, f32x4 v) { *(unsigned long long*)p = (unsigned long long)pk2(v[0], v[1]) | ((unsigned long long)pk2(v[2], v[3]) << 32); }
__device__ __forceinline__ float sigmoidf_(float x) { return 1.0f / (1.0f + __expf(-x)); }

__device__ __forceinline__ void p0_transpose_item(const float* W, int N, int k0, int n0, bf16* WT, int ldt, int drow0, const float* mu, int smode, LAS float* scr, int lane, int kdst = -1, int krows = 64) {
    if (kdst < 0) kdst = k0;
    float vals[32];
#pragma unroll
    for (int i = 0; i < 32; ++i) { const int kk = 2 * i + (lane >> 5); vals[i] = W[(size_t)(k0 + ((kk < krows) ? kk : krows - 1)) * N + n0 + (lane & 31)]; }
    if (smode) {
#pragma unroll
        for (int i = 0; i < 32; ++i) { const int kk = 2 * i + (lane >> 5); const float mm = mu[k0 + ((kk < krows) ? kk : krows - 1)]; vals[i] *= (smode == 1) ? (1.0f - mm) : mm; } }
#pragma unroll
    for (int i = 0; i < 32; ++i) { const int kk = 2 * i + (lane >> 5); scr[kk * 33 + (lane & 31)] = (kk < krows) ? vals[i] : 0.f; }
    LDS_WAIT(); asm volatile("" ::: "memory");
    const int c = lane & 7;
    if (8 * c < krows) {
#pragma unroll
        for (int j = 0; j < 4; ++j) { const int n = (lane >> 3) + 8 * j; const LAS float* s = scr + (8 * c) * 33 + n;
            v4u o; o.x = pk2(s[0 * 33], s[1 * 33]); o.y = pk2(s[2 * 33], s[3 * 33]); o.z = pk2(s[4 * 33], s[5 * 33]); o.w = pk2(s[6 * 33], s[7 * 33]);
            *(GAS v4u*)(WT + (size_t)(drow0 + n) * ldt + kdst + 8 * c) = o; }
    }
    LDS_WAIT(); asm volatile("" ::: "memory");
}
__device__ __forceinline__ int rel_bucket(int d) {
    if (d < 16) return d;
    const int large = 16 + (int)(logf((float)d / 16.0f) / logf(128.0f) * 16.0f);
    return large < 31 ? large : 31;
}
constexpr int I_IN = (DM / 64) * (6144 / 32), I_LD = (DM / 64) * 2, I_LG = (DM / 64) * 5, I_LV = (DM / 64) * 1, I_OUT = (DM / 64) * (DM / 32), I_GU = (DM / 64) * (2 * FF / 32), I_DN = (FF / 64) * (DM / 32);
constexpr int I_W2 = 32 * 6;
constexpr int I_LAYER = I_IN + 2 * (2 * I_LD + I_LG + I_LV) + I_W2 + I_OUT + I_GU + I_DN;
constexpr int CONV_BATCH = 32, N_CONV_BATCHES = (I_LAYER + CONV_BATCH - 1) / CONV_BATCH, N_MOD_ITEMS = MODW / 256, N_PREP_ITEMS = N_MOD_ITEMS + N_CONV_BATCHES;
constexpr int TAIL_PULLS = 2;
constexpr int CW_Q = 8192;
__device__ __forceinline__ void mod_block_item(const Args& args, int l, int c0, LAS unsigned char* lds, int tid, int lane, int wave) {
    unsigned char* ws = args.ws; float* MOD = (float*)(ws + WS_MOD);
        LAS float* sl = (LAS float*)lds;
        __syncthreads();
        for (int i = tid; i < 12 * DM; i += NTHR) { const int bb = i / DM, k = i % DM; const float c = (bb < 4) ? args.in[I_CP][bb * DM + k] : args.in[I_CS][(bb - 4) * DM + k];
            sl[k * 12 + bb] = c / (1.0f + __expf(-c)); }
        __syncthreads();
        const float* Wl = args.in[I_ADAW] + (size_t)l * DM * MODW + c0 + 4 * lane;
        f32x4 acc[12];
#pragma unroll
        for (int bb = 0; bb < 12; ++bb) acc[bb] = (f32x4){0.f, 0.f, 0.f, 0.f};
        const int kb = wave * 256;
#pragma unroll 4
        for (int k = kb; k < kb + 256; ++k) {
            const f32x4 w = *(const f32x4*)(Wl + (size_t)k * MODW);
            const f32x4 s0 = *(const LAS f32x4*)(sl + k * 12), s1 = *(const LAS f32x4*)(sl + k * 12 + 4), s2 = *(const LAS f32x4*)(sl + k * 12 + 8);
            acc[0] += w * s0.x; acc[1] += w * s0.y; acc[2] += w * s0.z; acc[3] += w * s0.w;
            acc[4] += w * s1.x; acc[5] += w * s1.y; acc[6] += w * s1.z; acc[7] += w * s1.w;
            acc[8] += w * s2.x; acc[9] += w * s2.y; acc[10] += w * s2.z; acc[11] += w * s2.w;
        }
        __syncthreads();
        LAS float* part = (LAS float*)lds;
#pragma unroll
        for (int bb = 0; bb < 12; ++bb) *(LAS f32x4*)(part + (wave * 12 + bb) * 256 + 4 * lane) = acc[bb];
        __syncthreads();
        for (int i = tid; i < 12 * 256; i += NTHR) { const int bb = i / 256, c = i % 256; float s = args.in[I_ADAB][l * MODW + c0 + c];
#pragma unroll
            for (int w = 0; w < 8; ++w) s += part[(w * 12 + bb) * 256 + c];
            MOD[((size_t)l * 12 + bb) * MODW + c0 + c] = s; }
        __syncthreads();
}
__device__ __forceinline__ void conv_wave_item(const Args& args, int l, int r, LAS float* scr, int lane) {
    unsigned char* ws = args.ws;
    bf16* WIN = (bf16*)(ws + WS_WIN) + (size_t)l * N1 * DM;
    const float* W = nullptr; int N = 0, k0 = 0, n0 = 0, ldt = DM, drow0 = 0, smode = 0, kdst = -1, krows = 64; bf16* WT = WIN; const float* mu = nullptr; bool skip = false;
    constexpr int LH = 2 * I_LD + I_LG + I_LV;
    if (r < I_IN) { const int nblk = 6144 / 32, kbk = r / nblk, nb = r % nblk; n0 = 32 * nb; k0 = 64 * kbk;
        drow0 = 256 * (n0 / 256) + 128 * ((n0 % 64) / 32) + 32 * ((n0 % 256) / 64);
        W = args.in[I_WIN] + (size_t)l * DM * 6144; N = 6144; }
    else if ((r -= I_IN) < 2 * LH) {
        const int half = r / LH, base = half ? PP0 : PC0; int q = r % LH; smode = 1 + half;
        if (q < I_LD) { W = args.in[I_DW1] + (size_t)l * DM * 64; N = 64; k0 = 64 * (q / 2); n0 = 32 * (q % 2); drow0 = base + 0 + n0; mu = args.in[I_MUWAG] + ((size_t)l * 3 + 0) * DM; }
        else if ((q -= I_LD) < I_LD) { W = args.in[I_AW1] + (size_t)l * DM * 64; N = 64; k0 = 64 * (q / 2); n0 = 32 * (q % 2); drow0 = base + 64 + n0; mu = args.in[I_MUWAG] + ((size_t)l * 3 + 1) * DM; }
        else if ((q -= I_LD) < I_LG) { W = args.in[I_GW1] + (size_t)l * DM * 160; N = 160; k0 = 64 * (q / 5); n0 = 32 * (q % 5); drow0 = base + 128 + n0; mu = args.in[I_MUWAG] + ((size_t)l * 3 + 2) * DM; }
        else { q -= I_LG; if (l > 0) { W = args.in[I_VW1] + (size_t)(l - 1) * DM * 32; N = 32; k0 = 64 * q; n0 = 0; drow0 = base + 288; mu = args.in[I_VMU] + (size_t)(l - 1) * DM; } else skip = true; } }
    else if ((r -= 2 * LH) < I_W2) { const int kb = r / 32; n0 = 32 * (r % 32); N = DRW; WT = (bf16*)(ws + WS_W2T) + (size_t)l * 1024 * NLORA; ldt = NLORA; drow0 = n0; k0 = 0;
        if (kb == 0) { W = args.in[I_DW2] + (size_t)l * 64 * DRW; kdst = 0; }
        else if (kb == 1) { W = args.in[I_AW2] + (size_t)l * 64 * DRW; kdst = 64; }
        else if (kb < 5) { W = args.in[I_GW2] + (size_t)l * 160 * DRW; k0 = 64 * (kb - 2); kdst = 128 + 64 * (kb - 2); krows = (kb == 4) ? 32 : 64; }
        else if (l > 0) { W = args.in[I_VW2] + (size_t)(l - 1) * 32 * DRW; kdst = 288; krows = 32; } else skip = true; }
    else if ((r -= I_W2) < I_OUT) { const int nblk = DM / 32; k0 = 64 * (r / nblk); n0 = 32 * (r % nblk); W = args.in[I_WOUT] + (size_t)l * DM * DM; N = DM; WT = (bf16*)(ws + WS_WOUT) + (size_t)l * DM * DM; drow0 = n0; }
    else if ((r -= I_OUT) < I_GU) { const int nblk = 2 * FF / 32; k0 = 64 * (r / nblk); n0 = 32 * (r % nblk);
        const int nn = (n0 < FF) ? n0 : n0 - FF; drow0 = 256 * (nn / 128) + (nn % 128) + ((n0 < FF) ? 0 : 128);
        W = args.in[I_WGU] + (size_t)l * DM * 2 * FF; N = 2 * FF; WT = (bf16*)(ws + WS_WGU) + (size_t)l * 2 * FF * DM; }
    else { r -= I_GU; const int nblk = DM / 32; k0 = 64 * (r / nblk); n0 = 32 * (r % nblk); W = args.in[I_WDN] + (size_t)l * FF * DM; N = DM; WT = (bf16*)(ws + WS_WDN) + (size_t)l * DM * FF; ldt = FF; drow0 = n0; }
    if (!skip) p0_transpose_item(W, N, k0, n0, WT, ldt, drow0, mu, smode, scr, lane, kdst, krows);
}
__device__ __forceinline__ void prep_item(const Args& args, int l, int item, LAS unsigned char* lds, int tid, int lane, int wave) {
    if (item < N_MOD_ITEMS) { mod_block_item(args, l, item * 256, lds, tid, lane, wave); return; }
    __syncthreads();
    LAS float* scr = (LAS float*)(lds + wave * 16384); const int r0 = (item - N_MOD_ITEMS) * CONV_BATCH + wave * (CONV_BATCH / NWAVES);
#pragma unroll 1
    for (int k = 0; k < CONV_BATCH / NWAVES; ++k) if (r0 + k < I_LAYER) conv_wave_item(args, l, r0 + k, scr, lane);
}
__device__ __forceinline__ void prep_layer_all(const Args& args, int l, LAS unsigned char* lds, int vcu, int G) {
    int tid_ = threadIdx.x; asm volatile("" : "+v"(tid_)); const int tid = tid_, lane = tid & 63, wave = __builtin_amdgcn_readfirstlane(tid >> 6);
#pragma unroll 1
    for (int it = vcu; it < N_PREP_ITEMS; it += G) prep_item(args, l, it, lds, tid, lane, wave);
    __syncthreads();
}
__device__ __forceinline__ void prep_layer_pull(const Args& args, int l, int kind, int max_items, LAS unsigned char* lds, volatile LAS unsigned* bcast) {
    int tid_ = threadIdx.x; asm volatile("" : "+v"(tid_)); const int tid = tid_, lane = tid & 63, wave = __builtin_amdgcn_readfirstlane(tid >> 6);
    unsigned* ctr = (unsigned*)(args.ws + WS_CTL) + CW_Q + 64 * (4 * kind + l); const int n_items = kind ? N_MOD_ITEMS : N_CONV_BATCHES;
#pragma unroll 1
    for (int k = 0; k < max_items; ++k) {
        __syncthreads();
        if (tid == 0) *bcast = __hip_atomic_fetch_add(ctr, 1u, __ATOMIC_RELAXED, __HIP_MEMORY_SCOPE_AGENT);
        __syncthreads();
        const int item = (int)*bcast;
        if (item >= n_items) break;
        prep_item(args, l, kind ? item : N_MOD_ITEMS + item, lds, tid, lane, wave);
    }
    __syncthreads();
}
__device__ __forceinline__ void p0_prologue(const Args& args, LAS unsigned char* lds, int vcu, int G) {
    if (vcu == G - 1) {
        float* BT = (float*)(args.ws + WS_BT);
        for (int i = threadIdx.x; i < 3 * 129 * 16; i += NTHR) { const int h = i & 15, m = (i >> 4) % 129, br = (i >> 4) / 129; BT[i] = args.in[I_RELB][rel_bucket(m << (2 * br)) * 16 + h]; }
    }
    prep_layer_all(args, 0, lds, vcu, G);
}

__device__ __forceinline__ void norm_mod_row(const float* xrow, const float* g, const float* sh, const float* sc, bf16* hrow, float* frow, int lane) {
    const GAS f32x4* xr = (const GAS f32x4*)xrow + lane;
    f32x4 v[8]; float s = 0.f;
#pragma unroll
    for (int j = 0; j < 8; ++j) { v[j] = xr[64 * j]; s += (v[j].x * v[j].x + v[j].y * v[j].y) + (v[j].z * v[j].z + v[j].w * v[j].w); }
    const float rstd = 1.0f / sqrtf(wave_sum(s) * (1.0f / DM) + RMS_EPS);
    GAS unsigned long long* o8 = (GAS unsigned long long*)hrow + lane;
#pragma unroll
    for (int j = 0; j < 8; ++j) { const f32x4 g4 = ((const GAS f32x4*)g)[lane + 64 * j], sh4 = ((const GAS f32x4*)sh)[lane + 64 * j], sc4 = ((const GAS f32x4*)sc)[lane + 64 * j];
        const f32x4 h = (v[j] * rstd * g4) * (sc4 + 1.0f) + sh4;
        o8[64 * j] = (unsigned long long)pk2(h.x, h.y) | ((unsigned long long)pk2(h.z, h.w) << 32);
        if (frow) ((GAS f32x4*)frow)[lane + 64 * j] = h; }
}

__device__ __forceinline__ void pw_phase(const Args& args, int l, LAS unsigned char* lds, int vcu, int G) {
    int tid_ = threadIdx.x; asm volatile("" : "+v"(tid_)); const int tid = tid_, lane = tid & 63, wave = __builtin_amdgcn_readfirstlane(tid >> 6);
    typedef float f32x16 __attribute__((ext_vector_type(16)));
    unsigned char* ws = args.ws;
    const bf16* RKV = (const bf16*)(ws + WS_RKV); const float* P = (const float*)(ws + WS_P); const bf16* W2T = (const bf16*)(ws + WS_W2T) + (size_t)l * 1024 * NLORA;
    bf16* Rr = (bf16*)(ws + WS_R); float* Ww = (float*)(ws + WS_W); bf16* Kk = (bf16*)(ws + WS_K); bf16* Vv = (bf16*)(ws + WS_V);
    bf16* Aa = (bf16*)(ws + WS_A); bf16* Bb = (bf16*)(ws + WS_B); bf16* Gg = (bf16*)(ws + WS_G); float* VF = (float*)(ws + WS_VF);
    constexpr int LST = 328, SST = 68;
    LAS unsigned short* L = (LAS unsigned short*)lds;
    LAS float* Sw = (LAS float*)(lds + 21504) + wave * (32 * SST);
    const int r32 = lane & 31, hf = lane >> 5, rs = lane >> 4, c4 = (lane & 15) * 4;
    const float* mur = args.in[I_MURKV] + (size_t)l * 3 * DRW;
    for (int tile = vcu; tile < 257; tile += G) {
        const int m0 = tile < 256 ? tile * 32 : MP, nv = tile < 256 ? 32 : 8;
        __syncthreads();
        for (int repl = 0; repl < REP_PWL; ++repl)
#pragma unroll 10
        for (int i = tid; i < 32 * NLORA; i += NTHR) { const int r = i / NLORA, c = i % NLORA; const int m = m0 + ((r < nv) ? r : nv - 1);
            const int pm = (m < MP) ? (((m & (SEQ - 1)) == 0) ? -1 : m - 1) : m + 8;
            const float v = P[(size_t)m * 768 + c] + ((pm >= 0) ? 1.f : 0.f) * P[(size_t)((pm >= 0) ? pm : m) * 768 + 384 + c];
            const float e2 = __expf(2.0f * v), th = 1.0f - 2.0f / (1.0f + e2), sg = 1.0f / (1.0f + __expf(-v));
            L[r * LST + c] = (unsigned short)f2bf((c < 64) ? th : ((c >= 128 && c < 288) ? sg : v)); }
        __syncthreads();
        const bf16* w2a = W2T + (size_t)(128 * wave + r32) * NLORA + 8 * hf; const LAS unsigned short* lb = L + r32 * LST + 8 * hf;
        f32x16 acc[4];
#define PW_MM(koff, nks, CH) do { for (int repm = 0; repm < REP_PWM; ++repm) { _Pragma("unroll") for (int nt = 0; nt < 4; ++nt) acc[nt] = (f32x16){0.f}; \
        _Pragma("unroll 1") for (int kp = 0; kp < (nks); kp += (CH)) { bf16x8 bl[CH], aw[CH][4]; \
            _Pragma("unroll") for (int k2 = 0; k2 < (CH); ++k2) { bl[k2] = *(const LAS bf16x8*)(lb + (koff) + 16 * (kp + k2)); \
                _Pragma("unroll") for (int nt = 0; nt < 4; ++nt) aw[k2][nt] = *(const bf16x8*)(w2a + (size_t)(32 * nt) * NLORA + (koff) + 16 * (kp + k2)); } \
            _Pragma("unroll") for (int k2 = 0; k2 < (CH); ++k2) _Pragma("unroll") for (int nt = 0; nt < 4; ++nt) acc[nt] = __builtin_amdgcn_mfma_f32_32x32x16_bf16(aw[k2][nt], bl[k2], acc[nt], 0, 0, 0); } } } while (0)
#define PW_STAGE(hp) do { _Pragma("unroll") for (int n2 = 0; n2 < 2; ++n2) _Pragma("unroll") for (int g = 0; g < 4; ++g) \
            *(LAS f32x4*)(Sw + r32 * SST + 32 * n2 + 8 * g + 4 * hf) = (f32x4){acc[2 * (hp) + n2][4 * g], acc[2 * (hp) + n2][4 * g + 1], acc[2 * (hp) + n2][4 * g + 2], acc[2 * (hp) + n2][4 * g + 3]}; } while (0)
#define PW_AV(it) (*(const LAS f32x4*)(Sw + (4 * (it) + rs) * SST + c4))
        const unsigned vo1_ = (unsigned)(rs * DRW + c4), vo3_ = (unsigned)(rs * 3072 + c4);
#define PW_LOCAL_OFFS unsigned vo1 = vo1_, vo3 = vo3_; asm volatile("" : "+v"(vo1), "+v"(vo3)); (void)vo3;
        const int pd = (tile < 256) ? -1 : 8;
        const float pm0 = (tile < 256 && (m0 & (SEQ - 1)) == 0 && rs == 0) ? 0.f : 1.f;
        PW_MM(0, 4, 4);
#pragma unroll
        for (int hp = 0; hp < 2; ++hp) { PW_LOCAL_OFFS const int chu = 128 * wave + 64 * hp; const f32x4 w0 = *(const f32x4*)(args.in[I_DW0] + (size_t)l * DRW + chu + c4);
            PW_STAGE(hp);
#pragma unroll
            for (int it = 0; it < 8; ++it) { const f32x4 x = w0 + PW_AV(it); f32x4 o;
#pragma unroll
                for (int e = 0; e < 4; ++e) { const float sp = fmaxf(-x[e], 0.f) + __logf(1.0f + __expf(-fabsf(x[e]))); o[e] = __expf(-__expf(-sp - 0.5f)); }
                *(f32x4*)(Ww + (size_t)(m0 + 4 * it) * DRW + chu + vo1) = o; } }
        if (l > 0) PW_MM(288, 2, 2);
#pragma unroll
        for (int hp = 0; hp < 2; ++hp) { PW_LOCAL_OFFS const int chu = 128 * wave + 64 * hp; const f32x4 mu2 = *(const f32x4*)(mur + 2 * DRW + chu + c4); f32x4 v0 = (f32x4){0.f, 0.f, 0.f, 0.f};
            if (l > 0) v0 = *(const f32x4*)(args.in[I_VV0] + (size_t)(l - 1) * DRW + chu + c4);
            PW_STAGE(hp);
#pragma unroll
            for (int half = 0; half < 2; ++half) { unsigned long long x0[4], xp[4]; f32x4 vf[4];
#pragma unroll
              for (int i = 0; i < 4; ++i) { const int it = 4 * half + i; const bf16* a_ = RKV + (size_t)(m0 + 4 * it) * 3072 + 2048 + chu; const bf16* b_ = RKV + ((size_t)(m0 + 4 * it) + pd) * 3072 + 2048 + chu;
                  x0[i] = *(const unsigned long long*)(a_ + vo3); xp[i] = *(const unsigned long long*)(b_ + vo3);
                  vf[i] = (l > 0) ? *(const f32x4*)(VF + (size_t)(m0 + 4 * it) * DRW + chu + vo1) : (f32x4){0.f, 0.f, 0.f, 0.f}; }
#pragma unroll
              for (int i = 0; i < 4; ++i) { const int it = 4 * half + i; const f32x4 xc = up4bf(x0[i]); f32x4 vr = xc + (up4bf(xp[i]) * ((it == 0) ? pm0 : 1.f) - xc) * mu2;
                  if (l > 0) { const f32x4 x = v0 + PW_AV(it); f32x4 vg;
#pragma unroll
                      for (int e = 0; e < 4; ++e) vg[e] = sigmoidf_(x[e]);
                      vr = vr + (vf[i] - vr) * vg; }
                  else *(f32x4*)(VF + (size_t)(m0 + 4 * it) * DRW + chu + vo1) = vr;
                  st4bf(Vv + (size_t)(m0 + 4 * it) * DRW + chu + vo1, vr); }
            } }
        PW_MM(128, 10, 2);
#pragma unroll
        for (int hp = 0; hp < 2; ++hp) { PW_LOCAL_OFFS const int chu = 128 * wave + 64 * hp;
            PW_STAGE(hp);
#pragma unroll
            for (int it = 0; it < 8; ++it) st4bf(Gg + (size_t)(m0 + 4 * it) * DRW + chu + vo1, PW_AV(it)); }
        PW_MM(64, 4, 4);
#pragma unroll
        for (int hp = 0; hp < 2; ++hp) { PW_LOCAL_OFFS const int chu = 128 * wave + 64 * hp;
            const f32x4 a0 = *(const f32x4*)(args.in[I_AA0] + (size_t)l * DRW + chu + c4), kk4 = *(const f32x4*)(args.in[I_KK] + (size_t)l * DRW + chu + c4), ka4 = *(const f32x4*)(args.in[I_KA] + (size_t)l * DRW + chu + c4);
            const f32x4 mu0 = *(const f32x4*)(mur + chu + c4), mu1 = *(const f32x4*)(mur + DRW + chu + c4);
            PW_STAGE(hp);
#pragma unroll
            for (int half = 0; half < 2; ++half) { unsigned long long k0[4], kp[4], r0[4], rp[4];
#pragma unroll
              for (int i = 0; i < 4; ++i) { const int it = 4 * half + i; const bf16* a_ = RKV + (size_t)(m0 + 4 * it) * 3072 + chu; const bf16* b_ = RKV + ((size_t)(m0 + 4 * it) + pd) * 3072 + chu;
                  k0[i] = *(const unsigned long long*)(a_ + 1024 + vo3); kp[i] = *(const unsigned long long*)(b_ + 1024 + vo3); r0[i] = *(const unsigned long long*)(a_ + vo3); rp[i] = *(const unsigned long long*)(b_ + vo3); }
#pragma unroll
              for (int i = 0; i < 4; ++i) { const int it = 4 * half + i; const size_t ou = (size_t)(m0 + 4 * it) * DRW + chu; const float pmask = (it == 0) ? pm0 : 1.f;
                  const f32x4 x = a0 + PW_AV(it); f32x4 a;
#pragma unroll
                  for (int e = 0; e < 4; ++e) a[e] = sigmoidf_(x[e]);
                  const f32x4 kc = up4bf(k0[i]), rc = up4bf(r0[i]);
                  const f32x4 kr = kc + (up4bf(kp[i]) * pmask - kc) * mu1; f32x4 q = kr * kk4;
                  const float s = row16_sum((q[0] * q[0] + q[1] * q[1]) + (q[2] * q[2] + q[3] * q[3]));
                  q = q * (1.0f / fmaxf(sqrtf(s), 1e-12f));
                  st4bf(Kk + ou + vo1, kr * ((a - 1.0f) * ka4 + 1.0f)); st4bf(Aa + ou + vo1, -q); st4bf(Bb + ou + vo1, q * a); st4bf(Rr + ou + vo1, rc + (up4bf(rp[i]) * pmask - rc) * mu0); }
            } }
#undef PW_MM
#undef PW_STAGE
#undef PW_AV
#undef PW_LOCAL_OFFS
    }
}

constexpr int MST = 144, MSLOT = 64 * MST;
__device__ __forceinline__ bf16x8 mfr_row(const LAS unsigned char* M, int row, int k0, int g) { return *(const LAS bf16x8*)(M + row * MST + (k0 + 8 * g) * 2); }
__device__ __forceinline__ bf16x8 mfr_tr(const LAS unsigned char* M, int k0, int col0, int g, int q) {
    typedef short v4i16 __attribute__((ext_vector_type(4)));
    const LAS unsigned char* p = M + (k0 + 8 * g + (q >> 2)) * MST + (col0 + 4 * (q & 3)) * 2;
    const v4i16 lo = __builtin_amdgcn_ds_read_tr16_b64_v4i16((LAS v4i16*)p), hi = __builtin_amdgcn_ds_read_tr16_b64_v4i16((LAS v4i16*)(p + 4 * MST));
    return (bf16x8){lo[0], lo[1], lo[2], lo[3], hi[0], hi[1], hi[2], hi[3]};
}
#define MFMA16(a, b, c) __builtin_amdgcn_mfma_f32_16x16x32_bf16((a), (b), (c), 0, 0, 0)
__device__ __forceinline__ f32x4 mm_nn(const LAS unsigned char* X, const LAS unsigned char* Y, int ti, int tj, int q, int g, f32x4 c) {
    c = MFMA16(mfr_row(X, 16 * ti + q, 0, g), mfr_tr(Y, 0, 16 * tj, g, q), c); return MFMA16(mfr_row(X, 16 * ti + q, 32, g), mfr_tr(Y, 32, 16 * tj, g, q), c); }
__device__ __forceinline__ f32x4 mm_nt(const LAS unsigned char* X, const LAS unsigned char* Yt, int ti, int tj, int q, int g, f32x4 c) {
    c = MFMA16(mfr_row(X, 16 * ti + q, 0, g), mfr_row(Yt, 16 * tj + q, 0, g), c); return MFMA16(mfr_row(X, 16 * ti + q, 32, g), mfr_row(Yt, 16 * tj + q, 32, g), c); }
__device__ __forceinline__ f32x4 mm_tn(const LAS unsigned char* Xt, const LAS unsigned char* Y, int ti, int tj, int q, int g, f32x4 c) {
    c = MFMA16(mfr_tr(Xt, 0, 16 * ti, g, q), mfr_tr(Y, 0, 16 * tj, g, q), c); return MFMA16(mfr_tr(Xt, 32, 16 * ti, g, q), mfr_tr(Y, 32, 16 * tj, g, q), c); }
typedef float f32x2_t __attribute__((ext_vector_type(2))); typedef __bf16 bf16x2_t __attribute__((ext_vector_type(2)));
__device__ __forceinline__ unsigned cvtpk(float lo, float hi) { f32x2_t v = {lo, hi}; bf16x2_t b = __builtin_convertvector(v, bf16x2_t); return __builtin_bit_cast(unsigned, b); }
__device__ __forceinline__ void mst_tile_t(LAS unsigned char* M, int ti, int tj, int q, int g, f32x4 c) {
    *(LAS unsigned long long*)(M + (16 * tj + q) * MST + (16 * ti + 4 * g) * 2) = (unsigned long long)cvtpk(c[0], c[1]) | ((unsigned long long)cvtpk(c[2], c[3]) << 32);
}
#define SC_BAR() do { asm volatile("s_waitcnt lgkmcnt(0)" ::: "memory"); __builtin_amdgcn_s_barrier(); asm volatile("" ::: "memory"); } while (0)
__device__ __forceinline__ void scan_units(const Args& args, int l, LAS unsigned char* lds, int vcu, int G) {
    int tid_ = threadIdx.x; asm volatile("" : "+v"(tid_)); const int tid = tid_, lane = tid & 63, wave = __builtin_amdgcn_readfirstlane(tid >> 6);
    unsigned char* ws = args.ws;
    const unsigned short* Rr = (const unsigned short*)(ws + WS_R); const float* Ww = (const float*)(ws + WS_W); const unsigned short* Kk = (const unsigned short*)(ws + WS_K); const unsigned short* Vv = (const unsigned short*)(ws + WS_V);
    const unsigned short* Aa = (const unsigned short*)(ws + WS_A); const unsigned short* Bb = (const unsigned short*)(ws + WS_B); float* Y = (float*)(ws + WS_Y);
    LAS unsigned char* iA = lds + 0 * MSLOT; LAS unsigned char* iR = lds + 1 * MSLOT; LAS unsigned char* iB = lds + 2 * MSLOT; LAS unsigned char* iK = lds + 3 * MSLOT;
    LAS unsigned char* iBh = lds + 4 * MSLOT; LAS unsigned char* iKh = lds + 5 * MSLOT; LAS unsigned char* iV = lds + 6 * MSLOT; LAS unsigned char* iS = lds + 7 * MSLOT;
    LAS unsigned char* iAak = lds + 8 * MSLOT; LAS unsigned char* iArb = lds + 9 * MSLOT; LAS unsigned char* iArk = lds + 10 * MSLOT; LAS unsigned char* iQa = lds + 11 * MSLOT;
    LAS unsigned char* iTa = lds + 12 * MSLOT; LAS unsigned char* iTb = lds + 13 * MSLOT;
    LAS unsigned char* iQb = iB; LAS unsigned char* iRHS = iK; LAS unsigned char* iU = iQa;
    LAS float* wtot = (LAS float*)(lds + LDSCTL_OFF + 1024); LAS float* sDC = wtot + 2 * 8 * 64;
    static_assert(14 * MSLOT <= RING_BYTES && LDSCTL_OFF + 1024 + 17 * 64 * 4 <= LDS_BYTES, "scan LDS map");
    const int q = lane & 15, g = lane >> 4, ti = wave >> 1, tj0 = 2 * (wave & 1);
    constexpr int C = 64, NCH = SEQ / C;
    for (int u = vcu; u < PBATCH * 16; u += G) {
        const int b = u >> 4, h = u & 15;
        const int hw = lane >> 5, jp = lane & 31;
        const size_t base0 = (size_t)(b * SEQ + 8 * wave + 4 * hw) * DRW + h * 64 + 2 * jp;
        typedef float f32x2v __attribute__((ext_vector_type(2)));
        f32x2v rw[4]; unsigned rk[4], ra[4], rb[4], rr[4], rv[4];
#define SC_LOAD(cc) do { _Pragma("unroll") for (int i = 0; i < 4; ++i) { const size_t o = base0 + (size_t)((cc) * C + i) * DRW; rw[i] = *(const f32x2v*)(Ww + o); \
            rk[i] = *(const unsigned*)(Kk + o); ra[i] = *(const unsigned*)(Aa + o); rb[i] = *(const unsigned*)(Bb + o); rr[i] = *(const unsigned*)(Rr + o); rv[i] = *(const unsigned*)(Vv + o); } } while (0)
#define BLO(U) __builtin_bit_cast(float, (U) << 16)
#define BHI(U) __builtin_bit_cast(float, (U) & 0xffff0000u)
#define SC_DECAY(cc) do { p[0] = rw[0]; _Pragma("unroll") for (int i = 1; i < 4; ++i) p[i] = p[i - 1] * rw[i]; \
            lo.x = __shfl(p[3].x, jp); lo.y = __shfl(p[3].y, jp);                                        \
            if (hw) { _Pragma("unroll") for (int i = 0; i < 4; ++i) p[i] = p[i] * lo; *(LAS f32x2v*)(wtot + ((cc) & 1) * 512 + wave * 64 + 2 * jp) = p[3]; } } while (0)
        SC_LOAD(0);
        f32x2v p[4], lo; SC_DECAY(0);
        f32x4 Sreg[2], Treg[2];
#pragma unroll
        for (int t2 = 0; t2 < 2; ++t2) Sreg[t2] = (f32x4){0.f, 0.f, 0.f, 0.f};
        __syncthreads();
        for (int i = tid; i < 64 * 36; i += NTHR) ((LAS unsigned*)iS)[i] = 0u;
        for (int c = 0; c < NCH; ++c) {
            LAS float* wt = wtot + (c & 1) * 512;
            f32x2v pre = (f32x2v){1.f, 1.f}, dc = (f32x2v){1.f, 1.f};
#pragma unroll
            for (int w2 = 0; w2 < 8; ++w2) { const f32x2v x = *(const LAS f32x2v*)(wt + w2 * 64 + 2 * jp); dc = dc * x; if (w2 < wave) pre = pre * x; }
            if (wave == 0 && hw == 0) *(LAS f32x2v*)(sDC + 2 * jp) = dc;
            { const f32x2v d0 = hw ? pre * lo : pre;
              f32x2v xa[4], xr[4], xb[4], xk[4], xbh[4], xkh[4], xv[4];
#pragma unroll
              for (int i = 0; i < 4; ++i) { const f32x2v Dt = pre * p[i], Dm = (i == 0) ? d0 : pre * p[i - 1]; f32x2v inv; inv.x = __builtin_amdgcn_rcpf(Dt.x); inv.y = __builtin_amdgcn_rcpf(Dt.y); const f32x2v sc = dc * inv;
                  const f32x2v a2 = (f32x2v){BLO(ra[i]), BHI(ra[i])}, r2 = (f32x2v){BLO(rr[i]), BHI(rr[i])}, b2 = (f32x2v){BLO(rb[i]), BHI(rb[i])}, k2 = (f32x2v){BLO(rk[i]), BHI(rk[i])};
                  xa[i] = a2 * Dm; xr[i] = r2 * Dt; xb[i] = b2 * inv; xk[i] = k2 * inv; xbh[i] = b2 * sc; xkh[i] = k2 * sc; xv[i] = (f32x2v){BLO(rv[i]), BHI(rv[i])}; }
              const int o0 = (2 * jp) * MST + (8 * wave + 4 * hw) * 2, o1 = o0 + MST;
#define SC_W4(img, ARR) do { *(LAS unsigned long long*)((img) + o0) = (unsigned long long)cvtpk(ARR[0].x, ARR[1].x) | ((unsigned long long)cvtpk(ARR[2].x, ARR[3].x) << 32); \
                           *(LAS unsigned long long*)((img) + o1) = (unsigned long long)cvtpk(ARR[0].y, ARR[1].y) | ((unsigned long long)cvtpk(ARR[2].y, ARR[3].y) << 32); } while (0)
              SC_W4(iA, xa); SC_W4(iR, xr); SC_W4(iB, xb); SC_W4(iK, xk); SC_W4(iBh, xbh); SC_W4(iKh, xkh); SC_W4(iV, xv);
#undef SC_W4
            }
            if (c + 1 < NCH) SC_LOAD(c + 1);
            SC_BAR();
#define FR_ROW2(dst, M, row) do { dst[0] = mfr_row(M, (row), 0, g); dst[1] = mfr_row(M, (row), 32, g); } while (0)
#define FR_TR2(dst, M, col0) do { dst[0] = mfr_tr(M, 0, (col0), g, q); dst[1] = mfr_tr(M, 32, (col0), g, q); } while (0)
#define MM2(c, a, b) MFMA16(a[1], b[1], MFMA16(a[0], b[0], (c)))
            const f32x4 z4 = (f32x4){0.f, 0.f, 0.f, 0.f};
            { bf16x8 aA[2], aR[2], bB[2][2], bK[2][2];
              FR_TR2(aA, iA, 16 * ti); FR_TR2(aR, iR, 16 * ti);
#pragma unroll
              for (int t2 = 0; t2 < 2; ++t2) { FR_TR2(bB[t2], iB, 16 * (tj0 + t2)); FR_TR2(bK[t2], iK, 16 * (tj0 + t2)); }
#pragma unroll
              for (int t2 = 0; t2 < 2; ++t2) { const int tj = tj0 + t2;
                f32x4 aab = MM2(z4, aA, bB[t2]), aak = MM2(z4, aA, bK[t2]), arb = MM2(z4, aR, bB[t2]), ark = MM2(z4, aR, bK[t2]);
#pragma unroll
                for (int e = 0; e < 4; ++e) { const int t = 16 * ti + 4 * g + e, s = 16 * tj + q; if (!(s < t)) { aab[e] = 0.f; aak[e] = 0.f; } if (!(s <= t)) { arb[e] = 0.f; ark[e] = 0.f; } }
                mst_tile_t(iQa, ti, tj, q, g, aab); mst_tile_t(iAak, ti, tj, q, g, aak); mst_tile_t(iArb, ti, tj, q, g, arb); mst_tile_t(iArk, ti, tj, q, g, ark);
#pragma unroll
                for (int e = 0; e < 4; ++e) if (16 * ti + 4 * g + e == 16 * tj + q) aab[e] += 1.0f;
                Treg[t2] = aab; mst_tile_t(iTa, ti, tj, q, g, aab); } }
            SC_BAR();
            { bf16x8 aQ[2], bQ[2][2], aA[2], bS[2][2], aK[2], bV[2][2];
              FR_TR2(aQ, iQa, 16 * ti); FR_TR2(aA, iA, 16 * ti); FR_TR2(aK, iAak, 16 * ti);
#pragma unroll
              for (int t2 = 0; t2 < 2; ++t2) { FR_ROW2(bQ[t2], iQa, 16 * (tj0 + t2) + q); FR_ROW2(bS[t2], iS, 16 * (tj0 + t2) + q); FR_ROW2(bV[t2], iV, 16 * (tj0 + t2) + q); }
#pragma unroll
              for (int t2 = 0; t2 < 2; ++t2) { const int tj = tj0 + t2;
                mst_tile_t(iQb, ti, tj, q, g, MM2(z4, aQ, bQ[t2])); mst_tile_t(iRHS, ti, tj, q, g, MM2(MM2(z4, aA, bS[t2]), aK, bV[t2])); } }
            SC_BAR();
#define SC_LEVEL(Qin, Qout, Tin, Tout, doq) do { bf16x8 aQ[2], bQ[2][2], aT[2]; FR_TR2(aQ, Qin, 16 * ti); FR_TR2(aT, Tin, 16 * ti); \
                _Pragma("unroll") for (int t2 = 0; t2 < 2; ++t2) FR_ROW2(bQ[t2], Qin, 16 * (tj0 + t2) + q); \
                _Pragma("unroll") for (int t2 = 0; t2 < 2; ++t2) { const int tj = tj0 + t2; \
                    if (doq) mst_tile_t(Qout, ti, tj, q, g, MM2(z4, aQ, bQ[t2])); \
                    Treg[t2] = MM2(Treg[t2], aT, bQ[t2]); mst_tile_t(Tout, ti, tj, q, g, Treg[t2]); } SC_BAR(); } while (0)
            SC_LEVEL(iQb, iQa, iTa, iTb, true);
            SC_LEVEL(iQa, iQb, iTb, iTa, true);
            SC_LEVEL(iQb, iQa, iTa, iTb, true);
            SC_LEVEL(iQa, iQb, iTb, iTa, true);
            SC_LEVEL(iQb, iQa, iTa, iTb, false);
#undef SC_LEVEL
            { bf16x8 aT[2], bR[2][2]; FR_TR2(aT, iTb, 16 * ti);
#pragma unroll
              for (int t2 = 0; t2 < 2; ++t2) FR_ROW2(bR[t2], iRHS, 16 * (tj0 + t2) + q);
#pragma unroll
              for (int t2 = 0; t2 < 2; ++t2) mst_tile_t(iU, ti, tj0 + t2, q, g, MM2(z4, aT, bR[t2])); }
            SC_BAR();
            { bf16x8 aRt[2], aArb[2], aArk[2], aBh[2], aKh[2], bS[2][2], bU[2][2], bV[2][2];
              FR_TR2(aRt, iR, 16 * ti); FR_TR2(aArb, iArb, 16 * ti); FR_TR2(aArk, iArk, 16 * ti); FR_ROW2(aBh, iBh, 16 * ti + q); FR_ROW2(aKh, iKh, 16 * ti + q);
#pragma unroll
              for (int t2 = 0; t2 < 2; ++t2) { FR_ROW2(bS[t2], iS, 16 * (tj0 + t2) + q); FR_ROW2(bU[t2], iU, 16 * (tj0 + t2) + q); FR_ROW2(bV[t2], iV, 16 * (tj0 + t2) + q); }
              const f32x4 dcv = *(const LAS f32x4*)(sDC + 16 * ti + 4 * g);
#pragma unroll
              for (int t2 = 0; t2 < 2; ++t2) { const int tj = tj0 + t2;
                const f32x4 y = MM2(MM2(MM2(z4, aRt, bS[t2]), aArb, bU[t2]), aArk, bV[t2]);
                float* yp = Y + (size_t)(b * SEQ + c * C + 16 * ti + 4 * g) * DRW + h * 64 + 16 * tj + q;
#pragma unroll
                for (int e = 0; e < 4; ++e) yp[(size_t)e * DRW] = y[e];
                Sreg[t2] = MM2(MM2(Sreg[t2] * dcv, aBh, bU[t2]), aKh, bV[t2]); } }
            if (c + 1 < NCH) SC_DECAY(c + 1);
            SC_BAR();
#undef FR_ROW2
#undef FR_TR2
#undef MM2
#pragma unroll
            for (int t2 = 0; t2 < 2; ++t2) mst_tile_t(iS, ti, tj0 + t2, q, g, Sreg[t2]);
        }
#pragma unroll
        for (int t2 = 0; t2 < 2; ++t2) { const int tj = tj0 + t2;
            *(f32x4*)(args.out + O_WP + ((((size_t)l * PBATCH + b) * 16 + h) * 64 + 16 * tj + q) * 64 + 16 * ti + 4 * g) = Sreg[t2]; }
        __syncthreads();
    }
#undef SC_LOAD
#undef SC_DECAY
#undef BLO
#undef BHI
}
#undef SC_BAR
__device__ __forceinline__ void sample_wkv_units(const Args& args, int l, int vcu, int G) {
    int tid_ = threadIdx.x; asm volatile("" : "+v"(tid_)); const int tid = tid_, lane = tid & 63, wave = __builtin_amdgcn_readfirstlane(tid >> 6); const int gw = vcu * NWAVES + wave, NGW = G * NWAVES; (void)tid; (void)lane; (void)wave; (void)gw; (void)NGW;
    unsigned char* ws = args.ws;
    const bf16* Rr = (const bf16*)(ws + WS_R); const float* Ww = (const float*)(ws + WS_W); const bf16* Kk = (const bf16*)(ws + WS_K); const bf16* Vv = (const bf16*)(ws + WS_V);
    const bf16* Aa = (const bf16*)(ws + WS_A); const bf16* Bb = (const bf16*)(ws + WS_B); float* Y = (float*)(ws + WS_Y);
    for (int u = gw; u < 128; u += NGW) {
        const int b = u >> 4, h = u & 15; const size_t vo = (size_t)(MP + b) * DRW + h * 64;
        const float* Sp = args.in[I_SWKV] + ((((size_t)l * 8 + b) * 16 + h) * 64 + lane) * 64;
        float* So = args.out + O_WS + ((((size_t)l * 8 + b) * 16 + h) * 64 + lane) * 64;
        f32x4 S[16];
#pragma unroll
        for (int j = 0; j < 16; ++j) S[j] = *(const f32x4*)(Sp + 4 * j);
        float sa = 0.f;
#pragma unroll
        for (int j = 0; j < 16; ++j) { const f32x4 a4 = ld4bf(Aa + vo + 4 * j); sa += (S[j].x * a4.x + S[j].y * a4.y) + (S[j].z * a4.z + S[j].w * a4.w); }
        const float vi = bf2f(Vv[vo + lane]); float y = 0.f;
#pragma unroll
        for (int j = 0; j < 16; ++j) { const f32x4 w4 = *(const f32x4*)(Ww + vo + 4 * j), k4 = ld4bf(Kk + vo + 4 * j), b4 = ld4bf(Bb + vo + 4 * j), r4 = ld4bf(Rr + vo + 4 * j);
            f32x4 s = S[j] * w4 + (b4 * sa + k4 * vi); y += (s.x * r4.x + s.y * r4.y) + (s.z * r4.z + s.w * r4.w); *(f32x4*)(So + 4 * j) = s; }
        Y[vo + lane] = y;
    }
}
typedef short v4i16_t __attribute__((ext_vector_type(4)));
typedef float f32x4v __attribute__((ext_vector_type(4)));
__device__ __forceinline__ void attn_units(const Args& args, int l, LAS unsigned char* lds, int vcu, int G) {
    int tid_ = threadIdx.x; asm volatile("" : "+v"(tid_)); const int tid = tid_, lane = tid & 63, wave = __builtin_amdgcn_readfirstlane(tid >> 6); const int gw = vcu * NWAVES + wave, NGW = G * NWAVES; (void)tid; (void)lane; (void)wave; (void)gw; (void)NGW;
    unsigned char* ws = args.ws;
    const bf16* QB = (const bf16*)(ws + WS_QB); const bf16* KB = (const bf16*)(ws + WS_KB); const bf16* VB = (const bf16*)(ws + WS_VB);
    bf16* OBR = (bf16*)(ws + WS_OBR); float* LSE = (float*)(ws + WS_LSE); const float* BT = (const float*)(ws + WS_BT);
    constexpr int KST = 144, VST = 160;
    LAS unsigned char* Kt = lds; LAS unsigned char* Vt = lds + 256 * KST; LAS float* btab = (LAS float*)(lds + 256 * KST + 256 * VST);
    const int q = lane & 15, g = lane >> 4;
    constexpr int NA_S = 0, NA_O = 16; static_assert(64 * NA_S + 192 * NA_O == PBATCH * NHEADS * 48, "attention unit deal");
    const bool deal = (G == 256); const int ufirst = deal ? ((vcu < 64) ? vcu * NA_S : 64 * NA_S + (vcu - 64) * NA_O) : vcu, ucnt = deal ? ((vcu < 64) ? NA_S : NA_O) : (PBATCH * NHEADS * 48 - vcu + G - 1) / G, ustep = deal ? 1 : G;
    v4u kreg[4], vreg[4]; float breg = 0.f; bf16x8 qn0, qn1;
#define AT_DECODE(uu) const int rn = (uu) & 15, br = ((uu) >> 4) % 3, h = ((uu) / 48) & 15, b = (uu) / 768; const int dsh = 2 * br, dil = 1 << dsh, r = rn & (dil - 1), n = rn >> dsh;
#define AT_FETCH(uu) do { AT_DECODE(uu) \
        _Pragma("unroll") for (int j = 0; j < 4; ++j) { const int i = tid + NTHR * j, row = i >> 3, chk = i & 7, sk = (n - 1) * 128 + row; kreg[j] = (v4u){0u, 0u, 0u, 0u}; vreg[j] = (v4u){0u, 0u, 0u, 0u}; \
            if (sk >= 0) { const size_t go = ((size_t)(b * SEQ + sk * dil + r)) * DATT + h * 64 + chk * 8; kreg[j] = *(const v4u*)(KB + go); vreg[j] = *(const v4u*)(VB + go); } } \
        if (tid < 129) breg = BT[(br * 129 + tid) * 16 + h]; \
        { const int mqn = b * SEQ + (n * 128 + 16 * wave + q) * dil + r; qn0 = *(const bf16x8*)(QB + (size_t)mqn * DATT + h * 64 + 8 * g); qn1 = *(const bf16x8*)(QB + (size_t)mqn * DATT + h * 64 + 32 + 8 * g); } } while (0)
    if (ucnt > 0) AT_FETCH(ufirst);
    for (int ui = 0; ui < ucnt; ++ui) { const int u = ufirst + ui * ustep;
        AT_DECODE(u)
        __syncthreads();
#pragma unroll
        for (int j = 0; j < 4; ++j) { const int i = tid + NTHR * j, row = i >> 3, chk = i & 7; *(LAS v4u*)(Kt + row * KST + chk * 16) = kreg[j]; *(LAS v4u*)(Vt + row * VST + chk * 16) = vreg[j]; }
        if (tid < 129) btab[tid] = breg;
        const bf16x8 qf0 = qn0, qf1 = qn1;
        __syncthreads();
        if (ui + 1 < ucnt) AT_FETCH(u + ustep);
        const int iq = 16 * wave + q, mq = b * SEQ + (n * 128 + iq) * dil + r;
        const int kb0 = wave >> 1;
        f32x4 sacc[10];
#pragma unroll
        for (int sb = 0; sb < 10; ++sb) { const int key0 = 32 * kb0 + 16 * sb;
            const bf16x8 a0 = *(const LAS bf16x8*)(Kt + (key0 + q) * KST + 16 * g), a1 = *(const LAS bf16x8*)(Kt + (key0 + q) * KST + 64 + 16 * g);
            f32x4 acc = (f32x4){0.f, 0.f, 0.f, 0.f};
            acc = __builtin_amdgcn_mfma_f32_16x16x32_bf16(a0, qf0, acc, 0, 0, 0); acc = __builtin_amdgcn_mfma_f32_16x16x32_bf16(a1, qf1, acc, 0, 0, 0); sacc[sb] = acc; }
        float mx = -INFINITY;
#pragma unroll
        for (int sb = 0; sb < 10; ++sb)
#pragma unroll
            for (int e = 0; e < 4; ++e) { const int jj = 32 * kb0 + 16 * sb + 4 * g + e, dsub = 128 + iq - jj, sk = (n - 1) * 128 + jj;
                const bool ok = (dsub >= 0) && (dsub <= 128) && (sk >= 0);
                const float s = ok ? sacc[sb][e] * ATT_SCALE + btab[ok ? dsub : 0] : -INFINITY; sacc[sb][e] = s; mx = fmaxf(mx, s); }
        mx = fmaxf(mx, __shfl_xor(mx, 16)); mx = fmaxf(mx, __shfl_xor(mx, 32));
        float sum = 0.f;
#pragma unroll
        for (int sb = 0; sb < 10; ++sb)
#pragma unroll
            for (int e = 0; e < 4; ++e) { const float p = __expf(sacc[sb][e] - mx); sacc[sb][e] = p; sum += p; }
        sum += __shfl_xor(sum, 16); sum += __shfl_xor(sum, 32);
        f32x4 o[4];
#pragma unroll
        for (int c = 0; c < 4; ++c) o[c] = (f32x4){0.f, 0.f, 0.f, 0.f};
#pragma unroll
        for (int kk = 0; kk < 5; ++kk) {
            v4u pw; pw.x = pk2(sacc[2 * kk][0], sacc[2 * kk][1]); pw.y = pk2(sacc[2 * kk][2], sacc[2 * kk][3]); pw.z = pk2(sacc[2 * kk + 1][0], sacc[2 * kk + 1][1]); pw.w = pk2(sacc[2 * kk + 1][2], sacc[2 * kk + 1][3]);
            const bf16x8 pb = __builtin_bit_cast(bf16x8, pw);
            const int R0 = 32 * (kb0 + kk) + 4 * g + (q >> 2);
#pragma unroll
            for (int c = 0; c < 4; ++c) {
                const v4i16_t lo = __builtin_amdgcn_ds_read_tr16_b64_v4i16((LAS v4i16_t*)(Vt + R0 * VST + (16 * c + 4 * (q & 3)) * 2));
                const v4i16_t hi = __builtin_amdgcn_ds_read_tr16_b64_v4i16((LAS v4i16_t*)(Vt + (R0 + 16) * VST + (16 * c + 4 * (q & 3)) * 2));
                const bf16x8 va = (bf16x8){lo[0], lo[1], lo[2], lo[3], hi[0], hi[1], hi[2], hi[3]};
                o[c] = __builtin_amdgcn_mfma_f32_16x16x32_bf16(va, pb, o[c], 0, 0, 0); }
        }
        const float inv = 1.0f / sum;
        bf16* op = OBR + ((size_t)br * MP + mq) * DATT + h * 64 + 4 * g;
#pragma unroll
        for (int c = 0; c < 4; ++c) { const unsigned long long w = (unsigned long long)pk2(o[c][0] * inv, o[c][1] * inv) | ((unsigned long long)pk2(o[c][2] * inv, o[c][3] * inv) << 32); *(unsigned long long*)(op + 16 * c) = w; }
        if (g == 0) LSE[((size_t)br * MP + mq) * 16 + h] = mx + __logf(sum);
    }
#undef AT_DECODE
#undef AT_FETCH
}
__device__ __forceinline__ void sample_attn_units(const Args& args, int l, LAS unsigned char* lds, int vcu, int G) {
    int tid_ = threadIdx.x; asm volatile("" : "+v"(tid_)); const int tid = tid_, lane = tid & 63, wave = __builtin_amdgcn_readfirstlane(tid >> 6); const int gw = vcu * NWAVES + wave, NGW = G * NWAVES; (void)tid; (void)lane; (void)wave; (void)gw; (void)NGW;
    unsigned char* ws = args.ws;
    const bf16* QB = (const bf16*)(ws + WS_QB); bf16* MIX = (bf16*)(ws + WS_MIX); const float* BT = (const float*)(ws + WS_BT);
    LAS float* pl = (LAS float*)(lds + 90112) + wave * 448;
    for (int u = gw; u < 128; u += NGW) {
        const int b = u >> 4, h = u & 15, m = MP + b;
        float qv[64];
#pragma unroll
        for (int j = 0; j < 8; ++j) { const v4u w = *(const v4u*)(QB + (size_t)m * DATT + h * 64 + 8 * j);
            qv[8 * j + 0] = bf2f((unsigned short)(w.x & 0xffff)); qv[8 * j + 1] = bf2f((unsigned short)(w.x >> 16)); qv[8 * j + 2] = bf2f((unsigned short)(w.y & 0xffff)); qv[8 * j + 3] = bf2f((unsigned short)(w.y >> 16));
            qv[8 * j + 4] = bf2f((unsigned short)(w.z & 0xffff)); qv[8 * j + 5] = bf2f((unsigned short)(w.z >> 16)); qv[8 * j + 6] = bf2f((unsigned short)(w.w & 0xffff)); qv[8 * j + 7] = bf2f((unsigned short)(w.w >> 16)); }
        const float* knew = args.out + O_KS + ((size_t)l * 8 + b) * DATT + h * 64; const float* vnew = args.out + O_VS + ((size_t)l * 8 + b) * DATT + h * 64;
        const float* kc = args.in[I_CK] + (((size_t)l * 8 + b) * 2048) * 1024 + h * 64; const float* vc = args.in[I_CV] + (((size_t)l * 8 + b) * 2048) * 1024 + h * 64;
        float mx = -INFINITY;
        for (int it = 0; it < 7; ++it) { const int kk = lane + 64 * it;
            if (kk < 387) { const int br = kk / 129, mm = kk % 129; const float* kp = (mm == 0) ? knew : kc + (size_t)(2048 - (mm << (2 * br))) * 1024;
                float d = 0.f;
#pragma unroll
                for (int j = 0; j < 16; ++j) { const f32x4 k4 = *(const f32x4*)(kp + 4 * j); d += (qv[4 * j] * k4.x + qv[4 * j + 1] * k4.y) + (qv[4 * j + 2] * k4.z + qv[4 * j + 3] * k4.w); }
                const float s = d * ATT_SCALE + BT[(br * 129 + mm) * 16 + h]; pl[kk] = s; mx = fmaxf(mx, s); } }
        mx = wave_max(mx);
        float sum = 0.f;
        for (int it = 0; it < 7; ++it) { const int kk = lane + 64 * it; if (kk < 387) { const float p = __expf(pl[kk] - mx); pl[kk] = p; sum += p; } }
        sum = wave_sum(sum);
        f32x4 o4 = (f32x4){0.f, 0.f, 0.f, 0.f}; const int kg = lane >> 4, dq = lane & 15;
#pragma unroll 8
        for (int i = 0; i < 97; ++i) { const int kk = kg + 4 * i; if (kk < 387) { const int br = kk / 129, mm = kk % 129; const float* vp = (mm == 0) ? vnew : vc + (size_t)(2048 - (mm << (2 * br))) * 1024;
            o4 += *(const f32x4*)(vp + 4 * dq) * pl[kk]; } }
#pragma unroll
        for (int e = 0; e < 4; ++e) { o4[e] += __shfl_xor(o4[e], 16); o4[e] += __shfl_xor(o4[e], 32); }
        if (kg == 0) { const float inv = 1.0f / sum; *(unsigned long long*)(MIX + (size_t)m * DM + h * 64 + 4 * dq) = (unsigned long long)pk2(o4.x * inv, o4.y * inv) | ((unsigned long long)pk2(o4.z * inv, o4.w * inv) << 32); }
    }
}

__device__ __forceinline__ void mx_phase(const Args& args, int l, int vcu, int G) {
    int tid_ = threadIdx.x; asm volatile("" : "+v"(tid_)); const int tid = tid_, lane = tid & 63, wave = __builtin_amdgcn_readfirstlane(tid >> 6); const int gw = vcu * NWAVES + wave, NGW = G * NWAVES; (void)tid; (void)lane; (void)wave; (void)gw; (void)NGW;
    unsigned char* ws = args.ws;
    const bf16* OBR = (const bf16*)(ws + WS_OBR); const float* LSE = (const float*)(ws + WS_LSE); bf16* MIX = (bf16*)(ws + WS_MIX);
    const bf16* Rr = (const bf16*)(ws + WS_R); const bf16* Kk = (const bf16*)(ws + WS_K); const bf16* Vv = (const bf16*)(ws + WS_V); const bf16* Gg = (const bf16*)(ws + WS_G); const float* Y = (const float*)(ws + WS_Y);
    const int hh = lane >> 2, p = lane & 3, c0 = hh * 64 + p * 16;
    f32x4 lng[4], lnb[4], rk[4];
#pragma unroll
    for (int j = 0; j < 4; ++j) { lng[j] = *(const f32x4*)(args.in[I_LNG] + (size_t)l * DRW + c0 + 4 * j); lnb[j] = *(const f32x4*)(args.in[I_LNB] + (size_t)l * DRW + c0 + 4 * j); rk[j] = *(const f32x4*)(args.in[I_RK] + (size_t)l * DRW + c0 + 4 * j); }
    for (int m = gw; m < NROWS; m += NGW) {
        if (m < MP) {
            const float l0 = LSE[((size_t)0 * MP + m) * 16 + hh], l1 = LSE[((size_t)1 * MP + m) * 16 + hh], l2 = LSE[((size_t)2 * MP + m) * 16 + hh];
            const float mx = fmaxf(l0, fmaxf(l1, l2)); float e0 = __expf(l0 - mx), e1 = __expf(l1 - mx), e2 = __expf(l2 - mx); const float inv = 1.0f / (e0 + e1 + e2); e0 *= inv; e1 *= inv; e2 *= inv;
            float acc[16];
#pragma unroll
            for (int i = 0; i < 16; ++i) acc[i] = 0.f;
#pragma unroll
            for (int br = 0; br < 3; ++br) { const float al = br == 0 ? e0 : br == 1 ? e1 : e2;
#pragma unroll
                for (int j = 0; j < 2; ++j) { const v4u w = *(const v4u*)(OBR + ((size_t)br * MP + m) * DATT + c0 + 8 * j);
                    acc[8 * j + 0] += al * bf2f((unsigned short)(w.x & 0xffff)); acc[8 * j + 1] += al * bf2f((unsigned short)(w.x >> 16)); acc[8 * j + 2] += al * bf2f((unsigned short)(w.y & 0xffff)); acc[8 * j + 3] += al * bf2f((unsigned short)(w.y >> 16));
                    acc[8 * j + 4] += al * bf2f((unsigned short)(w.z & 0xffff)); acc[8 * j + 5] += al * bf2f((unsigned short)(w.z >> 16)); acc[8 * j + 6] += al * bf2f((unsigned short)(w.w & 0xffff)); acc[8 * j + 7] += al * bf2f((unsigned short)(w.w >> 16)); } }
            v4u o0, o1; o0.x = pk2(acc[0], acc[1]); o0.y = pk2(acc[2], acc[3]); o0.z = pk2(acc[4], acc[5]); o0.w = pk2(acc[6], acc[7]); o1.x = pk2(acc[8], acc[9]); o1.y = pk2(acc[10], acc[11]); o1.z = pk2(acc[12], acc[13]); o1.w = pk2(acc[14], acc[15]);
            *(v4u*)(MIX + (size_t)m * DM + c0) = o0; *(v4u*)(MIX + (size_t)m * DM + c0 + 8) = o1;
        }
        const size_t ro = (size_t)m * DRW + c0;
        f32x4 y[4], rr[4], kk[4], vv[4], gg[4];
        float s = 0.f, bon = 0.f;
#pragma unroll
        for (int j = 0; j < 4; ++j) { y[j] = *(const f32x4*)(Y + ro + 4 * j); rr[j] = ld4bf(Rr + ro + 4 * j); kk[j] = ld4bf(Kk + ro + 4 * j); vv[j] = ld4bf(Vv + ro + 4 * j); gg[j] = ld4bf(Gg + ro + 4 * j);
            s += (y[j].x + y[j].y) + (y[j].z + y[j].w); const f32x4 t = rr[j] * kk[j] * rk[j]; bon += (t.x + t.y) + (t.z + t.w); }
        s += __shfl_xor(s, 1); s += __shfl_xor(s, 2); bon += __shfl_xor(bon, 1); bon += __shfl_xor(bon, 2);
        const float mean = s * (1.0f / 64.0f); float qq = 0.f;
#pragma unroll
        for (int j = 0; j < 4; ++j) { y[j] = y[j] - mean; qq += (y[j].x * y[j].x + y[j].y * y[j].y) + (y[j].z * y[j].z + y[j].w * y[j].w); }
        qq += __shfl_xor(qq, 1); qq += __shfl_xor(qq, 2);
        const float rstd = 1.0f / sqrtf(qq * (1.0f / 64.0f) + GN_EPS);
        v4u o0, o1; f32x4 z[4];
#pragma unroll
        for (int j = 0; j < 4; ++j) z[j] = ((y[j] * rstd) * lng[j] + lnb[j] + vv[j] * bon) * gg[j];
        o0.x = pk2(z[0].x, z[0].y); o0.y = pk2(z[0].z, z[0].w); o0.z = pk2(z[1].x, z[1].y); o0.w = pk2(z[1].z, z[1].w); o1.x = pk2(z[2].x, z[2].y); o1.y = pk2(z[2].z, z[2].w); o1.z = pk2(z[3].x, z[3].y); o1.w = pk2(z[3].z, z[3].w);
        *(v4u*)(MIX + (size_t)m * DM + DATT + c0) = o0; *(v4u*)(MIX + (size_t)m * DM + DATT + c0 + 8) = o1;
    }
}

template <int K> __device__ __forceinline__ void sample_proj(const bf16* A, const bf16* Bt, const float* base_s, float* out_s, const float* gate, LAS unsigned char* lds, int vcu, int G) {
    int tid_ = threadIdx.x; asm volatile("" : "+v"(tid_)); const int tid = tid_, lane = tid & 63, wave = __builtin_amdgcn_readfirstlane(tid >> 6);
    constexpr int KW = K / 8, NS = KW / 32; static_assert(KW % 32 == 0, "K split");
    LAS float* part = (LAS float*)lds;
    const int c = lane & 15, g = lane >> 4;
    for (int cg = vcu; cg < DM / 8; cg += G) {
        const int n0 = 8 * cg;
        const bf16* ap = A + (size_t)(MP + (c & 7)) * K + wave * KW + 8 * g; const bf16* bp = Bt + (size_t)(n0 + (c & 7)) * K + wave * KW + 8 * g;
        bf16x8 af[NS], bfr[NS];
#pragma unroll
        for (int s = 0; s < NS; ++s) { af[s] = *(const bf16x8*)(ap + 32 * s); bfr[s] = *(const bf16x8*)(bp + 32 * s); }
        f32x4 acc = (f32x4){0.f, 0.f, 0.f, 0.f};
#pragma unroll
        for (int s = 0; s < NS; ++s) acc = __builtin_amdgcn_mfma_f32_16x16x32_bf16(af[s], bfr[s], acc, 0, 0, 0);
        __syncthreads();
        if (g < 2 && c < 8) {
#pragma unroll
            for (int e = 0; e < 4; ++e) part[(wave * 8 + 4 * g + e) * 8 + c] = acc[e]; }
        __syncthreads();
        if (tid < 64) { const int r = tid >> 3, cc = tid & 7; float s = 0.f;
#pragma unroll
            for (int w = 0; w < 8; ++w) s += part[(w * 8 + r) * 8 + cc];
            const size_t o = (size_t)r * DM + n0 + cc; out_s[o] = base_s[o] + gate[(size_t)(4 + r) * MODW + n0 + cc] * s; }
    }
    __syncthreads();
}

__device__ __forceinline__ void n1_phase(const Args& args, int l, int vcu, int G, const float* Xp, const float* Xs, const float* modl, bf16* HB) {
    int tid_ = threadIdx.x; asm volatile("" : "+v"(tid_)); const int tid = tid_, lane = tid & 63, wave = __builtin_amdgcn_readfirstlane(tid >> 6); const int gw = vcu * NWAVES + wave, NGW = G * NWAVES; (void)tid; (void)lane; (void)wave; (void)gw; (void)NGW;
    for (int m = gw; m < NROWS + 8; m += NGW) {
        if (m < MP) { const int b = m >> 11, t = m & (SEQ - 1);
            norm_mod_row(Xp + (size_t)m * DM, args.in[I_N1G] + (size_t)l * DM, modl + (size_t)b * MODW, modl + (size_t)b * MODW + DM, HB + (size_t)m * DM,
                         (t == SEQ - 1) ? args.out + O_SP + ((size_t)l * PBATCH + b) * DM : nullptr, lane); }
        else if (m < NROWS) { const int b = m - MP;
            norm_mod_row(Xs + (size_t)b * DM, args.in[I_N1G] + (size_t)l * DM, modl + (size_t)(4 + b) * MODW, modl + (size_t)(4 + b) * MODW + DM, HB + (size_t)m * DM,
                         args.out + O_SS + ((size_t)l * 8 + b) * DM, lane); }
        else { const int b = m - NROWS; const float* s = args.in[I_SSH] + ((size_t)l * 8 + b) * DM; GAS unsigned long long* o8 = (GAS unsigned long long*)(HB + (size_t)m * DM) + lane;
#pragma unroll
            for (int j = 0; j < 8; ++j) { const f32x4 v = ((const GAS f32x4*)s)[lane + 64 * j]; o8[64 * j] = (unsigned long long)pk2(v.x, v.y) | ((unsigned long long)pk2(v.z, v.w) << 32); } }
    }
}
__device__ __forceinline__ void n2_phase(const Args& args, int l, int vcu, int G, const float* XB, const float* modl, bf16* HB) {
    int tid_ = threadIdx.x; asm volatile("" : "+v"(tid_)); const int tid = tid_, lane = tid & 63, wave = __builtin_amdgcn_readfirstlane(tid >> 6); const int gw = vcu * NWAVES + wave, NGW = G * NWAVES; (void)tid; (void)lane; (void)wave; (void)gw; (void)NGW;
    for (int m = gw; m < NROWS; m += NGW) { const int bb = (m < MP) ? (m >> 11) : 4 + (m - MP);
        norm_mod_row(XB + (size_t)m * DM, args.in[I_N2G] + (size_t)l * DM, modl + (size_t)bb * MODW + 3 * DM, modl + (size_t)bb * MODW + 4 * DM, HB + (size_t)m * DM, nullptr, lane); }
}

__global__ void __launch_bounds__(NTHR, 2) fwd(Args args) {
    extern __shared__ __attribute__((aligned(16))) unsigned char lds_raw[];
    LAS unsigned char* lds = (LAS unsigned char*)lds_raw;
    volatile LAS unsigned* MISC = (volatile LAS unsigned*)(lds + MISC_OFF);
    const int G = gridDim.x; const int bx = blockIdx.x; const int vcu = (G % 8 == 0) ? (bx % 8) * (G / 8) + bx / 8 : bx;
    unsigned char* ws = args.ws;
    for (int u = threadIdx.x; u < (LDS_BYTES - LDSCTL_OFF) / 4; u += NTHR) ((LAS unsigned*)(lds + LDSCTL_OFF))[u] = 0u;
    __syncthreads();
    const int lo = args.ph_lo, hi = args.ph_hi;
    XcdBarrier bar; bar.bar = (unsigned*)(ws + WS_CTL) + CW_BAR; bar.x = 0; bar.st = nullptr;
    if (hi - lo > 1) bar = xcd_barrier_post((unsigned*)(ws + WS_CTL) + CW_BAR, MISC + 8);
#define IN(k) (lo <= (k) && (k) < hi)
#define SEAM(k) do { if (IN(k) && IN((k) + 1)) { for (int repb = 0; repb < REP_BAR; ++repb) xcd_barrier(bar); } } while (0)

    if (IN(0)) { for (int rep = 0; rep < REP_P0; ++rep) { __syncthreads(); p0_prologue(args, lds, vcu, G); } }
    SEAM(0);

    float* MOD = (float*)(ws + WS_MOD);
    bf16* HB = (bf16*)(ws + WS_HB); bf16* MIX = (bf16*)(ws + WS_MIX); float* XB = (float*)(ws + WS_XB); bf16* ACT = (bf16*)(ws + WS_ACT);
    for (int l = 0; l < DEPTH; ++l) {
        const int pb = 1 + PH_PER_LAYER * l;
        const float* modl = MOD + (size_t)l * 12 * MODW;
        const float* Xp = (l == 0) ? args.in[I_XP] : XB; const float* Xs = (l == 0) ? args.in[I_XS] : XB + (size_t)MP * DM;
        if (IN(pb + 0)) { for (int rep = 0; rep < REP_N1; ++rep) { __syncthreads(); n1_phase(args, l, vcu, G, Xp, Xs, modl, HB); } }
        SEAM(pb + 0);
        if (IN(pb + 1)) {
            __syncthreads();
            pg8::Gemm g{(const pg8::bf16_t*)HB, (const pg8::bf16_t*)(ws + WS_WIN) + (size_t)l * N1 * DM, MH, N1, DM}; pg8::StaticOrder S; S.init(MH, N1, G, bx);
            pg8::EpiG1 E{(pg8::bf16_t*)(ws + WS_QB), (size_t)(WS_KB - WS_QB) / 2, (pg8::bf16_t*)(ws + WS_RKV), (float*)(ws + WS_P),
                         args.out + O_KP + (size_t)l * MP * DATT, args.out + O_KS + (size_t)l * 8 * DATT, (size_t)(O_VP - O_KP), (size_t)(O_VS - O_KS), args.in[I_QG] + l * 64, args.in[I_KG] + l * 64};
            for (int rep = 0; rep < REP_G1; ++rep) pg8::gemm_phase<pg8::EpiG1, pg8::StaticOrder, true, true>(lds, g, S, E);
            if (l + 1 < DEPTH && bx >= (MH / 256) * (N1 / 256) % G && G == 256) prep_layer_pull(args, l + 1, 0, TAIL_PULLS, lds, MISC + 16);
        }
        SEAM(pb + 1);
        if (IN(pb + 2)) { for (int rep = 0; rep < REP_PW; ++rep) { __syncthreads(); pw_phase(args, l, lds, vcu, G); } }
        SEAM(pb + 2);
        if (IN(pb + 3)) {
            __syncthreads();
            for (int rep = 0; rep < REP_SCAN; ++rep) { __syncthreads(); scan_units(args, l, lds, vcu, G); }
            sample_wkv_units(args, l, vcu, G);
            __syncthreads();
            for (int rep = 0; rep < REP_ATT; ++rep) { __syncthreads(); attn_units(args, l, lds, vcu, G); }
            __syncthreads();
            for (int rep = 0; rep < REP_SATT; ++rep) { __syncthreads(); sample_attn_units(args, l, lds, vcu, G); }
            if (l + 1 < DEPTH) { prep_layer_pull(args, l + 1, 1, 1 << 30, lds, MISC + 16); prep_layer_pull(args, l + 1, 0, 1 << 30, lds, MISC + 16); }
        }
        SEAM(pb + 3);
        if (IN(pb + 4)) { for (int rep = 0; rep < REP_MX; ++rep) mx_phase(args, l, vcu, G); }
        SEAM(pb + 4);
        if (IN(pb + 5)) {
            __syncthreads();
            sample_proj<DM>(MIX, (const bf16*)(ws + WS_WOUT) + (size_t)l * DM * DM, Xs, XB + (size_t)MP * DM, modl + 2 * DM, lds, vcu, G);
            pg8::Gemm g{(const pg8::bf16_t*)MIX, (const pg8::bf16_t*)(ws + WS_WOUT) + (size_t)l * DM * DM, MP, DM, DM}; pg8::StaticOrder S; S.init(MP, DM, G, bx);
            pg8::EpiResid E{Xp, Xs, XB, XB + (size_t)MP * DM, modl + 2 * DM};
            pg8::gemm_phase<pg8::EpiResid, pg8::StaticOrder, true, true>(lds, g, S, E);
        }
        SEAM(pb + 5);
        if (IN(pb + 6)) { for (int rep = 0; rep < REP_N2; ++rep) { __syncthreads(); n2_phase(args, l, vcu, G, XB, modl, HB); } }
        SEAM(pb + 6);
        if (IN(pb + 7)) {
            __syncthreads();
            pg8::Gemm g{(const pg8::bf16_t*)HB, (const pg8::bf16_t*)(ws + WS_WGU) + (size_t)l * 2 * FF * DM, MH, 2 * FF, DM}; pg8::StaticOrder S; S.init(MH, 2 * FF, G, bx);
            pg8::EpiSwiGLU E{(pg8::bf16_t*)ACT, FF};
            for (int rep = 0; rep < REP_G3; ++rep) pg8::gemm_phase<pg8::EpiSwiGLU, pg8::StaticOrder, true, true>(lds, g, S, E);
            if (l + 1 < DEPTH && bx >= (MH / 256) * (2 * FF / 256) % G && G == 256) prep_layer_pull(args, l + 1, 0, TAIL_PULLS, lds, MISC + 16);
        }
        SEAM(pb + 7);
        if (IN(pb + 8)) {
            __syncthreads();
            float* op = (l == DEPTH - 1) ? args.out + O_YP : XB; float* os = (l == DEPTH - 1) ? args.out + O_YS : XB + (size_t)MP * DM;
            sample_proj<FF>(ACT, (const bf16*)(ws + WS_WDN) + (size_t)l * DM * FF, XB + (size_t)MP * DM, os, modl + 5 * DM, lds, vcu, G);
            pg8::Gemm g{(const pg8::bf16_t*)ACT, (const pg8::bf16_t*)(ws + WS_WDN) + (size_t)l * DM * FF, MP, DM, FF}; pg8::StaticOrder S; S.init(MP, DM, G, bx);
            pg8::EpiResid E{XB, XB + (size_t)MP * DM, op, os, modl + 5 * DM};
            pg8::gemm_phase<pg8::EpiResid, pg8::StaticOrder, true, true>(lds, g, S, E);
        }
        SEAM(pb + 8);
    }
#undef IN
#undef SEAM
}

extern "C" void kernel_launch(void* const* d_in, const int* in_sizes, int n_in, void* d_out, int out_size, void* d_ws, size_t ws_size, hipStream_t stream) {
    static int grid = 0;
    if (grid == 0) {
        if (n_in != N_IN || (size_t)out_size != O_END || ws_size < WS_END) { fprintf(stderr, "kernel_launch: unexpected shapes: n_in %d, out %d, ws %zu (need %zu)\n", n_in, out_size, ws_size, (size_t)WS_END); grid = -1; return; }
        int dev = 0, cus = 0;
        if (hipGetDevice(&dev) != hipSuccess || hipDeviceGetAttribute(&cus, hipDeviceAttributeMultiprocessorCount, dev) != hipSuccess) { grid = -1; return; }
        if (hipFuncSetAttribute((const void*)fwd, hipFuncAttributeMaxDynamicSharedMemorySize, LDS_BYTES) != hipSuccess) { fprintf(stderr, "kernel_launch: hipFuncSetAttribute failed\n"); grid = -1; return; }
        int per_cu = 0;
        if (hipOccupancyMaxActiveBlocksPerMultiprocessor(&per_cu, (const void*)fwd, NTHR, LDS_BYTES) != hipSuccess || per_cu < 1) fprintf(stderr, "kernel_launch: occupancy query says %d blocks per CU\n", per_cu);
        (void)hipGetLastError();
        grid = cus;
    }
    if (grid < 0) return;
    if (hipMemsetAsync((char*)d_ws + WS_CTL, 0, CTL_ZERO_BYTES, stream) != hipSuccess) return;
    Args a{};
    for (int i = 0; i < N_IN; ++i) a.in[i] = (const float*)d_in[i];
    a.out = (float*)d_out; a.ws = (unsigned char*)d_ws;
#if MK_N_LAUNCHES == 1
    a.ph_lo = 0; a.ph_hi = N_PHASES;
    hipLaunchKernelGGL(fwd, dim3(grid), dim3(NTHR), LDS_BYTES, stream, a);
#else
    for (int li = 0; li < N_PHASES; ++li) { a.ph_lo = li; a.ph_hi = li + 1; hipLaunchKernelGGL(fwd, dim3(grid), dim3(NTHR), LDS_BYTES, stream, a); }
#endif
}
```

```cpp
#include <hip/hip_runtime.h>
#include <cstdio>
#include <cstdint>
#include <cmath>
namespace pg8 {
#define PG8_LAS __attribute__((address_space(3)))
typedef unsigned short bf16_t;
typedef short bf16x8 __attribute__((ext_vector_type(8)));
typedef float f32x4 __attribute__((ext_vector_type(4)));
typedef unsigned u32x4 __attribute__((ext_vector_type(4)));
constexpr int BM = 256, BK = 64, HALF = 128, HTB = HALF * BK * 2  , STAGE_BYTES = 8 * HTB, NXCD = 8, WGM = 8;

__host__ __device__ __forceinline__ int lds_byte(int r, int c) { const int st = (r >> 4) * 2 + (c >> 5), rr = r & 15, cc = c & 31, ob = rr * 64 + cc * 2; return st * 1024 + (ob ^ (((ob >> 9) & 1) << 5)); }
__host__ __device__ __forceinline__ void stage_rc(int b, int& R, int& C) { const int st = b / 1024, sb = b % 1024, swz = sb ^ (((sb >> 9) & 1) << 5); R = (st >> 1) * 16 + swz / 64; C = (st & 1) * 32 + (swz % 64) / 2; }
__host__ __device__ __forceinline__ int perm32(int rho) { const int n = rho >> 4, i = rho & 15; return 8 * (i >> 2) + 4 * n + (i & 3); }

struct Unit { int pm, pn; };
struct Gemm { const bf16_t* A; const bf16_t* Bt; int M, N, K; };

struct StaticOrder {
    int nM, nN, nwg, G, c;
    __host__ __device__ void init(int M, int N, int G_, int c_) { nM = M / BM; nN = N / BM; nwg = nM * nN; G = G_; c = c_; }
    __host__ __device__ bool next(int i, Unit& u) const {
        const long L = (long)i * G + c; if (L >= nwg) return false;
        int wgid = (int)L; { const int q = nwg / NXCD, r = nwg % NXCD, xcd = wgid % NXCD, off = wgid / NXCD; wgid = (xcd < r ? xcd * (q + 1) : r * (q + 1) + (xcd - r) * q) + off; }
        const int nig = WGM * nN, gid = wgid / nig, fm = gid * WGM, gsz = (nM - fm) < WGM ? (nM - fm) : WGM;
        u.pm = fm + ((wgid % nig) % gsz); u.pn = (wgid % nig) / gsz; return true;
    }
    __device__ __forceinline__ void a_ready(const Unit&) const {}
    __device__ __forceinline__ void done(const Unit&) const {}
};

__device__ __forceinline__ unsigned cvt_pk_bf16(float lo, float hi) { unsigned r; asm volatile("v_cvt_pk_bf16_f32 %0, %1, %2" : "=v"(r) : "v"(lo), "v"(hi)); return r; }
typedef float f32x2 __attribute__((ext_vector_type(2)));
__device__ __forceinline__ f32x2 gelu_pk(f32x2 v) {
    const f32x2 av = __builtin_elementwise_abs(v), d = av * 0.2316418882f + 1.0f;
    f32x2 t; t.x = __builtin_amdgcn_rcpf(d.x); t.y = __builtin_amdgcn_rcpf(d.y);
    f32x2 q = t * 0.5307027145f + (-0.7265760135f); q = q * t + 0.7107068705f; q = q * t + (-0.142248368f); q = q * t + 0.127414796f; q = q * t;
    const f32x2 s = (v * v) * (-0.72134752044f);
    f32x2 e; e.x = __builtin_amdgcn_exp2f(s.x); e.y = __builtin_amdgcn_exp2f(s.y);
    const f32x2 m = v * (q * e), r = v - m;
    f32x2 o; o.x = v.x < 0.f ? m.x : r.x; o.y = v.y < 0.f ? m.y : r.y; return o;
}

template <int ACT  > struct EpiBf16 {
    static constexpr bool PERM = true, AFTER_DRAIN = false; static_assert(ACT == 0 || ACT == 1, "EpiBf16: ACT is 0 (none) or 1 (gelu_pk)");
    bf16_t* O; int ldc; const float* bias; int split_cols; size_t split_stride; float scale0;
    __device__ __forceinline__ void operator()(const f32x4 (&acc)[2][2][4][2], const Unit& u, int wr, int wc, int fr, int fq) const {
        const int row0 = u.pm * BM + wr * 64 + fr; int colt = u.pn * BM; bf16_t* base = O;
        float sc = 1.f; if (split_cols) { const int t = colt / split_cols; base += (size_t)t * split_stride; colt -= t * split_cols; if (t == 0) sc = scale0; }
        const int col0 = colt + wc * 32 + 8 * fq, bcol0 = u.pn * BM + wc * 32 + 8 * fq;
        f32x4 bv[2][2];
#pragma unroll
        for (int bj = 0; bj < 2; ++bj)
#pragma unroll
            for (int n = 0; n < 2; ++n) bv[bj][n] = bias ? *(const f32x4*)(bias + bcol0 + bj * HALF + 4 * n) : (f32x4){0.f, 0.f, 0.f, 0.f};
#pragma unroll
        for (int ai = 0; ai < 2; ++ai)
#pragma unroll
            for (int m = 0; m < 4; ++m) { bf16_t* rowp = base + (size_t)(row0 + ai * HALF + m * 16) * ldc + col0;
#pragma unroll
                for (int bj = 0; bj < 2; ++bj) { f32x4 v0 = acc[ai][bj][m][0] + bv[bj][0], v1 = acc[ai][bj][m][1] + bv[bj][1];
                    if (ACT == 1) { f32x2 a = gelu_pk((f32x2){v0[0], v0[1]}), b = gelu_pk((f32x2){v0[2], v0[3]}), c = gelu_pk((f32x2){v1[0], v1[1]}), d = gelu_pk((f32x2){v1[2], v1[3]});
                        v0 = (f32x4){a.x, a.y, b.x, b.y}; v1 = (f32x4){c.x, c.y, d.x, d.y}; }
                    v0 = v0 * sc; v1 = v1 * sc; u32x4 w; w.x = cvt_pk_bf16(v0[0], v0[1]); w.y = cvt_pk_bf16(v0[2], v0[3]); w.z = cvt_pk_bf16(v1[0], v1[1]); w.w = cvt_pk_bf16(v1[2], v1[3]);
                    *(u32x4*)(rowp + bj * HALF) = w; } }
    }
};


struct EpiF32 {
    static constexpr bool PERM = false, AFTER_DRAIN = false;
    float* O; int ldc;
    __device__ __forceinline__ void operator()(const f32x4 (&acc)[2][2][4][2], const Unit& u, int wr, int wc, int fr, int fq) const {
        const int col0 = u.pn * BM + wc * 32 + 4 * fq;
#pragma unroll
        for (int ai = 0; ai < 2; ++ai)
#pragma unroll
            for (int m = 0; m < 4; ++m) { float* rowp = O + (size_t)(u.pm * BM + ai * HALF + wr * 64 + m * 16 + fr) * ldc + col0;
#pragma unroll
                for (int bj = 0; bj < 2; ++bj)
#pragma unroll
                    for (int n = 0; n < 2; ++n) *(f32x4*)(rowp + bj * HALF + n * 16) = acc[ai][bj][m][n]; }
    }
};
struct EpiResid {
    static constexpr bool PERM = false, AFTER_DRAIN = false;
    const float* base_p; const float* base_s; float* out_p; float* out_s; const float* gate;
    __device__ __forceinline__ void operator()(const f32x4 (&acc)[2][2][4][2], const Unit& u, int wr, int wc, int fr, int fq) const {
        const int col0 = u.pn * BM + wc * 32 + 4 * fq;
        if (u.pm < 32) {
            const float* g = gate + (size_t)(u.pm >> 3) * 12288 + col0;
            f32x4 gv[2][2];
#pragma unroll
            for (int bj = 0; bj < 2; ++bj)
#pragma unroll
                for (int n = 0; n < 2; ++n) gv[bj][n] = *(const f32x4*)(g + bj * HALF + n * 16);
#pragma unroll
            for (int ai = 0; ai < 2; ++ai) { f32x4 bs[4][2][2];
#pragma unroll
                for (int m = 0; m < 4; ++m) { const size_t off = (size_t)(u.pm * BM + ai * HALF + wr * 64 + m * 16 + fr) * 2048 + col0;
#pragma unroll
                    for (int bj = 0; bj < 2; ++bj)
#pragma unroll
                        for (int n = 0; n < 2; ++n) bs[m][bj][n] = *(const f32x4*)(base_p + off + bj * HALF + n * 16); }
#pragma unroll
                for (int m = 0; m < 4; ++m) { const size_t off = (size_t)(u.pm * BM + ai * HALF + wr * 64 + m * 16 + fr) * 2048 + col0;
#pragma unroll
                    for (int bj = 0; bj < 2; ++bj)
#pragma unroll
                        for (int n = 0; n < 2; ++n) *(f32x4*)(out_p + off + bj * HALF + n * 16) = bs[m][bj][n] + gv[bj][n] * acc[ai][bj][m][n]; } }
        } else if (wr == 0 && fr < 8) {
            const float* g = gate + (size_t)(4 + fr) * 12288 + col0; const size_t off = (size_t)fr * 2048 + col0;
#pragma unroll
            for (int bj = 0; bj < 2; ++bj)
#pragma unroll
                for (int n = 0; n < 2; ++n) { const f32x4 gv = *(const f32x4*)(g + bj * HALF + n * 16); const f32x4 bs = *(const f32x4*)(base_s + off + bj * HALF + n * 16);
                    *(f32x4*)(out_s + off + bj * HALF + n * 16) = bs + gv * acc[0][bj][0][n]; }
        }
    }
};
struct EpiSwiGLU {
    static constexpr bool PERM = true, AFTER_DRAIN = false;
    bf16_t* O; int ldc;
    __device__ __forceinline__ void operator()(const f32x4 (&acc)[2][2][4][2], const Unit& u, int wr, int wc, int fr, int fq) const {
        const int row0 = u.pm * BM + wr * 64 + fr, col0 = u.pn * HALF + wc * 32 + 8 * fq;
#pragma unroll
        for (int ai = 0; ai < 2; ++ai)
#pragma unroll
            for (int m = 0; m < 4; ++m) { bf16_t* rowp = O + (size_t)(row0 + ai * HALF + m * 16) * ldc + col0;
                float v[8];
#pragma unroll
                for (int n = 0; n < 2; ++n)
#pragma unroll
                    for (int e = 0; e < 4; ++e) { const float g = acc[ai][0][m][n][e], up = acc[ai][1][m][n][e]; v[4 * n + e] = g * __builtin_amdgcn_rcpf(1.0f + __expf(-g)) * up; }
                u32x4 w; w.x = cvt_pk_bf16(v[0], v[1]); w.y = cvt_pk_bf16(v[2], v[3]); w.z = cvt_pk_bf16(v[4], v[5]); w.w = cvt_pk_bf16(v[6], v[7]);
                *(u32x4*)rowp = w; }
    }
};
struct EpiG1 {
    static constexpr bool PERM = true, AFTER_DRAIN = false;
    bf16_t* QB; size_t qkv_stride; bf16_t* RKV; float* P; float *okp, *oks; size_t kv_stride_p, kv_stride_s; const float *qg, *kg;
    __device__ __forceinline__ void operator()(const f32x4 (&acc)[2][2][4][2], const Unit& u, int wr, int wc, int fr, int fq) const {
        const int row0 = u.pm * BM + wr * 64 + fr;
        if (u.pn >= 24) {
            const int col0 = (u.pn - 24) * BM + wc * 32 + 8 * fq;
#pragma unroll
            for (int ai = 0; ai < 2; ++ai)
#pragma unroll
                for (int m = 0; m < 4; ++m) { float* rp = P + (size_t)(row0 + ai * HALF + m * 16) * 768 + col0;
#pragma unroll
                    for (int bj = 0; bj < 2; ++bj) { *(f32x4*)(rp + bj * HALF) = acc[ai][bj][m][0]; *(f32x4*)(rp + bj * HALF + 4) = acc[ai][bj][m][1]; } }
            return;
        }
        const int reg = u.pn >> 2, cb = (4 * (u.pn & 3) + wc) * 64 + 8 * fq;
        if (reg >= 3) {
            const int col0 = (reg - 3) * 1024 + cb;
#pragma unroll
            for (int ai = 0; ai < 2; ++ai)
#pragma unroll
                for (int m = 0; m < 4; ++m) { bf16_t* rp = RKV + (size_t)(row0 + ai * HALF + m * 16) * 3072 + col0;
#pragma unroll
                    for (int bj = 0; bj < 2; ++bj) { u32x4 w; w.x = cvt_pk_bf16(acc[ai][bj][m][0][0], acc[ai][bj][m][0][1]); w.y = cvt_pk_bf16(acc[ai][bj][m][0][2], acc[ai][bj][m][0][3]); w.z = cvt_pk_bf16(acc[ai][bj][m][1][0], acc[ai][bj][m][1][1]); w.w = cvt_pk_bf16(acc[ai][bj][m][1][2], acc[ai][bj][m][1][3]);
                        *(u32x4*)(rp + 32 * bj) = w; } }
            return;
        }
        f32x4 gn[2][2];
#pragma unroll
        for (int bj = 0; bj < 2; ++bj)
#pragma unroll
            for (int n = 0; n < 2; ++n) { const f32x4 a = *(const f32x4*)(qg + 8 * fq + 32 * bj + 4 * n), b = *(const f32x4*)(kg + 8 * fq + 32 * bj + 4 * n); gn[bj][n] = (reg == 0) ? a : b; }
        bf16_t* dstb = QB + (size_t)reg * qkv_stride;
#pragma unroll
        for (int ai = 0; ai < 2; ++ai)
#pragma unroll
            for (int m = 0; m < 4; ++m) { const int row = row0 + ai * HALF + m * 16;
                f32x4 v[2][2];
#pragma unroll
                for (int bj = 0; bj < 2; ++bj)
#pragma unroll
                    for (int n = 0; n < 2; ++n) v[bj][n] = acc[ai][bj][m][n];
                if (reg < 2) { float ss = 0.f;
#pragma unroll
                    for (int bj = 0; bj < 2; ++bj)
#pragma unroll
                        for (int n = 0; n < 2; ++n) ss += (v[bj][n][0] * v[bj][n][0] + v[bj][n][1] * v[bj][n][1]) + (v[bj][n][2] * v[bj][n][2] + v[bj][n][3] * v[bj][n][3]);
                    ss += __shfl_xor(ss, 16); ss += __shfl_xor(ss, 32);
                    const float rs = 1.0f / sqrtf(ss * (1.0f / 64.0f) + 1e-6f);
#pragma unroll
                    for (int bj = 0; bj < 2; ++bj)
#pragma unroll
                        for (int n = 0; n < 2; ++n) v[bj][n] = v[bj][n] * rs * gn[bj][n]; }
                bf16_t* db = dstb + (size_t)row * 1024 + cb;
#pragma unroll
                for (int bj = 0; bj < 2; ++bj) { u32x4 w; w.x = cvt_pk_bf16(v[bj][0][0], v[bj][0][1]); w.y = cvt_pk_bf16(v[bj][0][2], v[bj][0][3]); w.z = cvt_pk_bf16(v[bj][1][0], v[bj][1][1]); w.w = cvt_pk_bf16(v[bj][1][2], v[bj][1][3]);
                    *(u32x4*)(db + 32 * bj) = w; }
                if (reg >= 1) { float* op = nullptr;
                    if (u.pm < 32) op = okp + (size_t)(reg - 1) * kv_stride_p + (size_t)row * 1024 + cb; else if (row - 32 * BM < 8) op = oks + (size_t)(reg - 1) * kv_stride_s + (size_t)(row - 32 * BM) * 1024 + cb;
                    if (op) {
#pragma unroll
                        for (int bj = 0; bj < 2; ++bj) { *(f32x4*)(op + 32 * bj) = v[bj][0]; *(f32x4*)(op + 32 * bj + 4) = v[bj][1]; } } }
            }
    }
};
template <class Epi, class Sched, bool ALIGN_EPI = false, bool SP2 = false>
__device__ __forceinline__ void gemm_phase(PG8_LAS unsigned char* lds, const Gemm g, const Sched& S, const Epi& E) {
    int tid_ = threadIdx.x; asm volatile("" : "+v"(tid_));
    const int tid = tid_, wid = __builtin_amdgcn_readfirstlane(tid >> 6), lane = tid & 63, wr = wid >> 2, wc = wid & 3, fr = lane & 15, fq = lane >> 4;
    const int K = g.K, nt = K / BK;
    unsigned voffA[2], voffB[2];
#pragma unroll
    for (int i = 0; i < 2; ++i) { int R, C; stage_rc(tid * 16 + i * 8192, R, C); const int Rb = Epi::PERM ? ((R & ~31) + perm32(R & 31)) : R;
        voffA[i] = (unsigned)(R * K + C) * 2u; voffB[i] = (unsigned)(Rb * K + C) * 2u; }
    const size_t kstep = (size_t)(BK * 2);
    const size_t hstep = (size_t)HALF * K * 2;
    const size_t tstep = 2 * hstep;
    const unsigned ldsw = (unsigned)wid * 1024u;
    const int aoff = lds_byte(wr * 64 + fr, fq * 8), boff = lds_byte(wc * 32 + fr, fq * 8);
#define PG8_SA(b, h) (((b) * 2 + (h)) * HTB)
#define PG8_SB(b, h) ((4 + (b) * 2 + (h)) * HTB)
#define PG8_STAGE(bufoff, gbase, voff) do { _Pragma("unroll") for (int _i = 0; _i < 2; ++_i) \
        __builtin_amdgcn_global_load_lds((const unsigned*)((const char*)(gbase) + (voff)[_i]), (PG8_LAS unsigned*)(lds + (bufoff) + ldsw + _i * 8192), 16, 0, 0); } while (0)
#define PG8_LDA(dst, b, h) do { _Pragma("unroll") for (int m = 0; m < 4; ++m) _Pragma("unroll") for (int k = 0; k < 2; ++k) dst[m][k] = *(const PG8_LAS bf16x8*)(lds + PG8_SA(b, h) + aoff + m * 2048 + k * 1024); } while (0)
#define PG8_LDB(dst, b, h) do { _Pragma("unroll") for (int n = 0; n < 2; ++n) _Pragma("unroll") for (int k = 0; k < 2; ++k) dst[n][k] = *(const PG8_LAS bf16x8*)(lds + PG8_SB(b, h) + boff + n * 2048 + k * 1024); } while (0)
#define PG8_MMA(ai, bj, At, Bt) do { __builtin_amdgcn_s_setprio(1); _Pragma("unroll") for (int m = 0; m < 4; ++m) _Pragma("unroll") for (int n = 0; n < 2; ++n) _Pragma("unroll") for (int k = 0; k < 2; ++k) \
        acc[ai][bj][m][n] = __builtin_amdgcn_mfma_f32_16x16x32_bf16(Bt[n][k], At[m][k], acc[ai][bj][m][n], 0, 0, 0); __builtin_amdgcn_s_setprio(0); } while (0)
#define PG8_WAIT_V(n) asm volatile("s_waitcnt vmcnt(" #n ")" ::: "memory")
#define PG8_WAIT_L(n) asm volatile("s_waitcnt lgkmcnt(" #n ")" ::: "memory")
#define PG8_BAR __builtin_amdgcn_s_barrier()
#define PG8_SCHED __builtin_amdgcn_sched_barrier(0)
    Unit cur, nxt; int ui = 0;
    if (!S.next(0, cur)) return;
    f32x4 acc[2][2][4][2];
#pragma unroll
    for (int a = 0; a < 2; ++a)
#pragma unroll
        for (int b = 0; b < 2; ++b)
#pragma unroll
            for (int m = 0; m < 4; ++m)
#pragma unroll
                for (int n = 0; n < 2; ++n) acc[a][b][m][n] = (f32x4){0.f, 0.f, 0.f, 0.f};
    bf16x8 At[4][2], B0[2][2], B1[2][2];
    const char* cA = (const char*)g.A + (size_t)cur.pm * tstep; const char* cB = (const char*)g.Bt + (size_t)cur.pn * tstep;
    S.a_ready(cur);
    if constexpr (SP2) {
        PG8_STAGE(PG8_SB(0, 0), cB, voffB); PG8_STAGE(PG8_SB(0, 1), cB + hstep, voffB); PG8_STAGE(PG8_SA(0, 0), cA, voffA); PG8_STAGE(PG8_SA(0, 1), cA + hstep, voffA);
        if (wr == 1) PG8_BAR;
        PG8_WAIT_V(2); PG8_BAR;
        PG8_STAGE(PG8_SB(1, 0), cB + kstep, voffB); PG8_STAGE(PG8_SA(1, 0), cA + kstep, voffA); PG8_STAGE(PG8_SB(1, 1), cB + hstep + kstep, voffB);
        PG8_WAIT_V(6); PG8_BAR;
    } else {
        PG8_STAGE(PG8_SB(0, 0), cB, voffB); PG8_STAGE(PG8_SA(0, 0), cA, voffA); PG8_STAGE(PG8_SB(0, 1), cB + hstep, voffB); PG8_STAGE(PG8_SA(0, 1), cA + hstep, voffA);
        if (wr == 1) PG8_BAR;
        PG8_WAIT_V(4); PG8_BAR;
        PG8_STAGE(PG8_SB(1, 0), cB + kstep, voffB); PG8_STAGE(PG8_SA(1, 0), cA + kstep, voffA); PG8_STAGE(PG8_SB(1, 1), cB + hstep + kstep, voffB);
        PG8_WAIT_V(6); PG8_BAR;
    }
    for (;;) {
        const bool has_next = S.next(ui + 1, nxt);
        const char* nA = has_next ? (const char*)g.A + (size_t)nxt.pm * tstep : cA; const char* nB = has_next ? (const char*)g.Bt + (size_t)nxt.pn * tstep : cB;
        for (int t = 0; t < nt; t += 2) {
            const bool last = (t == nt - 2);
            const char* a1 = cA + (size_t)(t + 1) * kstep;
            const char* a2 = last ? nA : cA + (size_t)(t + 2) * kstep; const char* b2 = last ? nB : cB + (size_t)(t + 2) * kstep;
            const char* a3 = a2 + kstep; const char* b3 = b2 + kstep;
            if (last && has_next) S.a_ready(nxt);
            if constexpr (SP2) {
            PG8_LDB(B0, 0, 0); PG8_LDB(B1, 0, 1); PG8_SCHED; PG8_LDA(At, 0, 0); PG8_STAGE(PG8_SA(1, 1), a1 + hstep, voffA);
            PG8_WAIT_V(8); PG8_WAIT_L(0); PG8_BAR; PG8_MMA(0, 0, At, B0); PG8_MMA(0, 1, At, B1); PG8_BAR; PG8_SCHED;
            PG8_LDA(At, 0, 1); PG8_STAGE(PG8_SB(0, 0), b2, voffB); PG8_STAGE(PG8_SB(0, 1), b2 + hstep, voffB); PG8_STAGE(PG8_SA(0, 0), a2, voffA);
            PG8_WAIT_V(8); PG8_WAIT_L(0); PG8_BAR; PG8_MMA(1, 0, At, B0); PG8_MMA(1, 1, At, B1); PG8_BAR; PG8_SCHED;
            PG8_LDB(B0, 1, 0); PG8_LDB(B1, 1, 1); PG8_SCHED; PG8_LDA(At, 1, 0); PG8_STAGE(PG8_SA(0, 1), a2 + hstep, voffA);
            PG8_WAIT_V(8); PG8_WAIT_L(0); PG8_BAR; PG8_MMA(0, 0, At, B0); PG8_MMA(0, 1, At, B1); PG8_BAR; PG8_SCHED;
            PG8_LDA(At, 1, 1); PG8_STAGE(PG8_SB(1, 0), b3, voffB); PG8_STAGE(PG8_SB(1, 1), b3 + hstep, voffB); PG8_STAGE(PG8_SA(1, 0), a3, voffA);
            PG8_WAIT_V(8); PG8_WAIT_L(0); PG8_BAR; PG8_MMA(1, 0, At, B0); PG8_MMA(1, 1, At, B1); PG8_BAR; PG8_SCHED;
            } else {
            PG8_LDB(B0, 0, 0); PG8_SCHED; PG8_LDA(At, 0, 0); PG8_STAGE(PG8_SA(1, 1), a1 + hstep, voffA);
            PG8_WAIT_L(8); PG8_BAR; PG8_WAIT_L(0); PG8_MMA(0, 0, At, B0); PG8_BAR; PG8_SCHED;
            PG8_LDB(B1, 0, 1); PG8_STAGE(PG8_SB(0, 0), b2, voffB);
            PG8_BAR; PG8_WAIT_L(0); PG8_MMA(0, 1, At, B1); PG8_BAR;
            PG8_LDA(At, 0, 1); PG8_STAGE(PG8_SA(0, 0), a2, voffA);
            PG8_BAR; PG8_WAIT_L(0); PG8_MMA(1, 0, At, B0); PG8_BAR; PG8_SCHED;
            PG8_STAGE(PG8_SB(0, 1), b2 + hstep, voffB);
            PG8_WAIT_V(6); PG8_BAR; PG8_MMA(1, 1, At, B1); PG8_BAR;
            PG8_LDB(B0, 1, 0); PG8_SCHED; PG8_LDA(At, 1, 0); PG8_STAGE(PG8_SA(0, 1), a2 + hstep, voffA);
            PG8_WAIT_L(8); PG8_BAR; PG8_WAIT_L(0); PG8_MMA(0, 0, At, B0); PG8_BAR; PG8_SCHED;
            PG8_LDB(B1, 1, 1); PG8_STAGE(PG8_SB(1, 0), b3, voffB);
            PG8_BAR; PG8_WAIT_L(0); PG8_MMA(0, 1, At, B1); PG8_BAR;
            PG8_LDA(At, 1, 1); PG8_STAGE(PG8_SA(1, 0), a3, voffA);
            PG8_BAR; PG8_WAIT_L(0); PG8_MMA(1, 0, At, B0); PG8_BAR; PG8_SCHED;
            PG8_STAGE(PG8_SB(1, 1), b3 + hstep, voffB);
            PG8_WAIT_V(6); PG8_BAR; PG8_MMA(1, 1, At, B1); PG8_BAR;
            }
        }
        if constexpr (ALIGN_EPI) { if (wr == 0) PG8_BAR; }
        if constexpr (!Epi::AFTER_DRAIN) { E(acc, cur, wr, wc, fr, fq); S.done(cur); }
        if (!has_next) break;
#pragma unroll
        for (int a = 0; a < 2; ++a)
#pragma unroll
            for (int b = 0; b < 2; ++b)
#pragma unroll
                for (int m = 0; m < 4; ++m)
#pragma unroll
                    for (int n = 0; n < 2; ++n) acc[a][b][m][n] = (f32x4){0.f, 0.f, 0.f, 0.f};
        cur = nxt; cA = nA; cB = nB; ++ui;
        if constexpr (ALIGN_EPI) { if (wr == 1) PG8_BAR; }
    }
    PG8_WAIT_V(0);
    if constexpr (!ALIGN_EPI) { if (wr == 0) PG8_BAR; }
    PG8_BAR;
    if constexpr (Epi::AFTER_DRAIN) { E.fused(acc, cur, wr, wc, fr, fq, lds, wid, lane); S.done(cur); }
#undef PG8_SA
#undef PG8_SB
#undef PG8_STAGE
#undef PG8_LDA
#undef PG8_LDB
#undef PG8_MMA
#undef PG8_WAIT_V
#undef PG8_WAIT_L
#undef PG8_BAR
#undef PG8_SCHED
}
}
#define GAS __attribute__((address_space(1)))
#define LAS __attribute__((address_space(3)))
typedef unsigned short bf16;
typedef unsigned v4u __attribute__((ext_vector_type(4)));
typedef float f32x4 __attribute__((ext_vector_type(4)));
typedef short bf16x8 __attribute__((ext_vector_type(8)));
typedef GAS unsigned gu32;
typedef GAS unsigned long long gu64;
#define RLX_AGENT __ATOMIC_RELAXED, __HIP_MEMORY_SCOPE_AGENT
#define LDS_WAIT() asm volatile("s_waitcnt lgkmcnt(0)" ::: "memory")
#define VM_WAIT() asm volatile("s_waitcnt vmcnt(0)" ::: "memory")
__device__ __forceinline__ unsigned long long rt() { return __builtin_amdgcn_s_memrealtime(); }
__device__ __forceinline__ unsigned f2bf(float f) { unsigned u = __builtin_bit_cast(unsigned, f); return (u + 0x7fffu + ((u >> 16) & 1u)) >> 16; }
__device__ __forceinline__ unsigned pk2(float lo, float hi) { return f2bf(lo) | (f2bf(hi) << 16); }
#define XB_TMO      128
#define XB_XCNT(j)  (256  + 64 * (j))
#define XB_XSUB(j)  (1280 + 64 * (j))
#define XB_XGEN(j)  (2304 + 64 * (j))
#define XB_TOP      3328
#define XB_TOPGEN   3392
#define XCD_BAR_WORDS 3456
#define XB_SPIN_CAP (1u << 18)

__device__ __forceinline__ unsigned xb_ld(unsigned* p)              { return __hip_atomic_load(p, __ATOMIC_RELAXED, __HIP_MEMORY_SCOPE_AGENT); }
__device__ __forceinline__ unsigned xb_add(unsigned* p, unsigned v) { return __hip_atomic_fetch_add(p, v, __ATOMIC_RELAXED, __HIP_MEMORY_SCOPE_AGENT); }
__device__ __forceinline__ unsigned xb_xcc_id() { return (unsigned)__builtin_amdgcn_s_getreg((3 << 11) | 20) & 0xFu; }
#define XB_SPIN(cond, bar) do { unsigned _sp = 0; while (cond) { __builtin_amdgcn_s_sleep(1); \
    if ((++_sp & 255u) == 0u) { if (xb_ld(&(bar)[XB_TMO])) break; if (_sp > XB_SPIN_CAP) { atomicAdd(&(bar)[XB_TMO], 1u); break; } } } } while (0)

struct XcdBarrier {
    unsigned* bar; unsigned x;
    volatile LAS unsigned* st;
};

__device__ __forceinline__ XcdBarrier xcd_barrier_post(unsigned* bar, volatile LAS unsigned* st) {
    XcdBarrier b; b.bar = bar; b.x = xb_xcc_id(); b.st = st;
    if (threadIdx.x == 0) (void)xb_add(&bar[XB_XCNT(b.x)], 1u);
    return b;
}
__device__ __forceinline__ void xcd_barrier_complete(unsigned* bar, unsigned x, unsigned& nloc, unsigned& nx) {
    const unsigned G = gridDim.x * gridDim.y * gridDim.z;
    unsigned sum, cnt, mine, sp = 0u;
    for (;;) {
        sum = 0u; cnt = 0u; mine = 0u;
#pragma unroll
        for (unsigned j = 0; j < 16; ++j) { const unsigned c = xb_ld(&bar[XB_XCNT(j)]); sum += c; cnt += (c > 0u) ? 1u : 0u; mine = (j == x) ? c : mine; }
        if (sum == G) break;
        __builtin_amdgcn_s_sleep(1);
        if ((++sp & 255u) == 0u) { if (xb_ld(&bar[XB_TMO])) break; if (sp > XB_SPIN_CAP) { atomicAdd(&bar[XB_TMO], 1u); break; } }
    }
    nloc = mine > 0u ? mine : 1u; nx = cnt > 0u ? cnt : 1u;
}

__device__ __forceinline__ void xcd_barrier(const XcdBarrier& b) {
    asm volatile("s_waitcnt vmcnt(0)" ::: "memory");
    __syncthreads();
    if (threadIdx.x == 0) {
        unsigned* bar = b.bar;
        __builtin_amdgcn_s_waitcnt(0);
        unsigned nloc = b.st[0], nx = b.st[1];
        if (nloc == 0u) { xcd_barrier_complete(bar, b.x, nloc, nx); b.st[0] = nloc; b.st[1] = nx; }
        const unsigned old = xb_add(&bar[XB_XSUB(b.x)], 1u);
        const unsigned gen = old / nloc;
        if (old + 1u == (gen + 1u) * nloc) {
            __builtin_amdgcn_fence(__ATOMIC_RELEASE, "agent");
            asm volatile("s_waitcnt vmcnt(0)" ::: "memory");
            const unsigned og = xb_add(&bar[XB_TOP], 1u);
            const unsigned tg = og / nx;
            if (og + 1u == (tg + 1u) * nx) xb_add(&bar[XB_TOPGEN], 1u);
            else XB_SPIN(xb_ld(&bar[XB_TOPGEN]) == tg, bar);
            __builtin_amdgcn_fence(__ATOMIC_ACQUIRE, "agent");
            xb_add(&bar[XB_XGEN(b.x)], 1u);
            asm volatile("s_waitcnt vmcnt(0)" ::: "memory");
        } else {
            XB_SPIN(xb_ld(&bar[XB_XGEN(b.x)]) == gen, bar);
            __builtin_amdgcn_fence(__ATOMIC_ACQUIRE, "agent");
            asm volatile("s_waitcnt vmcnt(0)" ::: "memory");
        }
    }
    __syncthreads();
}

#ifndef MK_N_LAUNCHES
#define MK_N_LAUNCHES 1
#endif
#ifndef REP_P0
#define REP_P0 1
#endif
#ifndef REP_N1
#define REP_N1 1
#endif
#ifndef REP_PW
#define REP_PW 1
#endif
#ifndef REP_SCAN
#define REP_SCAN 1
#endif
#ifndef REP_ATT
#define REP_ATT 1
#endif
#ifndef REP_SATT
#define REP_SATT 1
#endif
#ifndef REP_MX
#define REP_MX 1
#endif
#ifndef REP_N2
#define REP_N2 1
#endif
#ifndef REP_G3
#define REP_G3 1
#endif
#ifndef REP_G2
#define REP_G2 1
#endif
#ifndef REP_G4
#define REP_G4 1
#endif
#ifndef REP_BAR
#define REP_BAR 1
#endif
#ifndef REP_G1
#define REP_G1 1
#endif
#ifndef REP_PWL
#define REP_PWL 1
#endif
#ifndef REP_PWM
#define REP_PWM 1
#endif
#ifndef REP_PWR
#define REP_PWR 1
#endif
constexpr int NWAVES = 8, NTHR = 512;
constexpr int DM = 2048, SEQ = 2048, PBATCH = 4, SBATCH = 8, DEPTH = 4, NHEADS = 16, HD = 64, DATT = 1024, DRW = 1024, FF = 5632;
constexpr int MP = PBATCH * SEQ;
constexpr int ROW_S = MP;
constexpr int ROW_SS = MP + 8;
constexpr int NROWS = MP + 8;
constexpr int MH = MP + 256;
constexpr int N1 = 6912;
constexpr int PC0 = 6144, PP0 = 6144 + 384;
constexpr int NLORA = 320;
constexpr int MODW = 6 * DM;
constexpr float RMS_EPS = 1e-6f, GN_EPS = 64e-5f, ATT_SCALE = 0.125f;

enum { I_XP = 0, I_XS, I_CP, I_CS, I_CK, I_CV, I_SWKV, I_SSH, I_RELB, I_ADAW, I_ADAB, I_N1G, I_N2G, I_WIN, I_QG, I_KG, I_MUWAG, I_MURKV,
       I_DW0, I_DW1, I_DW2, I_AA0, I_AW1, I_AW2, I_GW1, I_GW2, I_VMU, I_VV0, I_VW1, I_VW2, I_KK, I_KA, I_RK, I_LNG, I_LNB, I_WOUT, I_WGU, I_WDN, N_IN };
constexpr size_t O_YP = 0, O_YS = O_YP + (size_t)MP * DM, O_KP = O_YS + 8 * DM, O_VP = O_KP + (size_t)DEPTH * MP * DATT, O_WP = O_VP + (size_t)DEPTH * MP * DATT,
                 O_SP = O_WP + (size_t)DEPTH * PBATCH * 16 * 4096, O_KS = O_SP + (size_t)DEPTH * PBATCH * DM, O_VS = O_KS + (size_t)DEPTH * 8 * DATT, O_WS = O_VS + (size_t)DEPTH * 8 * DATT,
                 O_SS = O_WS + (size_t)DEPTH * 8 * 16 * 4096, O_END = O_SS + (size_t)DEPTH * 8 * DM;
static_assert(O_END == 87212032, "output size");

constexpr size_t MiB = 1u << 20;
constexpr size_t WS_CTL = 0, CTL_ZERO_BYTES = 1 * MiB;
constexpr size_t WS_MOD = 1 * MiB;
constexpr size_t WS_BT = 4 * MiB;
constexpr size_t WS_WIN = 8 * MiB;
constexpr size_t WS_WOUT = 116 * MiB;
constexpr size_t WS_WGU = 148 * MiB;
constexpr size_t WS_WDN = 324 * MiB;
constexpr size_t WS_HB = 412 * MiB;
constexpr size_t WS_W2T = 5 * MiB;
constexpr size_t WS_RKV = 446 * MiB;
constexpr size_t WS_P = 546 * MiB;
constexpr size_t WS_QB = 670 * MiB, WS_KB = 687 * MiB, WS_VB = 704 * MiB;
constexpr size_t WS_R = 722 * MiB, WS_W = 755 * MiB, WS_K = 788 * MiB, WS_V = 821 * MiB, WS_A = 854 * MiB, WS_B = 887 * MiB, WS_G = 920 * MiB, WS_VF = 953 * MiB;
constexpr size_t WS_Y = 986 * MiB;
constexpr size_t WS_OBR = 1019 * MiB;
constexpr size_t WS_LSE = 1067 * MiB;
constexpr size_t WS_MIX = 1069 * MiB;
constexpr size_t WS_XB = 1102 * MiB;
constexpr size_t WS_ACT = 1168 * MiB;
constexpr size_t WS_END = 1260 * MiB;
static_assert(WS_WIN + (size_t)DEPTH * N1 * DM * 2 <= WS_WOUT && WS_WGU + (size_t)DEPTH * 2 * FF * DM * 2 <= WS_WDN && WS_WDN + (size_t)DEPTH * DM * FF * 2 <= WS_HB, "ws map (weights)");
static_assert(WS_VB - WS_KB == WS_KB - WS_QB, "q | k | v bf16 buffers are equally spaced");
static_assert(WS_HB + (size_t)MH * DM * 2 <= WS_RKV && WS_RKV + (size_t)MH * 3072 * 4 <= WS_P && WS_P + (size_t)MH * 768 * 4 <= WS_QB && WS_W2T + (size_t)DEPTH * 1024 * 320 * 2 <= WS_WIN && WS_QB + (size_t)MH * DATT * 2 <= WS_KB && WS_VB + (size_t)MH * DATT * 2 <= WS_R, "ws map (act 1)");
static_assert(WS_R + (size_t)NROWS * DRW * 4 <= WS_W && WS_Y + (size_t)NROWS * DRW * 4 <= WS_OBR && WS_OBR + (size_t)3 * MP * DATT * 2 <= WS_LSE && WS_LSE + (size_t)3 * MP * 16 * 4 <= WS_MIX, "ws map (act 2)");
static_assert(WS_MIX + (size_t)MH * DM * 2 <= WS_XB && WS_XB + (size_t)MH * DM * 4 <= WS_ACT && WS_ACT + (size_t)MH * FF * 2 <= WS_END, "ws map (act 3)");
constexpr int CW_BAR = 4096;

constexpr int RING_BYTES = 131072;
constexpr int LDSCTL_OFF = RING_BYTES, MISC_OFF = LDSCTL_OFF + 320;
constexpr int LDS_BYTES = 147456;

constexpr int PH_PER_LAYER = 9, N_PHASES = 1 + DEPTH * PH_PER_LAYER;

struct Args { const float* in[N_IN]; float* out; unsigned char* ws; int ph_lo, ph_hi; };
static_assert(sizeof(Args) == N_IN * 8 + 24, "Args has no padding");

__device__ __forceinline__ float wave_sum(float v) {
#pragma unroll
    for (int o = 1; o < 64; o <<= 1) v += __shfl_xor(v, o);
    return v;
}
__device__ __forceinline__ float wave_max(float v) {
#pragma unroll
    for (int o = 1; o < 64; o <<= 1) v = fmaxf(v, __shfl_xor(v, o));
    return v;
}
template <int CTRL> __device__ __forceinline__ float dpp_mov(float v) { return __builtin_bit_cast(float, __builtin_amdgcn_update_dpp(0, __builtin_bit_cast(int, v), CTRL, 0xf, 0xf, false)); }
__device__ __forceinline__ float row16_sum(float v) {
    v += dpp_mov<0xB1>(v);
    v += dpp_mov<0x4E>(v);
    v += dpp_mov<0x141>(v);
    v += dpp_mov<0x140>(v);
    return v;
}
__device__ __forceinline__ float bf2f(unsigned short b) { return __builtin_bit_cast(float, (unsigned)b << 16); }
__device__ __forceinline__ f32x4 ld4bf(const bf16* p) { const unsigned long long w = *(const unsigned long long*)p; return (f32x4){__builtin_bit_cast(float, (unsigned)w << 16), __builtin_bit_cast(float, (unsigned)w & 0xffff0000u), __builtin_bit_cast(float, (unsigned)(w >> 32) << 16), __builtin_bit_cast(float, (unsigned)(w >> 32) & 0xffff0000u)}; }
__device__ __forceinline__ f32x4 up4bf(unsigned long long w) { return (f32x4){__builtin_bit_cast(float, (unsigned)w << 16), __builtin_bit_cast(float, (unsigned)w & 0xffff0000u), __builtin_bit_cast(float, (unsigned)(w >> 32) << 16), __builtin_bit_cast(float, (unsigned)(w >> 32) & 0xffff0000u)}; }
__device__ __forceinline__ void st4bf(bf16* p, f32x4 v) { *(unsigned long long*)p = (unsigned long long)pk2(v[0], v[1]) | ((unsigned long long)pk2(v[2], v[3]) << 32); }
__device__ __forceinline__ float sigmoidf_(float x) { return 1.0f / (1.0f + __expf(-x)); }

__device__ __forceinline__ void p0_transpose_item(const float* W, int N, int k0, int n0, bf16* WT, int ldt, int drow0, const float* mu, int smode, LAS float* scr, int lane, int kdst = -1, int krows = 64) {
    if (kdst < 0) kdst = k0;
    float vals[32];
#pragma unroll
    for (int i = 0; i < 32; ++i) { const int kk = 2 * i + (lane >> 5); vals[i] = W[(size_t)(k0 + ((kk < krows) ? kk : krows - 1)) * N + n0 + (lane & 31)]; }
    if (smode) {
#pragma unroll
        for (int i = 0; i < 32; ++i) { const int kk = 2 * i + (lane >> 5); const float mm = mu[k0 + ((kk < krows) ? kk : krows - 1)]; vals[i] *= (smode == 1) ? (1.0f - mm) : mm; } }
#pragma unroll
    for (int i = 0; i < 32; ++i) { const int kk = 2 * i + (lane >> 5); scr[kk * 33 + (lane & 31)] = (kk < krows) ? vals[i] : 0.f; }
    LDS_WAIT(); asm volatile("" ::: "memory");
    const int c = lane & 7;
    if (8 * c < krows) {
#pragma unroll
        for (int j = 0; j < 4; ++j) { const int n = (lane >> 3) + 8 * j; const LAS float* s = scr + (8 * c) * 33 + n;
            v4u o; o.x = pk2(s[0 * 33], s[1 * 33]); o.y = pk2(s[2 * 33], s[3 * 33]); o.z = pk2(s[4 * 33], s[5 * 33]); o.w = pk2(s[6 * 33], s[7 * 33]);
            *(GAS v4u*)(WT + (size_t)(drow0 + n) * ldt + kdst + 8 * c) = o; }
    }
    LDS_WAIT(); asm volatile("" ::: "memory");
}
__device__ __forceinline__ int rel_bucket(int d) {
    if (d < 16) return d;
    const int large = 16 + (int)(logf((float)d / 16.0f) / logf(128.0f) * 16.0f);
    return large < 31 ? large : 31;
}
constexpr int I_IN = (DM / 64) * (6144 / 32), I_LD = (DM / 64) * 2, I_LG = (DM / 64) * 5, I_LV = (DM / 64) * 1, I_OUT = (DM / 64) * (DM / 32), I_GU = (DM / 64) * (2 * FF / 32), I_DN = (FF / 64) * (DM / 32);
constexpr int I_W2 = 32 * 6;
constexpr int I_LAYER = I_IN + 2 * (2 * I_LD + I_LG + I_LV) + I_W2 + I_OUT + I_GU + I_DN;
constexpr int CONV_BATCH = 32, N_CONV_BATCHES = (I_LAYER + CONV_BATCH - 1) / CONV_BATCH, N_MOD_ITEMS = MODW / 256, N_PREP_ITEMS = N_MOD_ITEMS + N_CONV_BATCHES;
constexpr int TAIL_PULLS = 3;
constexpr int CW_Q = 8192;
__device__ __forceinline__ void mod_block_item(const Args& args, int l, int c0, LAS unsigned char* lds, int tid, int lane, int wave) {
    unsigned char* ws = args.ws; float* MOD = (float*)(ws + WS_MOD);
        LAS float* sl = (LAS float*)lds;
        __syncthreads();
        for (int i = tid; i < 12 * DM; i += NTHR) { const int bb = i / DM, k = i % DM; const float c = (bb < 4) ? args.in[I_CP][bb * DM + k] : args.in[I_CS][(bb - 4) * DM + k];
            sl[k * 12 + bb] = c / (1.0f + __expf(-c)); }
        __syncthreads();
        const float* Wl = args.in[I_ADAW] + (size_t)l * DM * MODW + c0 + 4 * lane;
        f32x4 acc[12];
#pragma unroll
        for (int bb = 0; bb < 12; ++bb) acc[bb] = (f32x4){0.f, 0.f, 0.f, 0.f};
        const int kb = wave * 256;
#pragma unroll 1
        for (int k0 = kb; k0 < kb + 256; k0 += 16) {
            f32x4 wv[16];
#pragma unroll
            for (int i = 0; i < 16; ++i) wv[i] = *(const f32x4*)(Wl + (size_t)(k0 + i) * MODW);
#pragma unroll
            for (int i = 0; i < 16; ++i) { const int k = k0 + i; const f32x4 w = wv[i];
                const f32x4 s0 = *(const LAS f32x4*)(sl + k * 12), s1 = *(const LAS f32x4*)(sl + k * 12 + 4), s2 = *(const LAS f32x4*)(sl + k * 12 + 8);
                acc[0] += w * s0.x; acc[1] += w * s0.y; acc[2] += w * s0.z; acc[3] += w * s0.w;
                acc[4] += w * s1.x; acc[5] += w * s1.y; acc[6] += w * s1.z; acc[7] += w * s1.w;
                acc[8] += w * s2.x; acc[9] += w * s2.y; acc[10] += w * s2.z; acc[11] += w * s2.w; }
        }
        __syncthreads();
        LAS float* part = (LAS float*)lds;
#pragma unroll
        for (int bb = 0; bb < 12; ++bb) *(LAS f32x4*)(part + (wave * 12 + bb) * 256 + 4 * lane) = acc[bb];
        __syncthreads();
        for (int i = tid; i < 12 * 256; i += NTHR) { const int bb = i / 256, c = i % 256; float s = args.in[I_ADAB][l * MODW + c0 + c];
#pragma unroll
            for (int w = 0; w < 8; ++w) s += part[(w * 12 + bb) * 256 + c];
            MOD[((size_t)l * 12 + bb) * MODW + c0 + c] = s; }
        __syncthreads();
}
__device__ __forceinline__ void conv_wave_item(const Args& args, int l, int r, LAS float* scr, int lane) {
    unsigned char* ws = args.ws;
    bf16* WIN = (bf16*)(ws + WS_WIN) + (size_t)l * N1 * DM;
    const float* W = nullptr; int N = 0, k0 = 0, n0 = 0, ldt = DM, drow0 = 0, smode = 0, kdst = -1, krows = 64; bf16* WT = WIN; const float* mu = nullptr; bool skip = false;
    constexpr int LH = 2 * I_LD + I_LG + I_LV;
    if (r < I_IN) { const int nblk = 6144 / 32, kbk = r / nblk, nb = r % nblk; n0 = 32 * nb; k0 = 64 * kbk;
        drow0 = 256 * (n0 / 256) + 128 * ((n0 % 64) / 32) + 32 * ((n0 % 256) / 64);
        W = args.in[I_WIN] + (size_t)l * DM * 6144; N = 6144; }
    else if ((r -= I_IN) < 2 * LH) {
        const int half = r / LH, base = half ? PP0 : PC0; int q = r % LH; smode = 1 + half;
        if (q < I_LD) { W = args.in[I_DW1] + (size_t)l * DM * 64; N = 64; k0 = 64 * (q / 2); n0 = 32 * (q % 2); drow0 = base + 0 + n0; mu = args.in[I_MUWAG] + ((size_t)l * 3 + 0) * DM; }
        else if ((q -= I_LD) < I_LD) { W = args.in[I_AW1] + (size_t)l * DM * 64; N = 64; k0 = 64 * (q / 2); n0 = 32 * (q % 2); drow0 = base + 64 + n0; mu = args.in[I_MUWAG] + ((size_t)l * 3 + 1) * DM; }
        else if ((q -= I_LD) < I_LG) { W = args.in[I_GW1] + (size_t)l * DM * 160; N = 160; k0 = 64 * (q / 5); n0 = 32 * (q % 5); drow0 = base + 128 + n0; mu = args.in[I_MUWAG] + ((size_t)l * 3 + 2) * DM; }
        else { q -= I_LG; if (l > 0) { W = args.in[I_VW1] + (size_t)(l - 1) * DM * 32; N = 32; k0 = 64 * q; n0 = 0; drow0 = base + 288; mu = args.in[I_VMU] + (size_t)(l - 1) * DM; } else skip = true; } }
    else if ((r -= 2 * LH) < I_W2) { const int kb = r / 32; n0 = 32 * (r % 32); N = DRW; WT = (bf16*)(ws + WS_W2T) + (size_t)l * 1024 * NLORA; ldt = NLORA; drow0 = n0; k0 = 0;
        if (kb == 0) { W = args.in[I_DW2] + (size_t)l * 64 * DRW; kdst = 0; }
        else if (kb == 1) { W = args.in[I_AW2] + (size_t)l * 64 * DRW; kdst = 64; }
        else if (kb < 5) { W = args.in[I_GW2] + (size_t)l * 160 * DRW; k0 = 64 * (kb - 2); kdst = 128 + 64 * (kb - 2); krows = (kb == 4) ? 32 : 64; }
        else if (l > 0) { W = args.in[I_VW2] + (size_t)(l - 1) * 32 * DRW; kdst = 288; krows = 32; } else skip = true; }
    else if ((r -= I_W2) < I_OUT) { const int nblk = DM / 32; k0 = 64 * (r / nblk); n0 = 32 * (r % nblk); W = args.in[I_WOUT] + (size_t)l * DM * DM; N = DM; WT = (bf16*)(ws + WS_WOUT) + (size_t)l * DM * DM; drow0 = n0; }
    else if ((r -= I_OUT) < I_GU) { const int nblk = 2 * FF / 32; k0 = 64 * (r / nblk); n0 = 32 * (r % nblk);
        const int nn = (n0 < FF) ? n0 : n0 - FF; drow0 = 256 * (nn / 128) + (nn % 128) + ((n0 < FF) ? 0 : 128);
        W = args.in[I_WGU] + (size_t)l * DM * 2 * FF; N = 2 * FF; WT = (bf16*)(ws + WS_WGU) + (size_t)l * 2 * FF * DM; }
    else { r -= I_GU; const int nblk = DM / 32; k0 = 64 * (r / nblk); n0 = 32 * (r % nblk); W = args.in[I_WDN] + (size_t)l * FF * DM; N = DM; WT = (bf16*)(ws + WS_WDN) + (size_t)l * DM * FF; ldt = FF; drow0 = n0; }
    if (!skip) p0_transpose_item(W, N, k0, n0, WT, ldt, drow0, mu, smode, scr, lane, kdst, krows);
}
__device__ __forceinline__ void prep_item(const Args& args, int l, int item, LAS unsigned char* lds, int tid, int lane, int wave) {
    if (item < N_MOD_ITEMS) { mod_block_item(args, l, item * 256, lds, tid, lane, wave); return; }
    __syncthreads();
    LAS float* scr = (LAS float*)(lds + wave * 16384); const int r0 = (item - N_MOD_ITEMS) * CONV_BATCH + wave * (CONV_BATCH / NWAVES);
#pragma unroll 1
    for (int k = 0; k < CONV_BATCH / NWAVES; ++k) if (r0 + k < I_LAYER) conv_wave_item(args, l, r0 + k, scr, lane);
}
__device__ __forceinline__ void prep_layer_all(const Args& args, int l, LAS unsigned char* lds, int vcu, int G) {
    int tid_ = threadIdx.x; asm volatile("" : "+v"(tid_)); const int tid = tid_, lane = tid & 63, wave = __builtin_amdgcn_readfirstlane(tid >> 6);
#pragma unroll 1
    for (int it = vcu; it < N_PREP_ITEMS; it += G) prep_item(args, l, it, lds, tid, lane, wave);
    __syncthreads();
}
__device__ __forceinline__ void prep_layer_pull(const Args& args, int l, int kind, int max_items, LAS unsigned char* lds, volatile LAS unsigned* bcast) {
    int tid_ = threadIdx.x; asm volatile("" : "+v"(tid_)); const int tid = tid_, lane = tid & 63, wave = __builtin_amdgcn_readfirstlane(tid >> 6);
    unsigned* ctr = (unsigned*)(args.ws + WS_CTL) + CW_Q + 64 * (4 * kind + l); const int n_items = kind ? N_MOD_ITEMS : N_CONV_BATCHES;
#pragma unroll 1
    for (int k = 0; k < max_items; ++k) {
        __syncthreads();
        if (tid == 0) *bcast = __hip_atomic_fetch_add(ctr, 1u, __ATOMIC_RELAXED, __HIP_MEMORY_SCOPE_AGENT);
        __syncthreads();
        const int item = (int)*bcast;
        if (item >= n_items) break;
        prep_item(args, l, kind ? item : N_MOD_ITEMS + item, lds, tid, lane, wave);
    }
    __syncthreads();
}
__device__ __forceinline__ void p0_prologue(const Args& args, LAS unsigned char* lds, int vcu, int G, volatile LAS unsigned* bcast) {
    if (vcu == G - 1) {
        float* BT = (float*)(args.ws + WS_BT);
        for (int i = threadIdx.x; i < 3 * 129 * 16; i += NTHR) { const int h = i & 15, m = (i >> 4) % 129, br = (i >> 4) / 129; BT[i] = args.in[I_RELB][rel_bucket(m << (2 * br)) * 16 + h]; }
    }
    prep_layer_pull(args, 0, 1, 1 << 30, lds, bcast); prep_layer_pull(args, 0, 0, 1 << 30, lds, bcast);
}

__device__ __forceinline__ void norm_mod_row(const float* xrow, const float* g, const float* sh, const float* sc, bf16* hrow, float* frow, int lane) {
    const GAS f32x4* xr = (const GAS f32x4*)xrow + lane;
    f32x4 v[8]; float s = 0.f;
#pragma unroll
    for (int j = 0; j < 8; ++j) { v[j] = xr[64 * j]; s += (v[j].x * v[j].x + v[j].y * v[j].y) + (v[j].z * v[j].z + v[j].w * v[j].w); }
    const float rstd = 1.0f / sqrtf(wave_sum(s) * (1.0f / DM) + RMS_EPS);
    GAS unsigned long long* o8 = (GAS unsigned long long*)hrow + lane;
#pragma unroll
    for (int j = 0; j < 8; ++j) { const f32x4 g4 = ((const GAS f32x4*)g)[lane + 64 * j], sh4 = ((const GAS f32x4*)sh)[lane + 64 * j], sc4 = ((const GAS f32x4*)sc)[lane + 64 * j];
        const f32x4 h = (v[j] * rstd * g4) * (sc4 + 1.0f) + sh4;
        o8[64 * j] = (unsigned long long)pk2(h.x, h.y) | ((unsigned long long)pk2(h.z, h.w) << 32);
        if (frow) ((GAS f32x4*)frow)[lane + 64 * j] = h; }
}

__device__ __forceinline__ void pw_phase(const Args& args, int l, LAS unsigned char* lds, int vcu, int G) {
    int tid_ = threadIdx.x; asm volatile("" : "+v"(tid_)); const int tid = tid_, lane = tid & 63, wave = __builtin_amdgcn_readfirstlane(tid >> 6);
    typedef float f32x16 __attribute__((ext_vector_type(16)));
    unsigned char* ws = args.ws;
    const bf16* RKV = (const bf16*)(ws + WS_RKV); const float* P = (const float*)(ws + WS_P); const bf16* W2T = (const bf16*)(ws + WS_W2T) + (size_t)l * 1024 * NLORA;
    bf16* Rr = (bf16*)(ws + WS_R); float* Ww = (float*)(ws + WS_W); bf16* Kk = (bf16*)(ws + WS_K); bf16* Vv = (bf16*)(ws + WS_V);
    bf16* Aa = (bf16*)(ws + WS_A); bf16* Bb = (bf16*)(ws + WS_B); bf16* Gg = (bf16*)(ws + WS_G); float* VF = (float*)(ws + WS_VF);
    constexpr int LST = 328, SST = 68;
    LAS unsigned short* L = (LAS unsigned short*)lds;
    LAS float* Sw = (LAS float*)(lds + 21504) + wave * (32 * SST);
    const int r32 = lane & 31, hf = lane >> 5, rs = lane >> 4, c4 = (lane & 15) * 4;
    const float* mur = args.in[I_MURKV] + (size_t)l * 3 * DRW;
    for (int tile = vcu; tile < 257; tile += G) {
        const int m0 = tile < 256 ? tile * 32 : MP, nv = tile < 256 ? 32 : 8;
        __syncthreads();
        for (int repl = 0; repl < REP_PWL; ++repl)
#pragma unroll 10
        for (int i = tid; i < 32 * NLORA; i += NTHR) { const int r = i / NLORA, c = i % NLORA; const int m = m0 + ((r < nv) ? r : nv - 1);
            const int pm = (m < MP) ? (((m & (SEQ - 1)) == 0) ? -1 : m - 1) : m + 8;
            const float v = P[(size_t)m * 768 + c] + ((pm >= 0) ? 1.f : 0.f) * P[(size_t)((pm >= 0) ? pm : m) * 768 + 384 + c];
            const float e2 = __expf(2.0f * v), th = 1.0f - 2.0f / (1.0f + e2), sg = 1.0f / (1.0f + __expf(-v));
            L[r * LST + c] = (unsigned short)f2bf((c < 64) ? th : ((c >= 128 && c < 288) ? sg : v)); }
        __syncthreads();
        const bf16* w2a = W2T + (size_t)(128 * wave + r32) * NLORA + 8 * hf; const LAS unsigned short* lb = L + r32 * LST + 8 * hf;
        f32x16 acc[4];
#define PW_MM(koff, nks, CH) do { for (int repm = 0; repm < REP_PWM; ++repm) { _Pragma("unroll") for (int nt = 0; nt < 4; ++nt) acc[nt] = (f32x16){0.f}; \
        _Pragma("unroll 1") for (int kp = 0; kp < (nks); kp += (CH)) { bf16x8 bl[CH], aw[CH][4]; \
            _Pragma("unroll") for (int k2 = 0; k2 < (CH); ++k2) { bl[k2] = *(const LAS bf16x8*)(lb + (koff) + 16 * (kp + k2)); \
                _Pragma("unroll") for (int nt = 0; nt < 4; ++nt) aw[k2][nt] = *(const bf16x8*)(w2a + (size_t)(32 * nt) * NLORA + (koff) + 16 * (kp + k2)); } \
            _Pragma("unroll") for (int k2 = 0; k2 < (CH); ++k2) _Pragma("unroll") for (int nt = 0; nt < 4; ++nt) acc[nt] = __builtin_amdgcn_mfma_f32_32x32x16_bf16(aw[k2][nt], bl[k2], acc[nt], 0, 0, 0); } } } while (0)
#define PW_STAGE(hp) do { _Pragma("unroll") for (int n2 = 0; n2 < 2; ++n2) _Pragma("unroll") for (int g = 0; g < 4; ++g) \
            *(LAS f32x4*)(Sw + r32 * SST + 32 * n2 + 8 * g + 4 * hf) = (f32x4){acc[2 * (hp) + n2][4 * g], acc[2 * (hp) + n2][4 * g + 1], acc[2 * (hp) + n2][4 * g + 2], acc[2 * (hp) + n2][4 * g + 3]}; } while (0)
#define PW_AV(it) (*(const LAS f32x4*)(Sw + (4 * (it) + rs) * SST + c4))
        const unsigned vo1_ = (unsigned)(rs * DRW + c4), vo3_ = (unsigned)(rs * 3072 + c4);
#define PW_LOCAL_OFFS unsigned vo1 = vo1_, vo3 = vo3_; asm volatile("" : "+v"(vo1), "+v"(vo3)); (void)vo3;
        const int pd = (tile < 256) ? -1 : 8;
        const float pm0 = (tile < 256 && (m0 & (SEQ - 1)) == 0 && rs == 0) ? 0.f : 1.f;
        PW_MM(0, 4, 4);
#pragma unroll
        for (int hp = 0; hp < 2; ++hp) { PW_LOCAL_OFFS const int chu = 128 * wave + 64 * hp; const f32x4 w0 = *(const f32x4*)(args.in[I_DW0] + (size_t)l * DRW + chu + c4);
            PW_STAGE(hp);
#pragma unroll
            for (int it = 0; it < 8; ++it) { const f32x4 x = w0 + PW_AV(it); f32x4 o;
#pragma unroll
                for (int e = 0; e < 4; ++e) { const float sp = fmaxf(-x[e], 0.f) + __logf(1.0f + __expf(-fabsf(x[e]))); o[e] = __expf(-__expf(-sp - 0.5f)); }
                *(f32x4*)(Ww + (size_t)(m0 + 4 * it) * DRW + chu + vo1) = o; } }
        if (l > 0) PW_MM(288, 2, 2);
#pragma unroll
        for (int hp = 0; hp < 2; ++hp) { PW_LOCAL_OFFS const int chu = 128 * wave + 64 * hp; const f32x4 mu2 = *(const f32x4*)(mur + 2 * DRW + chu + c4); f32x4 v0 = (f32x4){0.f, 0.f, 0.f, 0.f};
            if (l > 0) v0 = *(const f32x4*)(args.in[I_VV0] + (size_t)(l - 1) * DRW + chu + c4);
            PW_STAGE(hp);
#pragma unroll
            for (int half = 0; half < 2; ++half) { unsigned long long x0[4], xp[4]; f32x4 vf[4];
#pragma unroll
              for (int i = 0; i < 4; ++i) { const int it = 4 * half + i; const bf16* a_ = RKV + (size_t)(m0 + 4 * it) * 3072 + 2048 + chu; const bf16* b_ = RKV + ((size_t)(m0 + 4 * it) + pd) * 3072 + 2048 + chu;
                  x0[i] = *(const unsigned long long*)(a_ + vo3); xp[i] = *(const unsigned long long*)(b_ + vo3);
                  vf[i] = (l > 0) ? *(const f32x4*)(VF + (size_t)(m0 + 4 * it) * DRW + chu + vo1) : (f32x4){0.f, 0.f, 0.f, 0.f}; }
#pragma unroll
              for (int i = 0; i < 4; ++i) { const int it = 4 * half + i; const f32x4 xc = up4bf(x0[i]); f32x4 vr = xc + (up4bf(xp[i]) * ((it == 0) ? pm0 : 1.f) - xc) * mu2;
                  if (l > 0) { const f32x4 x = v0 + PW_AV(it); f32x4 vg;
#pragma unroll
                      for (int e = 0; e < 4; ++e) vg[e] = sigmoidf_(x[e]);
                      vr = vr + (vf[i] - vr) * vg; }
                  else *(f32x4*)(VF + (size_t)(m0 + 4 * it) * DRW + chu + vo1) = vr;
                  st4bf(Vv + (size_t)(m0 + 4 * it) * DRW + chu + vo1, vr); }
            } }
        PW_MM(128, 10, 2);
#pragma unroll
        for (int hp = 0; hp < 2; ++hp) { PW_LOCAL_OFFS const int chu = 128 * wave + 64 * hp;
            PW_STAGE(hp);
#pragma unroll
            for (int it = 0; it < 8; ++it) st4bf(Gg + (size_t)(m0 + 4 * it) * DRW + chu + vo1, PW_AV(it)); }
        PW_MM(64, 4, 4);
#pragma unroll
        for (int hp = 0; hp < 2; ++hp) { PW_LOCAL_OFFS const int chu = 128 * wave + 64 * hp;
            const f32x4 a0 = *(const f32x4*)(args.in[I_AA0] + (size_t)l * DRW + chu + c4), kk4 = *(const f32x4*)(args.in[I_KK] + (size_t)l * DRW + chu + c4), ka4 = *(const f32x4*)(args.in[I_KA] + (size_t)l * DRW + chu + c4);
            const f32x4 mu0 = *(const f32x4*)(mur + chu + c4), mu1 = *(const f32x4*)(mur + DRW + chu + c4);
            PW_STAGE(hp);
#pragma unroll
            for (int half = 0; half < 2; ++half) { unsigned long long k0[4], kp[4], r0[4], rp[4];
#pragma unroll
              for (int i = 0; i < 4; ++i) { const int it = 4 * half + i; const bf16* a_ = RKV + (size_t)(m0 + 4 * it) * 3072 + chu; const bf16* b_ = RKV + ((size_t)(m0 + 4 * it) + pd) * 3072 + chu;
                  k0[i] = *(const unsigned long long*)(a_ + 1024 + vo3); kp[i] = *(const unsigned long long*)(b_ + 1024 + vo3); r0[i] = *(const unsigned long long*)(a_ + vo3); rp[i] = *(const unsigned long long*)(b_ + vo3); }
#pragma unroll
              for (int i = 0; i < 4; ++i) { const int it = 4 * half + i; const size_t ou = (size_t)(m0 + 4 * it) * DRW + chu; const float pmask = (it == 0) ? pm0 : 1.f;
                  const f32x4 x = a0 + PW_AV(it); f32x4 a;
#pragma unroll
                  for (int e = 0; e < 4; ++e) a[e] = sigmoidf_(x[e]);
                  const f32x4 kc = up4bf(k0[i]), rc = up4bf(r0[i]);
                  const f32x4 kr = kc + (up4bf(kp[i]) * pmask - kc) * mu1; f32x4 q = kr * kk4;
                  const float s = row16_sum((q[0] * q[0] + q[1] * q[1]) + (q[2] * q[2] + q[3] * q[3]));
                  q = q * (1.0f / fmaxf(sqrtf(s), 1e-12f));
                  st4bf(Kk + ou + vo1, kr * ((a - 1.0f) * ka4 + 1.0f)); st4bf(Aa + ou + vo1, -q); st4bf(Bb + ou + vo1, q * a); st4bf(Rr + ou + vo1, rc + (up4bf(rp[i]) * pmask - rc) * mu0); }
            } }
#undef PW_MM
#undef PW_STAGE
#undef PW_AV
#undef PW_LOCAL_OFFS
    }
}

constexpr int MST = 144, MSLOT = 64 * MST;
__device__ __forceinline__ bf16x8 mfr_row(const LAS unsigned char* M, int row, int k0, int g) { return *(const LAS bf16x8*)(M + row * MST + (k0 + 8 * g) * 2); }
__device__ __forceinline__ bf16x8 mfr_tr(const LAS unsigned char* M, int k0, int col0, int g, int q) {
    typedef short v4i16 __attribute__((ext_vector_type(4)));
    const LAS unsigned char* p = M + (k0 + 8 * g + (q >> 2)) * MST + (col0 + 4 * (q & 3)) * 2;
    const v4i16 lo = __builtin_amdgcn_ds_read_tr16_b64_v4i16((LAS v4i16*)p), hi = __builtin_amdgcn_ds_read_tr16_b64_v4i16((LAS v4i16*)(p + 4 * MST));
    return (bf16x8){lo[0], lo[1], lo[2], lo[3], hi[0], hi[1], hi[2], hi[3]};
}
#define MFMA16(a, b, c) __builtin_amdgcn_mfma_f32_16x16x32_bf16((a), (b), (c), 0, 0, 0)
__device__ __forceinline__ f32x4 mm_nn(const LAS unsigned char* X, const LAS unsigned char* Y, int ti, int tj, int q, int g, f32x4 c) {
    c = MFMA16(mfr_row(X, 16 * ti + q, 0, g), mfr_tr(Y, 0, 16 * tj, g, q), c); return MFMA16(mfr_row(X, 16 * ti + q, 32, g), mfr_tr(Y, 32, 16 * tj, g, q), c); }
__device__ __forceinline__ f32x4 mm_nt(const LAS unsigned char* X, const LAS unsigned char* Yt, int ti, int tj, int q, int g, f32x4 c) {
    c = MFMA16(mfr_row(X, 16 * ti + q, 0, g), mfr_row(Yt, 16 * tj + q, 0, g), c); return MFMA16(mfr_row(X, 16 * ti + q, 32, g), mfr_row(Yt, 16 * tj + q, 32, g), c); }
__device__ __forceinline__ f32x4 mm_tn(const LAS unsigned char* Xt, const LAS unsigned char* Y, int ti, int tj, int q, int g, f32x4 c) {
    c = MFMA16(mfr_tr(Xt, 0, 16 * ti, g, q), mfr_tr(Y, 0, 16 * tj, g, q), c); return MFMA16(mfr_tr(Xt, 32, 16 * ti, g, q), mfr_tr(Y, 32, 16 * tj, g, q), c); }
typedef float f32x2_t __attribute__((ext_vector_type(2))); typedef __bf16 bf16x2_t __attribute__((ext_vector_type(2)));
__device__ __forceinline__ unsigned cvtpk(float lo, float hi) { f32x2_t v = {lo, hi}; bf16x2_t b = __builtin_convertvector(v, bf16x2_t); return __builtin_bit_cast(unsigned, b); }
__device__ __forceinline__ void mst_tile_t(LAS unsigned char* M, int ti, int tj, int q, int g, f32x4 c) {
    *(LAS unsigned long long*)(M + (16 * tj + q) * MST + (16 * ti + 4 * g) * 2) = (unsigned long long)cvtpk(c[0], c[1]) | ((unsigned long long)cvtpk(c[2], c[3]) << 32);
}
#define SC_BAR() do { asm volatile("s_waitcnt lgkmcnt(0)" ::: "memory"); __builtin_amdgcn_s_barrier(); asm volatile("" ::: "memory"); } while (0)
__device__ __forceinline__ void scan_units(const Args& args, int l, LAS unsigned char* lds, int vcu, int G) {
    int tid_ = threadIdx.x; asm volatile("" : "+v"(tid_)); const int tid = tid_, lane = tid & 63, wave = __builtin_amdgcn_readfirstlane(tid >> 6);
    unsigned char* ws = args.ws;
    const unsigned short* Rr = (const unsigned short*)(ws + WS_R); const float* Ww = (const float*)(ws + WS_W); const unsigned short* Kk = (const unsigned short*)(ws + WS_K); const unsigned short* Vv = (const unsigned short*)(ws + WS_V);
    const unsigned short* Aa = (const unsigned short*)(ws + WS_A); const unsigned short* Bb = (const unsigned short*)(ws + WS_B); float* Y = (float*)(ws + WS_Y);
    LAS unsigned char* iA = lds + 0 * MSLOT; LAS unsigned char* iR = lds + 1 * MSLOT; LAS unsigned char* iB = lds + 2 * MSLOT; LAS unsigned char* iK = lds + 3 * MSLOT;
    LAS unsigned char* iBh = lds + 4 * MSLOT; LAS unsigned char* iKh = lds + 5 * MSLOT; LAS unsigned char* iV = lds + 6 * MSLOT; LAS unsigned char* iS = lds + 7 * MSLOT;
    LAS unsigned char* iAak = lds + 8 * MSLOT; LAS unsigned char* iArb = lds + 9 * MSLOT; LAS unsigned char* iArk = lds + 10 * MSLOT; LAS unsigned char* iQa = lds + 11 * MSLOT;
    LAS unsigned char* iTa = lds + 12 * MSLOT; LAS unsigned char* iTb = lds + 13 * MSLOT;
    LAS unsigned char* iQb = iB; LAS unsigned char* iRHS = iK; LAS unsigned char* iU = iQa;
    LAS float* wtot = (LAS float*)(lds + LDSCTL_OFF + 1024); LAS float* sDC = wtot + 2 * 8 * 64;
    static_assert(14 * MSLOT <= RING_BYTES && LDSCTL_OFF + 1024 + 17 * 64 * 4 <= LDS_BYTES, "scan LDS map");
    const int q = lane & 15, g = lane >> 4, ti = wave >> 1, tj0 = 2 * (wave & 1);
    constexpr int C = 64, NCH = SEQ / C;
    for (int u = vcu; u < PBATCH * 16; u += G) {
        const int b = u >> 4, h = u & 15;
        const int hw = lane >> 5, jp = lane & 31;
        const size_t base0 = (size_t)(b * SEQ + 8 * wave + 4 * hw) * DRW + h * 64 + 2 * jp;
        typedef float f32x2v __attribute__((ext_vector_type(2)));
        f32x2v rw[4]; unsigned rk[4], ra[4], rb[4], rr[4], rv[4];
#define SC_LOAD(cc) do { _Pragma("unroll") for (int i = 0; i < 4; ++i) { const size_t o = base0 + (size_t)((cc) * C + i) * DRW; rw[i] = *(const f32x2v*)(Ww + o); \
            rk[i] = *(const unsigned*)(Kk + o); ra[i] = *(const unsigned*)(Aa + o); rb[i] = *(const unsigned*)(Bb + o); rr[i] = *(const unsigned*)(Rr + o); rv[i] = *(const unsigned*)(Vv + o); } } while (0)
#define BLO(U) __builtin_bit_cast(float, (U) << 16)
#define BHI(U) __builtin_bit_cast(float, (U) & 0xffff0000u)
#define SC_DECAY(cc) do { p[0] = rw[0]; _Pragma("unroll") for (int i = 1; i < 4; ++i) p[i] = p[i - 1] * rw[i]; \
            lo.x = __shfl(p[3].x, jp); lo.y = __shfl(p[3].y, jp);                                        \
            if (hw) { _Pragma("unroll") for (int i = 0; i < 4; ++i) p[i] = p[i] * lo; *(LAS f32x2v*)(wtot + ((cc) & 1) * 512 + wave * 64 + 2 * jp) = p[3]; } } while (0)
        SC_LOAD(0);
        f32x2v p[4], lo; SC_DECAY(0);
        f32x4 Sreg[2], Treg[2];
#pragma unroll
        for (int t2 = 0; t2 < 2; ++t2) Sreg[t2] = (f32x4){0.f, 0.f, 0.f, 0.f};
        __syncthreads();
        for (int i = tid; i < 64 * 36; i += NTHR) ((LAS unsigned*)iS)[i] = 0u;
        for (int c = 0; c < NCH; ++c) {
            LAS float* wt = wtot + (c & 1) * 512;
            f32x2v pre = (f32x2v){1.f, 1.f}, dc = (f32x2v){1.f, 1.f};
#pragma unroll
            for (int w2 = 0; w2 < 8; ++w2) { const f32x2v x = *(const LAS f32x2v*)(wt + w2 * 64 + 2 * jp); dc = dc * x; if (w2 < wave) pre = pre * x; }
            if (wave == 0 && hw == 0) *(LAS f32x2v*)(sDC + 2 * jp) = dc;
            { const f32x2v d0 = hw ? pre * lo : pre;
              f32x2v xa[4], xr[4], xb[4], xk[4], xbh[4], xkh[4], xv[4];
#pragma unroll
              for (int i = 0; i < 4; ++i) { const f32x2v Dt = pre * p[i], Dm = (i == 0) ? d0 : pre * p[i - 1]; f32x2v inv; inv.x = __builtin_amdgcn_rcpf(Dt.x); inv.y = __builtin_amdgcn_rcpf(Dt.y); const f32x2v sc = dc * inv;
                  const f32x2v a2 = (f32x2v){BLO(ra[i]), BHI(ra[i])}, r2 = (f32x2v){BLO(rr[i]), BHI(rr[i])}, b2 = (f32x2v){BLO(rb[i]), BHI(rb[i])}, k2 = (f32x2v){BLO(rk[i]), BHI(rk[i])};
                  xa[i] = a2 * Dm; xr[i] = r2 * Dt; xb[i] = b2 * inv; xk[i] = k2 * inv; xbh[i] = b2 * sc; xkh[i] = k2 * sc; xv[i] = (f32x2v){BLO(rv[i]), BHI(rv[i])}; }
              const int o0 = (2 * jp) * MST + (8 * wave + 4 * hw) * 2, o1 = o0 + MST;
#define SC_W4(img, ARR) do { *(LAS unsigned long long*)((img) + o0) = (unsigned long long)cvtpk(ARR[0].x, ARR[1].x) | ((unsigned long long)cvtpk(ARR[2].x, ARR[3].x) << 32); \
                           *(LAS unsigned long long*)((img) + o1) = (unsigned long long)cvtpk(ARR[0].y, ARR[1].y) | ((unsigned long long)cvtpk(ARR[2].y, ARR[3].y) << 32); } while (0)
              SC_W4(iA, xa); SC_W4(iR, xr); SC_W4(iB, xb); SC_W4(iK, xk); SC_W4(iBh, xbh); SC_W4(iKh, xkh); SC_W4(iV, xv);
#undef SC_W4
            }
            if (c + 1 < NCH) SC_LOAD(c + 1);
            SC_BAR();
#define FR_ROW2(dst, M, row) do { dst[0] = mfr_row(M, (row), 0, g); dst[1] = mfr_row(M, (row), 32, g); } while (0)
#define FR_TR2(dst, M, col0) do { dst[0] = mfr_tr(M, 0, (col0), g, q); dst[1] = mfr_tr(M, 32, (col0), g, q); } while (0)
#define MM2(c, a, b) MFMA16(a[1], b[1], MFMA16(a[0], b[0], (c)))
            const f32x4 z4 = (f32x4){0.f, 0.f, 0.f, 0.f};
            { bf16x8 aA[2], aR[2], bB[2][2], bK[2][2];
              FR_TR2(aA, iA, 16 * ti); FR_TR2(aR, iR, 16 * ti);
#pragma unroll
              for (int t2 = 0; t2 < 2; ++t2) { FR_TR2(bB[t2], iB, 16 * (tj0 + t2)); FR_TR2(bK[t2], iK, 16 * (tj0 + t2)); }
#pragma unroll
              for (int t2 = 0; t2 < 2; ++t2) { const int tj = tj0 + t2;
                f32x4 aab = MM2(z4, aA, bB[t2]), aak = MM2(z4, aA, bK[t2]), arb = MM2(z4, aR, bB[t2]), ark = MM2(z4, aR, bK[t2]);
#pragma unroll
                for (int e = 0; e < 4; ++e) { const int t = 16 * ti + 4 * g + e, s = 16 * tj + q; if (!(s < t)) { aab[e] = 0.f; aak[e] = 0.f; } if (!(s <= t)) { arb[e] = 0.f; ark[e] = 0.f; } }
                mst_tile_t(iQa, ti, tj, q, g, aab); mst_tile_t(iAak, ti, tj, q, g, aak); mst_tile_t(iArb, ti, tj, q, g, arb); mst_tile_t(iArk, ti, tj, q, g, ark);
#pragma unroll
                for (int e = 0; e < 4; ++e) if (16 * ti + 4 * g + e == 16 * tj + q) aab[e] += 1.0f;
                Treg[t2] = aab; mst_tile_t(iTa, ti, tj, q, g, aab); } }
            SC_BAR();
            { bf16x8 aQ[2], bQ[2][2], aA[2], bS[2][2], aK[2], bV[2][2];
              FR_TR2(aQ, iQa, 16 * ti); FR_TR2(aA, iA, 16 * ti); FR_TR2(aK, iAak, 16 * ti);
#pragma unroll
              for (int t2 = 0; t2 < 2; ++t2) { FR_ROW2(bQ[t2], iQa, 16 * (tj0 + t2) + q); FR_ROW2(bS[t2], iS, 16 * (tj0 + t2) + q); FR_ROW2(bV[t2], iV, 16 * (tj0 + t2) + q); }
#pragma unroll
              for (int t2 = 0; t2 < 2; ++t2) { const int tj = tj0 + t2;
                mst_tile_t(iQb, ti, tj, q, g, MM2(z4, aQ, bQ[t2])); mst_tile_t(iRHS, ti, tj, q, g, MM2(MM2(z4, aA, bS[t2]), aK, bV[t2])); } }
            SC_BAR();
#define SC_LEVEL(Qin, Qout, Tin, Tout, doq) do { bf16x8 aQ[2], bQ[2][2], aT[2]; FR_TR2(aQ, Qin, 16 * ti); FR_TR2(aT, Tin, 16 * ti); \
                _Pragma("unroll") for (int t2 = 0; t2 < 2; ++t2) FR_ROW2(bQ[t2], Qin, 16 * (tj0 + t2) + q); \
                _Pragma("unroll") for (int t2 = 0; t2 < 2; ++t2) { const int tj = tj0 + t2; \
                    if (doq) mst_tile_t(Qout, ti, tj, q, g, MM2(z4, aQ, bQ[t2])); \
                    Treg[t2] = MM2(Treg[t2], aT, bQ[t2]); mst_tile_t(Tout, ti, tj, q, g, Treg[t2]); } SC_BAR(); } while (0)
            SC_LEVEL(iQb, iQa, iTa, iTb, true);
            SC_LEVEL(iQa, iQb, iTb, iTa, true);
            SC_LEVEL(iQb, iQa, iTa, iTb, true);
            SC_LEVEL(iQa, iQb, iTb, iTa, true);
            SC_LEVEL(iQb, iQa, iTa, iTb, false);
#undef SC_LEVEL
            { bf16x8 aT[2], bR[2][2]; FR_TR2(aT, iTb, 16 * ti);
#pragma unroll
              for (int t2 = 0; t2 < 2; ++t2) FR_ROW2(bR[t2], iRHS, 16 * (tj0 + t2) + q);
#pragma unroll
              for (int t2 = 0; t2 < 2; ++t2) mst_tile_t(iU, ti, tj0 + t2, q, g, MM2(z4, aT, bR[t2])); }
            SC_BAR();
            { bf16x8 aRt[2], aArb[2], aArk[2], aBh[2], aKh[2], bS[2][2], bU[2][2], bV[2][2];
              FR_TR2(aRt, iR, 16 * ti); FR_TR2(aArb, iArb, 16 * ti); FR_TR2(aArk, iArk, 16 * ti); FR_ROW2(aBh, iBh, 16 * ti + q); FR_ROW2(aKh, iKh, 16 * ti + q);
#pragma unroll
              for (int t2 = 0; t2 < 2; ++t2) { FR_ROW2(bS[t2], iS, 16 * (tj0 + t2) + q); FR_ROW2(bU[t2], iU, 16 * (tj0 + t2) + q); FR_ROW2(bV[t2], iV, 16 * (tj0 + t2) + q); }
              const f32x4 dcv = *(const LAS f32x4*)(sDC + 16 * ti + 4 * g);
#pragma unroll
              for (int t2 = 0; t2 < 2; ++t2) { const int tj = tj0 + t2;
                const f32x4 y = MM2(MM2(MM2(z4, aRt, bS[t2]), aArb, bU[t2]), aArk, bV[t2]);
                float* yp = Y + (size_t)(b * SEQ + c * C + 16 * ti + 4 * g) * DRW + h * 64 + 16 * tj + q;
#pragma unroll
                for (int e = 0; e < 4; ++e) yp[(size_t)e * DRW] = y[e];
                Sreg[t2] = MM2(MM2(Sreg[t2] * dcv, aBh, bU[t2]), aKh, bV[t2]); } }
            if (c + 1 < NCH) SC_DECAY(c + 1);
            SC_BAR();
#undef FR_ROW2
#undef FR_TR2
#undef MM2
#pragma unroll
            for (int t2 = 0; t2 < 2; ++t2) mst_tile_t(iS, ti, tj0 + t2, q, g, Sreg[t2]);
        }
#pragma unroll
        for (int t2 = 0; t2 < 2; ++t2) { const int tj = tj0 + t2;
            *(f32x4*)(args.out + O_WP + ((((size_t)l * PBATCH + b) * 16 + h) * 64 + 16 * tj + q) * 64 + 16 * ti + 4 * g) = Sreg[t2]; }
        __syncthreads();
    }
#undef SC_LOAD
#undef SC_DECAY
#undef BLO
#undef BHI
}
#undef SC_BAR
__device__ __forceinline__ void sample_wkv_units(const Args& args, int l, int vcu, int G) {
    int tid_ = threadIdx.x; asm volatile("" : "+v"(tid_)); const int tid = tid_, lane = tid & 63, wave = __builtin_amdgcn_readfirstlane(tid >> 6); const int vskip = (G == 256) ? 64 : 0; if (vcu < vskip) return; const int gw = (vcu - vskip) * NWAVES + wave, NGW = (G - vskip) * NWAVES;     (void)tid; (void)lane; (void)wave; (void)gw; (void)NGW;
    unsigned char* ws = args.ws;
    const bf16* Rr = (const bf16*)(ws + WS_R); const float* Ww = (const float*)(ws + WS_W); const bf16* Kk = (const bf16*)(ws + WS_K); const bf16* Vv = (const bf16*)(ws + WS_V);
    const bf16* Aa = (const bf16*)(ws + WS_A); const bf16* Bb = (const bf16*)(ws + WS_B); float* Y = (float*)(ws + WS_Y);
    for (int u = gw; u < 128; u += NGW) {
        const int b = u >> 4, h = u & 15; const size_t vo = (size_t)(MP + b) * DRW + h * 64;
        const float* Sp = args.in[I_SWKV] + ((((size_t)l * 8 + b) * 16 + h) * 64 + lane) * 64;
        float* So = args.out + O_WS + ((((size_t)l * 8 + b) * 16 + h) * 64 + lane) * 64;
        f32x4 S[16];
#pragma unroll
        for (int j = 0; j < 16; ++j) S[j] = *(const f32x4*)(Sp + 4 * j);
        float sa = 0.f;
#pragma unroll
        for (int j = 0; j < 16; ++j) { const f32x4 a4 = ld4bf(Aa + vo + 4 * j); sa += (S[j].x * a4.x + S[j].y * a4.y) + (S[j].z * a4.z + S[j].w * a4.w); }
        const float vi = bf2f(Vv[vo + lane]); float y = 0.f;
#pragma unroll
        for (int j = 0; j < 16; ++j) { const f32x4 w4 = *(const f32x4*)(Ww + vo + 4 * j), k4 = ld4bf(Kk + vo + 4 * j), b4 = ld4bf(Bb + vo + 4 * j), r4 = ld4bf(Rr + vo + 4 * j);
            f32x4 s = S[j] * w4 + (b4 * sa + k4 * vi); y += (s.x * r4.x + s.y * r4.y) + (s.z * r4.z + s.w * r4.w); *(f32x4*)(So + 4 * j) = s; }
        Y[vo + lane] = y;
    }
}
typedef short v4i16_t __attribute__((ext_vector_type(4)));
typedef float f32x4v __attribute__((ext_vector_type(4)));
__device__ __forceinline__ void attn_units(const Args& args, int l, LAS unsigned char* lds, int vcu, int G) {
    int tid_ = threadIdx.x; asm volatile("" : "+v"(tid_)); const int tid = tid_, lane = tid & 63, wave = __builtin_amdgcn_readfirstlane(tid >> 6); const int gw = vcu * NWAVES + wave, NGW = G * NWAVES; (void)tid; (void)lane; (void)wave; (void)gw; (void)NGW;
    unsigned char* ws = args.ws;
    const bf16* QB = (const bf16*)(ws + WS_QB); const bf16* KB = (const bf16*)(ws + WS_KB); const bf16* VB = (const bf16*)(ws + WS_VB);
    bf16* OBR = (bf16*)(ws + WS_OBR); float* LSE = (float*)(ws + WS_LSE); const float* BT = (const float*)(ws + WS_BT);
    constexpr int KST = 144, VST = 160;
    LAS unsigned char* Kt = lds; LAS unsigned char* Vt = lds + 256 * KST; LAS float* btab = (LAS float*)(lds + 256 * KST + 256 * VST);
    const int q = lane & 15, g = lane >> 4;
    constexpr int NA_S = 0, NA_O = 16; static_assert(64 * NA_S + 192 * NA_O == PBATCH * NHEADS * 48, "attention unit deal");
    const bool deal = (G == 256); const int ufirst = deal ? ((vcu < 64) ? vcu * NA_S : 64 * NA_S + (vcu - 64) * NA_O) : vcu, ucnt = deal ? ((vcu < 64) ? NA_S : NA_O) : (PBATCH * NHEADS * 48 - vcu + G - 1) / G, ustep = deal ? 1 : G;
    v4u kreg[4], vreg[4]; float breg = 0.f; bf16x8 qn0, qn1;
#define AT_DECODE(uu) const int rn = (uu) & 15, br = ((uu) >> 4) % 3, h = ((uu) / 48) & 15, b = (uu) / 768; const int dsh = 2 * br, dil = 1 << dsh, r = rn & (dil - 1), n = rn >> dsh;
#define AT_FETCH(uu) do { AT_DECODE(uu) \
        _Pragma("unroll") for (int j = 0; j < 4; ++j) { const int i = tid + NTHR * j, row = i >> 3, chk = i & 7, sk = (n - 1) * 128 + row; kreg[j] = (v4u){0u, 0u, 0u, 0u}; vreg[j] = (v4u){0u, 0u, 0u, 0u}; \
            if (sk >= 0) { const size_t go = ((size_t)(b * SEQ + sk * dil + r)) * DATT + h * 64 + chk * 8; kreg[j] = *(const v4u*)(KB + go); vreg[j] = *(const v4u*)(VB + go); } } \
        if (tid < 129) breg = BT[(br * 129 + tid) * 16 + h]; \
        { const int mqn = b * SEQ + (n * 128 + 16 * wave + q) * dil + r; qn0 = *(const bf16x8*)(QB + (size_t)mqn * DATT + h * 64 + 8 * g); qn1 = *(const bf16x8*)(QB + (size_t)mqn * DATT + h * 64 + 32 + 8 * g); } } while (0)
    if (ucnt > 0) AT_FETCH(ufirst);
    for (int ui = 0; ui < ucnt; ++ui) { const int u = ufirst + ui * ustep;
        AT_DECODE(u)
        __syncthreads();
#pragma unroll
        for (int j = 0; j < 4; ++j) { const int i = tid + NTHR * j, row = i >> 3, chk = i & 7; *(LAS v4u*)(Kt + row * KST + chk * 16) = kreg[j]; *(LAS v4u*)(Vt + row * VST + chk * 16) = vreg[j]; }
        if (tid < 129) btab[tid] = breg;
        const bf16x8 qf0 = qn0, qf1 = qn1;
        __syncthreads();
        if (ui + 1 < ucnt) AT_FETCH(u + ustep);
        const int iq = 16 * wave + q, mq = b * SEQ + (n * 128 + iq) * dil + r;
        const int kb0 = wave >> 1;
        f32x4 sacc[10];
#pragma unroll
        for (int sb = 0; sb < 10; ++sb) { const int key0 = 32 * kb0 + 16 * sb;
            const bf16x8 a0 = *(const LAS bf16x8*)(Kt + (key0 + q) * KST + 16 * g), a1 = *(const LAS bf16x8*)(Kt + (key0 + q) * KST + 64 + 16 * g);
            f32x4 acc = (f32x4){0.f, 0.f, 0.f, 0.f};
            acc = __builtin_amdgcn_mfma_f32_16x16x32_bf16(a0, qf0, acc, 0, 0, 0); acc = __builtin_amdgcn_mfma_f32_16x16x32_bf16(a1, qf1, acc, 0, 0, 0); sacc[sb] = acc; }
        float mx = -INFINITY;
#pragma unroll
        for (int sb = 0; sb < 10; ++sb)
#pragma unroll
            for (int e = 0; e < 4; ++e) { const int jj = 32 * kb0 + 16 * sb + 4 * g + e, dsub = 128 + iq - jj, sk = (n - 1) * 128 + jj;
                const bool ok = (dsub >= 0) && (dsub <= 128) && (sk >= 0);
                const float s = ok ? sacc[sb][e] * ATT_SCALE + btab[ok ? dsub : 0] : -INFINITY; sacc[sb][e] = s; mx = fmaxf(mx, s); }
        mx = fmaxf(mx, __shfl_xor(mx, 16)); mx = fmaxf(mx, __shfl_xor(mx, 32));
        float sum = 0.f;
#pragma unroll
        for (int sb = 0; sb < 10; ++sb)
#pragma unroll
            for (int e = 0; e < 4; ++e) { const float p = __expf(sacc[sb][e] - mx); sacc[sb][e] = p; sum += p; }
        sum += __shfl_xor(sum, 16); sum += __shfl_xor(sum, 32);
        f32x4 o[4];
#pragma unroll
        for (int c = 0; c < 4; ++c) o[c] = (f32x4){0.f, 0.f, 0.f, 0.f};
#pragma unroll
        for (int kk = 0; kk < 5; ++kk) {
            v4u pw; pw.x = pk2(sacc[2 * kk][0], sacc[2 * kk][1]); pw.y = pk2(sacc[2 * kk][2], sacc[2 * kk][3]); pw.z = pk2(sacc[2 * kk + 1][0], sacc[2 * kk + 1][1]); pw.w = pk2(sacc[2 * kk + 1][2], sacc[2 * kk + 1][3]);
            const bf16x8 pb = __builtin_bit_cast(bf16x8, pw);
            const int R0 = 32 * (kb0 + kk) + 4 * g + (q >> 2);
#pragma unroll
            for (int c = 0; c < 4; ++c) {
                const v4i16_t lo = __builtin_amdgcn_ds_read_tr16_b64_v4i16((LAS v4i16_t*)(Vt + R0 * VST + (16 * c + 4 * (q & 3)) * 2));
                const v4i16_t hi = __builtin_amdgcn_ds_read_tr16_b64_v4i16((LAS v4i16_t*)(Vt + (R0 + 16) * VST + (16 * c + 4 * (q & 3)) * 2));
                const bf16x8 va = (bf16x8){lo[0], lo[1], lo[2], lo[3], hi[0], hi[1], hi[2], hi[3]};
                o[c] = __builtin_amdgcn_mfma_f32_16x16x32_bf16(va, pb, o[c], 0, 0, 0); }
        }
        const float inv = 1.0f / sum;
        bf16* op = OBR + ((size_t)br * MP + mq) * DATT + h * 64 + 4 * g;
#pragma unroll
        for (int c = 0; c < 4; ++c) { const unsigned long long w = (unsigned long long)pk2(o[c][0] * inv, o[c][1] * inv) | ((unsigned long long)pk2(o[c][2] * inv, o[c][3] * inv) << 32); *(unsigned long long*)(op + 16 * c) = w; }
        if (g == 0) LSE[((size_t)br * MP + mq) * 16 + h] = mx + __logf(sum);
    }
#undef AT_DECODE
#undef AT_FETCH
}
__device__ __forceinline__ void sample_attn_units(const Args& args, int l, LAS unsigned char* lds, int vcu, int G) {
    int tid_ = threadIdx.x; asm volatile("" : "+v"(tid_)); const int tid = tid_, lane = tid & 63, wave = __builtin_amdgcn_readfirstlane(tid >> 6); const int vskip = (G == 256) ? 64 : 0; if (vcu < vskip) return; const int gw = (vcu - vskip) * NWAVES + wave, NGW = (G - vskip) * NWAVES; (void)tid; (void)lane; (void)wave; (void)gw; (void)NGW;
    unsigned char* ws = args.ws;
    const bf16* QB = (const bf16*)(ws + WS_QB); bf16* MIX = (bf16*)(ws + WS_MIX); const float* BT = (const float*)(ws + WS_BT);
    LAS float* pl = (LAS float*)(lds + 90112) + wave * 448;
    for (int u = gw; u < 128; u += NGW) {
        const int b = u >> 4, h = u & 15, m = MP + b;
        float qv[64];
#pragma unroll
        for (int j = 0; j < 8; ++j) { const v4u w = *(const v4u*)(QB + (size_t)m * DATT + h * 64 + 8 * j);
            qv[8 * j + 0] = bf2f((unsigned short)(w.x & 0xffff)); qv[8 * j + 1] = bf2f((unsigned short)(w.x >> 16)); qv[8 * j + 2] = bf2f((unsigned short)(w.y & 0xffff)); qv[8 * j + 3] = bf2f((unsigned short)(w.y >> 16));
            qv[8 * j + 4] = bf2f((unsigned short)(w.z & 0xffff)); qv[8 * j + 5] = bf2f((unsigned short)(w.z >> 16)); qv[8 * j + 6] = bf2f((unsigned short)(w.w & 0xffff)); qv[8 * j + 7] = bf2f((unsigned short)(w.w >> 16)); }
        const float* knew = args.out + O_KS + ((size_t)l * 8 + b) * DATT + h * 64; const float* vnew = args.out + O_VS + ((size_t)l * 8 + b) * DATT + h * 64;
        const float* kc = args.in[I_CK] + (((size_t)l * 8 + b) * 2048) * 1024 + h * 64; const float* vc = args.in[I_CV] + (((size_t)l * 8 + b) * 2048) * 1024 + h * 64;
        float mx = -INFINITY;
        for (int it = 0; it < 7; ++it) { const int kk = lane + 64 * it;
            if (kk < 387) { const int br = kk / 129, mm = kk % 129; const float* kp = (mm == 0) ? knew : kc + (size_t)(2048 - (mm << (2 * br))) * 1024;
                float d = 0.f;
#pragma unroll
                for (int j = 0; j < 16; ++j) { const f32x4 k4 = *(const f32x4*)(kp + 4 * j); d += (qv[4 * j] * k4.x + qv[4 * j + 1] * k4.y) + (qv[4 * j + 2] * k4.z + qv[4 * j + 3] * k4.w); }
                const float s = d * ATT_SCALE + BT[(br * 129 + mm) * 16 + h]; pl[kk] = s; mx = fmaxf(mx, s); } }
        mx = wave_max(mx);
        float sum = 0.f;
        for (int it = 0; it < 7; ++it) { const int kk = lane + 64 * it; if (kk < 387) { const float p = __expf(pl[kk] - mx); pl[kk] = p; sum += p; } }
        sum = wave_sum(sum);
        f32x4 o4 = (f32x4){0.f, 0.f, 0.f, 0.f}; const int kg = lane >> 4, dq = lane & 15;
#pragma unroll 8
        for (int i = 0; i < 97; ++i) { const int kk = kg + 4 * i; if (kk < 387) { const int br = kk / 129, mm = kk % 129; const float* vp = (mm == 0) ? vnew : vc + (size_t)(2048 - (mm << (2 * br))) * 1024;
            o4 += *(const f32x4*)(vp + 4 * dq) * pl[kk]; } }
#pragma unroll
        for (int e = 0; e < 4; ++e) { o4[e] += __shfl_xor(o4[e], 16); o4[e] += __shfl_xor(o4[e], 32); }
        if (kg == 0) { const float inv = 1.0f / sum; *(unsigned long long*)(MIX + (size_t)m * DM + h * 64 + 4 * dq) = (unsigned long long)pk2(o4.x * inv, o4.y * inv) | ((unsigned long long)pk2(o4.z * inv, o4.w * inv) << 32); }
    }
}

__device__ __forceinline__ void mx_phase(const Args& args, int l, int vcu, int G) {
    int tid_ = threadIdx.x; asm volatile("" : "+v"(tid_)); const int tid = tid_, lane = tid & 63, wave = __builtin_amdgcn_readfirstlane(tid >> 6); const int gw = vcu * NWAVES + wave, NGW = G * NWAVES; (void)tid; (void)lane; (void)wave; (void)gw; (void)NGW;
    unsigned char* ws = args.ws;
    const bf16* OBR = (const bf16*)(ws + WS_OBR); const float* LSE = (const float*)(ws + WS_LSE); bf16* MIX = (bf16*)(ws + WS_MIX);
    const bf16* Rr = (const bf16*)(ws + WS_R); const bf16* Kk = (const bf16*)(ws + WS_K); const bf16* Vv = (const bf16*)(ws + WS_V); const bf16* Gg = (const bf16*)(ws + WS_G); const float* Y = (const float*)(ws + WS_Y);
    const int hh = lane >> 2, p = lane & 3, c0 = hh * 64 + p * 16;
    f32x4 lng[4], lnb[4], rk[4];
#pragma unroll
    for (int j = 0; j < 4; ++j) { lng[j] = *(const f32x4*)(args.in[I_LNG] + (size_t)l * DRW + c0 + 4 * j); lnb[j] = *(const f32x4*)(args.in[I_LNB] + (size_t)l * DRW + c0 + 4 * j); rk[j] = *(const f32x4*)(args.in[I_RK] + (size_t)l * DRW + c0 + 4 * j); }
    struct Raw { float l0, l1, l2; v4u ob[6]; f32x4 y[4]; unsigned long long r[4], k[4], v[4], g[4]; };
#define MX_LOAD(R, mm) do { if ((mm) < MP) { R.l0 = LSE[((size_t)0 * MP + (mm)) * 16 + hh]; R.l1 = LSE[((size_t)1 * MP + (mm)) * 16 + hh]; R.l2 = LSE[((size_t)2 * MP + (mm)) * 16 + hh]; \
            _Pragma("unroll") for (int br = 0; br < 3; ++br) _Pragma("unroll") for (int j = 0; j < 2; ++j) R.ob[2 * br + j] = *(const v4u*)(OBR + ((size_t)br * MP + (mm)) * DATT + c0 + 8 * j); } \
        { const size_t ro_ = (size_t)(mm) * DRW + c0; _Pragma("unroll") for (int j = 0; j < 4; ++j) { R.y[j] = *(const f32x4*)(Y + ro_ + 4 * j); R.r[j] = *(const unsigned long long*)(Rr + ro_ + 4 * j); \
            R.k[j] = *(const unsigned long long*)(Kk + ro_ + 4 * j); R.v[j] = *(const unsigned long long*)(Vv + ro_ + 4 * j); R.g[j] = *(const unsigned long long*)(Gg + ro_ + 4 * j); } } } while (0)
    Raw cur; if (gw < NROWS) MX_LOAD(cur, gw);
    for (int m = gw; m < NROWS; m += NGW) {
        Raw nxt = cur; const int mn = m + NGW; if (mn < NROWS) MX_LOAD(nxt, mn);
        v4u a0 = (v4u){0u, 0u, 0u, 0u}, a1 = a0;
        if (m < MP) {
            const float l0 = cur.l0, l1 = cur.l1, l2 = cur.l2;
            const float mx = fmaxf(l0, fmaxf(l1, l2)); float e0 = __expf(l0 - mx), e1 = __expf(l1 - mx), e2 = __expf(l2 - mx); const float inv = 1.0f / (e0 + e1 + e2); e0 *= inv; e1 *= inv; e2 *= inv;
            float acc[16];
#pragma unroll
            for (int i = 0; i < 16; ++i) acc[i] = 0.f;
#pragma unroll
            for (int br = 0; br < 3; ++br) { const float al = br == 0 ? e0 : br == 1 ? e1 : e2;
#pragma unroll
                for (int j = 0; j < 2; ++j) { const v4u w = cur.ob[2 * br + j];
                    acc[8 * j + 0] += al * bf2f((unsigned short)(w.x & 0xffff)); acc[8 * j + 1] += al * bf2f((unsigned short)(w.x >> 16)); acc[8 * j + 2] += al * bf2f((unsigned short)(w.y & 0xffff)); acc[8 * j + 3] += al * bf2f((unsigned short)(w.y >> 16));
                    acc[8 * j + 4] += al * bf2f((unsigned short)(w.z & 0xffff)); acc[8 * j + 5] += al * bf2f((unsigned short)(w.z >> 16)); acc[8 * j + 6] += al * bf2f((unsigned short)(w.w & 0xffff)); acc[8 * j + 7] += al * bf2f((unsigned short)(w.w >> 16)); } }
            a0.x = pk2(acc[0], acc[1]); a0.y = pk2(acc[2], acc[3]); a0.z = pk2(acc[4], acc[5]); a0.w = pk2(acc[6], acc[7]); a1.x = pk2(acc[8], acc[9]); a1.y = pk2(acc[10], acc[11]); a1.z = pk2(acc[12], acc[13]); a1.w = pk2(acc[14], acc[15]);
        }
        f32x4 y[4], rr[4], kk[4], vv[4], gg[4];
        float s = 0.f, bon = 0.f;
#pragma unroll
        for (int j = 0; j < 4; ++j) { y[j] = cur.y[j]; rr[j] = up4bf(cur.r[j]); kk[j] = up4bf(cur.k[j]); vv[j] = up4bf(cur.v[j]); gg[j] = up4bf(cur.g[j]);
            s += (y[j].x + y[j].y) + (y[j].z + y[j].w); const f32x4 t = rr[j] * kk[j] * rk[j]; bon += (t.x + t.y) + (t.z + t.w); }
        s += __shfl_xor(s, 1); s += __shfl_xor(s, 2); bon += __shfl_xor(bon, 1); bon += __shfl_xor(bon, 2);
        const float mean = s * (1.0f / 64.0f); float qq = 0.f;
#pragma unroll
        for (int j = 0; j < 4; ++j) { y[j] = y[j] - mean; qq += (y[j].x * y[j].x + y[j].y * y[j].y) + (y[j].z * y[j].z + y[j].w * y[j].w); }
        qq += __shfl_xor(qq, 1); qq += __shfl_xor(qq, 2);
        const float rstd = 1.0f / sqrtf(qq * (1.0f / 64.0f) + GN_EPS);
        v4u o0, o1; f32x4 z[4];
#pragma unroll
        for (int j = 0; j < 4; ++j) z[j] = ((y[j] * rstd) * lng[j] + lnb[j] + vv[j] * bon) * gg[j];
        o0.x = pk2(z[0].x, z[0].y); o0.y = pk2(z[0].z, z[0].w); o0.z = pk2(z[1].x, z[1].y); o0.w = pk2(z[1].z, z[1].w); o1.x = pk2(z[2].x, z[2].y); o1.y = pk2(z[2].z, z[2].w); o1.z = pk2(z[3].x, z[3].y); o1.w = pk2(z[3].z, z[3].w);
        if (m < MP) { *(v4u*)(MIX + (size_t)m * DM + c0) = a0; *(v4u*)(MIX + (size_t)m * DM + c0 + 8) = a1; }
        *(v4u*)(MIX + (size_t)m * DM + DATT + c0) = o0; *(v4u*)(MIX + (size_t)m * DM + DATT + c0 + 8) = o1;
        cur = nxt;
    }
#undef MX_LOAD
}

template <int K> __device__ __forceinline__ void sample_proj(const bf16* A, const bf16* Bt, const float* base_s, float* out_s, const float* gate, LAS unsigned char* lds, int vcu, int G) {
    int tid_ = threadIdx.x; asm volatile("" : "+v"(tid_)); const int tid = tid_, lane = tid & 63, wave = __builtin_amdgcn_readfirstlane(tid >> 6);
    constexpr int KW = K / 8, NS = KW / 32; static_assert(KW % 32 == 0, "K split");
    LAS float* part = (LAS float*)lds;
    const int c = lane & 15, g = lane >> 4;
    for (int cg = vcu; cg < DM / 8; cg += G) {
        const int n0 = 8 * cg;
        const bf16* ap = A + (size_t)(MP + (c & 7)) * K + wave * KW + 8 * g; const bf16* bp = Bt + (size_t)(n0 + (c & 7)) * K + wave * KW + 8 * g;
        bf16x8 af[NS], bfr[NS];
#pragma unroll
        for (int s = 0; s < NS; ++s) { af[s] = *(const bf16x8*)(ap + 32 * s); bfr[s] = *(const bf16x8*)(bp + 32 * s); }
        f32x4 acc = (f32x4){0.f, 0.f, 0.f, 0.f};
#pragma unroll
        for (int s = 0; s < NS; ++s) acc = __builtin_amdgcn_mfma_f32_16x16x32_bf16(af[s], bfr[s], acc, 0, 0, 0);
        __syncthreads();
        if (g < 2 && c < 8) {
#pragma unroll
            for (int e = 0; e < 4; ++e) part[(wave * 8 + 4 * g + e) * 8 + c] = acc[e]; }
        __syncthreads();
        if (tid < 64) { const int r = tid >> 3, cc = tid & 7; float s = 0.f;
#pragma unroll
            for (int w = 0; w < 8; ++w) s += part[(w * 8 + r) * 8 + cc];
            const size_t o = (size_t)r * DM + n0 + cc; out_s[o] = base_s[o] + gate[(size_t)(4 + r) * MODW + n0 + cc] * s; }
    }
    __syncthreads();
}

__device__ __forceinline__ void n1_phase(const Args& args, int l, int vcu, int G, const float* Xp, const float* Xs, const float* modl, bf16* HB) {
    int tid_ = threadIdx.x; asm volatile("" : "+v"(tid_)); const int tid = tid_, lane = tid & 63, wave = __builtin_amdgcn_readfirstlane(tid >> 6); const int gw = vcu * NWAVES + wave, NGW = G * NWAVES; (void)tid; (void)lane; (void)wave; (void)gw; (void)NGW;
    for (int m = gw; m < NROWS + 8; m += NGW) {
        if (m < MP) { const int b = m >> 11, t = m & (SEQ - 1);
            norm_mod_row(Xp + (size_t)m * DM, args.in[I_N1G] + (size_t)l * DM, modl + (size_t)b * MODW, modl + (size_t)b * MODW + DM, HB + (size_t)m * DM,
                         (t == SEQ - 1) ? args.out + O_SP + ((size_t)l * PBATCH + b) * DM : nullptr, lane); }
        else if (m < NROWS) { const int b = m - MP;
            norm_mod_row(Xs + (size_t)b * DM, args.in[I_N1G] + (size_t)l * DM, modl + (size_t)(4 + b) * MODW, modl + (size_t)(4 + b) * MODW + DM, HB + (size_t)m * DM,
                         args.out + O_SS + ((size_t)l * 8 + b) * DM, lane); }
        else { const int b = m - NROWS; const float* s = args.in[I_SSH] + ((size_t)l * 8 + b) * DM; GAS unsigned long long* o8 = (GAS unsigned long long*)(HB + (size_t)m * DM) + lane;
#pragma unroll
            for (int j = 0; j < 8; ++j) { const f32x4 v = ((const GAS f32x4*)s)[lane + 64 * j]; o8[64 * j] = (unsigned long long)pk2(v.x, v.y) | ((unsigned long long)pk2(v.z, v.w) << 32); } }
    }
}
__device__ __forceinline__ void n2_phase(const Args& args, int l, int vcu, int G, const float* XB, const float* modl, bf16* HB) {
    int tid_ = threadIdx.x; asm volatile("" : "+v"(tid_)); const int tid = tid_, lane = tid & 63, wave = __builtin_amdgcn_readfirstlane(tid >> 6); const int gw = vcu * NWAVES + wave, NGW = G * NWAVES; (void)tid; (void)lane; (void)wave; (void)gw; (void)NGW;
    for (int m = gw; m < NROWS; m += NGW) { const int bb = (m < MP) ? (m >> 11) : 4 + (m - MP);
        norm_mod_row(XB + (size_t)m * DM, args.in[I_N2G] + (size_t)l * DM, modl + (size_t)bb * MODW + 3 * DM, modl + (size_t)bb * MODW + 4 * DM, HB + (size_t)m * DM, nullptr, lane); }
}

__global__ void __launch_bounds__(NTHR, 2) fwd(Args args) {
    extern __shared__ __attribute__((aligned(16))) unsigned char lds_raw[];
    LAS unsigned char* lds = (LAS unsigned char*)lds_raw;
    volatile LAS unsigned* MISC = (volatile LAS unsigned*)(lds + MISC_OFF);
    const int G = gridDim.x; const int bx = blockIdx.x; const int vcu = (G % 8 == 0) ? (bx % 8) * (G / 8) + bx / 8 : bx;
    unsigned char* ws = args.ws;
    for (int u = threadIdx.x; u < (LDS_BYTES - LDSCTL_OFF) / 4; u += NTHR) ((LAS unsigned*)(lds + LDSCTL_OFF))[u] = 0u;
    __syncthreads();
    const int lo = args.ph_lo, hi = args.ph_hi;
    XcdBarrier bar; bar.bar = (unsigned*)(ws + WS_CTL) + CW_BAR; bar.x = 0; bar.st = nullptr;
    if (hi - lo > 1) bar = xcd_barrier_post((unsigned*)(ws + WS_CTL) + CW_BAR, MISC + 8);
#define IN(k) (lo <= (k) && (k) < hi)
#define SEAM(k) do { if (IN(k) && IN((k) + 1)) { for (int repb = 0; repb < REP_BAR; ++repb) xcd_barrier(bar); } } while (0)

    if (IN(0)) { for (int rep = 0; rep < REP_P0; ++rep) { __syncthreads(); p0_prologue(args, lds, vcu, G, MISC + 16); } }
    SEAM(0);

    float* MOD = (float*)(ws + WS_MOD);
    bf16* HB = (bf16*)(ws + WS_HB); bf16* MIX = (bf16*)(ws + WS_MIX); float* XB = (float*)(ws + WS_XB); bf16* ACT = (bf16*)(ws + WS_ACT);
    for (int l = 0; l < DEPTH; ++l) {
        const int pb = 1 + PH_PER_LAYER * l;
        const float* modl = MOD + (size_t)l * 12 * MODW;
        const float* Xp = (l == 0) ? args.in[I_XP] : XB; const float* Xs = (l == 0) ? args.in[I_XS] : XB + (size_t)MP * DM;
        if (IN(pb + 0)) { for (int rep = 0; rep < REP_N1; ++rep) { __syncthreads(); n1_phase(args, l, vcu, G, Xp, Xs, modl, HB); } }
        SEAM(pb + 0);
        if (IN(pb + 1)) {
            __syncthreads();
            pg8::Gemm g{(const pg8::bf16_t*)HB, (const pg8::bf16_t*)(ws + WS_WIN) + (size_t)l * N1 * DM, MH, N1, DM}; pg8::StaticOrder S; S.init(MH, N1, G, bx);
            pg8::EpiG1 E{(pg8::bf16_t*)(ws + WS_QB), (size_t)(WS_KB - WS_QB) / 2, (pg8::bf16_t*)(ws + WS_RKV), (float*)(ws + WS_P),
                         args.out + O_KP + (size_t)l * MP * DATT, args.out + O_KS + (size_t)l * 8 * DATT, (size_t)(O_VP - O_KP), (size_t)(O_VS - O_KS), args.in[I_QG] + l * 64, args.in[I_KG] + l * 64};
            for (int rep = 0; rep < REP_G1; ++rep) pg8::gemm_phase<pg8::EpiG1, pg8::StaticOrder, true, true>(lds, g, S, E);
            if (l + 1 < DEPTH && bx >= (MH / 256) * (N1 / 256) % G && G == 256) prep_layer_pull(args, l + 1, 0, TAIL_PULLS, lds, MISC + 16);
        }
        SEAM(pb + 1);
        if (IN(pb + 2)) { for (int rep = 0; rep < REP_PW; ++rep) { __syncthreads(); pw_phase(args, l, lds, vcu, G); } }
        SEAM(pb + 2);
        if (IN(pb + 3)) {
            __syncthreads();
            for (int rep = 0; rep < REP_SCAN; ++rep) { __syncthreads(); scan_units(args, l, lds, vcu, G); }
            sample_wkv_units(args, l, vcu, G);
            __syncthreads();
            for (int rep = 0; rep < REP_ATT; ++rep) { __syncthreads(); attn_units(args, l, lds, vcu, G); }
            __syncthreads();
            for (int rep = 0; rep < REP_SATT; ++rep) { __syncthreads(); sample_attn_units(args, l, lds, vcu, G); }
            if (l + 1 < DEPTH && (vcu >= 64 || G != 256)) { prep_layer_pull(args, l + 1, 1, 1 << 30, lds, MISC + 16); prep_layer_pull(args, l + 1, 0, 1 << 30, lds, MISC + 16); }
        }
        SEAM(pb + 3);
        if (IN(pb + 4)) { for (int rep = 0; rep < REP_MX; ++rep) mx_phase(args, l, vcu, G); }
        SEAM(pb + 4);
        if (IN(pb + 5)) {
            __syncthreads();
            sample_proj<DM>(MIX, (const bf16*)(ws + WS_WOUT) + (size_t)l * DM * DM, Xs, XB + (size_t)MP * DM, modl + 2 * DM, lds, vcu, G);
            pg8::Gemm g{(const pg8::bf16_t*)MIX, (const pg8::bf16_t*)(ws + WS_WOUT) + (size_t)l * DM * DM, MP, DM, DM}; pg8::StaticOrder S; S.init(MP, DM, G, bx);
            for (int rep = 0; rep < REP_G2; ++rep) { float* dst = (rep + 1 < REP_G2) ? (float*)(ws + WS_END + 16 * MiB) : XB;
            pg8::EpiResid E{Xp, Xs, dst, dst + (size_t)MP * DM, modl + 2 * DM};
            pg8::gemm_phase<pg8::EpiResid, pg8::StaticOrder, true, true>(lds, g, S, E); }
        }
        SEAM(pb + 5);
        if (IN(pb + 6)) { for (int rep = 0; rep < REP_N2; ++rep) { __syncthreads(); n2_phase(args, l, vcu, G, XB, modl, HB); } }
        SEAM(pb + 6);
        if (IN(pb + 7)) {
            __syncthreads();
            pg8::Gemm g{(const pg8::bf16_t*)HB, (const pg8::bf16_t*)(ws + WS_WGU) + (size_t)l * 2 * FF * DM, MH, 2 * FF, DM}; pg8::StaticOrder S; S.init(MH, 2 * FF, G, bx);
            for (int rep = 0; rep < REP_G3; ++rep) { pg8::bf16_t* dst = (rep + 1 < REP_G3) ? (pg8::bf16_t*)(ws + WS_END + 16 * MiB) : (pg8::bf16_t*)ACT;
            pg8::EpiSwiGLU E{dst, FF};
            pg8::gemm_phase<pg8::EpiSwiGLU, pg8::StaticOrder, true, true>(lds, g, S, E); }
            if (l + 1 < DEPTH && bx >= (MH / 256) * (2 * FF / 256) % G && G == 256) prep_layer_pull(args, l + 1, 0, TAIL_PULLS, lds, MISC + 16);
        }
        SEAM(pb + 7);
        if (IN(pb + 8)) {
            __syncthreads();
            float* op = (l == DEPTH - 1) ? args.out + O_YP : XB; float* os = (l == DEPTH - 1) ? args.out + O_YS : XB + (size_t)MP * DM;
            sample_proj<FF>(ACT, (const bf16*)(ws + WS_WDN) + (size_t)l * DM * FF, XB + (size_t)MP * DM, os, modl + 5 * DM, lds, vcu, G);
            pg8::Gemm g{(const pg8::bf16_t*)ACT, (const pg8::bf16_t*)(ws + WS_WDN) + (size_t)l * DM * FF, MP, DM, FF}; pg8::StaticOrder S; S.init(MP, DM, G, bx);
            for (int rep = 0; rep < REP_G4; ++rep) { float* dst = (rep + 1 < REP_G4) ? (float*)(ws + WS_END + 16 * MiB) : op;
            pg8::EpiResid E{XB, XB + (size_t)MP * DM, dst, os, modl + 5 * DM};
            pg8::gemm_phase<pg8::EpiResid, pg8::StaticOrder, true, true>(lds, g, S, E); }
        }
        SEAM(pb + 8);
    }
#undef IN
#undef SEAM
}

extern "C" void kernel_launch(void* const* d_in, const int* in_sizes, int n_in, void* d_out, int out_size, void* d_ws, size_t ws_size, hipStream_t stream) {
    static int grid = 0;
    if (grid == 0) {
        if (n_in != N_IN || (size_t)out_size != O_END || ws_size < WS_END) { fprintf(stderr, "kernel_launch: unexpected shapes: n_in %d, out %d, ws %zu (need %zu)\n", n_in, out_size, ws_size, (size_t)WS_END); grid = -1; return; }
        int dev = 0, cus = 0;
        if (hipGetDevice(&dev) != hipSuccess || hipDeviceGetAttribute(&cus, hipDeviceAttributeMultiprocessorCount, dev) != hipSuccess) { grid = -1; return; }
        if (hipFuncSetAttribute((const void*)fwd, hipFuncAttributeMaxDynamicSharedMemorySize, LDS_BYTES) != hipSuccess) { fprintf(stderr, "kernel_launch: hipFuncSetAttribute failed\n"); grid = -1; return; }
        int per_cu = 0;
        if (hipOccupancyMaxActiveBlocksPerMultiprocessor(&per_cu, (const void*)fwd, NTHR, LDS_BYTES) != hipSuccess || per_cu < 1) fprintf(stderr, "kernel_launch: occupancy query says %d blocks per CU\n", per_cu);
        (void)hipGetLastError();
        grid = cus;
    }
    if (grid < 0) return;
    if (hipMemsetAsync((char*)d_ws + WS_CTL, 0, CTL_ZERO_BYTES, stream) != hipSuccess) return;
    Args a{};
    for (int i = 0; i < N_IN; ++i) a.in[i] = (const float*)d_in[i];
    a.out = (float*)d_out; a.ws = (unsigned char*)d_ws;
#if MK_N_LAUNCHES == 1
    a.ph_lo = 0; a.ph_hi = N_PHASES;
    hipLaunchKernelGGL(fwd, dim3(grid), dim3(NTHR), LDS_BYTES, stream, a);
#else
    for (int li = 0; li < N_PHASES; ++li) { a.ph_lo = li; a.ph_hi = li + 1; hipLaunchKernelGGL(fwd, dim3(grid), dim3(NTHR), LDS_BYTES, stream, a); }
#endif
}
```

```cpp
#include <hip/hip_runtime.h>
#include <cstdio>
#include <cstdint>
#include <cmath>
namespace pg8 {
#define PG8_LAS __attribute__((address_space(3)))
typedef unsigned short bf16_t;
typedef short bf16x8 __attribute__((ext_vector_type(8)));
typedef float f32x4 __attribute__((ext_vector_type(4)));
typedef unsigned u32x4 __attribute__((ext_vector_type(4)));
constexpr int BM = 256, BK = 64, HALF = 128, HTB = HALF * BK * 2  , STAGE_BYTES = 8 * HTB, NXCD = 8, WGM = 8;

__host__ __device__ __forceinline__ int lds_byte(int r, int c) { const int st = (r >> 4) * 2 + (c >> 5), rr = r & 15, cc = c & 31, ob = rr * 64 + cc * 2; return st * 1024 + (ob ^ (((ob >> 9) & 1) << 5)); }
__host__ __device__ __forceinline__ void stage_rc(int b, int& R, int& C) { const int st = b / 1024, sb = b % 1024, swz = sb ^ (((sb >> 9) & 1) << 5); R = (st >> 1) * 16 + swz / 64; C = (st & 1) * 32 + (swz % 64) / 2; }
__host__ __device__ __forceinline__ int perm32(int rho) { const int n = rho >> 4, i = rho & 15; return 8 * (i >> 2) + 4 * n + (i & 3); }

struct Unit { int pm, pn; };
struct Gemm { const bf16_t* A; const bf16_t* Bt; int M, N, K; };

struct StaticOrder {
    int nM, nN, nwg, G, c;
    __host__ __device__ void init(int M, int N, int G_, int c_) { nM = M / BM; nN = N / BM; nwg = nM * nN; G = G_; c = c_; }
    __host__ __device__ bool next(int i, Unit& u) const {
        const long L = (long)i * G + c; if (L >= nwg) return false;
        int wgid = (int)L; { const int q = nwg / NXCD, r = nwg % NXCD, xcd = wgid % NXCD, off = wgid / NXCD; wgid = (xcd < r ? xcd * (q + 1) : r * (q + 1) + (xcd - r) * q) + off; }
        const int nig = WGM * nN, gid = wgid / nig, fm = gid * WGM, gsz = (nM - fm) < WGM ? (nM - fm) : WGM;
        u.pm = fm + ((wgid % nig) % gsz); u.pn = (wgid % nig) / gsz; return true;
    }
    __device__ __forceinline__ void a_ready(const Unit&) const {}
    __device__ __forceinline__ void done(const Unit&) const {}
};

__device__ __forceinline__ unsigned cvt_pk_bf16(float lo, float hi) { unsigned r; asm volatile("v_cvt_pk_bf16_f32 %0, %1, %2" : "=v"(r) : "v"(lo), "v"(hi)); return r; }
typedef float f32x2 __attribute__((ext_vector_type(2)));
__device__ __forceinline__ f32x2 gelu_pk(f32x2 v) {
    const f32x2 av = __builtin_elementwise_abs(v), d = av * 0.2316418882f + 1.0f;
    f32x2 t; t.x = __builtin_amdgcn_rcpf(d.x); t.y = __builtin_amdgcn_rcpf(d.y);
    f32x2 q = t * 0.5307027145f + (-0.7265760135f); q = q * t + 0.7107068705f; q = q * t + (-0.142248368f); q = q * t + 0.127414796f; q = q * t;
    const f32x2 s = (v * v) * (-0.72134752044f);
    f32x2 e; e.x = __builtin_amdgcn_exp2f(s.x); e.y = __builtin_amdgcn_exp2f(s.y);
    const f32x2 m = v * (q * e), r = v - m;
    f32x2 o; o.x = v.x < 0.f ? m.x : r.x; o.y = v.y < 0.f ? m.y : r.y; return o;
}

template <int ACT  > struct EpiBf16 {
    static constexpr bool PERM = true, AFTER_DRAIN = false; static_assert(ACT == 0 || ACT == 1, "EpiBf16: ACT is 0 (none) or 1 (gelu_pk)");
    bf16_t* O; int ldc; const float* bias; int split_cols; size_t split_stride; float scale0;
    __device__ __forceinline__ void operator()(const f32x4 (&acc)[2][2][4][2], const Unit& u, int wr, int wc, int fr, int fq) const {
        const int row0 = u.pm * BM + wr * 64 + fr; int colt = u.pn * BM; bf16_t* base = O;
        float sc = 1.f; if (split_cols) { const int t = colt / split_cols; base += (size_t)t * split_stride; colt -= t * split_cols; if (t == 0) sc = scale0; }
        const int col0 = colt + wc * 32 + 8 * fq, bcol0 = u.pn * BM + wc * 32 + 8 * fq;
        f32x4 bv[2][2];
#pragma unroll
        for (int bj = 0; bj < 2; ++bj)
#pragma unroll
            for (int n = 0; n < 2; ++n) bv[bj][n] = bias ? *(const f32x4*)(bias + bcol0 + bj * HALF + 4 * n) : (f32x4){0.f, 0.f, 0.f, 0.f};
#pragma unroll
        for (int ai = 0; ai < 2; ++ai)
#pragma unroll
            for (int m = 0; m < 4; ++m) { bf16_t* rowp = base + (size_t)(row0 + ai * HALF + m * 16) * ldc + col0;
#pragma unroll
                for (int bj = 0; bj < 2; ++bj) { f32x4 v0 = acc[ai][bj][m][0] + bv[bj][0], v1 = acc[ai][bj][m][1] + bv[bj][1];
                    if (ACT == 1) { f32x2 a = gelu_pk((f32x2){v0[0], v0[1]}), b = gelu_pk((f32x2){v0[2], v0[3]}), c = gelu_pk((f32x2){v1[0], v1[1]}), d = gelu_pk((f32x2){v1[2], v1[3]});
                        v0 = (f32x4){a.x, a.y, b.x, b.y}; v1 = (f32x4){c.x, c.y, d.x, d.y}; }
                    v0 = v0 * sc; v1 = v1 * sc; u32x4 w; w.x = cvt_pk_bf16(v0[0], v0[1]); w.y = cvt_pk_bf16(v0[2], v0[3]); w.z = cvt_pk_bf16(v1[0], v1[1]); w.w = cvt_pk_bf16(v1[2], v1[3]);
                    *(u32x4*)(rowp + bj * HALF) = w; } }
    }
};


struct EpiF32 {
    static constexpr bool PERM = false, AFTER_DRAIN = false;
    float* O; int ldc;
    __device__ __forceinline__ void operator()(const f32x4 (&acc)[2][2][4][2], const Unit& u, int wr, int wc, int fr, int fq) const {
        const int col0 = u.pn * BM + wc * 32 + 4 * fq;
#pragma unroll
        for (int ai = 0; ai < 2; ++ai)
#pragma unroll
            for (int m = 0; m < 4; ++m) { float* rowp = O + (size_t)(u.pm * BM + ai * HALF + wr * 64 + m * 16 + fr) * ldc + col0;
#pragma unroll
                for (int bj = 0; bj < 2; ++bj)
#pragma unroll
                    for (int n = 0; n < 2; ++n) *(f32x4*)(rowp + bj * HALF + n * 16) = acc[ai][bj][m][n]; }
    }
};
struct EpiResid {
    static constexpr bool PERM = false, AFTER_DRAIN = false;
    const float* base_p; const float* base_s; float* out_p; float* out_s; const float* gate;
    __device__ __forceinline__ void operator()(const f32x4 (&acc)[2][2][4][2], const Unit& u, int wr, int wc, int fr, int fq) const {
        const int col0 = u.pn * BM + wc * 32 + 4 * fq;
        if (u.pm < 32) {
            const float* g = gate + (size_t)(u.pm >> 3) * 12288 + col0;
            f32x4 gv[2][2];
#pragma unroll
            for (int bj = 0; bj < 2; ++bj)
#pragma unroll
                for (int n = 0; n < 2; ++n) gv[bj][n] = *(const f32x4*)(g + bj * HALF + n * 16);
#pragma unroll
            for (int ai = 0; ai < 2; ++ai) { f32x4 bs[4][2][2];
#pragma unroll
                for (int m = 0; m < 4; ++m) { const size_t off = (size_t)(u.pm * BM + ai * HALF + wr * 64 + m * 16 + fr) * 2048 + col0;
#pragma unroll
                    for (int bj = 0; bj < 2; ++bj)
#pragma unroll
                        for (int n = 0; n < 2; ++n) bs[m][bj][n] = *(const f32x4*)(base_p + off + bj * HALF + n * 16); }
#pragma unroll
                for (int m = 0; m < 4; ++m) { const size_t off = (size_t)(u.pm * BM + ai * HALF + wr * 64 + m * 16 + fr) * 2048 + col0;
#pragma unroll
                    for (int bj = 0; bj < 2; ++bj)
#pragma unroll
                        for (int n = 0; n < 2; ++n) *(f32x4*)(out_p + off + bj * HALF + n * 16) = bs[m][bj][n] + gv[bj][n] * acc[ai][bj][m][n]; } }
        } else if (wr == 0 && fr < 8) {
            const float* g = gate + (size_t)(4 + fr) * 12288 + col0; const size_t off = (size_t)fr * 2048 + col0;
#pragma unroll
            for (int bj = 0; bj < 2; ++bj)
#pragma unroll
                for (int n = 0; n < 2; ++n) { const f32x4 gv = *(const f32x4*)(g + bj * HALF + n * 16); const f32x4 bs = *(const f32x4*)(base_s + off + bj * HALF + n * 16);
                    *(f32x4*)(out_s + off + bj * HALF + n * 16) = bs + gv * acc[0][bj][0][n]; }
        }
    }
};
struct EpiSwiGLU {
    static constexpr bool PERM = true, AFTER_DRAIN = false;
    bf16_t* O; int ldc;
    __device__ __forceinline__ void operator()(const f32x4 (&acc)[2][2][4][2], const Unit& u, int wr, int wc, int fr, int fq) const {
        const int row0 = u.pm * BM + wr * 64 + fr, col0 = u.pn * HALF + wc * 32 + 8 * fq;
#pragma unroll
        for (int ai = 0; ai < 2; ++ai)
#pragma unroll
            for (int m = 0; m < 4; ++m) { bf16_t* rowp = O + (size_t)(row0 + ai * HALF + m * 16) * ldc + col0;
                float v[8];
#pragma unroll
                for (int n = 0; n < 2; ++n)
#pragma unroll
                    for (int e = 0; e < 4; ++e) { const float g = acc[ai][0][m][n][e], up = acc[ai][1][m][n][e]; v[4 * n + e] = g * __builtin_amdgcn_rcpf(1.0f + __expf(-g)) * up; }
                u32x4 w; w.x = cvt_pk_bf16(v[0], v[1]); w.y = cvt_pk_bf16(v[2], v[3]); w.z = cvt_pk_bf16(v[4], v[5]); w.w = cvt_pk_bf16(v[6], v[7]);
                *(u32x4*)rowp = w; }
    }
};
struct EpiG1 {
    static constexpr bool PERM = true, AFTER_DRAIN = false;
    bf16_t* QB; size_t qkv_stride; bf16_t* RKV; float* P; float *okp, *oks; size_t kv_stride_p, kv_stride_s; const float *qg, *kg;
    __device__ __forceinline__ void operator()(const f32x4 (&acc)[2][2][4][2], const Unit& u, int wr, int wc, int fr, int fq) const {
        const int row0 = u.pm * BM + wr * 64 + fr;
        if (u.pn >= 24) {
            const int col0 = (u.pn - 24) * BM + wc * 32 + 8 * fq;
#pragma unroll
            for (int ai = 0; ai < 2; ++ai)
#pragma unroll
                for (int m = 0; m < 4; ++m) { float* rp = P + (size_t)(row0 + ai * HALF + m * 16) * 768 + col0;
#pragma unroll
                    for (int bj = 0; bj < 2; ++bj) { *(f32x4*)(rp + bj * HALF) = acc[ai][bj][m][0]; *(f32x4*)(rp + bj * HALF + 4) = acc[ai][bj][m][1]; } }
            return;
        }
        const int reg = u.pn >> 2, cb = (4 * (u.pn & 3) + wc) * 64 + 8 * fq;
        if (reg >= 3) {
            const int col0 = (reg - 3) * 1024 + cb;
#pragma unroll
            for (int ai = 0; ai < 2; ++ai)
#pragma unroll
                for (int m = 0; m < 4; ++m) { bf16_t* rp = RKV + (size_t)(row0 + ai * HALF + m * 16) * 3072 + col0;
#pragma unroll
                    for (int bj = 0; bj < 2; ++bj) { u32x4 w; w.x = cvt_pk_bf16(acc[ai][bj][m][0][0], acc[ai][bj][m][0][1]); w.y = cvt_pk_bf16(acc[ai][bj][m][0][2], acc[ai][bj][m][0][3]); w.z = cvt_pk_bf16(acc[ai][bj][m][1][0], acc[ai][bj][m][1][1]); w.w = cvt_pk_bf16(acc[ai][bj][m][1][2], acc[ai][bj][m][1][3]);
                        *(u32x4*)(rp + 32 * bj) = w; } }
            return;
        }
        f32x4 gn[2][2];
#pragma unroll
        for (int bj = 0; bj < 2; ++bj)
#pragma unroll
            for (int n = 0; n < 2; ++n) { const f32x4 a = *(const f32x4*)(qg + 8 * fq + 32 * bj + 4 * n), b = *(const f32x4*)(kg + 8 * fq + 32 * bj + 4 * n); gn[bj][n] = (reg == 0) ? a : b; }
        bf16_t* dstb = QB + (size_t)reg * qkv_stride;
#pragma unroll
        for (int ai = 0; ai < 2; ++ai)
#pragma unroll
            for (int m = 0; m < 4; ++m) { const int row = row0 + ai * HALF + m * 16;
                f32x4 v[2][2];
#pragma unroll
                for (int bj = 0; bj < 2; ++bj)
#pragma unroll
                    for (int n = 0; n < 2; ++n) v[bj][n] = acc[ai][bj][m][n];
                if (reg < 2) { float ss = 0.f;
#pragma unroll
                    for (int bj = 0; bj < 2; ++bj)
#pragma unroll
                        for (int n = 0; n < 2; ++n) ss += (v[bj][n][0] * v[bj][n][0] + v[bj][n][1] * v[bj][n][1]) + (v[bj][n][2] * v[bj][n][2] + v[bj][n][3] * v[bj][n][3]);
                    ss += __shfl_xor(ss, 16); ss += __shfl_xor(ss, 32);
                    const float rs = 1.0f / sqrtf(ss * (1.0f / 64.0f) + 1e-6f);
#pragma unroll
                    for (int bj = 0; bj < 2; ++bj)
#pragma unroll
                        for (int n = 0; n < 2; ++n) v[bj][n] = v[bj][n] * rs * gn[bj][n]; }
                bf16_t* db = dstb + (size_t)row * 1024 + cb;
#pragma unroll
                for (int bj = 0; bj < 2; ++bj) { u32x4 w; w.x = cvt_pk_bf16(v[bj][0][0], v[bj][0][1]); w.y = cvt_pk_bf16(v[bj][0][2], v[bj][0][3]); w.z = cvt_pk_bf16(v[bj][1][0], v[bj][1][1]); w.w = cvt_pk_bf16(v[bj][1][2], v[bj][1][3]);
                    *(u32x4*)(db + 32 * bj) = w; }
                if (reg >= 1) { float* op = nullptr;
                    if (u.pm < 32) op = okp + (size_t)(reg - 1) * kv_stride_p + (size_t)row * 1024 + cb; else if (row - 32 * BM < 8) op = oks + (size_t)(reg - 1) * kv_stride_s + (size_t)(row - 32 * BM) * 1024 + cb;
                    if (op) {
#pragma unroll
                        for (int bj = 0; bj < 2; ++bj) { *(f32x4*)(op + 32 * bj) = v[bj][0]; *(f32x4*)(op + 32 * bj + 4) = v[bj][1]; } } }
            }
    }
};
template <class Epi, class Sched, bool ALIGN_EPI = false, bool SP2 = false>
__device__ __forceinline__ void gemm_phase(PG8_LAS unsigned char* lds, const Gemm g, const Sched& S, const Epi& E) {
    int tid_ = threadIdx.x; asm volatile("" : "+v"(tid_));
    const int tid = tid_, wid = __builtin_amdgcn_readfirstlane(tid >> 6), lane = tid & 63, wr = wid >> 2, wc = wid & 3, fr = lane & 15, fq = lane >> 4;
    const int K = g.K, nt = K / BK;
    unsigned voffA[2], voffB[2];
#pragma unroll
    for (int i = 0; i < 2; ++i) { int R, C; stage_rc(tid * 16 + i * 8192, R, C); const int Rb = Epi::PERM ? ((R & ~31) + perm32(R & 31)) : R;
        voffA[i] = (unsigned)(R * K + C) * 2u; voffB[i] = (unsigned)(Rb * K + C) * 2u; }
    const size_t kstep = (size_t)(BK * 2);
    const size_t hstep = (size_t)HALF * K * 2;
    const size_t tstep = 2 * hstep;
    const unsigned ldsw = (unsigned)wid * 1024u;
    const int aoff = lds_byte(wr * 64 + fr, fq * 8), boff = lds_byte(wc * 32 + fr, fq * 8);
#define PG8_SA(b, h) (((b) * 2 + (h)) * HTB)
#define PG8_SB(b, h) ((4 + (b) * 2 + (h)) * HTB)
#define PG8_STAGE(bufoff, gbase, voff) do { _Pragma("unroll") for (int _i = 0; _i < 2; ++_i) \
        __builtin_amdgcn_global_load_lds((const unsigned*)((const char*)(gbase) + (voff)[_i]), (PG8_LAS unsigned*)(lds + (bufoff) + ldsw + _i * 8192), 16, 0, 0); } while (0)
#define PG8_LDA(dst, b, h) do { _Pragma("unroll") for (int m = 0; m < 4; ++m) _Pragma("unroll") for (int k = 0; k < 2; ++k) dst[m][k] = *(const PG8_LAS bf16x8*)(lds + PG8_SA(b, h) + aoff + m * 2048 + k * 1024); } while (0)
#define PG8_LDB(dst, b, h) do { _Pragma("unroll") for (int n = 0; n < 2; ++n) _Pragma("unroll") for (int k = 0; k < 2; ++k) dst[n][k] = *(const PG8_LAS bf16x8*)(lds + PG8_SB(b, h) + boff + n * 2048 + k * 1024); } while (0)
#define PG8_MMA(ai, bj, At, Bt) do { __builtin_amdgcn_s_setprio(1); _Pragma("unroll") for (int m = 0; m < 4; ++m) _Pragma("unroll") for (int n = 0; n < 2; ++n) _Pragma("unroll") for (int k = 0; k < 2; ++k) \
        acc[ai][bj][m][n] = __builtin_amdgcn_mfma_f32_16x16x32_bf16(Bt[n][k], At[m][k], acc[ai][bj][m][n], 0, 0, 0); __builtin_amdgcn_s_setprio(0); } while (0)
#define PG8_WAIT_V(n) asm volatile("s_waitcnt vmcnt(" #n ")" ::: "memory")
#define PG8_WAIT_L(n) asm volatile("s_waitcnt lgkmcnt(" #n ")" ::: "memory")
#define PG8_BAR __builtin_amdgcn_s_barrier()
#define PG8_SCHED __builtin_amdgcn_sched_barrier(0)
    Unit cur, nxt; int ui = 0;
    if (!S.next(0, cur)) return;
    f32x4 acc[2][2][4][2];
#pragma unroll
    for (int a = 0; a < 2; ++a)
#pragma unroll
        for (int b = 0; b < 2; ++b)
#pragma unroll
            for (int m = 0; m < 4; ++m)
#pragma unroll
                for (int n = 0; n < 2; ++n) acc[a][b][m][n] = (f32x4){0.f, 0.f, 0.f, 0.f};
    bf16x8 At[4][2], B0[2][2], B1[2][2];
    const char* cA = (const char*)g.A + (size_t)cur.pm * tstep; const char* cB = (const char*)g.Bt + (size_t)cur.pn * tstep;
    S.a_ready(cur);
    if constexpr (SP2) {
        PG8_STAGE(PG8_SB(0, 0), cB, voffB); PG8_STAGE(PG8_SB(0, 1), cB + hstep, voffB); PG8_STAGE(PG8_SA(0, 0), cA, voffA); PG8_STAGE(PG8_SA(0, 1), cA + hstep, voffA);
        if (wr == 1) PG8_BAR;
        PG8_WAIT_V(2); PG8_BAR;
        PG8_STAGE(PG8_SB(1, 0), cB + kstep, voffB); PG8_STAGE(PG8_SA(1, 0), cA + kstep, voffA); PG8_STAGE(PG8_SB(1, 1), cB + hstep + kstep, voffB);
        PG8_WAIT_V(6); PG8_BAR;
    } else {
        PG8_STAGE(PG8_SB(0, 0), cB, voffB); PG8_STAGE(PG8_SA(0, 0), cA, voffA); PG8_STAGE(PG8_SB(0, 1), cB + hstep, voffB); PG8_STAGE(PG8_SA(0, 1), cA + hstep, voffA);
        if (wr == 1) PG8_BAR;
        PG8_WAIT_V(4); PG8_BAR;
        PG8_STAGE(PG8_SB(1, 0), cB + kstep, voffB); PG8_STAGE(PG8_SA(1, 0), cA + kstep, voffA); PG8_STAGE(PG8_SB(1, 1), cB + hstep + kstep, voffB);
        PG8_WAIT_V(6); PG8_BAR;
    }
    for (;;) {
        const bool has_next = S.next(ui + 1, nxt);
        const char* nA = has_next ? (const char*)g.A + (size_t)nxt.pm * tstep : cA; const char* nB = has_next ? (const char*)g.Bt + (size_t)nxt.pn * tstep : cB;
        for (int t = 0; t < nt; t += 2) {
            const bool last = (t == nt - 2);
            const char* a1 = cA + (size_t)(t + 1) * kstep;
            const char* a2 = last ? nA : cA + (size_t)(t + 2) * kstep; const char* b2 = last ? nB : cB + (size_t)(t + 2) * kstep;
            const char* a3 = a2 + kstep; const char* b3 = b2 + kstep;
            if (last && has_next) S.a_ready(nxt);
            if constexpr (SP2) {
            PG8_LDB(B0, 0, 0); PG8_LDB(B1, 0, 1); PG8_SCHED; PG8_LDA(At, 0, 0); PG8_STAGE(PG8_SA(1, 1), a1 + hstep, voffA);
            PG8_WAIT_V(8); PG8_WAIT_L(0); PG8_BAR; PG8_MMA(0, 0, At, B0); PG8_MMA(0, 1, At, B1); PG8_BAR; PG8_SCHED;
            PG8_LDA(At, 0, 1); PG8_STAGE(PG8_SB(0, 0), b2, voffB); PG8_STAGE(PG8_SB(0, 1), b2 + hstep, voffB); PG8_STAGE(PG8_SA(0, 0), a2, voffA);
            PG8_WAIT_V(8); PG8_WAIT_L(0); PG8_BAR; PG8_MMA(1, 0, At, B0); PG8_MMA(1, 1, At, B1); PG8_BAR; PG8_SCHED;
            PG8_LDB(B0, 1, 0); PG8_LDB(B1, 1, 1); PG8_SCHED; PG8_LDA(At, 1, 0); PG8_STAGE(PG8_SA(0, 1), a2 + hstep, voffA);
            PG8_WAIT_V(8); PG8_WAIT_L(0); PG8_BAR; PG8_MMA(0, 0, At, B0); PG8_MMA(0, 1, At, B1); PG8_BAR; PG8_SCHED;
            PG8_LDA(At, 1, 1); PG8_STAGE(PG8_SB(1, 0), b3, voffB); PG8_STAGE(PG8_SB(1, 1), b3 + hstep, voffB); PG8_STAGE(PG8_SA(1, 0), a3, voffA);
            PG8_WAIT_V(8); PG8_WAIT_L(0); PG8_BAR; PG8_MMA(1, 0, At, B0); PG8_MMA(1, 1, At, B1); PG8_BAR; PG8_SCHED;
            } else {
            PG8_LDB(B0, 0, 0); PG8_SCHED; PG8_LDA(At, 0, 0); PG8_STAGE(PG8_SA(1, 1), a1 + hstep, voffA);
            PG8_WAIT_L(8); PG8_BAR; PG8_WAIT_L(0); PG8_MMA(0, 0, At, B0); PG8_BAR; PG8_SCHED;
            PG8_LDB(B1, 0, 1); PG8_STAGE(PG8_SB(0, 0), b2, voffB);
            PG8_BAR; PG8_WAIT_L(0); PG8_MMA(0, 1, At, B1); PG8_BAR;
            PG8_LDA(At, 0, 1); PG8_STAGE(PG8_SA(0, 0), a2, voffA);
            PG8_BAR; PG8_WAIT_L(0); PG8_MMA(1, 0, At, B0); PG8_BAR; PG8_SCHED;
            PG8_STAGE(PG8_SB(0, 1), b2 + hstep, voffB);
            PG8_WAIT_V(6); PG8_BAR; PG8_MMA(1, 1, At, B1); PG8_BAR;
            PG8_LDB(B0, 1, 0); PG8_SCHED; PG8_LDA(At, 1, 0); PG8_STAGE(PG8_SA(0, 1), a2 + hstep, voffA);
            PG8_WAIT_L(8); PG8_BAR; PG8_WAIT_L(0); PG8_MMA(0, 0, At, B0); PG8_BAR; PG8_SCHED;
            PG8_LDB(B1, 1, 1); PG8_STAGE(PG8_SB(1, 0), b3, voffB);
            PG8_BAR; PG8_WAIT_L(0); PG8_MMA(0, 1, At, B1); PG8_BAR;
            PG8_LDA(At, 1, 1); PG8_STAGE(PG8_SA(1, 0), a3, voffA);
            PG8_BAR; PG8_WAIT_L(0); PG8_MMA(1, 0, At, B0); PG8_BAR; PG8_SCHED;
            PG8_STAGE(PG8_SB(1, 1), b3 + hstep, voffB);
            PG8_WAIT_V(6); PG8_BAR; PG8_MMA(1, 1, At, B1); PG8_BAR;
            }
        }
        if constexpr (ALIGN_EPI) { if (wr == 0) PG8_BAR; }
        if constexpr (!Epi::AFTER_DRAIN) { E(acc, cur, wr, wc, fr, fq); S.done(cur); }
        if (!has_next) break;
#pragma unroll
        for (int a = 0; a < 2; ++a)
#pragma unroll
            for (int b = 0; b < 2; ++b)
#pragma unroll
                for (int m = 0; m < 4; ++m)
#pragma unroll
                    for (int n = 0; n < 2; ++n) acc[a][b][m][n] = (f32x4){0.f, 0.f, 0.f, 0.f};
        cur = nxt; cA = nA; cB = nB; ++ui;
        if constexpr (ALIGN_EPI) { if (wr == 1) PG8_BAR; }
    }
    PG8_WAIT_V(0);
    if constexpr (!ALIGN_EPI) { if (wr == 0) PG8_BAR; }
    PG8_BAR;
    if constexpr (Epi::AFTER_DRAIN) { E.fused(acc, cur, wr, wc, fr, fq, lds, wid, lane); S.done(cur); }
#undef PG8_SA
#undef PG8_SB
#undef PG8_STAGE
#undef PG8_LDA
#undef PG8_LDB
#undef PG8_MMA
#undef PG8_WAIT_V
#undef PG8_WAIT_L
#undef PG8_BAR
#undef PG8_SCHED
}
}
#define GAS __attribute__((address_space(1)))
#define LAS __attribute__((address_space(3)))
typedef unsigned short bf16;
typedef unsigned v4u __attribute__((ext_vector_type(4)));
typedef float f32x4 __attribute__((ext_vector_type(4)));
typedef short bf16x8 __attribute__((ext_vector_type(8)));
typedef GAS unsigned gu32;
typedef GAS unsigned long long gu64;
#define RLX_AGENT __ATOMIC_RELAXED, __HIP_MEMORY_SCOPE_AGENT
#define LDS_WAIT() asm volatile("s_waitcnt lgkmcnt(0)" ::: "memory")
#define VM_WAIT() asm volatile("s_waitcnt vmcnt(0)" ::: "memory")
__device__ __forceinline__ unsigned long long rt() { return __builtin_amdgcn_s_memrealtime(); }
__device__ __forceinline__ unsigned f2bf(float f) { unsigned u = __builtin_bit_cast(unsigned, f); return (u + 0x7fffu + ((u >> 16) & 1u)) >> 16; }
__device__ __forceinline__ unsigned pk2(float lo, float hi) { return f2bf(lo) | (f2bf(hi) << 16); }
#define XB_TMO      128
#define XB_XCNT(j)  (256  + 64 * (j))
#define XB_XSUB(j)  (1280 + 64 * (j))
#define XB_XGEN(j)  (2304 + 64 * (j))
#define XB_TOP      3328
#define XB_TOPGEN   3392
#define XCD_BAR_WORDS 3456
#define XB_SPIN_CAP (1u << 18)

__device__ __forceinline__ unsigned xb_ld(unsigned* p)              { return __hip_atomic_load(p, __ATOMIC_RELAXED, __HIP_MEMORY_SCOPE_AGENT); }
__device__ __forceinline__ unsigned xb_add(unsigned* p, unsigned v) { return __hip_atomic_fetch_add(p, v, __ATOMIC_RELAXED, __HIP_MEMORY_SCOPE_AGENT); }
__device__ __forceinline__ unsigned xb_xcc_id() { return (unsigned)__builtin_amdgcn_s_getreg((3 << 11) | 20) & 0xFu; }
#define XB_SPIN(cond, bar) do { unsigned _sp = 0; while (cond) { __builtin_amdgcn_s_sleep(1); \
    if ((++_sp & 255u) == 0u) { if (xb_ld(&(bar)[XB_TMO])) break; if (_sp > XB_SPIN_CAP) { atomicAdd(&(bar)[XB_TMO], 1u); break; } } } } while (0)

struct XcdBarrier {
    unsigned* bar; unsigned x;
    volatile LAS unsigned* st;
};

__device__ __forceinline__ XcdBarrier xcd_barrier_post(unsigned* bar, volatile LAS unsigned* st) {
    XcdBarrier b; b.bar = bar; b.x = xb_xcc_id(); b.st = st;
    if (threadIdx.x == 0) (void)xb_add(&bar[XB_XCNT(b.x)], 1u);
    return b;
}
__device__ __forceinline__ void xcd_barrier_complete(unsigned* bar, unsigned x, unsigned& nloc, unsigned& nx) {
    const unsigned G = gridDim.x * gridDim.y * gridDim.z;
    unsigned sum, cnt, mine, sp = 0u;
    for (;;) {
        sum = 0u; cnt = 0u; mine = 0u;
#pragma unroll
        for (unsigned j = 0; j < 16; ++j) { const unsigned c = xb_ld(&bar[XB_XCNT(j)]); sum += c; cnt += (c > 0u) ? 1u : 0u; mine = (j == x) ? c : mine; }
        if (sum == G) break;
        __builtin_amdgcn_s_sleep(1);
        if ((++sp & 255u) == 0u) { if (xb_ld(&bar[XB_TMO])) break; if (sp > XB_SPIN_CAP) { atomicAdd(&bar[XB_TMO], 1u); break; } }
    }
    nloc = mine > 0u ? mine : 1u; nx = cnt > 0u ? cnt : 1u;
}

__device__ __forceinline__ void xcd_barrier(const XcdBarrier& b) {
    asm volatile("s_waitcnt vmcnt(0)" ::: "memory");
    __syncthreads();
    if (threadIdx.x == 0) {
        unsigned* bar = b.bar;
        __builtin_amdgcn_s_waitcnt(0);
        unsigned nloc = b.st[0], nx = b.st[1];
        if (nloc == 0u) { xcd_barrier_complete(bar, b.x, nloc, nx); b.st[0] = nloc; b.st[1] = nx; }
        const unsigned old = xb_add(&bar[XB_XSUB(b.x)], 1u);
        const unsigned gen = old / nloc;
        if (old + 1u == (gen + 1u) * nloc) {
            __builtin_amdgcn_fence(__ATOMIC_RELEASE, "agent");
            asm volatile("s_waitcnt vmcnt(0)" ::: "memory");
            const unsigned og = xb_add(&bar[XB_TOP], 1u);
            const unsigned tg = og / nx;
            if (og + 1u == (tg + 1u) * nx) xb_add(&bar[XB_TOPGEN], 1u);
            else XB_SPIN(xb_ld(&bar[XB_TOPGEN]) == tg, bar);
            __builtin_amdgcn_fence(__ATOMIC_ACQUIRE, "agent");
            xb_add(&bar[XB_XGEN(b.x)], 1u);
            asm volatile("s_waitcnt vmcnt(0)" ::: "memory");
        } else {
            XB_SPIN(xb_ld(&bar[XB_XGEN(b.x)]) == gen, bar);
            __builtin_amdgcn_fence(__ATOMIC_ACQUIRE, "agent");
            asm volatile("s_waitcnt vmcnt(0)" ::: "memory");
        }
    }
    __syncthreads();
}

#ifndef MK_N_LAUNCHES
#define MK_N_LAUNCHES 1
#endif
#ifndef REP_P0
#define REP_P0 1
#endif
#ifndef REP_N1
#define REP_N1 1
#endif
#ifndef REP_PW
#define REP_PW 1
#endif
#ifndef REP_SCAN
#define REP_SCAN 1
#endif
#ifndef REP_ATT
#define REP_ATT 1
#endif
#ifndef REP_SATT
#define REP_SATT 1
#endif
#ifndef REP_MX
#define REP_MX 1
#endif
#ifndef REP_N2
#define REP_N2 1
#endif
#ifndef REP_G3
#define REP_G3 1
#endif
#ifndef REP_G2
#define REP_G2 1
#endif
#ifndef REP_G4
#define REP_G4 1
#endif
#ifndef REP_BAR
#define REP_BAR 1
#endif
#ifndef REP_G1
#define REP_G1 1
#endif
#ifndef REP_PWL
#define REP_PWL 1
#endif
#ifndef REP_PWM
#define REP_PWM 1
#endif
#ifndef REP_PWR
#define REP_PWR 1
#endif
constexpr int NWAVES = 8, NTHR = 512;
constexpr int DM = 2048, SEQ = 2048, PBATCH = 4, SBATCH = 8, DEPTH = 4, NHEADS = 16, HD = 64, DATT = 1024, DRW = 1024, FF = 5632;
constexpr int MP = PBATCH * SEQ;
constexpr int ROW_S = MP;
constexpr int ROW_SS = MP + 8;
constexpr int NROWS = MP + 8;
constexpr int MH = MP + 256;
constexpr int N1 = 6912;
constexpr int PC0 = 6144, PP0 = 6144 + 384;
constexpr int NLORA = 320;
constexpr int MODW = 6 * DM;
constexpr float RMS_EPS = 1e-6f, GN_EPS = 64e-5f, ATT_SCALE = 0.125f;

enum { I_XP = 0, I_XS, I_CP, I_CS, I_CK, I_CV, I_SWKV, I_SSH, I_RELB, I_ADAW, I_ADAB, I_N1G, I_N2G, I_WIN, I_QG, I_KG, I_MUWAG, I_MURKV,
       I_DW0, I_DW1, I_DW2, I_AA0, I_AW1, I_AW2, I_GW1, I_GW2, I_VMU, I_VV0, I_VW1, I_VW2, I_KK, I_KA, I_RK, I_LNG, I_LNB, I_WOUT, I_WGU, I_WDN, N_IN };
constexpr size_t O_YP = 0, O_YS = O_YP + (size_t)MP * DM, O_KP = O_YS + 8 * DM, O_VP = O_KP + (size_t)DEPTH * MP * DATT, O_WP = O_VP + (size_t)DEPTH * MP * DATT,
                 O_SP = O_WP + (size_t)DEPTH * PBATCH * 16 * 4096, O_KS = O_SP + (size_t)DEPTH * PBATCH * DM, O_VS = O_KS + (size_t)DEPTH * 8 * DATT, O_WS = O_VS + (size_t)DEPTH * 8 * DATT,
                 O_SS = O_WS + (size_t)DEPTH * 8 * 16 * 4096, O_END = O_SS + (size_t)DEPTH * 8 * DM;
static_assert(O_END == 87212032, "output size");

constexpr size_t MiB = 1u << 20;
constexpr size_t WS_CTL = 0, CTL_ZERO_BYTES = 1 * MiB;
constexpr size_t WS_MOD = 1 * MiB;
constexpr size_t WS_BT = 4 * MiB;
constexpr size_t WS_WIN = 8 * MiB;
constexpr size_t WS_WOUT = 116 * MiB;
constexpr size_t WS_WGU = 148 * MiB;
constexpr size_t WS_WDN = 324 * MiB;
constexpr size_t WS_HB = 412 * MiB;
constexpr size_t WS_W2T = 5 * MiB;
constexpr size_t WS_RKV = 446 * MiB;
constexpr size_t WS_P = 546 * MiB;
constexpr size_t WS_QB = 670 * MiB, WS_KB = 687 * MiB, WS_VB = 704 * MiB;
constexpr size_t WS_R = 722 * MiB, WS_W = 755 * MiB, WS_K = 788 * MiB, WS_V = 821 * MiB, WS_A = 854 * MiB, WS_B = 887 * MiB, WS_G = 920 * MiB, WS_VF = 953 * MiB;
constexpr size_t WS_Y = 986 * MiB;
constexpr size_t WS_OBR = 1019 * MiB;
constexpr size_t WS_LSE = 1067 * MiB;
constexpr size_t WS_MIX = 1069 * MiB;
constexpr size_t WS_XB = 1102 * MiB;
constexpr size_t WS_ACT = 1168 * MiB;
constexpr size_t WS_END = 1260 * MiB;
static_assert(WS_WIN + (size_t)DEPTH * N1 * DM * 2 <= WS_WOUT && WS_WGU + (size_t)DEPTH * 2 * FF * DM * 2 <= WS_WDN && WS_WDN + (size_t)DEPTH * DM * FF * 2 <= WS_HB, "ws map (weights)");
static_assert(WS_VB - WS_KB == WS_KB - WS_QB, "q | k | v bf16 buffers are equally spaced");
static_assert(WS_HB + (size_t)MH * DM * 2 <= WS_RKV && WS_RKV + (size_t)MH * 3072 * 4 <= WS_P && WS_P + (size_t)MH * 768 * 4 <= WS_QB && WS_W2T + (size_t)DEPTH * 1024 * 320 * 2 <= WS_WIN && WS_QB + (size_t)MH * DATT * 2 <= WS_KB && WS_VB + (size_t)MH * DATT * 2 <= WS_R, "ws map (act 1)");
static_assert(WS_R + (size_t)NROWS * DRW * 4 <= WS_W && WS_Y + (size_t)NROWS * DRW * 4 <= WS_OBR && WS_OBR + (size_t)3 * MP * DATT * 2 <= WS_LSE && WS_LSE + (size_t)3 * MP * 16 * 4 <= WS_MIX, "ws map (act 2)");
static_assert(WS_MIX + (size_t)MH * DM * 2 <= WS_XB && WS_XB + (size_t)MH * DM * 4 <= WS_ACT && WS_ACT + (size_t)MH * FF * 2 <= WS_END, "ws map (act 3)");
constexpr int CW_BAR = 4096;

constexpr int RING_BYTES = 131072;
constexpr int LDSCTL_OFF = RING_BYTES, MISC_OFF = LDSCTL_OFF + 320;
constexpr int LDS_BYTES = 147456;

constexpr int PH_PER_LAYER = 9, N_PHASES = 1 + DEPTH * PH_PER_LAYER;

struct Args { const float* in[N_IN]; float* out; unsigned char* ws; int ph_lo, ph_hi; };
static_assert(sizeof(Args) == N_IN * 8 + 24, "Args has no padding");

__device__ __forceinline__ float wave_sum(float v) {
#pragma unroll
    for (int o = 1; o < 64; o <<= 1) v += __shfl_xor(v, o);
    return v;
}
__device__ __forceinline__ float wave_max(float v) {
#pragma unroll
    for (int o = 1; o < 64; o <<= 1) v = fmaxf(v, __shfl_xor(v, o));
    return v;
}
template <int CTRL> __device__ __forceinline__ float dpp_mov(float v) { return __builtin_bit_cast(float, __builtin_amdgcn_update_dpp(0, __builtin_bit_cast(int, v), CTRL, 0xf, 0xf, false)); }
__device__ __forceinline__ float row16_sum(float v) {
    v += dpp_mov<0xB1>(v);
    v += dpp_mov<0x4E>(v);
    v += dpp_mov<0x141>(v);
    v += dpp_mov<0x140>(v);
    return v;
}
__device__ __forceinline__ float bf2f(unsigned short b) { return __builtin_bit_cast(float, (unsigned)b << 16); }
__device__ __forceinline__ f32x4 ld4bf(const bf16* p) { const unsigned long long w = *(const unsigned long long*)p; return (f32x4){__builtin_bit_cast(float, (unsigned)w << 16), __builtin_bit_cast(float, (unsigned)w & 0xffff0000u), __builtin_bit_cast(float, (unsigned)(w >> 32) << 16), __builtin_bit_cast(float, (unsigned)(w >> 32) & 0xffff0000u)}; }
__device__ __forceinline__ f32x4 up4bf(unsigned long long w) { return (f32x4){__builtin_bit_cast(float, (unsigned)w << 16), __builtin_bit_cast(float, (unsigned)w & 0xffff0000u), __builtin_bit_cast(float, (unsigned)(w >> 32) << 16), __builtin_bit_cast(float, (unsigned)(w >> 32) & 0xffff0000u)}; }
__device__ __forceinline__ void st4bf(bf16* p, f32x4 v) { *(unsigned long long*)p = (unsigned long long)pk2(v[0], v[1]) | ((unsigned long long)pk2(v[2], v[3]) << 32); }
__device__ __forceinline__ float sigmoidf_(float x) { return 1.0f / (1.0f + __expf(-x)); }

__device__ __forceinline__ void p0_transpose_item(const float* W, int N, int k0, int n0, bf16* WT, int ldt, int drow0, const float* mu, int smode, LAS float* scr, int lane, int kdst = -1, int krows = 64) {
    if (kdst < 0) kdst = k0;
    float vals[32];
#pragma unroll
    for (int i = 0; i < 32; ++i) { const int kk = 2 * i + (lane >> 5); vals[i] = W[(size_t)(k0 + ((kk < krows) ? kk : krows - 1)) * N + n0 + (lane & 31)]; }
    if (smode) {
#pragma unroll
        for (int i = 0; i < 32; ++i) { const int kk = 2 * i + (lane >> 5); const float mm = mu[k0 + ((kk < krows) ? kk : krows - 1)]; vals[i] *= (smode == 1) ? (1.0f - mm) : mm; } }
#pragma unroll
    for (int i = 0; i < 32; ++i) { const int kk = 2 * i + (lane >> 5); scr[kk * 33 + (lane & 31)] = (kk < krows) ? vals[i] : 0.f; }
    LDS_WAIT(); asm volatile("" ::: "memory");
    const int c = lane & 7;
    if (8 * c < krows) {
#pragma unroll
        for (int j = 0; j < 4; ++j) { const int n = (lane >> 3) + 8 * j; const LAS float* s = scr + (8 * c) * 33 + n;
            v4u o; o.x = pk2(s[0 * 33], s[1 * 33]); o.y = pk2(s[2 * 33], s[3 * 33]); o.z = pk2(s[4 * 33], s[5 * 33]); o.w = pk2(s[6 * 33], s[7 * 33]);
            *(GAS v4u*)(WT + (size_t)(drow0 + n) * ldt + kdst + 8 * c) = o; }
    }
    LDS_WAIT(); asm volatile("" ::: "memory");
}
__device__ __forceinline__ int rel_bucket(int d) {
    if (d < 16) return d;
    const int large = 16 + (int)(logf((float)d / 16.0f) / logf(128.0f) * 16.0f);
    return large < 31 ? large : 31;
}
constexpr int I_IN = (DM / 64) * (6144 / 32), I_LD = (DM / 64) * 2, I_LG = (DM / 64) * 5, I_LV = (DM / 64) * 1, I_OUT = (DM / 64) * (DM / 32), I_GU = (DM / 64) * (2 * FF / 32), I_DN = (FF / 64) * (DM / 32);
constexpr int I_W2 = 32 * 6;
constexpr int I_LAYER = I_IN + 2 * (2 * I_LD + I_LG + I_LV) + I_W2 + I_OUT + I_GU + I_DN;
constexpr int CONV_BATCH = 32, N_CONV_BATCHES = (I_LAYER + CONV_BATCH - 1) / CONV_BATCH, N_MOD_ITEMS = MODW / 256, N_PREP_ITEMS = N_MOD_ITEMS + N_CONV_BATCHES;
constexpr int TAIL_PULLS = 3;
constexpr int CW_Q = 8192;
__device__ __forceinline__ void mod_block_item(const Args& args, int l, int c0, LAS unsigned char* lds, int tid, int lane, int wave) {
    unsigned char* ws = args.ws; float* MOD = (float*)(ws + WS_MOD);
        LAS float* sl = (LAS float*)lds;
        __syncthreads();
        for (int i = tid; i < 12 * DM; i += NTHR) { const int bb = i / DM, k = i % DM; const float c = (bb < 4) ? args.in[I_CP][bb * DM + k] : args.in[I_CS][(bb - 4) * DM + k];
            sl[k * 12 + bb] = c / (1.0f + __expf(-c)); }
        __syncthreads();
        const float* Wl = args.in[I_ADAW] + (size_t)l * DM * MODW + c0 + 4 * lane;
        f32x4 acc[12];
#pragma unroll
        for (int bb = 0; bb < 12; ++bb) acc[bb] = (f32x4){0.f, 0.f, 0.f, 0.f};
        const int kb = wave * 256;
#pragma unroll 1
        for (int k0 = kb; k0 < kb + 256; k0 += 16) {
            f32x4 wv[16];
#pragma unroll
            for (int i = 0; i < 16; ++i) wv[i] = *(const f32x4*)(Wl + (size_t)(k0 + i) * MODW);
#pragma unroll
            for (int i = 0; i < 16; ++i) { const int k = k0 + i; const f32x4 w = wv[i];
                const f32x4 s0 = *(const LAS f32x4*)(sl + k * 12), s1 = *(const LAS f32x4*)(sl + k * 12 + 4), s2 = *(const LAS f32x4*)(sl + k * 12 + 8);
                acc[0] += w * s0.x; acc[1] += w * s0.y; acc[2] += w * s0.z; acc[3] += w * s0.w;
                acc[4] += w * s1.x; acc[5] += w * s1.y; acc[6] += w * s1.z; acc[7] += w * s1.w;
                acc[8] += w * s2.x; acc[9] += w * s2.y; acc[10] += w * s2.z; acc[11] += w * s2.w; }
        }
        __syncthreads();
        LAS float* part = (LAS float*)lds;
#pragma unroll
        for (int bb = 0; bb < 12; ++bb) *(LAS f32x4*)(part + (wave * 12 + bb) * 256 + 4 * lane) = acc[bb];
        __syncthreads();
        for (int i = tid; i < 12 * 256; i += NTHR) { const int bb = i / 256, c = i % 256; float s = args.in[I_ADAB][l * MODW + c0 + c];
#pragma unroll
            for (int w = 0; w < 8; ++w) s += part[(w * 12 + bb) * 256 + c];
            MOD[((size_t)l * 12 + bb) * MODW + c0 + c] = s; }
        __syncthreads();
}
__device__ __forceinline__ void conv_wave_item(const Args& args, int l, int r, LAS float* scr, int lane) {
    unsigned char* ws = args.ws;
    bf16* WIN = (bf16*)(ws + WS_WIN) + (size_t)l * N1 * DM;
    const float* W = nullptr; int N = 0, k0 = 0, n0 = 0, ldt = DM, drow0 = 0, smode = 0, kdst = -1, krows = 64; bf16* WT = WIN; const float* mu = nullptr; bool skip = false;
    constexpr int LH = 2 * I_LD + I_LG + I_LV;
    if (r < I_IN) { const int nblk = 6144 / 32, kbk = r / nblk, nb = r % nblk; n0 = 32 * nb; k0 = 64 * kbk;
        drow0 = 256 * (n0 / 256) + 128 * ((n0 % 64) / 32) + 32 * ((n0 % 256) / 64);
        W = args.in[I_WIN] + (size_t)l * DM * 6144; N = 6144; }
    else if ((r -= I_IN) < 2 * LH) {
        const int half = r / LH, base = half ? PP0 : PC0; int q = r % LH; smode = 1 + half;
        if (q < I_LD) { W = args.in[I_DW1] + (size_t)l * DM * 64; N = 64; k0 = 64 * (q / 2); n0 = 32 * (q % 2); drow0 = base + 0 + n0; mu = args.in[I_MUWAG] + ((size_t)l * 3 + 0) * DM; }
        else if ((q -= I_LD) < I_LD) { W = args.in[I_AW1] + (size_t)l * DM * 64; N = 64; k0 = 64 * (q / 2); n0 = 32 * (q % 2); drow0 = base + 64 + n0; mu = args.in[I_MUWAG] + ((size_t)l * 3 + 1) * DM; }
        else if ((q -= I_LD) < I_LG) { W = args.in[I_GW1] + (size_t)l * DM * 160; N = 160; k0 = 64 * (q / 5); n0 = 32 * (q % 5); drow0 = base + 128 + n0; mu = args.in[I_MUWAG] + ((size_t)l * 3 + 2) * DM; }
        else { q -= I_LG; if (l > 0) { W = args.in[I_VW1] + (size_t)(l - 1) * DM * 32; N = 32; k0 = 64 * q; n0 = 0; drow0 = base + 288; mu = args.in[I_VMU] + (size_t)(l - 1) * DM; } else skip = true; } }
    else if ((r -= 2 * LH) < I_W2) { const int kb = r / 32; n0 = 32 * (r % 32); N = DRW; WT = (bf16*)(ws + WS_W2T) + (size_t)l * 1024 * NLORA; ldt = NLORA; drow0 = n0; k0 = 0;
        if (kb == 0) { W = args.in[I_DW2] + (size_t)l * 64 * DRW; kdst = 0; }
        else if (kb == 1) { W = args.in[I_AW2] + (size_t)l * 64 * DRW; kdst = 64; }
        else if (kb < 5) { W = args.in[I_GW2] + (size_t)l * 160 * DRW; k0 = 64 * (kb - 2); kdst = 128 + 64 * (kb - 2); krows = (kb == 4) ? 32 : 64; }
        else if (l > 0) { W = args.in[I_VW2] + (size_t)(l - 1) * 32 * DRW; kdst = 288; krows = 32; } else skip = true; }
    else if ((r -= I_W2) < I_OUT) { const int nblk = DM / 32; k0 = 64 * (r / nblk); n0 = 32 * (r % nblk); W = args.in[I_WOUT] + (size_t)l * DM * DM; N = DM; WT = (bf16*)(ws + WS_WOUT) + (size_t)l * DM * DM; drow0 = n0; }
    else if ((r -= I_OUT) < I_GU) { const int nblk = 2 * FF / 32; k0 = 64 * (r / nblk); n0 = 32 * (r % nblk);
        const int nn = (n0 < FF) ? n0 : n0 - FF; drow0 = 256 * (nn / 128) + (nn % 128) + ((n0 < FF) ? 0 : 128);
        W = args.in[I_WGU] + (size_t)l * DM * 2 * FF; N = 2 * FF; WT = (bf16*)(ws + WS_WGU) + (size_t)l * 2 * FF * DM; }
    else { r -= I_GU; const int nblk = DM / 32; k0 = 64 * (r / nblk); n0 = 32 * (r % nblk); W = args.in[I_WDN] + (size_t)l * FF * DM; N = DM; WT = (bf16*)(ws + WS_WDN) + (size_t)l * DM * FF; ldt = FF; drow0 = n0; }
    if (!skip) p0_transpose_item(W, N, k0, n0, WT, ldt, drow0, mu, smode, scr, lane, kdst, krows);
}
__device__ __forceinline__ void prep_item(const Args& args, int l, int item, LAS unsigned char* lds, int tid, int lane, int wave) {
    if (item < N_MOD_ITEMS) { mod_block_item(args, l, item * 256, lds, tid, lane, wave); return; }
    __syncthreads();
    LAS float* scr = (LAS float*)(lds + wave * 16384); const int r0 = (item - N_MOD_ITEMS) * CONV_BATCH + wave * (CONV_BATCH / NWAVES);
#pragma unroll 1
    for (int k = 0; k < CONV_BATCH / NWAVES; ++k) if (r0 + k < I_LAYER) conv_wave_item(args, l, r0 + k, scr, lane);
}
__device__ __forceinline__ void prep_layer_all(const Args& args, int l, LAS unsigned char* lds, int vcu, int G) {
    int tid_ = threadIdx.x; asm volatile("" : "+v"(tid_)); const int tid = tid_, lane = tid & 63, wave = __builtin_amdgcn_readfirstlane(tid >> 6);
#pragma unroll 1
    for (int it = vcu; it < N_PREP_ITEMS; it += G) prep_item(args, l, it, lds, tid, lane, wave);
    __syncthreads();
}
__device__ __forceinline__ void prep_layer_pull(const Args& args, int l, int kind, int max_items, LAS unsigned char* lds, volatile LAS unsigned* bcast) {
    int tid_ = threadIdx.x; asm volatile("" : "+v"(tid_)); const int tid = tid_, lane = tid & 63, wave = __builtin_amdgcn_readfirstlane(tid >> 6);
    unsigned* ctr = (unsigned*)(args.ws + WS_CTL) + CW_Q + 64 * (4 * kind + l); const int n_items = kind ? N_MOD_ITEMS : N_CONV_BATCHES;
#pragma unroll 1
    for (int k = 0; k < max_items; ++k) {
        __syncthreads();
        if (tid == 0) *bcast = __hip_atomic_fetch_add(ctr, 1u, __ATOMIC_RELAXED, __HIP_MEMORY_SCOPE_AGENT);
        __syncthreads();
        const int item = (int)*bcast;
        if (item >= n_items) break;
        prep_item(args, l, kind ? item : N_MOD_ITEMS + item, lds, tid, lane, wave);
    }
    __syncthreads();
}
__device__ __forceinline__ void p0_prologue(const Args& args, LAS unsigned char* lds, int vcu, int G, volatile LAS unsigned* bcast) {
    if (vcu == G - 1) {
        float* BT = (float*)(args.ws + WS_BT);
        for (int i = threadIdx.x; i < 3 * 129 * 16; i += NTHR) { const int h = i & 15, m = (i >> 4) % 129, br = (i >> 4) / 129; BT[i] = args.in[I_RELB][rel_bucket(m << (2 * br)) * 16 + h]; }
    }
    prep_layer_pull(args, 0, 1, 1 << 30, lds, bcast); prep_layer_pull(args, 0, 0, 1 << 30, lds, bcast);
}

__device__ __forceinline__ void norm_mod_row(const float* xrow, const float* g, const float* sh, const float* sc, bf16* hrow, float* frow, int lane) {
    const GAS f32x4* xr = (const GAS f32x4*)xrow + lane;
    f32x4 v[8]; float s = 0.f;
#pragma unroll
    for (int j = 0; j < 8; ++j) { v[j] = xr[64 * j]; s += (v[j].x * v[j].x + v[j].y * v[j].y) + (v[j].z * v[j].z + v[j].w * v[j].w); }
    const float rstd = 1.0f / sqrtf(wave_sum(s) * (1.0f / DM) + RMS_EPS);
    GAS unsigned long long* o8 = (GAS unsigned long long*)hrow + lane;
#pragma unroll
    for (int j = 0; j < 8; ++j) { const f32x4 g4 = ((const GAS f32x4*)g)[lane + 64 * j], sh4 = ((const GAS f32x4*)sh)[lane + 64 * j], sc4 = ((const GAS f32x4*)sc)[lane + 64 * j];
        const f32x4 h = (v[j] * rstd * g4) * (sc4 + 1.0f) + sh4;
        o8[64 * j] = (unsigned long long)pk2(h.x, h.y) | ((unsigned long long)pk2(h.z, h.w) << 32);
        if (frow) ((GAS f32x4*)frow)[lane + 64 * j] = h; }
}

__device__ __forceinline__ void pw_phase(const Args& args, int l, LAS unsigned char* lds, int vcu, int G) {
    int tid_ = threadIdx.x; asm volatile("" : "+v"(tid_)); const int tid = tid_, lane = tid & 63, wave = __builtin_amdgcn_readfirstlane(tid >> 6);
    typedef float f32x16 __attribute__((ext_vector_type(16)));
    unsigned char* ws = args.ws;
    const bf16* RKV = (const bf16*)(ws + WS_RKV); const float* P = (const float*)(ws + WS_P); const bf16* W2T = (const bf16*)(ws + WS_W2T) + (size_t)l * 1024 * NLORA;
    bf16* Rr = (bf16*)(ws + WS_R); float* Ww = (float*)(ws + WS_W); bf16* Kk = (bf16*)(ws + WS_K); bf16* Vv = (bf16*)(ws + WS_V);
    bf16* Aa = (bf16*)(ws + WS_A); bf16* Bb = (bf16*)(ws + WS_B); bf16* Gg = (bf16*)(ws + WS_G); float* VF = (float*)(ws + WS_VF);
    constexpr int LST = 328, SST = 68;
    LAS unsigned short* L = (LAS unsigned short*)lds;
    LAS float* Sw = (LAS float*)(lds + 21504) + wave * (32 * SST);
    const int r32 = lane & 31, hf = lane >> 5, rs = lane >> 4, c4 = (lane & 15) * 4;
    const float* mur = args.in[I_MURKV] + (size_t)l * 3 * DRW;
    for (int tile = vcu; tile < 257; tile += G) {
        const int m0 = tile < 256 ? tile * 32 : MP, nv = tile < 256 ? 32 : 8;
        __syncthreads();
        for (int repl = 0; repl < REP_PWL; ++repl)
#pragma unroll 10
        for (int i = tid; i < 32 * NLORA; i += NTHR) { const int r = i / NLORA, c = i % NLORA; const int m = m0 + ((r < nv) ? r : nv - 1);
            const int pm = (m < MP) ? (((m & (SEQ - 1)) == 0) ? -1 : m - 1) : m + 8;
            const float v = P[(size_t)m * 768 + c] + ((pm >= 0) ? 1.f : 0.f) * P[(size_t)((pm >= 0) ? pm : m) * 768 + 384 + c];
            const float e2 = __expf(2.0f * v), th = 1.0f - 2.0f / (1.0f + e2), sg = 1.0f / (1.0f + __expf(-v));
            L[r * LST + c] = (unsigned short)f2bf((c < 64) ? th : ((c >= 128 && c < 288) ? sg : v)); }
        __syncthreads();
        const bf16* w2a = W2T + (size_t)(128 * wave + r32) * NLORA + 8 * hf; const LAS unsigned short* lb = L + r32 * LST + 8 * hf;
        f32x16 acc[4];
#define PW_MM(koff, nks, CH) do { for (int repm = 0; repm < REP_PWM; ++repm) { _Pragma("unroll") for (int nt = 0; nt < 4; ++nt) acc[nt] = (f32x16){0.f}; \
        _Pragma("unroll 1") for (int kp = 0; kp < (nks); kp += (CH)) { bf16x8 bl[CH], aw[CH][4]; \
            _Pragma("unroll") for (int k2 = 0; k2 < (CH); ++k2) { bl[k2] = *(const LAS bf16x8*)(lb + (koff) + 16 * (kp + k2)); \
                _Pragma("unroll") for (int nt = 0; nt < 4; ++nt) aw[k2][nt] = *(const bf16x8*)(w2a + (size_t)(32 * nt) * NLORA + (koff) + 16 * (kp + k2)); } \
            _Pragma("unroll") for (int k2 = 0; k2 < (CH); ++k2) _Pragma("unroll") for (int nt = 0; nt < 4; ++nt) acc[nt] = __builtin_amdgcn_mfma_f32_32x32x16_bf16(aw[k2][nt], bl[k2], acc[nt], 0, 0, 0); } } } while (0)
#define PW_STAGE(hp) do { _Pragma("unroll") for (int n2 = 0; n2 < 2; ++n2) _Pragma("unroll") for (int g = 0; g < 4; ++g) \
            *(LAS f32x4*)(Sw + r32 * SST + 32 * n2 + 8 * g + 4 * hf) = (f32x4){acc[2 * (hp) + n2][4 * g], acc[2 * (hp) + n2][4 * g + 1], acc[2 * (hp) + n2][4 * g + 2], acc[2 * (hp) + n2][4 * g + 3]}; } while (0)
#define PW_AV(it) (*(const LAS f32x4*)(Sw + (4 * (it) + rs) * SST + c4))
        const unsigned vo1_ = (unsigned)(rs * DRW + c4), vo3_ = (unsigned)(rs * 3072 + c4);
#define PW_LOCAL_OFFS unsigned vo1 = vo1_, vo3 = vo3_; asm volatile("" : "+v"(vo1), "+v"(vo3)); (void)vo3;
        const int pd = (tile < 256) ? -1 : 8;
        const float pm0 = (tile < 256 && (m0 & (SEQ - 1)) == 0 && rs == 0) ? 0.f : 1.f;
        PW_MM(0, 4, 4);
#pragma unroll
        for (int hp = 0; hp < 2; ++hp) { PW_LOCAL_OFFS const int chu = 128 * wave + 64 * hp; const f32x4 w0 = *(const f32x4*)(args.in[I_DW0] + (size_t)l * DRW + chu + c4);
            PW_STAGE(hp);
#pragma unroll
            for (int it = 0; it < 8; ++it) { const f32x4 x = w0 + PW_AV(it); f32x4 o;
#pragma unroll
                for (int e = 0; e < 4; ++e) { const float sp = fmaxf(-x[e], 0.f) + __logf(1.0f + __expf(-fabsf(x[e]))); o[e] = __expf(-__expf(-sp - 0.5f)); }
                *(f32x4*)(Ww + (size_t)(m0 + 4 * it) * DRW + chu + vo1) = o; } }
        if (l > 0) PW_MM(288, 2, 2);
#pragma unroll
        for (int hp = 0; hp < 2; ++hp) { PW_LOCAL_OFFS const int chu = 128 * wave + 64 * hp; const f32x4 mu2 = *(const f32x4*)(mur + 2 * DRW + chu + c4); f32x4 v0 = (f32x4){0.f, 0.f, 0.f, 0.f};
            if (l > 0) v0 = *(const f32x4*)(args.in[I_VV0] + (size_t)(l - 1) * DRW + chu + c4);
            PW_STAGE(hp);
#pragma unroll
            for (int half = 0; half < 2; ++half) { unsigned long long x0[4], xp[4]; f32x4 vf[4];
#pragma unroll
              for (int i = 0; i < 4; ++i) { const int it = 4 * half + i; const bf16* a_ = RKV + (size_t)(m0 + 4 * it) * 3072 + 2048 + chu; const bf16* b_ = RKV + ((size_t)(m0 + 4 * it) + pd) * 3072 + 2048 + chu;
                  x0[i] = *(const unsigned long long*)(a_ + vo3); xp[i] = *(const unsigned long long*)(b_ + vo3);
                  vf[i] = (l > 0) ? *(const f32x4*)(VF + (size_t)(m0 + 4 * it) * DRW + chu + vo1) : (f32x4){0.f, 0.f, 0.f, 0.f}; }
#pragma unroll
              for (int i = 0; i < 4; ++i) { const int it = 4 * half + i; const f32x4 xc = up4bf(x0[i]); f32x4 vr = xc + (up4bf(xp[i]) * ((it == 0) ? pm0 : 1.f) - xc) * mu2;
                  if (l > 0) { const f32x4 x = v0 + PW_AV(it); f32x4 vg;
#pragma unroll
                      for (int e = 0; e < 4; ++e) vg[e] = sigmoidf_(x[e]);
                      vr = vr + (vf[i] - vr) * vg; }
                  else *(f32x4*)(VF + (size_t)(m0 + 4 * it) * DRW + chu + vo1) = vr;
                  st4bf(Vv + (size_t)(m0 + 4 * it) * DRW + chu + vo1, vr); }
            } }
        PW_MM(128, 10, 2);
#pragma unroll
        for (int hp = 0; hp < 2; ++hp) { PW_LOCAL_OFFS const int chu = 128 * wave + 64 * hp;
            PW_STAGE(hp);
#pragma unroll
            for (int it = 0; it < 8; ++it) st4bf(Gg + (size_t)(m0 + 4 * it) * DRW + chu + vo1, PW_AV(it)); }
        PW_MM(64, 4, 4);
#pragma unroll
        for (int hp = 0; hp < 2; ++hp) { PW_LOCAL_OFFS const int chu = 128 * wave + 64 * hp;
            const f32x4 a0 = *(const f32x4*)(args.in[I_AA0] + (size_t)l * DRW + chu + c4), kk4 = *(const f32x4*)(args.in[I_KK] + (size_t)l * DRW + chu + c4), ka4 = *(const f32x4*)(args.in[I_KA] + (size_t)l * DRW + chu + c4);
            const f32x4 mu0 = *(const f32x4*)(mur + chu + c4), mu1 = *(const f32x4*)(mur + DRW + chu + c4);
            PW_STAGE(hp);
#pragma unroll
            for (int half = 0; half < 2; ++half) { unsigned long long k0[4], kp[4], r0[4], rp[4];
#pragma unroll
              for (int i = 0; i < 4; ++i) { const int it = 4 * half + i; const bf16* a_ = RKV + (size_t)(m0 + 4 * it) * 3072 + chu; const bf16* b_ = RKV + ((size_t)(m0 + 4 * it) + pd) * 3072 + chu;
                  k0[i] = *(const unsigned long long*)(a_ + 1024 + vo3); kp[i] = *(const unsigned long long*)(b_ + 1024 + vo3); r0[i] = *(const unsigned long long*)(a_ + vo3); rp[i] = *(const unsigned long long*)(b_ + vo3); }
#pragma unroll
              for (int i = 0; i < 4; ++i) { const int it = 4 * half + i; const size_t ou = (size_t)(m0 + 4 * it) * DRW + chu; const float pmask = (it == 0) ? pm0 : 1.f;
                  const f32x4 x = a0 + PW_AV(it); f32x4 a;
#pragma unroll
                  for (int e = 0; e < 4; ++e) a[e] = sigmoidf_(x[e]);
                  const f32x4 kc = up4bf(k0[i]), rc = up4bf(r0[i]);
                  const f32x4 kr = kc + (up4bf(kp[i]) * pmask - kc) * mu1; f32x4 q = kr * kk4;
                  const float s = row16_sum((q[0] * q[0] + q[1] * q[1]) + (q[2] * q[2] + q[3] * q[3]));
                  q = q * (1.0f / fmaxf(sqrtf(s), 1e-12f));
                  st4bf(Kk + ou + vo1, kr * ((a - 1.0f) * ka4 + 1.0f)); st4bf(Aa + ou + vo1, -q); st4bf(Bb + ou + vo1, q * a); st4bf(Rr + ou + vo1, rc + (up4bf(rp[i]) * pmask - rc) * mu0); }
            } }
#undef PW_MM
#undef PW_STAGE
#undef PW_AV
#undef PW_LOCAL_OFFS
    }
}

constexpr int MST = 144, MSLOT = 64 * MST;
__device__ __forceinline__ bf16x8 mfr_row(const LAS unsigned char* M, int row, int k0, int g) { return *(const LAS bf16x8*)(M + row * MST + (k0 + 8 * g) * 2); }
__device__ __forceinline__ bf16x8 mfr_tr(const LAS unsigned char* M, int k0, int col0, int g, int q) {
    typedef short v4i16 __attribute__((ext_vector_type(4)));
    const LAS unsigned char* p = M + (k0 + 8 * g + (q >> 2)) * MST + (col0 + 4 * (q & 3)) * 2;
    const v4i16 lo = __builtin_amdgcn_ds_read_tr16_b64_v4i16((LAS v4i16*)p), hi = __builtin_amdgcn_ds_read_tr16_b64_v4i16((LAS v4i16*)(p + 4 * MST));
    return (bf16x8){lo[0], lo[1], lo[2], lo[3], hi[0], hi[1], hi[2], hi[3]};
}
#define MFMA16(a, b, c) __builtin_amdgcn_mfma_f32_16x16x32_bf16((a), (b), (c), 0, 0, 0)
__device__ __forceinline__ f32x4 mm_nn(const LAS unsigned char* X, const LAS unsigned char* Y, int ti, int tj, int q, int g, f32x4 c) {
    c = MFMA16(mfr_row(X, 16 * ti + q, 0, g), mfr_tr(Y, 0, 16 * tj, g, q), c); return MFMA16(mfr_row(X, 16 * ti + q, 32, g), mfr_tr(Y, 32, 16 * tj, g, q), c); }
__device__ __forceinline__ f32x4 mm_nt(const LAS unsigned char* X, const LAS unsigned char* Yt, int ti, int tj, int q, int g, f32x4 c) {
    c = MFMA16(mfr_row(X, 16 * ti + q, 0, g), mfr_row(Yt, 16 * tj + q, 0, g), c); return MFMA16(mfr_row(X, 16 * ti + q, 32, g), mfr_row(Yt, 16 * tj + q, 32, g), c); }
__device__ __forceinline__ f32x4 mm_tn(const LAS unsigned char* Xt, const LAS unsigned char* Y, int ti, int tj, int q, int g, f32x4 c) {
    c = MFMA16(mfr_tr(Xt, 0, 16 * ti, g, q), mfr_tr(Y, 0, 16 * tj, g, q), c); return MFMA16(mfr_tr(Xt, 32, 16 * ti, g, q), mfr_tr(Y, 32, 16 * tj, g, q), c); }
typedef float f32x2_t __attribute__((ext_vector_type(2))); typedef __bf16 bf16x2_t __attribute__((ext_vector_type(2)));
__device__ __forceinline__ unsigned cvtpk(float lo, float hi) { f32x2_t v = {lo, hi}; bf16x2_t b = __builtin_convertvector(v, bf16x2_t); return __builtin_bit_cast(unsigned, b); }
__device__ __forceinline__ void mst_tile_t(LAS unsigned char* M, int ti, int tj, int q, int g, f32x4 c) {
    *(LAS unsigned long long*)(M + (16 * tj + q) * MST + (16 * ti + 4 * g) * 2) = (unsigned long long)cvtpk(c[0], c[1]) | ((unsigned long long)cvtpk(c[2], c[3]) << 32);
}
#define SC_BAR() do { asm volatile("s_waitcnt lgkmcnt(0)" ::: "memory"); __builtin_amdgcn_s_barrier(); asm volatile("" ::: "memory"); } while (0)
__device__ __forceinline__ void scan_units(const Args& args, int l, LAS unsigned char* lds, int vcu, int G) {
    int tid_ = threadIdx.x; asm volatile("" : "+v"(tid_)); const int tid = tid_, lane = tid & 63, wave = __builtin_amdgcn_readfirstlane(tid >> 6);
    unsigned char* ws = args.ws;
    const unsigned short* Rr = (const unsigned short*)(ws + WS_R); const float* Ww = (const float*)(ws + WS_W); const unsigned short* Kk = (const unsigned short*)(ws + WS_K); const unsigned short* Vv = (const unsigned short*)(ws + WS_V);
    const unsigned short* Aa = (const unsigned short*)(ws + WS_A); const unsigned short* Bb = (const unsigned short*)(ws + WS_B); float* Y = (float*)(ws + WS_Y);
    LAS unsigned char* iA = lds + 0 * MSLOT; LAS unsigned char* iR = lds + 1 * MSLOT; LAS unsigned char* iB = lds + 2 * MSLOT; LAS unsigned char* iK = lds + 3 * MSLOT;
    LAS unsigned char* iBh = lds + 4 * MSLOT; LAS unsigned char* iKh = lds + 5 * MSLOT; LAS unsigned char* iV = lds + 6 * MSLOT; LAS unsigned char* iS = lds + 7 * MSLOT;
    LAS unsigned char* iAak = lds + 8 * MSLOT; LAS unsigned char* iArb = lds + 9 * MSLOT; LAS unsigned char* iArk = lds + 10 * MSLOT; LAS unsigned char* iQa = lds + 11 * MSLOT;
    LAS unsigned char* iTa = lds + 12 * MSLOT; LAS unsigned char* iTb = lds + 13 * MSLOT;
    LAS unsigned char* iQb = iB; LAS unsigned char* iRHS = iK; LAS unsigned char* iU = iQa;
    LAS float* wtot = (LAS float*)(lds + LDSCTL_OFF + 1024); LAS float* sDC = wtot + 2 * 8 * 64;
    static_assert(14 * MSLOT <= RING_BYTES && LDSCTL_OFF + 1024 + 17 * 64 * 4 <= LDS_BYTES, "scan LDS map");
    const int q = lane & 15, g = lane >> 4, ti = wave >> 1, tj0 = 2 * (wave & 1);
    constexpr int C = 64, NCH = SEQ / C;
    for (int u = vcu; u < PBATCH * 16; u += G) {
        const int b = u >> 4, h = u & 15;
        const int hw = lane >> 5, jp = lane & 31;
        const size_t base0 = (size_t)(b * SEQ + 8 * wave + 4 * hw) * DRW + h * 64 + 2 * jp;
        typedef float f32x2v __attribute__((ext_vector_type(2)));
        f32x2v rw[4]; unsigned rk[4], ra[4], rb[4], rr[4], rv[4];
#define SC_LOAD(cc) do { _Pragma("unroll") for (int i = 0; i < 4; ++i) { const size_t o = base0 + (size_t)((cc) * C + i) * DRW; rw[i] = *(const f32x2v*)(Ww + o); \
            rk[i] = *(const unsigned*)(Kk + o); ra[i] = *(const unsigned*)(Aa + o); rb[i] = *(const unsigned*)(Bb + o); rr[i] = *(const unsigned*)(Rr + o); rv[i] = *(const unsigned*)(Vv + o); } } while (0)
#define BLO(U) __builtin_bit_cast(float, (U) << 16)
#define BHI(U) __builtin_bit_cast(float, (U) & 0xffff0000u)
#define SC_DECAY(cc) do { p[0] = rw[0]; _Pragma("unroll") for (int i = 1; i < 4; ++i) p[i] = p[i - 1] * rw[i]; \
            lo.x = __shfl(p[3].x, jp); lo.y = __shfl(p[3].y, jp);                                        \
            if (hw) { _Pragma("unroll") for (int i = 0; i < 4; ++i) p[i] = p[i] * lo; *(LAS f32x2v*)(wtot + ((cc) & 1) * 512 + wave * 64 + 2 * jp) = p[3]; } } while (0)
        SC_LOAD(0);
        f32x2v p[4], lo; SC_DECAY(0);
        f32x4 Sreg[2], Treg[2];
#pragma unroll
        for (int t2 = 0; t2 < 2; ++t2) Sreg[t2] = (f32x4){0.f, 0.f, 0.f, 0.f};
        __syncthreads();
        for (int i = tid; i < 64 * 36; i += NTHR) ((LAS unsigned*)iS)[i] = 0u;
        for (int c = 0; c < NCH; ++c) {
            LAS float* wt = wtot + (c & 1) * 512;
            f32x2v pre = (f32x2v){1.f, 1.f}, dc = (f32x2v){1.f, 1.f};
#pragma unroll
            for (int w2 = 0; w2 < 8; ++w2) { const f32x2v x = *(const LAS f32x2v*)(wt + w2 * 64 + 2 * jp); dc = dc * x; if (w2 < wave) pre = pre * x; }
            if (wave == 0 && hw == 0) *(LAS f32x2v*)(sDC + 2 * jp) = dc;
            { const f32x2v d0 = hw ? pre * lo : pre;
              f32x2v xa[4], xr[4], xb[4], xk[4], xbh[4], xkh[4], xv[4];
#pragma unroll
              for (int i = 0; i < 4; ++i) { const f32x2v Dt = pre * p[i], Dm = (i == 0) ? d0 : pre * p[i - 1]; f32x2v inv; inv.x = __builtin_amdgcn_rcpf(Dt.x); inv.y = __builtin_amdgcn_rcpf(Dt.y); const f32x2v sc = dc * inv;
                  const f32x2v a2 = (f32x2v){BLO(ra[i]), BHI(ra[i])}, r2 = (f32x2v){BLO(rr[i]), BHI(rr[i])}, b2 = (f32x2v){BLO(rb[i]), BHI(rb[i])}, k2 = (f32x2v){BLO(rk[i]), BHI(rk[i])};
                  xa[i] = a2 * Dm; xr[i] = r2 * Dt; xb[i] = b2 * inv; xk[i] = k2 * inv; xbh[i] = b2 * sc; xkh[i] = k2 * sc; xv[i] = (f32x2v){BLO(rv[i]), BHI(rv[i])}; }
              const int o0 = (2 * jp) * MST + (8 * wave + 4 * hw) * 2, o1 = o0 + MST;
#define SC_W4(img, ARR) do { *(LAS unsigned long long*)((img) + o0) = (unsigned long long)cvtpk(ARR[0].x, ARR[1].x) | ((unsigned long long)cvtpk(ARR[2].x, ARR[3].x) << 32); \
                           *(LAS unsigned long long*)((img) + o1) = (unsigned long long)cvtpk(ARR[0].y, ARR[1].y) | ((unsigned long long)cvtpk(ARR[2].y, ARR[3].y) << 32); } while (0)
              SC_W4(iA, xa); SC_W4(iR, xr); SC_W4(iB, xb); SC_W4(iK, xk); SC_W4(iBh, xbh); SC_W4(iKh, xkh); SC_W4(iV, xv);
#undef SC_W4
            }
            if (c + 1 < NCH) SC_LOAD(c + 1);
            SC_BAR();
#define FR_ROW2(dst, M, row) do { dst[0] = mfr_row(M, (row), 0, g); dst[1] = mfr_row(M, (row), 32, g); } while (0)
#define FR_TR2(dst, M, col0) do { dst[0] = mfr_tr(M, 0, (col0), g, q); dst[1] = mfr_tr(M, 32, (col0), g, q); } while (0)
#define MM2(c, a, b) MFMA16(a[1], b[1], MFMA16(a[0], b[0], (c)))
            const f32x4 z4 = (f32x4){0.f, 0.f, 0.f, 0.f};
            { bf16x8 aA[2], aR[2], bB[2][2], bK[2][2];
              FR_TR2(aA, iA, 16 * ti); FR_TR2(aR, iR, 16 * ti);
#pragma unroll
              for (int t2 = 0; t2 < 2; ++t2) { FR_TR2(bB[t2], iB, 16 * (tj0 + t2)); FR_TR2(bK[t2], iK, 16 * (tj0 + t2)); }
#pragma unroll
              for (int t2 = 0; t2 < 2; ++t2) { const int tj = tj0 + t2;
                f32x4 aab = MM2(z4, aA, bB[t2]), aak = MM2(z4, aA, bK[t2]), arb = MM2(z4, aR, bB[t2]), ark = MM2(z4, aR, bK[t2]);
#pragma unroll
                for (int e = 0; e < 4; ++e) { const int t = 16 * ti + 4 * g + e, s = 16 * tj + q; if (!(s < t)) { aab[e] = 0.f; aak[e] = 0.f; } if (!(s <= t)) { arb[e] = 0.f; ark[e] = 0.f; } }
                mst_tile_t(iQa, ti, tj, q, g, aab); mst_tile_t(iAak, ti, tj, q, g, aak); mst_tile_t(iArb, ti, tj, q, g, arb); mst_tile_t(iArk, ti, tj, q, g, ark);
#pragma unroll
                for (int e = 0; e < 4; ++e) if (16 * ti + 4 * g + e == 16 * tj + q) aab[e] += 1.0f;
                Treg[t2] = aab; mst_tile_t(iTa, ti, tj, q, g, aab); } }
            SC_BAR();
            { bf16x8 aQ[2], bQ[2][2], aA[2], bS[2][2], aK[2], bV[2][2];
              FR_TR2(aQ, iQa, 16 * ti); FR_TR2(aA, iA, 16 * ti); FR_TR2(aK, iAak, 16 * ti);
#pragma unroll
              for (int t2 = 0; t2 < 2; ++t2) { FR_ROW2(bQ[t2], iQa, 16 * (tj0 + t2) + q); FR_ROW2(bS[t2], iS, 16 * (tj0 + t2) + q); FR_ROW2(bV[t2], iV, 16 * (tj0 + t2) + q); }
#pragma unroll
              for (int t2 = 0; t2 < 2; ++t2) { const int tj = tj0 + t2;
                mst_tile_t(iQb, ti, tj, q, g, MM2(z4, aQ, bQ[t2])); mst_tile_t(iRHS, ti, tj, q, g, MM2(MM2(z4, aA, bS[t2]), aK, bV[t2])); } }
            SC_BAR();
#define SC_LEVEL(Qin, Qout, Tin, Tout, doq) do { bf16x8 aQ[2], bQ[2][2], aT[2]; FR_TR2(aQ, Qin, 16 * ti); FR_TR2(aT, Tin, 16 * ti); \
                _Pragma("unroll") for (int t2 = 0; t2 < 2; ++t2) FR_ROW2(bQ[t2], Qin, 16 * (tj0 + t2) + q); \
                _Pragma("unroll") for (int t2 = 0; t2 < 2; ++t2) { const int tj = tj0 + t2; \
                    if (doq) mst_tile_t(Qout, ti, tj, q, g, MM2(z4, aQ, bQ[t2])); \
                    Treg[t2] = MM2(Treg[t2], aT, bQ[t2]); mst_tile_t(Tout, ti, tj, q, g, Treg[t2]); } SC_BAR(); } while (0)
            SC_LEVEL(iQb, iQa, iTa, iTb, true);
            SC_LEVEL(iQa, iQb, iTb, iTa, true);
            SC_LEVEL(iQb, iQa, iTa, iTb, true);
            SC_LEVEL(iQa, iQb, iTb, iTa, true);
            SC_LEVEL(iQb, iQa, iTa, iTb, false);
#undef SC_LEVEL
            { bf16x8 aT[2], bR[2][2]; FR_TR2(aT, iTb, 16 * ti);
#pragma unroll
              for (int t2 = 0; t2 < 2; ++t2) FR_ROW2(bR[t2], iRHS, 16 * (tj0 + t2) + q);
#pragma unroll
              for (int t2 = 0; t2 < 2; ++t2) mst_tile_t(iU, ti, tj0 + t2, q, g, MM2(z4, aT, bR[t2])); }
            SC_BAR();
            { bf16x8 aRt[2], aArb[2], aArk[2], aBh[2], aKh[2], bS[2][2], bU[2][2], bV[2][2];
              FR_TR2(aRt, iR, 16 * ti); FR_TR2(aArb, iArb, 16 * ti); FR_TR2(aArk, iArk, 16 * ti); FR_ROW2(aBh, iBh, 16 * ti + q); FR_ROW2(aKh, iKh, 16 * ti + q);
#pragma unroll
              for (int t2 = 0; t2 < 2; ++t2) { FR_ROW2(bS[t2], iS, 16 * (tj0 + t2) + q); FR_ROW2(bU[t2], iU, 16 * (tj0 + t2) + q); FR_ROW2(bV[t2], iV, 16 * (tj0 + t2) + q); }
              const f32x4 dcv = *(const LAS f32x4*)(sDC + 16 * ti + 4 * g);
#pragma unroll
              for (int t2 = 0; t2 < 2; ++t2) { const int tj = tj0 + t2;
                const f32x4 y = MM2(MM2(MM2(z4, aRt, bS[t2]), aArb, bU[t2]), aArk, bV[t2]);
                float* yp = Y + (size_t)(b * SEQ + c * C + 16 * ti + 4 * g) * DRW + h * 64 + 16 * tj + q;
#pragma unroll
                for (int e = 0; e < 4; ++e) yp[(size_t)e * DRW] = y[e];
                Sreg[t2] = MM2(MM2(Sreg[t2] * dcv, aBh, bU[t2]), aKh, bV[t2]); } }
            if (c + 1 < NCH) SC_DECAY(c + 1);
            SC_BAR();
#undef FR_ROW2
#undef FR_TR2
#undef MM2
#pragma unroll
            for (int t2 = 0; t2 < 2; ++t2) mst_tile_t(iS, ti, tj0 + t2, q, g, Sreg[t2]);
        }
#pragma unroll
        for (int t2 = 0; t2 < 2; ++t2) { const int tj = tj0 + t2;
            *(f32x4*)(args.out + O_WP + ((((size_t)l * PBATCH + b) * 16 + h) * 64 + 16 * tj + q) * 64 + 16 * ti + 4 * g) = Sreg[t2]; }
        __syncthreads();
    }
#undef SC_LOAD
#undef SC_DECAY
#undef BLO
#undef BHI
}
#undef SC_BAR
__device__ __forceinline__ void sample_wkv_units(const Args& args, int l, int vcu, int G) {
    int tid_ = threadIdx.x; asm volatile("" : "+v"(tid_)); const int tid = tid_, lane = tid & 63, wave = __builtin_amdgcn_readfirstlane(tid >> 6); const int vskip = (G == 256) ? 64 : 0; if (vcu < vskip) return; const int gw = (vcu - vskip) * NWAVES + wave, NGW = (G - vskip) * NWAVES;     (void)tid; (void)lane; (void)wave; (void)gw; (void)NGW;
    unsigned char* ws = args.ws;
    const bf16* Rr = (const bf16*)(ws + WS_R); const float* Ww = (const float*)(ws + WS_W); const bf16* Kk = (const bf16*)(ws + WS_K); const bf16* Vv = (const bf16*)(ws + WS_V);
    const bf16* Aa = (const bf16*)(ws + WS_A); const bf16* Bb = (const bf16*)(ws + WS_B); float* Y = (float*)(ws + WS_Y);
    for (int u = gw; u < 128; u += NGW) {
        const int b = u >> 4, h = u & 15; const size_t vo = (size_t)(MP + b) * DRW + h * 64;
        const float* Sp = args.in[I_SWKV] + ((((size_t)l * 8 + b) * 16 + h) * 64 + lane) * 64;
        float* So = args.out + O_WS + ((((size_t)l * 8 + b) * 16 + h) * 64 + lane) * 64;
        f32x4 S[16];
#pragma unroll
        for (int j = 0; j < 16; ++j) S[j] = *(const f32x4*)(Sp + 4 * j);
        float sa = 0.f;
#pragma unroll
        for (int j = 0; j < 16; ++j) { const f32x4 a4 = ld4bf(Aa + vo + 4 * j); sa += (S[j].x * a4.x + S[j].y * a4.y) + (S[j].z * a4.z + S[j].w * a4.w); }
        const float vi = bf2f(Vv[vo + lane]); float y = 0.f;
#pragma unroll
        for (int j = 0; j < 16; ++j) { const f32x4 w4 = *(const f32x4*)(Ww + vo + 4 * j), k4 = ld4bf(Kk + vo + 4 * j), b4 = ld4bf(Bb + vo + 4 * j), r4 = ld4bf(Rr + vo + 4 * j);
            f32x4 s = S[j] * w4 + (b4 * sa + k4 * vi); y += (s.x * r4.x + s.y * r4.y) + (s.z * r4.z + s.w * r4.w); *(f32x4*)(So + 4 * j) = s; }
        Y[vo + lane] = y;
    }
}
typedef short v4i16_t __attribute__((ext_vector_type(4)));
typedef float f32x4v __attribute__((ext_vector_type(4)));
__device__ __forceinline__ void attn_units(const Args& args, int l, LAS unsigned char* lds, int vcu, int G) {
    int tid_ = threadIdx.x; asm volatile("" : "+v"(tid_)); const int tid = tid_, lane = tid & 63, wave = __builtin_amdgcn_readfirstlane(tid >> 6); const int gw = vcu * NWAVES + wave, NGW = G * NWAVES; (void)tid; (void)lane; (void)wave; (void)gw; (void)NGW;
    unsigned char* ws = args.ws;
    const bf16* QB = (const bf16*)(ws + WS_QB); const bf16* KB = (const bf16*)(ws + WS_KB); const bf16* VB = (const bf16*)(ws + WS_VB);
    bf16* OBR = (bf16*)(ws + WS_OBR); float* LSE = (float*)(ws + WS_LSE); const float* BT = (const float*)(ws + WS_BT);
    constexpr int KST = 144, VST = 160;
    LAS unsigned char* Kt = lds; LAS unsigned char* Vt = lds + 256 * KST; LAS float* btab = (LAS float*)(lds + 256 * KST + 256 * VST);
    const int q = lane & 15, g = lane >> 4;
    constexpr int NA_S = 0, NA_O = 16; static_assert(64 * NA_S + 192 * NA_O == PBATCH * NHEADS * 48, "attention unit deal");
    const bool deal = (G == 256); const int ufirst = deal ? ((vcu < 64) ? vcu * NA_S : 64 * NA_S + (vcu - 64) * NA_O) : vcu, ucnt = deal ? ((vcu < 64) ? NA_S : NA_O) : (PBATCH * NHEADS * 48 - vcu + G - 1) / G, ustep = deal ? 1 : G;
    v4u kreg[4], vreg[4]; float breg = 0.f; bf16x8 qn0, qn1;
#define AT_DECODE(uu) const int rn = (uu) & 15, br = ((uu) >> 4) % 3, h = ((uu) / 48) & 15, b = (uu) / 768; const int dsh = 2 * br, dil = 1 << dsh, r = rn & (dil - 1), n = rn >> dsh;
#define AT_FETCH(uu) do { AT_DECODE(uu) \
        _Pragma("unroll") for (int j = 0; j < 4; ++j) { const int i = tid + NTHR * j, row = i >> 3, chk = i & 7, sk = (n - 1) * 128 + row; kreg[j] = (v4u){0u, 0u, 0u, 0u}; vreg[j] = (v4u){0u, 0u, 0u, 0u}; \
            if (sk >= 0) { const size_t go = ((size_t)(b * SEQ + sk * dil + r)) * DATT + h * 64 + chk * 8; kreg[j] = *(const v4u*)(KB + go); vreg[j] = *(const v4u*)(VB + go); } } \
        if (tid < 129) breg = BT[(br * 129 + tid) * 16 + h]; \
        { const int mqn = b * SEQ + (n * 128 + 16 * wave + q) * dil + r; qn0 = *(const bf16x8*)(QB + (size_t)mqn * DATT + h * 64 + 8 * g); qn1 = *(const bf16x8*)(QB + (size_t)mqn * DATT + h * 64 + 32 + 8 * g); } } while (0)
    if (ucnt > 0) AT_FETCH(ufirst);
    for (int ui = 0; ui < ucnt; ++ui) { const int u = ufirst + ui * ustep;
        AT_DECODE(u)
        __syncthreads();
#pragma unroll
        for (int j = 0; j < 4; ++j) { const int i = tid + NTHR * j, row = i >> 3, chk = i & 7; *(LAS v4u*)(Kt + row * KST + chk * 16) = kreg[j]; *(LAS v4u*)(Vt + row * VST + chk * 16) = vreg[j]; }
        if (tid < 129) btab[tid] = breg;
        const bf16x8 qf0 = qn0, qf1 = qn1;
        __syncthreads();
        if (ui + 1 < ucnt) AT_FETCH(u + ustep);
        const int iq = 16 * wave + q, mq = b * SEQ + (n * 128 + iq) * dil + r;
        const int kb0 = wave >> 1;
        f32x4 sacc[10];
        { bf16x8 ka[10][2];
#pragma unroll
          for (int sb = 0; sb < 10; ++sb) { const int key0 = 32 * kb0 + 16 * sb; ka[sb][0] = *(const LAS bf16x8*)(Kt + (key0 + q) * KST + 16 * g); ka[sb][1] = *(const LAS bf16x8*)(Kt + (key0 + q) * KST + 64 + 16 * g); }
#pragma unroll
          for (int sb = 0; sb < 10; ++sb) { f32x4 acc = (f32x4){0.f, 0.f, 0.f, 0.f};
              acc = __builtin_amdgcn_mfma_f32_16x16x32_bf16(ka[sb][0], qf0, acc, 0, 0, 0); acc = __builtin_amdgcn_mfma_f32_16x16x32_bf16(ka[sb][1], qf1, acc, 0, 0, 0); sacc[sb] = acc; } }
        float mx = -INFINITY;
#pragma unroll
        for (int sb = 0; sb < 10; ++sb)
#pragma unroll
            for (int e = 0; e < 4; ++e) { const int jj = 32 * kb0 + 16 * sb + 4 * g + e, dsub = 128 + iq - jj, sk = (n - 1) * 128 + jj;
                const bool ok = (dsub >= 0) && (dsub <= 128) && (sk >= 0);
                const float s = ok ? sacc[sb][e] * ATT_SCALE + btab[ok ? dsub : 0] : -INFINITY; sacc[sb][e] = s; mx = fmaxf(mx, s); }
        mx = fmaxf(mx, __shfl_xor(mx, 16)); mx = fmaxf(mx, __shfl_xor(mx, 32));
        float sum = 0.f;
#pragma unroll
        for (int sb = 0; sb < 10; ++sb)
#pragma unroll
            for (int e = 0; e < 4; ++e) { const float p = __expf(sacc[sb][e] - mx); sacc[sb][e] = p; sum += p; }
        sum += __shfl_xor(sum, 16); sum += __shfl_xor(sum, 32);
        f32x4 o[4];
#pragma unroll
        for (int c = 0; c < 4; ++c) o[c] = (f32x4){0.f, 0.f, 0.f, 0.f};
        { bf16x8 va[5][4];
#pragma unroll
          for (int kk = 0; kk < 5; ++kk) { const int R0 = 32 * (kb0 + kk) + 4 * g + (q >> 2);
#pragma unroll
              for (int c = 0; c < 4; ++c) {
                  const v4i16_t lo = __builtin_amdgcn_ds_read_tr16_b64_v4i16((LAS v4i16_t*)(Vt + R0 * VST + (16 * c + 4 * (q & 3)) * 2));
                  const v4i16_t hi = __builtin_amdgcn_ds_read_tr16_b64_v4i16((LAS v4i16_t*)(Vt + (R0 + 16) * VST + (16 * c + 4 * (q & 3)) * 2));
                  va[kk][c] = (bf16x8){lo[0], lo[1], lo[2], lo[3], hi[0], hi[1], hi[2], hi[3]}; } }
#pragma unroll
          for (int kk = 0; kk < 5; ++kk) {
              v4u pw; pw.x = cvtpk(sacc[2 * kk][0], sacc[2 * kk][1]); pw.y = cvtpk(sacc[2 * kk][2], sacc[2 * kk][3]); pw.z = cvtpk(sacc[2 * kk + 1][0], sacc[2 * kk + 1][1]); pw.w = cvtpk(sacc[2 * kk + 1][2], sacc[2 * kk + 1][3]);
              const bf16x8 pb = __builtin_bit_cast(bf16x8, pw);
#pragma unroll
              for (int c = 0; c < 4; ++c) o[c] = __builtin_amdgcn_mfma_f32_16x16x32_bf16(va[kk][c], pb, o[c], 0, 0, 0); } }
        const float inv = 1.0f / sum;
        bf16* op = OBR + ((size_t)br * MP + mq) * DATT + h * 64 + 4 * g;
#pragma unroll
        for (int c = 0; c < 4; ++c) { const unsigned long long w = (unsigned long long)pk2(o[c][0] * inv, o[c][1] * inv) | ((unsigned long long)pk2(o[c][2] * inv, o[c][3] * inv) << 32); *(unsigned long long*)(op + 16 * c) = w; }
        if (g == 0) LSE[((size_t)br * MP + mq) * 16 + h] = mx + __logf(sum);
    }
#undef AT_DECODE
#undef AT_FETCH
}
__device__ __forceinline__ void sample_attn_units(const Args& args, int l, LAS unsigned char* lds, int vcu, int G) {
    int tid_ = threadIdx.x; asm volatile("" : "+v"(tid_)); const int tid = tid_, lane = tid & 63, wave = __builtin_amdgcn_readfirstlane(tid >> 6); const int vskip = (G == 256) ? 64 : 0; if (vcu < vskip) return; const int gw = (vcu - vskip) * NWAVES + wave, NGW = (G - vskip) * NWAVES; (void)tid; (void)lane; (void)wave; (void)gw; (void)NGW;
    unsigned char* ws = args.ws;
    const bf16* QB = (const bf16*)(ws + WS_QB); bf16* MIX = (bf16*)(ws + WS_MIX); const float* BT = (const float*)(ws + WS_BT);
    LAS float* pl = (LAS float*)(lds + 90112) + wave * 448;
    for (int u = gw; u < 128; u += NGW) {
        const int b = u >> 4, h = u & 15, m = MP + b;
        float qv[64];
#pragma unroll
        for (int j = 0; j < 8; ++j) { const v4u w = *(const v4u*)(QB + (size_t)m * DATT + h * 64 + 8 * j);
            qv[8 * j + 0] = bf2f((unsigned short)(w.x & 0xffff)); qv[8 * j + 1] = bf2f((unsigned short)(w.x >> 16)); qv[8 * j + 2] = bf2f((unsigned short)(w.y & 0xffff)); qv[8 * j + 3] = bf2f((unsigned short)(w.y >> 16));
            qv[8 * j + 4] = bf2f((unsigned short)(w.z & 0xffff)); qv[8 * j + 5] = bf2f((unsigned short)(w.z >> 16)); qv[8 * j + 6] = bf2f((unsigned short)(w.w & 0xffff)); qv[8 * j + 7] = bf2f((unsigned short)(w.w >> 16)); }
        const float* knew = args.out + O_KS + ((size_t)l * 8 + b) * DATT + h * 64; const float* vnew = args.out + O_VS + ((size_t)l * 8 + b) * DATT + h * 64;
        const float* kc = args.in[I_CK] + (((size_t)l * 8 + b) * 2048) * 1024 + h * 64; const float* vc = args.in[I_CV] + (((size_t)l * 8 + b) * 2048) * 1024 + h * 64;
        float mx = -INFINITY;
        for (int it = 0; it < 7; ++it) { const int kk = lane + 64 * it;
            if (kk < 387) { const int br = kk / 129, mm = kk % 129; const float* kp = (mm == 0) ? knew : kc + (size_t)(2048 - (mm << (2 * br))) * 1024;
                float d = 0.f;
#pragma unroll
                for (int j = 0; j < 16; ++j) { const f32x4 k4 = *(const f32x4*)(kp + 4 * j); d += (qv[4 * j] * k4.x + qv[4 * j + 1] * k4.y) + (qv[4 * j + 2] * k4.z + qv[4 * j + 3] * k4.w); }
                const float s = d * ATT_SCALE + BT[(br * 129 + mm) * 16 + h]; pl[kk] = s; mx = fmaxf(mx, s); } }
        mx = wave_max(mx);
        float sum = 0.f;
        for (int it = 0; it < 7; ++it) { const int kk = lane + 64 * it; if (kk < 387) { const float p = __expf(pl[kk] - mx); pl[kk] = p; sum += p; } }
        sum = wave_sum(sum);
        f32x4 o4 = (f32x4){0.f, 0.f, 0.f, 0.f}; const int kg = lane >> 4, dq = lane & 15;
#pragma unroll 8
        for (int i = 0; i < 97; ++i) { const int kk = kg + 4 * i; if (kk < 387) { const int br = kk / 129, mm = kk % 129; const float* vp = (mm == 0) ? vnew : vc + (size_t)(2048 - (mm << (2 * br))) * 1024;
            o4 += *(const f32x4*)(vp + 4 * dq) * pl[kk]; } }
#pragma unroll
        for (int e = 0; e < 4; ++e) { o4[e] += __shfl_xor(o4[e], 16); o4[e] += __shfl_xor(o4[e], 32); }
        if (kg == 0) { const float inv = 1.0f / sum; *(unsigned long long*)(MIX + (size_t)m * DM + h * 64 + 4 * dq) = (unsigned long long)pk2(o4.x * inv, o4.y * inv) | ((unsigned long long)pk2(o4.z * inv, o4.w * inv) << 32); }
    }
}

__device__ __forceinline__ void mx_phase(const Args& args, int l, int vcu, int G) {
    int tid_ = threadIdx.x; asm volatile("" : "+v"(tid_)); const int tid = tid_, lane = tid & 63, wave = __builtin_amdgcn_readfirstlane(tid >> 6); const int gw = vcu * NWAVES + wave, NGW = G * NWAVES; (void)tid; (void)lane; (void)wave; (void)gw; (void)NGW;
    unsigned char* ws = args.ws;
    const bf16* OBR = (const bf16*)(ws + WS_OBR); const float* LSE = (const float*)(ws + WS_LSE); bf16* MIX = (bf16*)(ws + WS_MIX);
    const bf16* Rr = (const bf16*)(ws + WS_R); const bf16* Kk = (const bf16*)(ws + WS_K); const bf16* Vv = (const bf16*)(ws + WS_V); const bf16* Gg = (const bf16*)(ws + WS_G); const float* Y = (const float*)(ws + WS_Y);
    const int hh = lane >> 2, p = lane & 3, c0 = hh * 64 + p * 16;
    f32x4 lng[4], lnb[4], rk[4];
#pragma unroll
    for (int j = 0; j < 4; ++j) { lng[j] = *(const f32x4*)(args.in[I_LNG] + (size_t)l * DRW + c0 + 4 * j); lnb[j] = *(const f32x4*)(args.in[I_LNB] + (size_t)l * DRW + c0 + 4 * j); rk[j] = *(const f32x4*)(args.in[I_RK] + (size_t)l * DRW + c0 + 4 * j); }
    struct Raw { float l0, l1, l2; v4u ob[6]; f32x4 y[4]; unsigned long long r[4], k[4], v[4], g[4]; };
#define MX_LOAD(R, mm) do { if ((mm) < MP) { R.l0 = LSE[((size_t)0 * MP + (mm)) * 16 + hh]; R.l1 = LSE[((size_t)1 * MP + (mm)) * 16 + hh]; R.l2 = LSE[((size_t)2 * MP + (mm)) * 16 + hh]; \
            _Pragma("unroll") for (int br = 0; br < 3; ++br) _Pragma("unroll") for (int j = 0; j < 2; ++j) R.ob[2 * br + j] = *(const v4u*)(OBR + ((size_t)br * MP + (mm)) * DATT + c0 + 8 * j); } \
        { const size_t ro_ = (size_t)(mm) * DRW + c0; _Pragma("unroll") for (int j = 0; j < 4; ++j) { R.y[j] = *(const f32x4*)(Y + ro_ + 4 * j); R.r[j] = *(const unsigned long long*)(Rr + ro_ + 4 * j); \
            R.k[j] = *(const unsigned long long*)(Kk + ro_ + 4 * j); R.v[j] = *(const unsigned long long*)(Vv + ro_ + 4 * j); R.g[j] = *(const unsigned long long*)(Gg + ro_ + 4 * j); } } } while (0)
    Raw cur; if (gw < NROWS) MX_LOAD(cur, gw);
    for (int m = gw; m < NROWS; m += NGW) {
        Raw nxt = cur; const int mn = m + NGW; if (mn < NROWS) MX_LOAD(nxt, mn);
        v4u a0 = (v4u){0u, 0u, 0u, 0u}, a1 = a0;
        if (m < MP) {
            const float l0 = cur.l0, l1 = cur.l1, l2 = cur.l2;
            const float mx = fmaxf(l0, fmaxf(l1, l2)); float e0 = __expf(l0 - mx), e1 = __expf(l1 - mx), e2 = __expf(l2 - mx); const float inv = 1.0f / (e0 + e1 + e2); e0 *= inv; e1 *= inv; e2 *= inv;
            float acc[16];
#pragma unroll
            for (int i = 0; i < 16; ++i) acc[i] = 0.f;
#pragma unroll
            for (int br = 0; br < 3; ++br) { const float al = br == 0 ? e0 : br == 1 ? e1 : e2;
#pragma unroll
                for (int j = 0; j < 2; ++j) { const v4u w = cur.ob[2 * br + j];
                    acc[8 * j + 0] += al * bf2f((unsigned short)(w.x & 0xffff)); acc[8 * j + 1] += al * bf2f((unsigned short)(w.x >> 16)); acc[8 * j + 2] += al * bf2f((unsigned short)(w.y & 0xffff)); acc[8 * j + 3] += al * bf2f((unsigned short)(w.y >> 16));
                    acc[8 * j + 4] += al * bf2f((unsigned short)(w.z & 0xffff)); acc[8 * j + 5] += al * bf2f((unsigned short)(w.z >> 16)); acc[8 * j + 6] += al * bf2f((unsigned short)(w.w & 0xffff)); acc[8 * j + 7] += al * bf2f((unsigned short)(w.w >> 16)); } }
            a0.x = pk2(acc[0], acc[1]); a0.y = pk2(acc[2], acc[3]); a0.z = pk2(acc[4], acc[5]); a0.w = pk2(acc[6], acc[7]); a1.x = pk2(acc[8], acc[9]); a1.y = pk2(acc[10], acc[11]); a1.z = pk2(acc[12], acc[13]); a1.w = pk2(acc[14], acc[15]);
        }
        f32x4 y[4], rr[4], kk[4], vv[4], gg[4];
        float s = 0.f, bon = 0.f;
#pragma unroll
        for (int j = 0; j < 4; ++j) { y[j] = cur.y[j]; rr[j] = up4bf(cur.r[j]); kk[j] = up4bf(cur.k[j]); vv[j] = up4bf(cur.v[j]); gg[j] = up4bf(cur.g[j]);
            s += (y[j].x + y[j].y) + (y[j].z + y[j].w); const f32x4 t = rr[j] * kk[j] * rk[j]; bon += (t.x + t.y) + (t.z + t.w); }
        s += __shfl_xor(s, 1); s += __shfl_xor(s, 2); bon += __shfl_xor(bon, 1); bon += __shfl_xor(bon, 2);
        const float mean = s * (1.0f / 64.0f); float qq = 0.f;
#pragma unroll
        for (int j = 0; j < 4; ++j) { y[j] = y[j] - mean; qq += (y[j].x * y[j].x + y[j].y * y[j].y) + (y[j].z * y[j].z + y[j].w * y[j].w); }
        qq += __shfl_xor(qq, 1); qq += __shfl_xor(qq, 2);
        const float rstd = 1.0f / sqrtf(qq * (1.0f / 64.0f) + GN_EPS);
        v4u o0, o1; f32x4 z[4];
#pragma unroll
        for (int j = 0; j < 4; ++j) z[j] = ((y[j] * rstd) * lng[j] + lnb[j] + vv[j] * bon) * gg[j];
        o0.x = pk2(z[0].x, z[0].y); o0.y = pk2(z[0].z, z[0].w); o0.z = pk2(z[1].x, z[1].y); o0.w = pk2(z[1].z, z[1].w); o1.x = pk2(z[2].x, z[2].y); o1.y = pk2(z[2].z, z[2].w); o1.z = pk2(z[3].x, z[3].y); o1.w = pk2(z[3].z, z[3].w);
        if (m < MP) { *(v4u*)(MIX + (size_t)m * DM + c0) = a0; *(v4u*)(MIX + (size_t)m * DM + c0 + 8) = a1; }
        *(v4u*)(MIX + (size_t)m * DM + DATT + c0) = o0; *(v4u*)(MIX + (size_t)m * DM + DATT + c0 + 8) = o1;
        cur = nxt;
    }
#undef MX_LOAD
}

template <int K> __device__ __forceinline__ void sample_proj(const bf16* A, const bf16* Bt, const float* base_s, float* out_s, const float* gate, LAS unsigned char* lds, int vcu, int G) {
    int tid_ = threadIdx.x; asm volatile("" : "+v"(tid_)); const int tid = tid_, lane = tid & 63, wave = __builtin_amdgcn_readfirstlane(tid >> 6);
    constexpr int KW = K / 8, NS = KW / 32; static_assert(KW % 32 == 0, "K split");
    LAS float* part = (LAS float*)lds;
    const int c = lane & 15, g = lane >> 4;
    for (int cg = vcu; cg < DM / 8; cg += G) {
        const int n0 = 8 * cg;
        const bf16* ap = A + (size_t)(MP + (c & 7)) * K + wave * KW + 8 * g; const bf16* bp = Bt + (size_t)(n0 + (c & 7)) * K + wave * KW + 8 * g;
        bf16x8 af[NS], bfr[NS];
#pragma unroll
        for (int s = 0; s < NS; ++s) { af[s] = *(const bf16x8*)(ap + 32 * s); bfr[s] = *(const bf16x8*)(bp + 32 * s); }
        f32x4 acc = (f32x4){0.f, 0.f, 0.f, 0.f};
#pragma unroll
        for (int s = 0; s < NS; ++s) acc = __builtin_amdgcn_mfma_f32_16x16x32_bf16(af[s], bfr[s], acc, 0, 0, 0);
        __syncthreads();
        if (g < 2 && c < 8) {
#pragma unroll
            for (int e = 0; e < 4; ++e) part[(wave * 8 + 4 * g + e) * 8 + c] = acc[e]; }
        __syncthreads();
        if (tid < 64) { const int r = tid >> 3, cc = tid & 7; float s = 0.f;
#pragma unroll
            for (int w = 0; w < 8; ++w) s += part[(w * 8 + r) * 8 + cc];
            const size_t o = (size_t)r * DM + n0 + cc; out_s[o] = base_s[o] + gate[(size_t)(4 + r) * MODW + n0 + cc] * s; }
    }
    __syncthreads();
}

__device__ __forceinline__ void n1_phase(const Args& args, int l, int vcu, int G, const float* Xp, const float* Xs, const float* modl, bf16* HB) {
    int tid_ = threadIdx.x; asm volatile("" : "+v"(tid_)); const int tid = tid_, lane = tid & 63, wave = __builtin_amdgcn_readfirstlane(tid >> 6); const int gw = vcu * NWAVES + wave, NGW = G * NWAVES; (void)tid; (void)lane; (void)wave; (void)gw; (void)NGW;
    for (int m = gw; m < NROWS + 8; m += NGW) {
        if (m < MP) { const int b = m >> 11, t = m & (SEQ - 1);
            norm_mod_row(Xp + (size_t)m * DM, args.in[I_N1G] + (size_t)l * DM, modl + (size_t)b * MODW, modl + (size_t)b * MODW + DM, HB + (size_t)m * DM,
                         (t == SEQ - 1) ? args.out + O_SP + ((size_t)l * PBATCH + b) * DM : nullptr, lane); }
        else if (m < NROWS) { const int b = m - MP;
            norm_mod_row(Xs + (size_t)b * DM, args.in[I_N1G] + (size_t)l * DM, modl + (size_t)(4 + b) * MODW, modl + (size_t)(4 + b) * MODW + DM, HB + (size_t)m * DM,
                         args.out + O_SS + ((size_t)l * 8 + b) * DM, lane); }
        else { const int b = m - NROWS; const float* s = args.in[I_SSH] + ((size_t)l * 8 + b) * DM; GAS unsigned long long* o8 = (GAS unsigned long long*)(HB + (size_t)m * DM) + lane;
#pragma unroll
            for (int j = 0; j < 8; ++j) { const f32x4 v = ((const GAS f32x4*)s)[lane + 64 * j]; o8[64 * j] = (unsigned long long)pk2(v.x, v.y) | ((unsigned long long)pk2(v.z, v.w) << 32); } }
    }
}
__device__ __forceinline__ void n2_phase(const Args& args, int l, int vcu, int G, const float* XB, const float* modl, bf16* HB) {
    int tid_ = threadIdx.x; asm volatile("" : "+v"(tid_)); const int tid = tid_, lane = tid & 63, wave = __builtin_amdgcn_readfirstlane(tid >> 6); const int gw = vcu * NWAVES + wave, NGW = G * NWAVES; (void)tid; (void)lane; (void)wave; (void)gw; (void)NGW;
    for (int m = gw; m < NROWS; m += NGW) { const int bb = (m < MP) ? (m >> 11) : 4 + (m - MP);
        norm_mod_row(XB + (size_t)m * DM, args.in[I_N2G] + (size_t)l * DM, modl + (size_t)bb * MODW + 3 * DM, modl + (size_t)bb * MODW + 4 * DM, HB + (size_t)m * DM, nullptr, lane); }
}

__global__ void __launch_bounds__(NTHR, 2) fwd(Args args) {
    extern __shared__ __attribute__((aligned(16))) unsigned char lds_raw[];
    LAS unsigned char* lds = (LAS unsigned char*)lds_raw;
    volatile LAS unsigned* MISC = (volatile LAS unsigned*)(lds + MISC_OFF);
    const int G = gridDim.x; const int bx = blockIdx.x; const int vcu = (G % 8 == 0) ? (bx % 8) * (G / 8) + bx / 8 : bx;
    unsigned char* ws = args.ws;
    for (int u = threadIdx.x; u < (LDS_BYTES - LDSCTL_OFF) / 4; u += NTHR) ((LAS unsigned*)(lds + LDSCTL_OFF))[u] = 0u;
    __syncthreads();
    const int lo = args.ph_lo, hi = args.ph_hi;
    XcdBarrier bar; bar.bar = (unsigned*)(ws + WS_CTL) + CW_BAR; bar.x = 0; bar.st = nullptr;
    if (hi - lo > 1) bar = xcd_barrier_post((unsigned*)(ws + WS_CTL) + CW_BAR, MISC + 8);
#define IN(k) (lo <= (k) && (k) < hi)
#define SEAM(k) do { if (IN(k) && IN((k) + 1)) { for (int repb = 0; repb < REP_BAR; ++repb) xcd_barrier(bar); } } while (0)

    if (IN(0)) { for (int rep = 0; rep < REP_P0; ++rep) { __syncthreads(); p0_prologue(args, lds, vcu, G, MISC + 16); } }
    SEAM(0);

    float* MOD = (float*)(ws + WS_MOD);
    bf16* HB = (bf16*)(ws + WS_HB); bf16* MIX = (bf16*)(ws + WS_MIX); float* XB = (float*)(ws + WS_XB); bf16* ACT = (bf16*)(ws + WS_ACT);
    for (int l = 0; l < DEPTH; ++l) {
        const int pb = 1 + PH_PER_LAYER * l;
        const float* modl = MOD + (size_t)l * 12 * MODW;
        const float* Xp = (l == 0) ? args.in[I_XP] : XB; const float* Xs = (l == 0) ? args.in[I_XS] : XB + (size_t)MP * DM;
        if (IN(pb + 0)) { for (int rep = 0; rep < REP_N1; ++rep) { __syncthreads(); n1_phase(args, l, vcu, G, Xp, Xs, modl, HB); } }
        SEAM(pb + 0);
        if (IN(pb + 1)) {
            __syncthreads();
            pg8::Gemm g{(const pg8::bf16_t*)HB, (const pg8::bf16_t*)(ws + WS_WIN) + (size_t)l * N1 * DM, MH, N1, DM}; pg8::StaticOrder S; S.init(MH, N1, G, bx);
            pg8::EpiG1 E{(pg8::bf16_t*)(ws + WS_QB), (size_t)(WS_KB - WS_QB) / 2, (pg8::bf16_t*)(ws + WS_RKV), (float*)(ws + WS_P),
                         args.out + O_KP + (size_t)l * MP * DATT, args.out + O_KS + (size_t)l * 8 * DATT, (size_t)(O_VP - O_KP), (size_t)(O_VS - O_KS), args.in[I_QG] + l * 64, args.in[I_KG] + l * 64};
            for (int rep = 0; rep < REP_G1; ++rep) pg8::gemm_phase<pg8::EpiG1, pg8::StaticOrder, true, true>(lds, g, S, E);
            if (l + 1 < DEPTH && bx >= (MH / 256) * (N1 / 256) % G && G == 256) prep_layer_pull(args, l + 1, 0, TAIL_PULLS, lds, MISC + 16);
        }
        SEAM(pb + 1);
        if (IN(pb + 2)) { for (int rep = 0; rep < REP_PW; ++rep) { __syncthreads(); pw_phase(args, l, lds, vcu, G); } }
        SEAM(pb + 2);
        if (IN(pb + 3)) {
            __syncthreads();
            for (int rep = 0; rep < REP_SCAN; ++rep) { __syncthreads(); scan_units(args, l, lds, vcu, G); }
            sample_wkv_units(args, l, vcu, G);
            __syncthreads();
            for (int rep = 0; rep < REP_ATT; ++rep) { __syncthreads(); attn_units(args, l, lds, vcu, G); }
            __syncthreads();
            for (int rep = 0; rep < REP_SATT; ++rep) { __syncthreads(); sample_attn_units(args, l, lds, vcu, G); }
            if (l + 1 < DEPTH && (vcu >= 64 || G != 256)) { prep_layer_pull(args, l + 1, 1, 1 << 30, lds, MISC + 16); prep_layer_pull(args, l + 1, 0, 1 << 30, lds, MISC + 16); }
        }
        SEAM(pb + 3);
        if (IN(pb + 4)) { for (int rep = 0; rep < REP_MX; ++rep) mx_phase(args, l, vcu, G); }
        SEAM(pb + 4);
        if (IN(pb + 5)) {
            __syncthreads();
            sample_proj<DM>(MIX, (const bf16*)(ws + WS_WOUT) + (size_t)l * DM * DM, Xs, XB + (size_t)MP * DM, modl + 2 * DM, lds, vcu, G);
            pg8::Gemm g{(const pg8::bf16_t*)MIX, (const pg8::bf16_t*)(ws + WS_WOUT) + (size_t)l * DM * DM, MP, DM, DM}; pg8::StaticOrder S; S.init(MP, DM, G, bx);
            for (int rep = 0; rep < REP_G2; ++rep) { float* dst = (rep + 1 < REP_G2) ? (float*)(ws + WS_END + 16 * MiB) : XB;
            pg8::EpiResid E{Xp, Xs, dst, dst + (size_t)MP * DM, modl + 2 * DM};
            pg8::gemm_phase<pg8::EpiResid, pg8::StaticOrder, true, true>(lds, g, S, E); }
        }
        SEAM(pb + 5);
        if (IN(pb + 6)) { for (int rep = 0; rep < REP_N2; ++rep) { __syncthreads(); n2_phase(args, l, vcu, G, XB, modl, HB); } }
        SEAM(pb + 6);
        if (IN(pb + 7)) {
            __syncthreads();
            pg8::Gemm g{(const pg8::bf16_t*)HB, (const pg8::bf16_t*)(ws + WS_WGU) + (size_t)l * 2 * FF * DM, MH, 2 * FF, DM}; pg8::StaticOrder S; S.init(MH, 2 * FF, G, bx);
            for (int rep = 0; rep < REP_G3; ++rep) { pg8::bf16_t* dst = (rep + 1 < REP_G3) ? (pg8::bf16_t*)(ws + WS_END + 16 * MiB) : (pg8::bf16_t*)ACT;
            pg8::EpiSwiGLU E{dst, FF};
            pg8::gemm_phase<pg8::EpiSwiGLU, pg8::StaticOrder, true, true>(lds, g, S, E); }
            if (l + 1 < DEPTH && bx >= (MH / 256) * (2 * FF / 256) % G && G == 256) prep_layer_pull(args, l + 1, 0, TAIL_PULLS, lds, MISC + 16);
        }
        SEAM(pb + 7);
        if (IN(pb + 8)) {
            __syncthreads();
            float* op = (l == DEPTH - 1) ? args.out + O_YP : XB; float* os = (l == DEPTH - 1) ? args.out + O_YS : XB + (size_t)MP * DM;
            sample_proj<FF>(ACT, (const bf16*)(ws + WS_WDN) + (size_t)l * DM * FF, XB + (size_t)MP * DM, os, modl + 5 * DM, lds, vcu, G);
            pg8::Gemm g{(const pg8::bf16_t*)ACT, (const pg8::bf16_t*)(ws + WS_WDN) + (size_t)l * DM * FF, MP, DM, FF}; pg8::StaticOrder S; S.init(MP, DM, G, bx);
            for (int rep = 0; rep < REP_G4; ++rep) { float* dst = (rep + 1 < REP_G4) ? (float*)(ws + WS_END + 16 * MiB) : op;
            pg8::EpiResid E{XB, XB + (size_t)MP * DM, dst, os, modl + 5 * DM};
            pg8::gemm_phase<pg8::EpiResid, pg8::StaticOrder, true, true>(lds, g, S, E); }
        }
        SEAM(pb + 8);
    }
#undef IN
#undef SEAM
}

extern "C" void kernel_launch(void* const* d_in, const int* in_sizes, int n_in, void* d_out, int out_size, void* d_ws, size_t ws_size, hipStream_t stream) {
    static int grid = 0;
    if (grid == 0) {
        if (n_in != N_IN || (size_t)out_size != O_END || ws_size < WS_END) { fprintf(stderr, "kernel_launch: unexpected shapes: n_in %d, out %d, ws %zu (need %zu)\n", n_in, out_size, ws_size, (size_t)WS_END); grid = -1; return; }
        int dev = 0, cus = 0;
        if (hipGetDevice(&dev) != hipSuccess || hipDeviceGetAttribute(&cus, hipDeviceAttributeMultiprocessorCount, dev) != hipSuccess) { grid = -1; return; }
        if (hipFuncSetAttribute((const void*)fwd, hipFuncAttributeMaxDynamicSharedMemorySize, LDS_BYTES) != hipSuccess) { fprintf(stderr, "kernel_launch: hipFuncSetAttribute failed\n"); grid = -1; return; }
        int per_cu = 0;
        if (hipOccupancyMaxActiveBlocksPerMultiprocessor(&per_cu, (const void*)fwd, NTHR, LDS_BYTES) != hipSuccess || per_cu < 1) fprintf(stderr, "kernel_launch: occupancy query says %d blocks per CU\n", per_cu);
        (void)hipGetLastError();
        grid = cus;
    }
    if (grid < 0) return;
    if (hipMemsetAsync((char*)d_ws + WS_CTL, 0, CTL_ZERO_BYTES, stream) != hipSuccess) return;
    Args a{};
    for (int i = 0; i < N_IN; ++i) a.in[i] = (const float*)d_in[i];
    a.out = (float*)d_out; a.ws = (unsigned char*)d_ws;
#if MK_N_LAUNCHES == 1
    a.ph_lo = 0; a.ph_hi = N_PHASES;
    hipLaunchKernelGGL(fwd, dim3(grid), dim3(NTHR), LDS_BYTES, stream, a);
#else
    for (int li = 0; li < N_PHASES; ++li) { a.ph_lo = li; a.ph_hi = li + 1; hipLaunchKernelGGL(fwd, dim3(grid), dim3(NTHR), LDS_BYTES, stream, a); }
#endif
}
```

```cpp
#include <hip/hip_runtime.h>
#include <cstdio>
#include <cstdint>
#include <cmath>
namespace pg8 {
#define PG8_LAS __attribute__((address_space(3)))
typedef unsigned short bf16_t;
typedef short bf16x8 __attribute__((ext_vector_type(8)));
typedef float f32x4 __attribute__((ext_vector_type(4)));
typedef unsigned u32x4 __attribute__((ext_vector_type(4)));
constexpr int BM = 256, BK = 64, HALF = 128, HTB = HALF * BK * 2  , STAGE_BYTES = 8 * HTB, NXCD = 8, WGM = 8;

__host__ __device__ __forceinline__ int lds_byte(int r, int c) { const int st = (r >> 4) * 2 + (c >> 5), rr = r & 15, cc = c & 31, ob = rr * 64 + cc * 2; return st * 1024 + (ob ^ (((ob >> 9) & 1) << 5)); }
__host__ __device__ __forceinline__ void stage_rc(int b, int& R, int& C) { const int st = b / 1024, sb = b % 1024, swz = sb ^ (((sb >> 9) & 1) << 5); R = (st >> 1) * 16 + swz / 64; C = (st & 1) * 32 + (swz % 64) / 2; }
__host__ __device__ __forceinline__ int perm32(int rho) { const int n = rho >> 4, i = rho & 15; return 8 * (i >> 2) + 4 * n + (i & 3); }

struct Unit { int pm, pn; };
struct Gemm { const bf16_t* A; const bf16_t* Bt; int M, N, K; };

struct StaticOrder {
    int nM, nN, nwg, G, c;
    __host__ __device__ void init(int M, int N, int G_, int c_) { nM = M / BM; nN = N / BM; nwg = nM * nN; G = G_; c = c_; }
    __host__ __device__ bool next(int i, Unit& u) const {
        const long L = (long)i * G + c; if (L >= nwg) return false;
        int wgid = (int)L; { const int q = nwg / NXCD, r = nwg % NXCD, xcd = wgid % NXCD, off = wgid / NXCD; wgid = (xcd < r ? xcd * (q + 1) : r * (q + 1) + (xcd - r) * q) + off; }
        const int nig = WGM * nN, gid = wgid / nig, fm = gid * WGM, gsz = (nM - fm) < WGM ? (nM - fm) : WGM;
        u.pm = fm + ((wgid % nig) % gsz); u.pn = (wgid % nig) / gsz; return true;
    }
    __device__ __forceinline__ void a_ready(const Unit&) const {}
    __device__ __forceinline__ void done(const Unit&) const {}
};

__device__ __forceinline__ unsigned cvt_pk_bf16(float lo, float hi) { unsigned r; asm volatile("v_cvt_pk_bf16_f32 %0, %1, %2" : "=v"(r) : "v"(lo), "v"(hi)); return r; }
typedef float f32x2 __attribute__((ext_vector_type(2)));
__device__ __forceinline__ f32x2 gelu_pk(f32x2 v) {
    const f32x2 av = __builtin_elementwise_abs(v), d = av * 0.2316418882f + 1.0f;
    f32x2 t; t.x = __builtin_amdgcn_rcpf(d.x); t.y = __builtin_amdgcn_rcpf(d.y);
    f32x2 q = t * 0.5307027145f + (-0.7265760135f); q = q * t + 0.7107068705f; q = q * t + (-0.142248368f); q = q * t + 0.127414796f; q = q * t;
    const f32x2 s = (v * v) * (-0.72134752044f);
    f32x2 e; e.x = __builtin_amdgcn_exp2f(s.x); e.y = __builtin_amdgcn_exp2f(s.y);
    const f32x2 m = v * (q * e), r = v - m;
    f32x2 o; o.x = v.x < 0.f ? m.x : r.x; o.y = v.y < 0.f ? m.y : r.y; return o;
}

template <int ACT  > struct EpiBf16 {
    static constexpr bool PERM = true, AFTER_DRAIN = false; static_assert(ACT == 0 || ACT == 1, "EpiBf16: ACT is 0 (none) or 1 (gelu_pk)");
    bf16_t* O; int ldc; const float* bias; int split_cols; size_t split_stride; float scale0;
    __device__ __forceinline__ void operator()(const f32x4 (&acc)[2][2][4][2], const Unit& u, int wr, int wc, int fr, int fq) const {
        const int row0 = u.pm * BM + wr * 64 + fr; int colt = u.pn * BM; bf16_t* base = O;
        float sc = 1.f; if (split_cols) { const int t = colt / split_cols; base += (size_t)t * split_stride; colt -= t * split_cols; if (t == 0) sc = scale0; }
        const int col0 = colt + wc * 32 + 8 * fq, bcol0 = u.pn * BM + wc * 32 + 8 * fq;
        f32x4 bv[2][2];
#pragma unroll
        for (int bj = 0; bj < 2; ++bj)
#pragma unroll
            for (int n = 0; n < 2; ++n) bv[bj][n] = bias ? *(const f32x4*)(bias + bcol0 + bj * HALF + 4 * n) : (f32x4){0.f, 0.f, 0.f, 0.f};
#pragma unroll
        for (int ai = 0; ai < 2; ++ai)
#pragma unroll
            for (int m = 0; m < 4; ++m) { bf16_t* rowp = base + (size_t)(row0 + ai * HALF + m * 16) * ldc + col0;
#pragma unroll
                for (int bj = 0; bj < 2; ++bj) { f32x4 v0 = acc[ai][bj][m][0] + bv[bj][0], v1 = acc[ai][bj][m][1] + bv[bj][1];
                    if (ACT == 1) { f32x2 a = gelu_pk((f32x2){v0[0], v0[1]}), b = gelu_pk((f32x2){v0[2], v0[3]}), c = gelu_pk((f32x2){v1[0], v1[1]}), d = gelu_pk((f32x2){v1[2], v1[3]});
                        v0 = (f32x4){a.x, a.y, b.x, b.y}; v1 = (f32x4){c.x, c.y, d.x, d.y}; }
                    v0 = v0 * sc; v1 = v1 * sc; u32x4 w; w.x = cvt_pk_bf16(v0[0], v0[1]); w.y = cvt_pk_bf16(v0[2], v0[3]); w.z = cvt_pk_bf16(v1[0], v1[1]); w.w = cvt_pk_bf16(v1[2], v1[3]);
                    *(u32x4*)(rowp + bj * HALF) = w; } }
    }
};


struct EpiF32 {
    static constexpr bool PERM = false, AFTER_DRAIN = false;
    float* O; int ldc;
    __device__ __forceinline__ void operator()(const f32x4 (&acc)[2][2][4][2], const Unit& u, int wr, int wc, int fr, int fq) const {
        const int col0 = u.pn * BM + wc * 32 + 4 * fq;
#pragma unroll
        for (int ai = 0; ai < 2; ++ai)
#pragma unroll
            for (int m = 0; m < 4; ++m) { float* rowp = O + (size_t)(u.pm * BM + ai * HALF + wr * 64 + m * 16 + fr) * ldc + col0;
#pragma unroll
                for (int bj = 0; bj < 2; ++bj)
#pragma unroll
                    for (int n = 0; n < 2; ++n) *(f32x4*)(rowp + bj * HALF + n * 16) = acc[ai][bj][m][n]; }
    }
};
struct EpiResid {
    static constexpr bool PERM = false, AFTER_DRAIN = false;
    const float* base_p; const float* base_s; float* out_p; float* out_s; const float* gate;
    __device__ __forceinline__ void operator()(const f32x4 (&acc)[2][2][4][2], const Unit& u, int wr, int wc, int fr, int fq) const {
        const int col0 = u.pn * BM + wc * 32 + 4 * fq;
        if (u.pm < 32) {
            const float* g = gate + (size_t)(u.pm >> 3) * 12288 + col0;
            f32x4 gv[2][2];
#pragma unroll
            for (int bj = 0; bj < 2; ++bj)
#pragma unroll
                for (int n = 0; n < 2; ++n) gv[bj][n] = *(const f32x4*)(g + bj * HALF + n * 16);
#pragma unroll
            for (int ai = 0; ai < 2; ++ai) { f32x4 bs[4][2][2];
#pragma unroll
                for (int m = 0; m < 4; ++m) { const size_t off = (size_t)(u.pm * BM + ai * HALF + wr * 64 + m * 16 + fr) * 2048 + col0;
#pragma unroll
                    for (int bj = 0; bj < 2; ++bj)
#pragma unroll
                        for (int n = 0; n < 2; ++n) bs[m][bj][n] = *(const f32x4*)(base_p + off + bj * HALF + n * 16); }
#pragma unroll
                for (int m = 0; m < 4; ++m) { const size_t off = (size_t)(u.pm * BM + ai * HALF + wr * 64 + m * 16 + fr) * 2048 + col0;
#pragma unroll
                    for (int bj = 0; bj < 2; ++bj)
#pragma unroll
                        for (int n = 0; n < 2; ++n) *(f32x4*)(out_p + off + bj * HALF + n * 16) = bs[m][bj][n] + gv[bj][n] * acc[ai][bj][m][n]; } }
        } else if (wr == 0 && fr < 8) {
            const float* g = gate + (size_t)(4 + fr) * 12288 + col0; const size_t off = (size_t)fr * 2048 + col0;
#pragma unroll
            for (int bj = 0; bj < 2; ++bj)
#pragma unroll
                for (int n = 0; n < 2; ++n) { const f32x4 gv = *(const f32x4*)(g + bj * HALF + n * 16); const f32x4 bs = *(const f32x4*)(base_s + off + bj * HALF + n * 16);
                    *(f32x4*)(out_s + off + bj * HALF + n * 16) = bs + gv * acc[0][bj][0][n]; }
        }
    }
};
struct EpiSwiGLU {
    static constexpr bool PERM = true, AFTER_DRAIN = false;
    bf16_t* O; int ldc;
    __device__ __forceinline__ void operator()(const f32x4 (&acc)[2][2][4][2], const Unit& u, int wr, int wc, int fr, int fq) const {
        const int row0 = u.pm * BM + wr * 64 + fr, col0 = u.pn * HALF + wc * 32 + 8 * fq;
#pragma unroll
        for (int ai = 0; ai < 2; ++ai)
#pragma unroll
            for (int m = 0; m < 4; ++m) { bf16_t* rowp = O + (size_t)(row0 + ai * HALF + m * 16) * ldc + col0;
                float v[8];
#pragma unroll
                for (int n = 0; n < 2; ++n)
#pragma unroll
                    for (int e = 0; e < 4; ++e) { const float g = acc[ai][0][m][n][e], up = acc[ai][1][m][n][e]; v[4 * n + e] = g * __builtin_amdgcn_rcpf(1.0f + __expf(-g)) * up; }
                u32x4 w; w.x = cvt_pk_bf16(v[0], v[1]); w.y = cvt_pk_bf16(v[2], v[3]); w.z = cvt_pk_bf16(v[4], v[5]); w.w = cvt_pk_bf16(v[6], v[7]);
                *(u32x4*)rowp = w; }
    }
};
struct EpiG1 {
    static constexpr bool PERM = true, AFTER_DRAIN = false;
    bf16_t* QB; size_t qkv_stride; bf16_t* RKV; float* P; float *okp, *oks; size_t kv_stride_p, kv_stride_s; const float *qg, *kg;
    __device__ __forceinline__ void operator()(const f32x4 (&acc)[2][2][4][2], const Unit& u, int wr, int wc, int fr, int fq) const {
        const int row0 = u.pm * BM + wr * 64 + fr;
        if (u.pn >= 24) {
            const int col0 = (u.pn - 24) * BM + wc * 32 + 8 * fq;
#pragma unroll
            for (int ai = 0; ai < 2; ++ai)
#pragma unroll
                for (int m = 0; m < 4; ++m) { float* rp = P + (size_t)(row0 + ai * HALF + m * 16) * 768 + col0;
#pragma unroll
                    for (int bj = 0; bj < 2; ++bj) { *(f32x4*)(rp + bj * HALF) = acc[ai][bj][m][0]; *(f32x4*)(rp + bj * HALF + 4) = acc[ai][bj][m][1]; } }
            return;
        }
        const int reg = u.pn >> 2, cb = (4 * (u.pn & 3) + wc) * 64 + 8 * fq;
        if (reg >= 3) {
            const int col0 = (reg - 3) * 1024 + cb;
#pragma unroll
            for (int ai = 0; ai < 2; ++ai)
#pragma unroll
                for (int m = 0; m < 4; ++m) { bf16_t* rp = RKV + (size_t)(row0 + ai * HALF + m * 16) * 3072 + col0;
#pragma unroll
                    for (int bj = 0; bj < 2; ++bj) { u32x4 w; w.x = cvt_pk_bf16(acc[ai][bj][m][0][0], acc[ai][bj][m][0][1]); w.y = cvt_pk_bf16(acc[ai][bj][m][0][2], acc[ai][bj][m][0][3]); w.z = cvt_pk_bf16(acc[ai][bj][m][1][0], acc[ai][bj][m][1][1]); w.w = cvt_pk_bf16(acc[ai][bj][m][1][2], acc[ai][bj][m][1][3]);
                        *(u32x4*)(rp + 32 * bj) = w; } }
            return;
        }
        f32x4 gn[2][2];
#pragma unroll
        for (int bj = 0; bj < 2; ++bj)
#pragma unroll
            for (int n = 0; n < 2; ++n) { const f32x4 a = *(const f32x4*)(qg + 8 * fq + 32 * bj + 4 * n), b = *(const f32x4*)(kg + 8 * fq + 32 * bj + 4 * n); gn[bj][n] = (reg == 0) ? a : b; }
        bf16_t* dstb = QB + (size_t)reg * qkv_stride;
#pragma unroll
        for (int ai = 0; ai < 2; ++ai)
#pragma unroll
            for (int m = 0; m < 4; ++m) { const int row = row0 + ai * HALF + m * 16;
                f32x4 v[2][2];
#pragma unroll
                for (int bj = 0; bj < 2; ++bj)
#pragma unroll
                    for (int n = 0; n < 2; ++n) v[bj][n] = acc[ai][bj][m][n];
                if (reg < 2) { float ss = 0.f;
#pragma unroll
                    for (int bj = 0; bj < 2; ++bj)
#pragma unroll
                        for (int n = 0; n < 2; ++n) ss += (v[bj][n][0] * v[bj][n][0] + v[bj][n][1] * v[bj][n][1]) + (v[bj][n][2] * v[bj][n][2] + v[bj][n][3] * v[bj][n][3]);
                    ss += __shfl_xor(ss, 16); ss += __shfl_xor(ss, 32);
                    const float rs = 1.0f / sqrtf(ss * (1.0f / 64.0f) + 1e-6f);
#pragma unroll
                    for (int bj = 0; bj < 2; ++bj)
#pragma unroll
                        for (int n = 0; n < 2; ++n) v[bj][n] = v[bj][n] * rs * gn[bj][n]; }
                bf16_t* db = dstb + (size_t)row * 1024 + cb;
#pragma unroll
                for (int bj = 0; bj < 2; ++bj) { u32x4 w; w.x = cvt_pk_bf16(v[bj][0][0], v[bj][0][1]); w.y = cvt_pk_bf16(v[bj][0][2], v[bj][0][3]); w.z = cvt_pk_bf16(v[bj][1][0], v[bj][1][1]); w.w = cvt_pk_bf16(v[bj][1][2], v[bj][1][3]);
                    *(u32x4*)(db + 32 * bj) = w; }
                if (reg >= 1) { float* op = nullptr;
                    if (u.pm < 32) op = okp + (size_t)(reg - 1) * kv_stride_p + (size_t)row * 1024 + cb; else if (row - 32 * BM < 8) op = oks + (size_t)(reg - 1) * kv_stride_s + (size_t)(row - 32 * BM) * 1024 + cb;
                    if (op) {
#pragma unroll
                        for (int bj = 0; bj < 2; ++bj) { *(f32x4*)(op + 32 * bj) = v[bj][0]; *(f32x4*)(op + 32 * bj + 4) = v[bj][1]; } } }
            }
    }
};
template <class Epi, class Sched, bool ALIGN_EPI = false, bool SP2 = false>
__device__ __forceinline__ void gemm_phase(PG8_LAS unsigned char* lds, const Gemm g, const Sched& S, const Epi& E) {
    int tid_ = threadIdx.x; asm volatile("" : "+v"(tid_));
    const int tid = tid_, wid = __builtin_amdgcn_readfirstlane(tid >> 6), lane = tid & 63, wr = wid >> 2, wc = wid & 3, fr = lane & 15, fq = lane >> 4;
    const int K = g.K, nt = K / BK;
    unsigned voffA[2], voffB[2];
#pragma unroll
    for (int i = 0; i < 2; ++i) { int R, C; stage_rc(tid * 16 + i * 8192, R, C); const int Rb = Epi::PERM ? ((R & ~31) + perm32(R & 31)) : R;
        voffA[i] = (unsigned)(R * K + C) * 2u; voffB[i] = (unsigned)(Rb * K + C) * 2u; }
    const size_t kstep = (size_t)(BK * 2);
    const size_t hstep = (size_t)HALF * K * 2;
    const size_t tstep = 2 * hstep;
    const unsigned ldsw = (unsigned)wid * 1024u;
    const int aoff = lds_byte(wr * 64 + fr, fq * 8), boff = lds_byte(wc * 32 + fr, fq * 8);
#define PG8_SA(b, h) (((b) * 2 + (h)) * HTB)
#define PG8_SB(b, h) ((4 + (b) * 2 + (h)) * HTB)
#define PG8_STAGE(bufoff, gbase, voff) do { _Pragma("unroll") for (int _i = 0; _i < 2; ++_i) \
        __builtin_amdgcn_global_load_lds((const unsigned*)((const char*)(gbase) + (voff)[_i]), (PG8_LAS unsigned*)(lds + (bufoff) + ldsw + _i * 8192), 16, 0, 0); } while (0)
#define PG8_LDA(dst, b, h) do { _Pragma("unroll") for (int m = 0; m < 4; ++m) _Pragma("unroll") for (int k = 0; k < 2; ++k) dst[m][k] = *(const PG8_LAS bf16x8*)(lds + PG8_SA(b, h) + aoff + m * 2048 + k * 1024); } while (0)
#define PG8_LDB(dst, b, h) do { _Pragma("unroll") for (int n = 0; n < 2; ++n) _Pragma("unroll") for (int k = 0; k < 2; ++k) dst[n][k] = *(const PG8_LAS bf16x8*)(lds + PG8_SB(b, h) + boff + n * 2048 + k * 1024); } while (0)
#define PG8_MMA(ai, bj, At, Bt) do { __builtin_amdgcn_s_setprio(1); _Pragma("unroll") for (int m = 0; m < 4; ++m) _Pragma("unroll") for (int n = 0; n < 2; ++n) _Pragma("unroll") for (int k = 0; k < 2; ++k) \
        acc[ai][bj][m][n] = __builtin_amdgcn_mfma_f32_16x16x32_bf16(Bt[n][k], At[m][k], acc[ai][bj][m][n], 0, 0, 0); __builtin_amdgcn_s_setprio(0); } while (0)
#define PG8_WAIT_V(n) asm volatile("s_waitcnt vmcnt(" #n ")" ::: "memory")
#define PG8_WAIT_L(n) asm volatile("s_waitcnt lgkmcnt(" #n ")" ::: "memory")
#define PG8_BAR __builtin_amdgcn_s_barrier()
#define PG8_SCHED __builtin_amdgcn_sched_barrier(0)
    Unit cur, nxt; int ui = 0;
    if (!S.next(0, cur)) return;
    f32x4 acc[2][2][4][2];
#pragma unroll
    for (int a = 0; a < 2; ++a)
#pragma unroll
        for (int b = 0; b < 2; ++b)
#pragma unroll
            for (int m = 0; m < 4; ++m)
#pragma unroll
                for (int n = 0; n < 2; ++n) acc[a][b][m][n] = (f32x4){0.f, 0.f, 0.f, 0.f};
    bf16x8 At[4][2], B0[2][2], B1[2][2];
    const char* cA = (const char*)g.A + (size_t)cur.pm * tstep; const char* cB = (const char*)g.Bt + (size_t)cur.pn * tstep;
    S.a_ready(cur);
    if constexpr (SP2) {
        PG8_STAGE(PG8_SB(0, 0), cB, voffB); PG8_STAGE(PG8_SB(0, 1), cB + hstep, voffB); PG8_STAGE(PG8_SA(0, 0), cA, voffA); PG8_STAGE(PG8_SA(0, 1), cA + hstep, voffA);
        if (wr == 1) PG8_BAR;
        PG8_WAIT_V(2); PG8_BAR;
        PG8_STAGE(PG8_SB(1, 0), cB + kstep, voffB); PG8_STAGE(PG8_SA(1, 0), cA + kstep, voffA); PG8_STAGE(PG8_SB(1, 1), cB + hstep + kstep, voffB);
        PG8_WAIT_V(6); PG8_BAR;
    } else {
        PG8_STAGE(PG8_SB(0, 0), cB, voffB); PG8_STAGE(PG8_SA(0, 0), cA, voffA); PG8_STAGE(PG8_SB(0, 1), cB + hstep, voffB); PG8_STAGE(PG8_SA(0, 1), cA + hstep, voffA);
        if (wr == 1) PG8_BAR;
        PG8_WAIT_V(4); PG8_BAR;
        PG8_STAGE(PG8_SB(1, 0), cB + kstep, voffB); PG8_STAGE(PG8_SA(1, 0), cA + kstep, voffA); PG8_STAGE(PG8_SB(1, 1), cB + hstep + kstep, voffB);
        PG8_WAIT_V(6); PG8_BAR;
    }
    for (;;) {
        const bool has_next = S.next(ui + 1, nxt);
        const char* nA = has_next ? (const char*)g.A + (size_t)nxt.pm * tstep : cA; const char* nB = has_next ? (const char*)g.Bt + (size_t)nxt.pn * tstep : cB;
        for (int t = 0; t < nt; t += 2) {
            const bool last = (t == nt - 2);
            const char* a1 = cA + (size_t)(t + 1) * kstep;
            const char* a2 = last ? nA : cA + (size_t)(t + 2) * kstep; const char* b2 = last ? nB : cB + (size_t)(t + 2) * kstep;
            const char* a3 = a2 + kstep; const char* b3 = b2 + kstep;
            if (last && has_next) S.a_ready(nxt);
            if constexpr (SP2) {
            PG8_LDB(B0, 0, 0); PG8_LDB(B1, 0, 1); PG8_SCHED; PG8_LDA(At, 0, 0); PG8_STAGE(PG8_SA(1, 1), a1 + hstep, voffA);
            PG8_WAIT_V(8); PG8_WAIT_L(0); PG8_BAR; PG8_MMA(0, 0, At, B0); PG8_MMA(0, 1, At, B1); PG8_BAR; PG8_SCHED;
            PG8_LDA(At, 0, 1); PG8_STAGE(PG8_SB(0, 0), b2, voffB); PG8_STAGE(PG8_SB(0, 1), b2 + hstep, voffB); PG8_STAGE(PG8_SA(0, 0), a2, voffA);
            PG8_WAIT_V(8); PG8_WAIT_L(0); PG8_BAR; PG8_MMA(1, 0, At, B0); PG8_MMA(1, 1, At, B1); PG8_BAR; PG8_SCHED;
            PG8_LDB(B0, 1, 0); PG8_LDB(B1, 1, 1); PG8_SCHED; PG8_LDA(At, 1, 0); PG8_STAGE(PG8_SA(0, 1), a2 + hstep, voffA);
            PG8_WAIT_V(8); PG8_WAIT_L(0); PG8_BAR; PG8_MMA(0, 0, At, B0); PG8_MMA(0, 1, At, B1); PG8_BAR; PG8_SCHED;
            PG8_LDA(At, 1, 1); PG8_STAGE(PG8_SB(1, 0), b3, voffB); PG8_STAGE(PG8_SB(1, 1), b3 + hstep, voffB); PG8_STAGE(PG8_SA(1, 0), a3, voffA);
            PG8_WAIT_V(8); PG8_WAIT_L(0); PG8_BAR; PG8_MMA(1, 0, At, B0); PG8_MMA(1, 1, At, B1); PG8_BAR; PG8_SCHED;
            } else {
            PG8_LDB(B0, 0, 0); PG8_SCHED; PG8_LDA(At, 0, 0); PG8_STAGE(PG8_SA(1, 1), a1 + hstep, voffA);
            PG8_WAIT_L(8); PG8_BAR; PG8_WAIT_L(0); PG8_MMA(0, 0, At, B0); PG8_BAR; PG8_SCHED;
            PG8_LDB(B1, 0, 1); PG8_STAGE(PG8_SB(0, 0), b2, voffB);
            PG8_BAR; PG8_WAIT_L(0); PG8_MMA(0, 1, At, B1); PG8_BAR;
            PG8_LDA(At, 0, 1); PG8_STAGE(PG8_SA(0, 0), a2, voffA);
            PG8_BAR; PG8_WAIT_L(0); PG8_MMA(1, 0, At, B0); PG8_BAR; PG8_SCHED;
            PG8_STAGE(PG8_SB(0, 1), b2 + hstep, voffB);
            PG8_WAIT_V(6); PG8_BAR; PG8_MMA(1, 1, At, B1); PG8_BAR;
            PG8_LDB(B0, 1, 0); PG8_SCHED; PG8_LDA(At, 1, 0); PG8_STAGE(PG8_SA(0, 1), a2 + hstep, voffA);
            PG8_WAIT_L(8); PG8_BAR; PG8_WAIT_L(0); PG8_MMA(0, 0, At, B0); PG8_BAR; PG8_SCHED;
            PG8_LDB(B1, 1, 1); PG8_STAGE(PG8_SB(1, 0), b3, voffB);
            PG8_BAR; PG8_WAIT_L(0); PG8_MMA(0, 1, At, B1); PG8_BAR;
            PG8_LDA(At, 1, 1); PG8_STAGE(PG8_SA(1, 0), a3, voffA);
            PG8_BAR; PG8_WAIT_L(0); PG8_MMA(1, 0, At, B0); PG8_BAR; PG8_SCHED;
            PG8_STAGE(PG8_SB(1, 1), b3 + hstep, voffB);
            PG8_WAIT_V(6); PG8_BAR; PG8_MMA(1, 1, At, B1); PG8_BAR;
            }
        }
        if constexpr (ALIGN_EPI) { if (wr == 0) PG8_BAR; }
        if constexpr (!Epi::AFTER_DRAIN) { E(acc, cur, wr, wc, fr, fq); S.done(cur); }
        if (!has_next) break;
#pragma unroll
        for (int a = 0; a < 2; ++a)
#pragma unroll
            for (int b = 0; b < 2; ++b)
#pragma unroll
                for (int m = 0; m < 4; ++m)
#pragma unroll
                    for (int n = 0; n < 2; ++n) acc[a][b][m][n] = (f32x4){0.f, 0.f, 0.f, 0.f};
        cur = nxt; cA = nA; cB = nB; ++ui;
        if constexpr (ALIGN_EPI) { if (wr == 1) PG8_BAR; }
    }
    PG8_WAIT_V(0);
    if constexpr (!ALIGN_EPI) { if (wr == 0) PG8_BAR; }
    PG8_BAR;
    if constexpr (Epi::AFTER_DRAIN) { E.fused(acc, cur, wr, wc, fr, fq, lds, wid, lane); S.done(cur); }
#undef PG8_SA
#undef PG8_SB
#undef PG8_STAGE
#undef PG8_LDA
#undef PG8_LDB
#undef PG8_MMA
#undef PG8_WAIT_V
#undef PG8_WAIT_L
#undef PG8_BAR
#undef PG8_SCHED
}
}
#define GAS __attribute__((address_space(1)))
#define LAS __attribute__((address_space(3)))
typedef unsigned short bf16;
typedef unsigned v4u __attribute__((ext_vector_type(4)));
typedef float f32x4 __attribute__((ext_vector_type(4)));
typedef short bf16x8 __attribute__((ext_vector_type(8)));
typedef GAS unsigned gu32;
typedef GAS unsigned long long gu64;
#define RLX_AGENT __ATOMIC_RELAXED, __HIP_MEMORY_SCOPE_AGENT
#define LDS_WAIT() asm volatile("s_waitcnt lgkmcnt(0)" ::: "memory")
#define VM_WAIT() asm volatile("s_waitcnt vmcnt(0)" ::: "memory")
__device__ __forceinline__ unsigned long long rt() { return __builtin_amdgcn_s_memrealtime(); }
__device__ __forceinline__ unsigned f2bf(float f) { unsigned u = __builtin_bit_cast(unsigned, f); return (u + 0x7fffu + ((u >> 16) & 1u)) >> 16; }
__device__ __forceinline__ unsigned pk2(float lo, float hi) { return f2bf(lo) | (f2bf(hi) << 16); }
#define XB_TMO      128
#define XB_XCNT(j)  (256  + 64 * (j))
#define XB_XSUB(j)  (1280 + 64 * (j))
#define XB_XGEN(j)  (2304 + 64 * (j))
#define XB_TOP      3328
#define XB_TOPGEN   3392
#define XCD_BAR_WORDS 3456
#define XB_SPIN_CAP (1u << 18)

__device__ __forceinline__ unsigned xb_ld(unsigned* p)              { return __hip_atomic_load(p, __ATOMIC_RELAXED, __HIP_MEMORY_SCOPE_AGENT); }
__device__ __forceinline__ unsigned xb_add(unsigned* p, unsigned v) { return __hip_atomic_fetch_add(p, v, __ATOMIC_RELAXED, __HIP_MEMORY_SCOPE_AGENT); }
__device__ __forceinline__ unsigned xb_xcc_id() { return (unsigned)__builtin_amdgcn_s_getreg((3 << 11) | 20) & 0xFu; }
#define XB_SPIN(cond, bar) do { unsigned _sp = 0; while (cond) { __builtin_amdgcn_s_sleep(1); \
    if ((++_sp & 255u) == 0u) { if (xb_ld(&(bar)[XB_TMO])) break; if (_sp > XB_SPIN_CAP) { atomicAdd(&(bar)[XB_TMO], 1u); break; } } } } while (0)

struct XcdBarrier {
    unsigned* bar; unsigned x;
    volatile LAS unsigned* st;
};

__device__ __forceinline__ XcdBarrier xcd_barrier_post(unsigned* bar, volatile LAS unsigned* st) {
    XcdBarrier b; b.bar = bar; b.x = xb_xcc_id(); b.st = st;
    if (threadIdx.x == 0) (void)xb_add(&bar[XB_XCNT(b.x)], 1u);
    return b;
}
__device__ __forceinline__ void xcd_barrier_complete(unsigned* bar, unsigned x, unsigned& nloc, unsigned& nx) {
    const unsigned G = gridDim.x * gridDim.y * gridDim.z;
    unsigned sum, cnt, mine, sp = 0u;
    for (;;) {
        sum = 0u; cnt = 0u; mine = 0u;
#pragma unroll
        for (unsigned j = 0; j < 16; ++j) { const unsigned c = xb_ld(&bar[XB_XCNT(j)]); sum += c; cnt += (c > 0u) ? 1u : 0u; mine = (j == x) ? c : mine; }
        if (sum == G) break;
        __builtin_amdgcn_s_sleep(1);
        if ((++sp & 255u) == 0u) { if (xb_ld(&bar[XB_TMO])) break; if (sp > XB_SPIN_CAP) { atomicAdd(&bar[XB_TMO], 1u); break; } }
    }
    nloc = mine > 0u ? mine : 1u; nx = cnt > 0u ? cnt : 1u;
}

__device__ __forceinline__ void xcd_barrier(const XcdBarrier& b) {
    asm volatile("s_waitcnt vmcnt(0)" ::: "memory");
    __syncthreads();
    if (threadIdx.x == 0) {
        unsigned* bar = b.bar; asm volatile("" : "+s"(bar));
        __builtin_amdgcn_s_waitcnt(0);
        unsigned nloc = b.st[0], nx = b.st[1];
        if (nloc == 0u) { xcd_barrier_complete(bar, b.x, nloc, nx); b.st[0] = nloc; b.st[1] = nx; }
        const unsigned old = xb_add(&bar[XB_XSUB(b.x)], 1u);
        const unsigned gen = old / nloc;
        if (old + 1u == (gen + 1u) * nloc) {
            __builtin_amdgcn_fence(__ATOMIC_RELEASE, "agent");
            asm volatile("s_waitcnt vmcnt(0)" ::: "memory");
            const unsigned og = xb_add(&bar[XB_TOP], 1u);
            const unsigned tg = og / nx;
            if (og + 1u == (tg + 1u) * nx) xb_add(&bar[XB_TOPGEN], 1u);
            else XB_SPIN(xb_ld(&bar[XB_TOPGEN]) == tg, bar);
            __builtin_amdgcn_fence(__ATOMIC_ACQUIRE, "agent");
            xb_add(&bar[XB_XGEN(b.x)], 1u);
            asm volatile("s_waitcnt vmcnt(0)" ::: "memory");
        } else {
            XB_SPIN(xb_ld(&bar[XB_XGEN(b.x)]) == gen, bar);
            __builtin_amdgcn_fence(__ATOMIC_ACQUIRE, "agent");
            asm volatile("s_waitcnt vmcnt(0)" ::: "memory");
        }
    }
    __syncthreads();
}

#ifndef MK_N_LAUNCHES
#define MK_N_LAUNCHES 1
#endif
#ifndef REP_P0
#define REP_P0 1
#endif
#ifndef REP_N1
#define REP_N1 1
#endif
#ifndef REP_PW
#define REP_PW 1
#endif
#ifndef REP_SCAN
#define REP_SCAN 1
#endif
#ifndef REP_ATT
#define REP_ATT 1
#endif
#ifndef REP_SATT
#define REP_SATT 1
#endif
#ifndef REP_MX
#define REP_MX 1
#endif
#ifndef REP_N2
#define REP_N2 1
#endif
#ifndef REP_G3
#define REP_G3 1
#endif
#ifndef REP_G2
#define REP_G2 1
#endif
#ifndef REP_G4
#define REP_G4 1
#endif
#ifndef REP_BAR
#define REP_BAR 1
#endif
#ifndef REP_G1
#define REP_G1 1
#endif
#ifndef REP_PWL
#define REP_PWL 1
#endif
#ifndef REP_PWM
#define REP_PWM 1
#endif
#ifndef REP_PWR
#define REP_PWR 1
#endif
constexpr int NWAVES = 8, NTHR = 512;
constexpr int DM = 2048, SEQ = 2048, PBATCH = 4, SBATCH = 8, DEPTH = 4, NHEADS = 16, HD = 64, DATT = 1024, DRW = 1024, FF = 5632;
constexpr int MP = PBATCH * SEQ;
constexpr int ROW_S = MP;
constexpr int ROW_SS = MP + 8;
constexpr int NROWS = MP + 8;
constexpr int MH = MP + 256;
constexpr int N1 = 6912;
constexpr int PC0 = 6144, PP0 = 6144 + 384;
constexpr int NLORA = 320;
constexpr int MODW = 6 * DM;
constexpr float RMS_EPS = 1e-6f, GN_EPS = 64e-5f, ATT_SCALE = 0.125f;

enum { I_XP = 0, I_XS, I_CP, I_CS, I_CK, I_CV, I_SWKV, I_SSH, I_RELB, I_ADAW, I_ADAB, I_N1G, I_N2G, I_WIN, I_QG, I_KG, I_MUWAG, I_MURKV,
       I_DW0, I_DW1, I_DW2, I_AA0, I_AW1, I_AW2, I_GW1, I_GW2, I_VMU, I_VV0, I_VW1, I_VW2, I_KK, I_KA, I_RK, I_LNG, I_LNB, I_WOUT, I_WGU, I_WDN, N_IN };
constexpr size_t O_YP = 0, O_YS = O_YP + (size_t)MP * DM, O_KP = O_YS + 8 * DM, O_VP = O_KP + (size_t)DEPTH * MP * DATT, O_WP = O_VP + (size_t)DEPTH * MP * DATT,
                 O_SP = O_WP + (size_t)DEPTH * PBATCH * 16 * 4096, O_KS = O_SP + (size_t)DEPTH * PBATCH * DM, O_VS = O_KS + (size_t)DEPTH * 8 * DATT, O_WS = O_VS + (size_t)DEPTH * 8 * DATT,
                 O_SS = O_WS + (size_t)DEPTH * 8 * 16 * 4096, O_END = O_SS + (size_t)DEPTH * 8 * DM;
static_assert(O_END == 87212032, "output size");

constexpr size_t MiB = 1u << 20;
constexpr size_t WS_CTL = 0, CTL_ZERO_BYTES = 1 * MiB;
constexpr size_t WS_MOD = 1 * MiB;
constexpr size_t WS_BT = 4 * MiB;
constexpr size_t WS_BON = 4 * MiB + 256 * 1024;
constexpr size_t WS_WIN = 8 * MiB;
constexpr size_t WS_WOUT = 116 * MiB;
constexpr size_t WS_WGU = 148 * MiB;
constexpr size_t WS_WDN = 324 * MiB;
constexpr size_t WS_HB = 412 * MiB;
constexpr size_t WS_W2T = 5 * MiB;
constexpr size_t WS_RKV = 446 * MiB;
constexpr size_t WS_P = 546 * MiB;
constexpr size_t WS_QB = 670 * MiB, WS_KB = 687 * MiB, WS_VB = 704 * MiB;
constexpr size_t WS_R = 722 * MiB, WS_W = 755 * MiB, WS_K = 788 * MiB, WS_V = 821 * MiB, WS_A = 854 * MiB, WS_B = 887 * MiB, WS_G = 920 * MiB, WS_VF = 953 * MiB;
constexpr size_t WS_Y = 986 * MiB;
constexpr size_t WS_OBR = 1019 * MiB;
constexpr size_t WS_LSE = 1067 * MiB;
constexpr size_t WS_MIX = 1069 * MiB;
constexpr size_t WS_XB = 1102 * MiB;
constexpr size_t WS_ACT = 1168 * MiB;
constexpr size_t WS_END = 1260 * MiB;
static_assert(WS_WIN + (size_t)DEPTH * N1 * DM * 2 <= WS_WOUT && WS_WGU + (size_t)DEPTH * 2 * FF * DM * 2 <= WS_WDN && WS_WDN + (size_t)DEPTH * DM * FF * 2 <= WS_HB, "ws map (weights)");
static_assert(WS_VB - WS_KB == WS_KB - WS_QB, "q | k | v bf16 buffers are equally spaced");
static_assert(WS_HB + (size_t)MH * DM * 2 <= WS_RKV && WS_RKV + (size_t)MH * 3072 * 4 <= WS_P && WS_P + (size_t)MH * 768 * 4 <= WS_QB && WS_W2T + (size_t)DEPTH * 1024 * 320 * 2 <= WS_WIN && WS_QB + (size_t)MH * DATT * 2 <= WS_KB && WS_VB + (size_t)MH * DATT * 2 <= WS_R, "ws map (act 1)");
static_assert(WS_R + (size_t)NROWS * DRW * 4 <= WS_W && WS_Y + (size_t)NROWS * DRW * 4 <= WS_OBR && WS_OBR + (size_t)3 * MP * DATT * 2 <= WS_LSE && WS_LSE + (size_t)3 * MP * 16 * 4 <= WS_MIX, "ws map (act 2)");
static_assert(WS_MIX + (size_t)MH * DM * 2 <= WS_XB && WS_XB + (size_t)MH * DM * 4 <= WS_ACT && WS_ACT + (size_t)MH * FF * 2 <= WS_END, "ws map (act 3)");
constexpr int CW_BAR = 4096;

constexpr int RING_BYTES = 131072;
constexpr int LDSCTL_OFF = RING_BYTES, MISC_OFF = LDSCTL_OFF + 320;
constexpr int LDS_BYTES = 147456;

constexpr int PH_PER_LAYER = 9, N_PHASES = 1 + DEPTH * PH_PER_LAYER;

struct Args { const float* in[N_IN]; float* out; unsigned char* ws; int ph_lo, ph_hi; };
static_assert(sizeof(Args) == N_IN * 8 + 24, "Args has no padding");

__device__ __forceinline__ float wave_sum(float v) {
#pragma unroll
    for (int o = 1; o < 64; o <<= 1) v += __shfl_xor(v, o);
    return v;
}
__device__ __forceinline__ float wave_max(float v) {
#pragma unroll
    for (int o = 1; o < 64; o <<= 1) v = fmaxf(v, __shfl_xor(v, o));
    return v;
}
template <int CTRL> __device__ __forceinline__ float dpp_mov(float v) { return __builtin_bit_cast(float, __builtin_amdgcn_update_dpp(0, __builtin_bit_cast(int, v), CTRL, 0xf, 0xf, false)); }
__device__ __forceinline__ float row16_sum(float v) {
    v += dpp_mov<0xB1>(v);
    v += dpp_mov<0x4E>(v);
    v += dpp_mov<0x141>(v);
    v += dpp_mov<0x140>(v);
    return v;
}
__device__ __forceinline__ float bf2f(unsigned short b) { return __builtin_bit_cast(float, (unsigned)b << 16); }
__device__ __forceinline__ f32x4 ld4bf(const bf16* p) { const unsigned long long w = *(const unsigned long long*)p; return (f32x4){__builtin_bit_cast(float, (unsigned)w << 16), __builtin_bit_cast(float, (unsigned)w & 0xffff0000u), __builtin_bit_cast(float, (unsigned)(w >> 32) << 16), __builtin_bit_cast(float, (unsigned)(w >> 32) & 0xffff0000u)}; }
__device__ __forceinline__ f32x4 up4bf(unsigned long long w) { return (f32x4){__builtin_bit_cast(float, (unsigned)w << 16), __builtin_bit_cast(float, (unsigned)w & 0xffff0000u), __builtin_bit_cast(float, (unsigned)(w >> 32) << 16), __builtin_bit_cast(float, (unsigned)(w >> 32) & 0xffff0000u)}; }
__device__ __forceinline__ void st4bf(bf16* p, f32x4 v) { *(unsigned long long*)p = (unsigned long long)pk2(v[0], v[1]) | ((unsigned long long)pk2(v[2], v[3]) << 32); }
__device__ __forceinline__ float sigmoidf_(float x) { return 1.0f / (1.0f + __expf(-x)); }

__device__ __forceinline__ void p0_transpose_item(const float* W, int N, int k0, int n0, bf16* WT, int ldt, int drow0, const float* mu, int smode, LAS float* scr, int lane, int kdst = -1, int krows = 64) {
    if (kdst < 0) kdst = k0;
    float vals[32];
#pragma unroll
    for (int i = 0; i < 32; ++i) { const int kk = 2 * i + (lane >> 5); vals[i] = W[(size_t)(k0 + ((kk < krows) ? kk : krows - 1)) * N + n0 + (lane & 31)]; }
    if (smode) {
#pragma unroll
        for (int i = 0; i < 32; ++i) { const int kk = 2 * i + (lane >> 5); const float mm = mu[k0 + ((kk < krows) ? kk : krows - 1)]; vals[i] *= (smode == 1) ? (1.0f - mm) : mm; } }
#pragma unroll
    for (int i = 0; i < 32; ++i) { const int kk = 2 * i + (lane >> 5); scr[kk * 33 + (lane & 31)] = (kk < krows) ? vals[i] : 0.f; }
    LDS_WAIT(); asm volatile("" ::: "memory");
    const int c = lane & 7;
    if (8 * c < krows) {
#pragma unroll
        for (int j = 0; j < 4; ++j) { const int n = (lane >> 3) + 8 * j; const LAS float* s = scr + (8 * c) * 33 + n;
            v4u o; o.x = pk2(s[0 * 33], s[1 * 33]); o.y = pk2(s[2 * 33], s[3 * 33]); o.z = pk2(s[4 * 33], s[5 * 33]); o.w = pk2(s[6 * 33], s[7 * 33]);
            *(GAS v4u*)(WT + (size_t)(drow0 + n) * ldt + kdst + 8 * c) = o; }
    }
    LDS_WAIT(); asm volatile("" ::: "memory");
}
__device__ __forceinline__ int rel_bucket(int d) {
    if (d < 16) return d;
    const int large = 16 + (int)(logf((float)d / 16.0f) / logf(128.0f) * 16.0f);
    return large < 31 ? large : 31;
}
constexpr int I_IN = (DM / 64) * (6144 / 32), I_LD = (DM / 64) * 2, I_LG = (DM / 64) * 5, I_LV = (DM / 64) * 1, I_OUT = (DM / 64) * (DM / 32), I_GU = (DM / 64) * (2 * FF / 32), I_DN = (FF / 64) * (DM / 32);
constexpr int I_W2 = 32 * 6;
constexpr int I_LAYER = I_IN + 2 * (2 * I_LD + I_LG + I_LV) + I_W2 + I_OUT + I_GU + I_DN;
constexpr int CONV_BATCH = 32, N_CONV_BATCHES = (I_LAYER + CONV_BATCH - 1) / CONV_BATCH, N_MOD_ITEMS = MODW / 256, N_PREP_ITEMS = N_MOD_ITEMS + N_CONV_BATCHES;
#ifndef TAIL_PULLS_N
#define TAIL_PULLS_N 3
#endif
#ifndef CONV_GS_N
#define CONV_GS_N 4
#endif
constexpr int TAIL_PULLS = TAIL_PULLS_N;
constexpr int CONV_GS = CONV_GS_N;
constexpr int CW_PWF = 9216;
constexpr int CW_Q = 8192;
__device__ __forceinline__ void mod_block_item(const Args& args, int l, int c0, LAS unsigned char* lds, int tid, int lane, int wave) {
    unsigned char* ws = args.ws; float* MOD = (float*)(ws + WS_MOD);
        LAS float* sl = (LAS float*)lds;
        __syncthreads();
        for (int i = tid; i < 12 * DM; i += NTHR) { const int bb = i / DM, k = i % DM; const float c = (bb < 4) ? args.in[I_CP][bb * DM + k] : args.in[I_CS][(bb - 4) * DM + k];
            sl[k * 12 + bb] = c / (1.0f + __expf(-c)); }
        __syncthreads();
        const float* Wl = args.in[I_ADAW] + (size_t)l * DM * MODW + c0 + 4 * lane;
        f32x4 acc[12];
#pragma unroll
        for (int bb = 0; bb < 12; ++bb) acc[bb] = (f32x4){0.f, 0.f, 0.f, 0.f};
        const int kb = wave * 256;
#pragma unroll 1
        for (int k0 = kb; k0 < kb + 256; k0 += 16) {
            f32x4 wv[16];
#pragma unroll
            for (int i = 0; i < 16; ++i) wv[i] = *(const f32x4*)(Wl + (size_t)(k0 + i) * MODW);
#pragma unroll
            for (int i = 0; i < 16; ++i) { const int k = k0 + i; const f32x4 w = wv[i];
                const f32x4 s0 = *(const LAS f32x4*)(sl + k * 12), s1 = *(const LAS f32x4*)(sl + k * 12 + 4), s2 = *(const LAS f32x4*)(sl + k * 12 + 8);
                acc[0] += w * s0.x; acc[1] += w * s0.y; acc[2] += w * s0.z; acc[3] += w * s0.w;
                acc[4] += w * s1.x; acc[5] += w * s1.y; acc[6] += w * s1.z; acc[7] += w * s1.w;
                acc[8] += w * s2.x; acc[9] += w * s2.y; acc[10] += w * s2.z; acc[11] += w * s2.w; }
        }
        __syncthreads();
        LAS float* part = (LAS float*)lds;
#pragma unroll
        for (int bb = 0; bb < 12; ++bb) *(LAS f32x4*)(part + (wave * 12 + bb) * 256 + 4 * lane) = acc[bb];
        __syncthreads();
        for (int i = tid; i < 12 * 256; i += NTHR) { const int bb = i / 256, c = i % 256; float s = args.in[I_ADAB][l * MODW + c0 + c];
#pragma unroll
            for (int w = 0; w < 8; ++w) s += part[(w * 12 + bb) * 256 + c];
            MOD[((size_t)l * 12 + bb) * MODW + c0 + c] = s; }
        __syncthreads();
}
__device__ __forceinline__ void conv_wave_item(const Args& args, int l, int r, LAS float* scr, int lane) {
    unsigned char* ws = args.ws;
    bf16* WIN = (bf16*)(ws + WS_WIN) + (size_t)l * N1 * DM;
    const float* W = nullptr; int N = 0, k0 = 0, n0 = 0, ldt = DM, drow0 = 0, smode = 0, kdst = -1, krows = 64; bf16* WT = WIN; const float* mu = nullptr; bool skip = false;
    constexpr int LH = 2 * I_LD + I_LG + I_LV;
    if (r < I_IN) { const int nblk = 6144 / 32, kbk = r / nblk, nb = r % nblk; n0 = 32 * nb; k0 = 64 * kbk;
        drow0 = 256 * (n0 / 256) + 128 * ((n0 % 64) / 32) + 32 * ((n0 % 256) / 64);
        W = args.in[I_WIN] + (size_t)l * DM * 6144; N = 6144; }
    else if ((r -= I_IN) < 2 * LH) {
        const int half = r / LH, base = half ? PP0 : PC0; int q = r % LH; smode = 1 + half;
        if (q < I_LD) { W = args.in[I_DW1] + (size_t)l * DM * 64; N = 64; k0 = 64 * (q / 2); n0 = 32 * (q % 2); drow0 = base + 0 + n0; mu = args.in[I_MUWAG] + ((size_t)l * 3 + 0) * DM; }
        else if ((q -= I_LD) < I_LD) { W = args.in[I_AW1] + (size_t)l * DM * 64; N = 64; k0 = 64 * (q / 2); n0 = 32 * (q % 2); drow0 = base + 64 + n0; mu = args.in[I_MUWAG] + ((size_t)l * 3 + 1) * DM; }
        else if ((q -= I_LD) < I_LG) { W = args.in[I_GW1] + (size_t)l * DM * 160; N = 160; k0 = 64 * (q / 5); n0 = 32 * (q % 5); drow0 = base + 128 + n0; mu = args.in[I_MUWAG] + ((size_t)l * 3 + 2) * DM; }
        else { q -= I_LG; if (l > 0) { W = args.in[I_VW1] + (size_t)(l - 1) * DM * 32; N = 32; k0 = 64 * q; n0 = 0; drow0 = base + 288; mu = args.in[I_VMU] + (size_t)(l - 1) * DM; } else skip = true; } }
    else if ((r -= 2 * LH) < I_W2) { const int kb = r / 32; n0 = 32 * (r % 32); N = DRW; WT = (bf16*)(ws + WS_W2T) + (size_t)l * 1024 * NLORA; ldt = NLORA; drow0 = n0; k0 = 0;
        if (kb == 0) { W = args.in[I_DW2] + (size_t)l * 64 * DRW; kdst = 0; }
        else if (kb == 1) { W = args.in[I_AW2] + (size_t)l * 64 * DRW; kdst = 64; }
        else if (kb < 5) { W = args.in[I_GW2] + (size_t)l * 160 * DRW; k0 = 64 * (kb - 2); kdst = 128 + 64 * (kb - 2); krows = (kb == 4) ? 32 : 64; }
        else if (l > 0) { W = args.in[I_VW2] + (size_t)(l - 1) * 32 * DRW; kdst = 288; krows = 32; } else skip = true; }
    else if ((r -= I_W2) < I_OUT) { const int nblk = DM / 32; k0 = 64 * (r / nblk); n0 = 32 * (r % nblk); W = args.in[I_WOUT] + (size_t)l * DM * DM; N = DM; WT = (bf16*)(ws + WS_WOUT) + (size_t)l * DM * DM; drow0 = n0; }
    else if ((r -= I_OUT) < I_GU) { const int nblk = 2 * FF / 32; k0 = 64 * (r / nblk); n0 = 32 * (r % nblk);
        const int nn = (n0 < FF) ? n0 : n0 - FF; drow0 = 256 * (nn / 128) + (nn % 128) + ((n0 < FF) ? 0 : 128);
        W = args.in[I_WGU] + (size_t)l * DM * 2 * FF; N = 2 * FF; WT = (bf16*)(ws + WS_WGU) + (size_t)l * 2 * FF * DM; }
    else { r -= I_GU; const int nblk = DM / 32; k0 = 64 * (r / nblk); n0 = 32 * (r % nblk); W = args.in[I_WDN] + (size_t)l * FF * DM; N = DM; WT = (bf16*)(ws + WS_WDN) + (size_t)l * DM * FF; ldt = FF; drow0 = n0; }
    if (!skip) p0_transpose_item(W, N, k0, n0, WT, ldt, drow0, mu, smode, scr, lane, kdst, krows);
}
typedef float f32x2_t __attribute__((ext_vector_type(2))); typedef __bf16 bf16x2_t __attribute__((ext_vector_type(2)));
__device__ __forceinline__ unsigned cvtpk(float lo, float hi) { f32x2_t v = {lo, hi}; bf16x2_t b = __builtin_convertvector(v, bf16x2_t); return __builtin_bit_cast(unsigned, b); }
constexpr int T_IN = (DM / 128) * (6144 / 128), T_OUT = (DM / 128) * (DM / 128), T_GU = (DM / 128) * (2 * FF / 128), T_DN = (FF / 128) * (DM / 128), T_BIG = T_IN + T_OUT + T_GU + T_DN;
constexpr int I_SMALL = 2 * (2 * I_LD + I_LG + I_LV) + I_W2, N_SMALL_B = (I_SMALL + CONV_BATCH - 1) / CONV_BATCH, N_CONV_ITEMS = T_BIG;
#define CT_DECODE(t_, W_, WT_, N_, ldt_, kind_, k0_, n0_) do { int t = (t_); unsigned char* ws_ = args.ws; \
        if (t < T_IN) { W_ = pWIN_ + (size_t)l * DM * 6144; N_ = 6144; WT_ = (bf16*)(ws_ + WS_WIN) + (size_t)l * N1 * DM; ldt_ = DM; kind_ = 0; k0_ = 128 * (t / 48); n0_ = 128 * (t % 48); } \
        else if ((t -= T_IN) < T_OUT) { W_ = pWOUT_ + (size_t)l * DM * DM; N_ = DM; WT_ = (bf16*)(ws_ + WS_WOUT) + (size_t)l * DM * DM; ldt_ = DM; kind_ = 1; k0_ = 128 * (t / 16); n0_ = 128 * (t % 16); } \
        else if ((t -= T_OUT) < T_GU) { W_ = pWGU_ + (size_t)l * DM * 2 * FF; N_ = 2 * FF; WT_ = (bf16*)(ws_ + WS_WGU) + (size_t)l * 2 * FF * DM; ldt_ = DM; kind_ = 2; k0_ = 128 * (t / 88); n0_ = 128 * (t % 88); } \
        else { t -= T_GU; W_ = pWDN_ + (size_t)l * FF * DM; N_ = DM; WT_ = (bf16*)(ws_ + WS_WDN) + (size_t)l * DM * FF; ldt_ = FF; kind_ = 1; k0_ = 128 * (t / 16); n0_ = 128 * (t % 16); } } while (0)
#define CT_LOAD(W_, N_, k0_, n0_) do { const float* wb_ = (W_) + (size_t)(k0_) * (N_) + (n0_); const unsigned lo_ = (unsigned)((2 * (2 * wave + half)) * (N_) + 4 * l5); \
        _Pragma("unroll") for (int i = 0; i < 4; ++i) { va[i] = *(const f32x4*)(wb_ + lo_ + (unsigned)(32 * i * (N_))); vb[i] = *(const f32x4*)(wb_ + lo_ + (unsigned)((32 * i + 1) * (N_))); } } while (0)
__device__ __forceinline__ void conv_pull(const Args& args, int l, int gs, bool unlimited, LAS unsigned char* lds, volatile LAS unsigned* bcast) {
    int tid_ = threadIdx.x; asm volatile("" : "+v"(tid_)); const int tid = tid_, lane = tid & 63, wave = __builtin_amdgcn_readfirstlane(tid >> 6);
    unsigned* ctr = (unsigned*)(args.ws + WS_CTL) + CW_Q + 64 * l;
    const int half = lane >> 5, l5 = lane & 31;
    const float* pWIN_ = args.in[I_WIN]; const float* pWOUT_ = args.in[I_WOUT]; const float* pWGU_ = args.in[I_WGU]; const float* pWDN_ = args.in[I_WDN];
    asm volatile("" : "+s"(pWIN_), "+s"(pWOUT_), "+s"(pWGU_), "+s"(pWDN_));
    __syncthreads();
    if (tid == 0) *bcast = __hip_atomic_fetch_add(ctr, (unsigned)gs, __ATOMIC_RELAXED, __HIP_MEMORY_SCOPE_AGENT);
    __syncthreads();
    int base = __builtin_amdgcn_readfirstlane((int)*bcast), buf = 0;
#pragma unroll 1
    while (base < N_CONV_ITEMS) {
        unsigned pending = 0u;
        if (unlimited && tid == 0) pending = __hip_atomic_fetch_add(ctr, (unsigned)gs, __ATOMIC_RELAXED, __HIP_MEMORY_SCOPE_AGENT);
        const int cnt = (N_CONV_ITEMS - base < gs) ? N_CONV_ITEMS - base : gs;
        bool have = false; f32x4 va[4], vb[4];
#pragma unroll
        for (int i = 0; i < 4; ++i) { va[i] = (f32x4){0.f, 0.f, 0.f, 0.f}; vb[i] = va[i]; }
#pragma unroll 1
        for (int j = 0; j < cnt; ++j) { const int it = base + j;
            const float* W; bf16* WT; int N, ldt, kind, k0, n0;
            CT_DECODE(it, W, WT, N, ldt, kind, k0, n0);
            if (!have) CT_LOAD(W, N, k0, n0);
            { LAS unsigned char* tb = lds + buf * 32768 + (4 * l5) * 256;
#pragma unroll
              for (int i = 0; i < 4; ++i) { const int rp = 2 * wave + half + 16 * i; const int dw = (rp ^ (2 * l5)) << 2;
#pragma unroll
                  for (int jn = 0; jn < 4; ++jn) *(LAS unsigned*)(tb + jn * 256 + dw) = cvtpk(va[i][jn], vb[i][jn]); } }
            __syncthreads();
            have = (j + 1 < cnt);
            if (have) { const float* W2; bf16* WT2; int N2, ldt2, kind2, k02, n02; CT_DECODE(it + 1, W2, WT2, N2, ldt2, kind2, k02, n02); (void)WT2; (void)ldt2; (void)kind2;
                CT_LOAD(W2, N2, k02, n02); }
            { v4u o[4];
#pragma unroll
              for (int s = 0; s < 4; ++s) { const int nl = 16 * wave + 4 * s + (lane >> 4), kc = lane & 15, swz = 2 * ((nl >> 2) & 31);
                  const v4u v = *(const LAS v4u*)(lds + buf * 32768 + nl * 256 + (((4 * kc) ^ (swz & 60)) << 2)); o[s] = (swz & 2) ? (v4u){v.z, v.w, v.x, v.y} : v; }
#pragma unroll
              for (int s = 0; s < 4; ++s) { const int nl = 16 * wave + 4 * s + (lane >> 4), kc = lane & 15, n = n0 + nl;
                  int drow = n;
                  if (kind == 0) drow = 256 * (n / 256) + 128 * ((n % 64) / 32) + 32 * ((n % 256) / 64) + (n % 32);
                  else if (kind == 2) { const int nn = (n < FF) ? n : n - FF; drow = 256 * (nn / 128) + (nn % 128) + ((n < FF) ? 0 : 128); }
                  *(GAS v4u*)(WT + (size_t)drow * ldt + k0 + 8 * kc) = o[s]; } }
            buf ^= 1;
        }
        if (!unlimited) break;
        __syncthreads();
        if (tid == 0) *bcast = pending;
        __syncthreads();
        base = __builtin_amdgcn_readfirstlane((int)*bcast);
    }
    __syncthreads();
}
#undef CT_DECODE
#undef CT_LOAD
__device__ __forceinline__ void prep_item(const Args& args, int l, int item, LAS unsigned char* lds, int tid, int lane, int wave) {
    if (item < N_MOD_ITEMS) { mod_block_item(args, l, item * 256, lds, tid, lane, wave); return; }
    __syncthreads();
    LAS float* scr = (LAS float*)(lds + wave * 16384); const int r0 = (item - N_MOD_ITEMS) * CONV_BATCH + wave * (CONV_BATCH / NWAVES);
#pragma unroll 1
    for (int k = 0; k < CONV_BATCH / NWAVES; ++k) if (r0 + k < I_LAYER) conv_wave_item(args, l, r0 + k, scr, lane);
}
__device__ __forceinline__ void prep_layer_all(const Args& args, int l, LAS unsigned char* lds, int vcu, int G) {
    int tid_ = threadIdx.x; asm volatile("" : "+v"(tid_)); const int tid = tid_, lane = tid & 63, wave = __builtin_amdgcn_readfirstlane(tid >> 6);
#pragma unroll 1
    for (int it = vcu; it < N_PREP_ITEMS; it += G) prep_item(args, l, it, lds, tid, lane, wave);
    __syncthreads();
}
__device__ __forceinline__ void prep_layer_pull(const Args& args, int l, int kind, int max_items, LAS unsigned char* lds, volatile LAS unsigned* bcast) {
    int tid_ = threadIdx.x; asm volatile("" : "+v"(tid_)); const int tid = tid_, lane = tid & 63, wave = __builtin_amdgcn_readfirstlane(tid >> 6);
    unsigned* ctr = (unsigned*)(args.ws + WS_CTL) + CW_Q + 64 * (4 * kind + l); const int n_items = (kind == 2) ? N_SMALL_B : kind ? N_MOD_ITEMS : N_CONV_BATCHES;
#pragma unroll 1
    for (int k = 0; k < max_items; ++k) {
        __syncthreads();
        if (tid == 0) *bcast = __hip_atomic_fetch_add(ctr, 1u, __ATOMIC_RELAXED, __HIP_MEMORY_SCOPE_AGENT);
        __syncthreads();
        const int item = (int)*bcast;
        if (item >= n_items) break;
        if (kind == 2) {
            __syncthreads();
            LAS float* scr = (LAS float*)(lds + wave * 16384); const int r0 = I_IN + item * CONV_BATCH + wave * (CONV_BATCH / NWAVES);
#pragma unroll 1
            for (int k = 0; k < CONV_BATCH / NWAVES; ++k) if (r0 + k < I_IN + I_SMALL) conv_wave_item(args, l, r0 + k, scr, lane);
            continue; }
        prep_item(args, l, kind ? item : N_MOD_ITEMS + item, lds, tid, lane, wave);
    }
    __syncthreads();
}
__device__ __forceinline__ void p0_prologue(const Args& args, LAS unsigned char* lds, int vcu, int G, volatile LAS unsigned* bcast) {
    if (vcu == G - 1) {
        float* BT = (float*)(args.ws + WS_BT);
        for (int i = threadIdx.x; i < 3 * 129 * 16; i += NTHR) { const int h = i & 15, m = (i >> 4) % 129, br = (i >> 4) / 129; BT[i] = args.in[I_RELB][rel_bucket(m << (2 * br)) * 16 + h]; }
    }
    prep_layer_pull(args, 0, 1, 1 << 30, lds, bcast); prep_layer_pull(args, 0, 2, 1 << 30, lds, bcast); conv_pull(args, 0, CONV_GS, true, lds, bcast);
}

__device__ __forceinline__ void norm_mod_row(const float* xrow, const float* g, const float* sh, const float* sc, bf16* hrow, float* frow, int lane) {
    const GAS f32x4* xr = (const GAS f32x4*)xrow + lane;
    f32x4 v[8]; float s = 0.f;
#pragma unroll
    for (int j = 0; j < 8; ++j) { v[j] = xr[64 * j]; s += (v[j].x * v[j].x + v[j].y * v[j].y) + (v[j].z * v[j].z + v[j].w * v[j].w); }
    const float rstd = 1.0f / sqrtf(wave_sum(s) * (1.0f / DM) + RMS_EPS);
    GAS unsigned long long* o8 = (GAS unsigned long long*)hrow + lane;
#pragma unroll
    for (int j = 0; j < 8; ++j) { const f32x4 g4 = ((const GAS f32x4*)g)[lane + 64 * j], sh4 = ((const GAS f32x4*)sh)[lane + 64 * j], sc4 = ((const GAS f32x4*)sc)[lane + 64 * j];
        const f32x4 h = (v[j] * rstd * g4) * (sc4 + 1.0f) + sh4;
        o8[64 * j] = (unsigned long long)pk2(h.x, h.y) | ((unsigned long long)pk2(h.z, h.w) << 32);
        if (frow) ((GAS f32x4*)frow)[lane + 64 * j] = h; }
}

__device__ __forceinline__ void pw_phase(const Args& args, int l, LAS unsigned char* lds, int vcu, int G, int t_lo, int t_hi) {
    int tid_ = threadIdx.x; asm volatile("" : "+v"(tid_)); const int tid = tid_, lane = tid & 63, wave = __builtin_amdgcn_readfirstlane(tid >> 6);
    typedef float f32x16 __attribute__((ext_vector_type(16)));
    unsigned char* ws = args.ws;
    const bf16* RKV = (const bf16*)(ws + WS_RKV); const float* P = (const float*)(ws + WS_P); const bf16* W2T = (const bf16*)(ws + WS_W2T) + (size_t)l * 1024 * NLORA;
    bf16* Rr = (bf16*)(ws + WS_R); float* Ww = (float*)(ws + WS_W); bf16* Kk = (bf16*)(ws + WS_K); bf16* Vv = (bf16*)(ws + WS_V);
    bf16* Aa = (bf16*)(ws + WS_A); bf16* Bb = (bf16*)(ws + WS_B); bf16* Gg = (bf16*)(ws + WS_G); float* VF = (float*)(ws + WS_VF); float* BON = (float*)(ws + WS_BON);
    constexpr int LST = 328, SST = 68;
    LAS unsigned short* L = (LAS unsigned short*)lds;
    LAS float* Sw = (LAS float*)(lds + 21504) + wave * (32 * SST);
    const int r32 = lane & 31, hf = lane >> 5, rs = lane >> 4, c4 = (lane & 15) * 4;
    const float* mur = args.in[I_MURKV] + (size_t)l * 3 * DRW;
    for (int tile = t_lo; tile < t_hi; tile += G) {
        const int m0 = tile < 256 ? tile * 32 : MP, nv = tile < 256 ? 32 : 8;
        __syncthreads();
        for (int repl = 0; repl < REP_PWL; ++repl)
#pragma unroll 10
        for (int i = tid; i < nv * NLORA; i += NTHR) { const int r = i / NLORA, c = i % NLORA; const int m = m0 + r;
            const int pm = (m < MP) ? (((m & (SEQ - 1)) == 0) ? -1 : m - 1) : m + 8;
            const float v = P[(size_t)m * 768 + c] + ((pm >= 0) ? 1.f : 0.f) * P[(size_t)((pm >= 0) ? pm : m) * 768 + 384 + c];
            const float e2 = __expf(2.0f * v), th = 1.0f - 2.0f / (1.0f + e2), sg = 1.0f / (1.0f + __expf(-v));
            L[r * LST + c] = (unsigned short)f2bf((c < 64) ? th : ((c >= 128 && c < 288) ? sg : v)); }
        __syncthreads();
        const bf16* w2a = W2T + (size_t)(128 * wave + r32) * NLORA + 8 * hf; const LAS unsigned short* lb = L + r32 * LST + 8 * hf;
        asm volatile("" : "+v"(w2a));
        f32x16 acc[4];
#define PW_MM(koff, nks, CH) do { for (int repm = 0; repm < REP_PWM; ++repm) { _Pragma("unroll") for (int nt = 0; nt < 4; ++nt) acc[nt] = (f32x16){0.f}; \
        _Pragma("unroll 1") for (int kp = 0; kp < (nks); kp += (CH)) { bf16x8 bl[CH], aw[CH][4]; \
            _Pragma("unroll") for (int k2 = 0; k2 < (CH); ++k2) { bl[k2] = *(const LAS bf16x8*)(lb + (koff) + 16 * (kp + k2)); \
                _Pragma("unroll") for (int nt = 0; nt < 4; ++nt) aw[k2][nt] = *(const bf16x8*)(w2a + (size_t)(32 * nt) * NLORA + (koff) + 16 * (kp + k2)); } \
            _Pragma("unroll") for (int k2 = 0; k2 < (CH); ++k2) _Pragma("unroll") for (int nt = 0; nt < 4; ++nt) acc[nt] = __builtin_amdgcn_mfma_f32_32x32x16_bf16(aw[k2][nt], bl[k2], acc[nt], 0, 0, 0); } } } while (0)
#define PW_STAGE(hp) do { _Pragma("unroll") for (int n2 = 0; n2 < 2; ++n2) _Pragma("unroll") for (int g = 0; g < 4; ++g) \
            *(LAS f32x4*)(Sw + r32 * SST + 32 * n2 + 8 * g + 4 * hf) = (f32x4){acc[2 * (hp) + n2][4 * g], acc[2 * (hp) + n2][4 * g + 1], acc[2 * (hp) + n2][4 * g + 2], acc[2 * (hp) + n2][4 * g + 3]}; } while (0)
#define PW_AV(it) (*(const LAS f32x4*)(Sw + (4 * (it) + rs) * SST + c4))
        const unsigned vo1_ = (unsigned)(rs * DRW + c4), vo3_ = (unsigned)(rs * 3072 + c4);
        const unsigned voh_ = (tile < 256) ? (unsigned)(rs * 64 + c4) : vo1_;
#define PW_HM(it, chu) ((tile < 256) ? ((size_t)(((m0 >> 11) * 16 + ((chu) >> 6)) * SEQ + (m0 & (SEQ - 1)) + 4 * (it)) * 64) : ((size_t)(m0 + 4 * (it)) * DRW + (chu)))
#define PW_LOCAL_OFFS unsigned vo1 = vo1_, vo3 = vo3_, voh = voh_; asm volatile("" : "+v"(vo1), "+v"(vo3), "+v"(voh)); (void)vo3; (void)voh;
        const int pd = (tile < 256) ? -1 : 8;
        const int nhalf = (tile < 256) ? 2 : 1;
        const float pm0 = (tile < 256 && (m0 & (SEQ - 1)) == 0 && rs == 0) ? 0.f : 1.f;
        PW_MM(0, 4, 4);
#pragma unroll
        for (int hp = 0; hp < 2; ++hp) { PW_LOCAL_OFFS const int chu = 128 * wave + 64 * hp; const f32x4 w0 = *(const f32x4*)(args.in[I_DW0] + (size_t)l * DRW + chu + c4);
            PW_STAGE(hp);
#pragma unroll 1
            for (int half = 0; half < nhalf; ++half)
#pragma unroll
            for (int it = 4 * half; it < 4 * half + 4; ++it) { const f32x4 x = w0 + PW_AV(it); f32x4 o;
#pragma unroll
                for (int e = 0; e < 4; ++e) { const float sp = fmaxf(-x[e], 0.f) + __logf(1.0f + __expf(-fabsf(x[e]))); o[e] = __expf(-__expf(-sp - 0.5f)); }
                *(f32x4*)(Ww + PW_HM(it, chu) + voh) = o; } }
        if (l > 0) PW_MM(288, 2, 2);
#pragma unroll
        for (int hp = 0; hp < 2; ++hp) { PW_LOCAL_OFFS const int chu = 128 * wave + 64 * hp; const f32x4 mu2 = *(const f32x4*)(mur + 2 * DRW + chu + c4); f32x4 v0 = (f32x4){0.f, 0.f, 0.f, 0.f};
            if (l > 0) v0 = *(const f32x4*)(args.in[I_VV0] + (size_t)(l - 1) * DRW + chu + c4);
            PW_STAGE(hp);
#pragma unroll 1
            for (int half = 0; half < nhalf; ++half) { unsigned long long x0[4], xp[4]; f32x4 vf[4];
#pragma unroll
              for (int i = 0; i < 4; ++i) { const int it = 4 * half + i; const bf16* a_ = RKV + (size_t)(m0 + 4 * it) * 3072 + 2048 + chu; const bf16* b_ = RKV + ((size_t)(m0 + 4 * it) + pd) * 3072 + 2048 + chu;
                  x0[i] = *(const unsigned long long*)(a_ + vo3); xp[i] = *(const unsigned long long*)(b_ + vo3);
                  vf[i] = (l > 0) ? *(const f32x4*)(VF + (size_t)(m0 + 4 * it) * DRW + chu + vo1) : (f32x4){0.f, 0.f, 0.f, 0.f}; }
#pragma unroll
              for (int i = 0; i < 4; ++i) { const int it = 4 * half + i; const f32x4 xc = up4bf(x0[i]); f32x4 vr = xc + (up4bf(xp[i]) * ((it == 0) ? pm0 : 1.f) - xc) * mu2;
                  if (l > 0) { const f32x4 x = v0 + PW_AV(it); f32x4 vg;
#pragma unroll
                      for (int e = 0; e < 4; ++e) vg[e] = sigmoidf_(x[e]);
                      vr = vr + (vf[i] - vr) * vg; }
                  else *(f32x4*)(VF + (size_t)(m0 + 4 * it) * DRW + chu + vo1) = vr;
                  st4bf(Vv + PW_HM(it, chu) + voh, vr); }
            } }
        PW_MM(128, 10, 2);
#pragma unroll
        for (int hp = 0; hp < 2; ++hp) { PW_LOCAL_OFFS const int chu = 128 * wave + 64 * hp;
            PW_STAGE(hp);
#pragma unroll 1
            for (int half = 0; half < nhalf; ++half)
#pragma unroll
            for (int it = 4 * half; it < 4 * half + 4; ++it) st4bf(Gg + (size_t)(m0 + 4 * it) * DRW + chu + vo1, PW_AV(it)); }
        PW_MM(64, 4, 4);
#pragma unroll
        for (int hp = 0; hp < 2; ++hp) { PW_LOCAL_OFFS const int chu = 128 * wave + 64 * hp;
            const f32x4 a0 = *(const f32x4*)(args.in[I_AA0] + (size_t)l * DRW + chu + c4), kk4 = *(const f32x4*)(args.in[I_KK] + (size_t)l * DRW + chu + c4), ka4 = *(const f32x4*)(args.in[I_KA] + (size_t)l * DRW + chu + c4);
            const f32x4 mu0 = *(const f32x4*)(mur + chu + c4), mu1 = *(const f32x4*)(mur + DRW + chu + c4), rk4 = *(const f32x4*)(args.in[I_RK] + (size_t)l * DRW + chu + c4);
            PW_STAGE(hp);
#pragma unroll 1
            for (int half = 0; half < nhalf; ++half) { unsigned long long k0[4], kp[4], r0[4], rp[4];
#pragma unroll
              for (int i = 0; i < 4; ++i) { const int it = 4 * half + i; const bf16* a_ = RKV + (size_t)(m0 + 4 * it) * 3072 + chu; const bf16* b_ = RKV + ((size_t)(m0 + 4 * it) + pd) * 3072 + chu;
                  k0[i] = *(const unsigned long long*)(a_ + 1024 + vo3); kp[i] = *(const unsigned long long*)(b_ + 1024 + vo3); r0[i] = *(const unsigned long long*)(a_ + vo3); rp[i] = *(const unsigned long long*)(b_ + vo3); }
#pragma unroll
              for (int i = 0; i < 4; ++i) { const int it = 4 * half + i; const size_t ou = PW_HM(it, chu); const float pmask = (it == 0) ? pm0 : 1.f;
                  const f32x4 x = a0 + PW_AV(it); f32x4 a;
#pragma unroll
                  for (int e = 0; e < 4; ++e) a[e] = sigmoidf_(x[e]);
                  const f32x4 kc = up4bf(k0[i]), rc = up4bf(r0[i]);
                  const f32x4 kr = kc + (up4bf(kp[i]) * pmask - kc) * mu1; f32x4 q = kr * kk4;
                  const float s = row16_sum((q[0] * q[0] + q[1] * q[1]) + (q[2] * q[2] + q[3] * q[3]));
                  q = q * (1.0f / fmaxf(sqrtf(s), 1e-12f));
                  const f32x4 kf = kr * ((a - 1.0f) * ka4 + 1.0f), rf = rc + (up4bf(rp[i]) * pmask - rc) * mu0, t3 = rf * kf * rk4;
                  const float bon = row16_sum((t3[0] + t3[1]) + (t3[2] + t3[3]));
                  if ((lane & 15) == 0) BON[(size_t)(m0 + 4 * it + rs) * 16 + (chu >> 6)] = bon;
                  st4bf(Kk + ou + voh, kf); st4bf(Aa + ou + voh, -q); st4bf(Bb + ou + voh, q * a); st4bf(Rr + ou + voh, rf); }
            } }
#undef PW_MM
#undef PW_STAGE
#undef PW_AV
#undef PW_LOCAL_OFFS
#undef PW_HM
    }
}

constexpr int MST = 144, MSLOT = 64 * MST;
__device__ __forceinline__ bf16x8 mfr_row(const LAS unsigned char* M, int row, int k0, int g) { return *(const LAS bf16x8*)(M + row * MST + (k0 + 8 * g) * 2); }
__device__ __forceinline__ bf16x8 mfr_tr(const LAS unsigned char* M, int k0, int col0, int g, int q) {
    typedef short v4i16 __attribute__((ext_vector_type(4)));
    const LAS unsigned char* p = M + (k0 + 8 * g + (q >> 2)) * MST + (col0 + 4 * (q & 3)) * 2;
    const v4i16 lo = __builtin_amdgcn_ds_read_tr16_b64_v4i16((LAS v4i16*)p), hi = __builtin_amdgcn_ds_read_tr16_b64_v4i16((LAS v4i16*)(p + 4 * MST));
    return (bf16x8){lo[0], lo[1], lo[2], lo[3], hi[0], hi[1], hi[2], hi[3]};
}
#define MFMA16(a, b, c) __builtin_amdgcn_mfma_f32_16x16x32_bf16((a), (b), (c), 0, 0, 0)
__device__ __forceinline__ f32x4 mm_nn(const LAS unsigned char* X, const LAS unsigned char* Y, int ti, int tj, int q, int g, f32x4 c) {
    c = MFMA16(mfr_row(X, 16 * ti + q, 0, g), mfr_tr(Y, 0, 16 * tj, g, q), c); return MFMA16(mfr_row(X, 16 * ti + q, 32, g), mfr_tr(Y, 32, 16 * tj, g, q), c); }
__device__ __forceinline__ f32x4 mm_nt(const LAS unsigned char* X, const LAS unsigned char* Yt, int ti, int tj, int q, int g, f32x4 c) {
    c = MFMA16(mfr_row(X, 16 * ti + q, 0, g), mfr_row(Yt, 16 * tj + q, 0, g), c); return MFMA16(mfr_row(X, 16 * ti + q, 32, g), mfr_row(Yt, 16 * tj + q, 32, g), c); }
__device__ __forceinline__ f32x4 mm_tn(const LAS unsigned char* Xt, const LAS unsigned char* Y, int ti, int tj, int q, int g, f32x4 c) {
    c = MFMA16(mfr_tr(Xt, 0, 16 * ti, g, q), mfr_tr(Y, 0, 16 * tj, g, q), c); return MFMA16(mfr_tr(Xt, 32, 16 * ti, g, q), mfr_tr(Y, 32, 16 * tj, g, q), c); }
__device__ __forceinline__ void mst_tile_t(LAS unsigned char* M, int ti, int tj, int q, int g, f32x4 c) {
    *(LAS unsigned long long*)(M + (16 * tj + q) * MST + (16 * ti + 4 * g) * 2) = (unsigned long long)cvtpk(c[0], c[1]) | ((unsigned long long)cvtpk(c[2], c[3]) << 32);
}
#define SC_BAR() do { asm volatile("s_waitcnt lgkmcnt(0)" ::: "memory"); __builtin_amdgcn_s_barrier(); asm volatile("" ::: "memory"); } while (0)
__device__ __forceinline__ void scan_units(const Args& args, int l, LAS unsigned char* lds, int vcu, int G) {
    int tid_ = threadIdx.x; asm volatile("" : "+v"(tid_)); const int tid = tid_, lane = tid & 63, wave = __builtin_amdgcn_readfirstlane(tid >> 6);
    unsigned char* ws = args.ws;
    const unsigned short* Rr = (const unsigned short*)(ws + WS_R); const float* Ww = (const float*)(ws + WS_W); const unsigned short* Kk = (const unsigned short*)(ws + WS_K); const unsigned short* Vv = (const unsigned short*)(ws + WS_V);
    const unsigned short* Aa = (const unsigned short*)(ws + WS_A); const unsigned short* Bb = (const unsigned short*)(ws + WS_B); float* Y = (float*)(ws + WS_Y);
    LAS unsigned char* iA = lds + 0 * MSLOT; LAS unsigned char* iR = lds + 1 * MSLOT; LAS unsigned char* iB = lds + 2 * MSLOT; LAS unsigned char* iK = lds + 3 * MSLOT;
    LAS unsigned char* iBh = lds + 4 * MSLOT; LAS unsigned char* iKh = lds + 5 * MSLOT; LAS unsigned char* iV = lds + 6 * MSLOT; LAS unsigned char* iS = lds + 7 * MSLOT;
    LAS unsigned char* iAak = lds + 8 * MSLOT; LAS unsigned char* iArb = lds + 9 * MSLOT; LAS unsigned char* iArk = lds + 10 * MSLOT; LAS unsigned char* iQa = lds + 11 * MSLOT;
    LAS unsigned char* iTa = lds + 12 * MSLOT; LAS unsigned char* iTb = lds + 13 * MSLOT;
    LAS unsigned char* iQb = iB; LAS unsigned char* iRHS = iK; LAS unsigned char* iU = iQa;
    LAS float* wtot = (LAS float*)(lds + LDSCTL_OFF + 1024); LAS float* sDC = wtot + 2 * 8 * 64;
    static_assert(14 * MSLOT <= RING_BYTES && LDSCTL_OFF + 1024 + 17 * 64 * 4 <= LDS_BYTES, "scan LDS map");
    const int q = lane & 15, g = lane >> 4, ti = wave >> 1, tj0 = 2 * (wave & 1);
    constexpr int C = 64, NCH = SEQ / C;
    for (int u = vcu; u < PBATCH * 16; u += G) {
        const int b = u >> 4, h = u & 15;
        const int hw = lane >> 5, jp = lane & 31;
        const size_t base0 = ((size_t)(b * 16 + h) * SEQ + 8 * wave + 4 * hw) * 64 + 2 * jp;
        typedef float f32x2v __attribute__((ext_vector_type(2)));
        f32x2v rw[4]; unsigned rk[4], ra[4], rb[4], rr[4], rv[4];
#define SC_LOAD(cc) do { _Pragma("unroll") for (int i = 0; i < 4; ++i) { const size_t o = base0 + (size_t)((cc) * C + i) * 64; rw[i] = *(const f32x2v*)(Ww + o); \
            rk[i] = *(const unsigned*)(Kk + o); ra[i] = *(const unsigned*)(Aa + o); rb[i] = *(const unsigned*)(Bb + o); rr[i] = *(const unsigned*)(Rr + o); rv[i] = *(const unsigned*)(Vv + o); } } while (0)
#define BLO(U) __builtin_bit_cast(float, (U) << 16)
#define BHI(U) __builtin_bit_cast(float, (U) & 0xffff0000u)
#define SC_DECAY(cc) do { p[0] = rw[0]; _Pragma("unroll") for (int i = 1; i < 4; ++i) p[i] = p[i - 1] * rw[i]; \
            lo.x = __shfl(p[3].x, jp); lo.y = __shfl(p[3].y, jp);                                        \
            if (hw) { _Pragma("unroll") for (int i = 0; i < 4; ++i) p[i] = p[i] * lo; *(LAS f32x2v*)(wtot + ((cc) & 1) * 512 + wave * 64 + 2 * jp) = p[3]; } } while (0)
        SC_LOAD(0);
        f32x2v p[4], lo; SC_DECAY(0);
        f32x4 Sreg[2], Treg[2];
#pragma unroll
        for (int t2 = 0; t2 < 2; ++t2) Sreg[t2] = (f32x4){0.f, 0.f, 0.f, 0.f};
        __syncthreads();
        for (int i = tid; i < 64 * 36; i += NTHR) ((LAS unsigned*)iS)[i] = 0u;
        for (int c = 0; c < NCH; ++c) {
            LAS float* wt = wtot + (c & 1) * 512;
            f32x2v pre = (f32x2v){1.f, 1.f}, dc = (f32x2v){1.f, 1.f};
#pragma unroll
            for (int w2 = 0; w2 < 8; ++w2) { const f32x2v x = *(const LAS f32x2v*)(wt + w2 * 64 + 2 * jp); dc = dc * x; if (w2 < wave) pre = pre * x; }
            if (wave == 0 && hw == 0) *(LAS f32x2v*)(sDC + 2 * jp) = dc;
            { const f32x2v d0 = hw ? pre * lo : pre;
              f32x2v xa[4], xr[4], xb[4], xk[4], xbh[4], xkh[4], xv[4];
#pragma unroll
              for (int i = 0; i < 4; ++i) { const f32x2v Dt = pre * p[i], Dm = (i == 0) ? d0 : pre * p[i - 1]; f32x2v inv; inv.x = __builtin_amdgcn_rcpf(Dt.x); inv.y = __builtin_amdgcn_rcpf(Dt.y); const f32x2v sc = dc * inv;
                  const f32x2v a2 = (f32x2v){BLO(ra[i]), BHI(ra[i])}, r2 = (f32x2v){BLO(rr[i]), BHI(rr[i])}, b2 = (f32x2v){BLO(rb[i]), BHI(rb[i])}, k2 = (f32x2v){BLO(rk[i]), BHI(rk[i])};
                  xa[i] = a2 * Dm; xr[i] = r2 * Dt; xb[i] = b2 * inv; xk[i] = k2 * inv; xbh[i] = b2 * sc; xkh[i] = k2 * sc; xv[i] = (f32x2v){BLO(rv[i]), BHI(rv[i])}; }
              const int o0 = (2 * jp) * MST + (8 * wave + 4 * hw) * 2, o1 = o0 + MST;
#define SC_W4(img, ARR) do { *(LAS unsigned long long*)((img) + o0) = (unsigned long long)cvtpk(ARR[0].x, ARR[1].x) | ((unsigned long long)cvtpk(ARR[2].x, ARR[3].x) << 32); \
                           *(LAS unsigned long long*)((img) + o1) = (unsigned long long)cvtpk(ARR[0].y, ARR[1].y) | ((unsigned long long)cvtpk(ARR[2].y, ARR[3].y) << 32); } while (0)
              SC_W4(iA, xa); SC_W4(iR, xr); SC_W4(iB, xb); SC_W4(iK, xk); SC_W4(iBh, xbh); SC_W4(iKh, xkh); SC_W4(iV, xv);
#undef SC_W4
            }
            if (c + 1 < NCH) SC_LOAD(c + 1);
            SC_BAR();
#define FR_ROW2(dst, M, row) do { dst[0] = mfr_row(M, (row), 0, g); dst[1] = mfr_row(M, (row), 32, g); } while (0)
#define FR_TR2(dst, M, col0) do { dst[0] = mfr_tr(M, 0, (col0), g, q); dst[1] = mfr_tr(M, 32, (col0), g, q); } while (0)
#define MM2(c, a, b) MFMA16(a[1], b[1], MFMA16(a[0], b[0], (c)))
            const f32x4 z4 = (f32x4){0.f, 0.f, 0.f, 0.f};
            { bf16x8 aA[2], aR[2], bB[2][2], bK[2][2];
              FR_TR2(aA, iA, 16 * ti); FR_TR2(aR, iR, 16 * ti);
#pragma unroll
              for (int t2 = 0; t2 < 2; ++t2) { FR_TR2(bB[t2], iB, 16 * (tj0 + t2)); FR_TR2(bK[t2], iK, 16 * (tj0 + t2)); }
#pragma unroll
              for (int t2 = 0; t2 < 2; ++t2) { const int tj = tj0 + t2;
                f32x4 aab = MM2(z4, aA, bB[t2]), aak = MM2(z4, aA, bK[t2]), arb = MM2(z4, aR, bB[t2]), ark = MM2(z4, aR, bK[t2]);
#pragma unroll
                for (int e = 0; e < 4; ++e) { const int t = 16 * ti + 4 * g + e, s = 16 * tj + q; if (!(s < t)) { aab[e] = 0.f; aak[e] = 0.f; } if (!(s <= t)) { arb[e] = 0.f; ark[e] = 0.f; } }
                mst_tile_t(iQa, ti, tj, q, g, aab); mst_tile_t(iAak, ti, tj, q, g, aak); mst_tile_t(iArb, ti, tj, q, g, arb); mst_tile_t(iArk, ti, tj, q, g, ark);
#pragma unroll
                for (int e = 0; e < 4; ++e) if (16 * ti + 4 * g + e == 16 * tj + q) aab[e] += 1.0f;
                Treg[t2] = aab; mst_tile_t(iTa, ti, tj, q, g, aab); } }
            SC_BAR();
            { bf16x8 aQ[2], bQ[2][2], aA[2], bS[2][2], aK[2], bV[2][2];
              FR_TR2(aQ, iQa, 16 * ti); FR_TR2(aA, iA, 16 * ti); FR_TR2(aK, iAak, 16 * ti);
#pragma unroll
              for (int t2 = 0; t2 < 2; ++t2) { FR_ROW2(bQ[t2], iQa, 16 * (tj0 + t2) + q); FR_ROW2(bS[t2], iS, 16 * (tj0 + t2) + q); FR_ROW2(bV[t2], iV, 16 * (tj0 + t2) + q); }
#pragma unroll
              for (int t2 = 0; t2 < 2; ++t2) { const int tj = tj0 + t2;
                mst_tile_t(iQb, ti, tj, q, g, MM2(z4, aQ, bQ[t2])); mst_tile_t(iRHS, ti, tj, q, g, MM2(MM2(z4, aA, bS[t2]), aK, bV[t2])); } }
            SC_BAR();
#define SC_LEVEL(Qin, Qout, Tin, Tout, doq) do { bf16x8 aQ[2], bQ[2][2], aT[2]; FR_TR2(aQ, Qin, 16 * ti); FR_TR2(aT, Tin, 16 * ti); \
                _Pragma("unroll") for (int t2 = 0; t2 < 2; ++t2) FR_ROW2(bQ[t2], Qin, 16 * (tj0 + t2) + q); \
                _Pragma("unroll") for (int t2 = 0; t2 < 2; ++t2) { const int tj = tj0 + t2; \
                    if (doq) mst_tile_t(Qout, ti, tj, q, g, MM2(z4, aQ, bQ[t2])); \
                    Treg[t2] = MM2(Treg[t2], aT, bQ[t2]); mst_tile_t(Tout, ti, tj, q, g, Treg[t2]); } SC_BAR(); } while (0)
            SC_LEVEL(iQb, iQa, iTa, iTb, true);
            SC_LEVEL(iQa, iQb, iTb, iTa, true);
            SC_LEVEL(iQb, iQa, iTa, iTb, true);
            SC_LEVEL(iQa, iQb, iTb, iTa, true);
            SC_LEVEL(iQb, iQa, iTa, iTb, false);
#undef SC_LEVEL
            { bf16x8 aT[2], bR[2][2]; FR_TR2(aT, iTb, 16 * ti);
#pragma unroll
              for (int t2 = 0; t2 < 2; ++t2) FR_ROW2(bR[t2], iRHS, 16 * (tj0 + t2) + q);
#pragma unroll
              for (int t2 = 0; t2 < 2; ++t2) mst_tile_t(iU, ti, tj0 + t2, q, g, MM2(z4, aT, bR[t2])); }
            SC_BAR();
            { bf16x8 aRt[2], aArb[2], aArk[2], aBh[2], aKh[2], bS[2][2], bU[2][2], bV[2][2];
              FR_TR2(aRt, iR, 16 * ti); FR_TR2(aArb, iArb, 16 * ti); FR_TR2(aArk, iArk, 16 * ti); FR_ROW2(aBh, iBh, 16 * ti + q); FR_ROW2(aKh, iKh, 16 * ti + q);
#pragma unroll
              for (int t2 = 0; t2 < 2; ++t2) { FR_ROW2(bS[t2], iS, 16 * (tj0 + t2) + q); FR_ROW2(bU[t2], iU, 16 * (tj0 + t2) + q); FR_ROW2(bV[t2], iV, 16 * (tj0 + t2) + q); }
              const f32x4 dcv = *(const LAS f32x4*)(sDC + 16 * ti + 4 * g);
#pragma unroll
              for (int t2 = 0; t2 < 2; ++t2) { const int tj = tj0 + t2;
                const f32x4 y = MM2(MM2(MM2(z4, aRt, bS[t2]), aArb, bU[t2]), aArk, bV[t2]);
                float* yp = Y + ((size_t)(b * 16 + h) * SEQ + c * C + 16 * ti + 4 * g) * 64 + 16 * tj + q;
#pragma unroll
                for (int e = 0; e < 4; ++e) yp[e * 64] = y[e];
                Sreg[t2] = MM2(MM2(Sreg[t2] * dcv, aBh, bU[t2]), aKh, bV[t2]); } }
            if (c + 1 < NCH) SC_DECAY(c + 1);
            SC_BAR();
#undef FR_ROW2
#undef FR_TR2
#undef MM2
#pragma unroll
            for (int t2 = 0; t2 < 2; ++t2) mst_tile_t(iS, ti, tj0 + t2, q, g, Sreg[t2]);
        }
#pragma unroll
        for (int t2 = 0; t2 < 2; ++t2) { const int tj = tj0 + t2;
            *(f32x4*)(args.out + O_WP + ((((size_t)l * PBATCH + b) * 16 + h) * 64 + 16 * tj + q) * 64 + 16 * ti + 4 * g) = Sreg[t2]; }
        __syncthreads();
    }
#undef SC_LOAD
#undef SC_DECAY
#undef BLO
#undef BHI
}
#undef SC_BAR
__device__ __forceinline__ void sample_wkv_units(const Args& args, int l, int vcu, int G) {
    int tid_ = threadIdx.x; asm volatile("" : "+v"(tid_)); const int tid = tid_, lane = tid & 63, wave = __builtin_amdgcn_readfirstlane(tid >> 6); const int vskip = (G == 256) ? 64 : 0; if (vcu < vskip) return; const int gw = (vcu - vskip) * NWAVES + wave, NGW = (G - vskip) * NWAVES;     (void)tid; (void)lane; (void)wave; (void)gw; (void)NGW;
    unsigned char* ws = args.ws;
    if (G == 256 && (vcu - vskip) * NWAVES < 128) {
        if (threadIdx.x == 0) { unsigned* f = (unsigned*)(ws + WS_CTL) + CW_PWF + 64 * l; unsigned sp = 0u; while (xb_ld(f) == 0u) { __builtin_amdgcn_s_sleep(1); if (++sp > (1u << 22)) break; }
            __builtin_amdgcn_fence(__ATOMIC_ACQUIRE, "agent"); asm volatile("s_waitcnt vmcnt(0)" ::: "memory"); }
        __syncthreads(); }
    const bf16* Rr = (const bf16*)(ws + WS_R); const float* Ww = (const float*)(ws + WS_W); const bf16* Kk = (const bf16*)(ws + WS_K); const bf16* Vv = (const bf16*)(ws + WS_V);
    const bf16* Aa = (const bf16*)(ws + WS_A); const bf16* Bb = (const bf16*)(ws + WS_B); float* Y = (float*)(ws + WS_Y);
    for (int u = gw; u < 128; u += NGW) {
        const int b = u >> 4, h = u & 15; const size_t vo = (size_t)(MP + b) * DRW + h * 64;
        const float* Sp = args.in[I_SWKV] + ((((size_t)l * 8 + b) * 16 + h) * 64 + lane) * 64;
        float* So = args.out + O_WS + ((((size_t)l * 8 + b) * 16 + h) * 64 + lane) * 64;
        f32x4 S[16];
#pragma unroll
        for (int j = 0; j < 16; ++j) S[j] = *(const f32x4*)(Sp + 4 * j);
        float sa = 0.f;
#pragma unroll
        for (int j = 0; j < 16; ++j) { const f32x4 a4 = ld4bf(Aa + vo + 4 * j); sa += (S[j].x * a4.x + S[j].y * a4.y) + (S[j].z * a4.z + S[j].w * a4.w); }
        const float vi = bf2f(Vv[vo + lane]); float y = 0.f;
#pragma unroll
        for (int j = 0; j < 16; ++j) { const f32x4 w4 = *(const f32x4*)(Ww + vo + 4 * j), k4 = ld4bf(Kk + vo + 4 * j), b4 = ld4bf(Bb + vo + 4 * j), r4 = ld4bf(Rr + vo + 4 * j);
            f32x4 s = S[j] * w4 + (b4 * sa + k4 * vi); y += (s.x * r4.x + s.y * r4.y) + (s.z * r4.z + s.w * r4.w); *(f32x4*)(So + 4 * j) = s; }
        Y[vo + lane] = y;
    }
}
typedef short v4i16_t __attribute__((ext_vector_type(4)));
typedef float f32x4v __attribute__((ext_vector_type(4)));
__device__ __forceinline__ void attn_units(const Args& args, int l, LAS unsigned char* lds, int vcu, int G) {
    int tid_ = threadIdx.x; asm volatile("" : "+v"(tid_)); const int tid = tid_, lane = tid & 63, wave = __builtin_amdgcn_readfirstlane(tid >> 6); const int gw = vcu * NWAVES + wave, NGW = G * NWAVES; (void)tid; (void)lane; (void)wave; (void)gw; (void)NGW;
    unsigned char* ws = args.ws;
    const bf16* QB = (const bf16*)(ws + WS_QB); const bf16* KB = (const bf16*)(ws + WS_KB); const bf16* VB = (const bf16*)(ws + WS_VB);
    bf16* OBR = (bf16*)(ws + WS_OBR); float* LSE = (float*)(ws + WS_LSE); const float* BT = (const float*)(ws + WS_BT);
    constexpr int KST = 144, VST = 160;
    LAS unsigned char* Kt = lds; LAS unsigned char* Vt = lds + 256 * KST; LAS float* btab = (LAS float*)(lds + 256 * KST + 256 * VST);
    const int q = lane & 15, g = lane >> 4;
    constexpr int NA_S = 0, NA_O = 16; static_assert(64 * NA_S + 192 * NA_O == PBATCH * NHEADS * 48, "attention unit deal");
    const bool deal = (G == 256); const int ufirst = deal ? ((vcu < 64) ? vcu * NA_S : 64 * NA_S + (vcu - 64) * NA_O) : vcu, ucnt = deal ? ((vcu < 64) ? NA_S : NA_O) : (PBATCH * NHEADS * 48 - vcu + G - 1) / G, ustep = deal ? 1 : G;
    v4u kreg[4], vreg[4]; float breg = 0.f; bf16x8 qn0, qn1;
#define AT_DECODE(uu) const int rn = (uu) & 15, br = ((uu) >> 4) % 3, h = ((uu) / 48) & 15, b = (uu) / 768; const int dsh = 2 * br, dil = 1 << dsh, r = rn & (dil - 1), n = rn >> dsh;
#define AT_FETCH(uu) do { AT_DECODE(uu) \
        _Pragma("unroll") for (int j = 0; j < 4; ++j) { const int i = tid + NTHR * j, row = i >> 3, chk = i & 7, sk = (n - 1) * 128 + row; kreg[j] = (v4u){0u, 0u, 0u, 0u}; vreg[j] = (v4u){0u, 0u, 0u, 0u}; \
            if (sk >= 0) { const size_t go = ((size_t)(b * SEQ + sk * dil + r)) * DATT + h * 64 + chk * 8; kreg[j] = *(const v4u*)(KB + go); vreg[j] = *(const v4u*)(VB + go); } } \
        if (tid < 129) breg = BT[(br * 129 + tid) * 16 + h]; \
        { const int mqn = b * SEQ + (n * 128 + 16 * wave + q) * dil + r; qn0 = *(const bf16x8*)(QB + (size_t)mqn * DATT + h * 64 + 8 * g); qn1 = *(const bf16x8*)(QB + (size_t)mqn * DATT + h * 64 + 32 + 8 * g); } } while (0)
    if (ucnt > 0) AT_FETCH(ufirst);
    for (int ui = 0; ui < ucnt; ++ui) { const int u = ufirst + ui * ustep;
        AT_DECODE(u)
        __syncthreads();
#pragma unroll
        for (int j = 0; j < 4; ++j) { const int i = tid + NTHR * j, row = i >> 3, chk = i & 7; *(LAS v4u*)(Kt + row * KST + chk * 16) = kreg[j]; *(LAS v4u*)(Vt + row * VST + chk * 16) = vreg[j]; }
        if (tid < 129) btab[tid] = breg;
        const bf16x8 qf0 = qn0, qf1 = qn1;
        __syncthreads();
        if (ui + 1 < ucnt) AT_FETCH(u + ustep);
        const int iq = 16 * wave + q, mq = b * SEQ + (n * 128 + iq) * dil + r;
        const int kb0 = wave >> 1;
        f32x4 sacc[10];
        { bf16x8 ka[10][2];
#pragma unroll
          for (int sb = 0; sb < 10; ++sb) { const int key0 = 32 * kb0 + 16 * sb; ka[sb][0] = *(const LAS bf16x8*)(Kt + (key0 + q) * KST + 16 * g); ka[sb][1] = *(const LAS bf16x8*)(Kt + (key0 + q) * KST + 64 + 16 * g); }
#pragma unroll
          for (int sb = 0; sb < 10; ++sb) { f32x4 acc = (f32x4){0.f, 0.f, 0.f, 0.f};
              acc = __builtin_amdgcn_mfma_f32_16x16x32_bf16(ka[sb][0], qf0, acc, 0, 0, 0); acc = __builtin_amdgcn_mfma_f32_16x16x32_bf16(ka[sb][1], qf1, acc, 0, 0, 0); sacc[sb] = acc; } }
        float mx = -INFINITY;
#pragma unroll
        for (int sb = 0; sb < 10; ++sb)
#pragma unroll
            for (int e = 0; e < 4; ++e) { const int jj = 32 * kb0 + 16 * sb + 4 * g + e, dsub = 128 + iq - jj, sk = (n - 1) * 128 + jj;
                const bool ok = (dsub >= 0) && (dsub <= 128) && (sk >= 0);
                const float s = ok ? sacc[sb][e] * ATT_SCALE + btab[ok ? dsub : 0] : -INFINITY; sacc[sb][e] = s; mx = fmaxf(mx, s); }
        mx = fmaxf(mx, __shfl_xor(mx, 16)); mx = fmaxf(mx, __shfl_xor(mx, 32));
        float sum = 0.f;
#pragma unroll
        for (int sb = 0; sb < 10; ++sb)
#pragma unroll
            for (int e = 0; e < 4; ++e) { const float p = __expf(sacc[sb][e] - mx); sacc[sb][e] = p; sum += p; }
        sum += __shfl_xor(sum, 16); sum += __shfl_xor(sum, 32);
        f32x4 o[4];
#pragma unroll
        for (int c = 0; c < 4; ++c) o[c] = (f32x4){0.f, 0.f, 0.f, 0.f};
        { bf16x8 va[5][4];
#pragma unroll
          for (int kk = 0; kk < 5; ++kk) { const int R0 = 32 * (kb0 + kk) + 4 * g + (q >> 2);
#pragma unroll
              for (int c = 0; c < 4; ++c) {
                  const v4i16_t lo = __builtin_amdgcn_ds_read_tr16_b64_v4i16((LAS v4i16_t*)(Vt + R0 * VST + (16 * c + 4 * (q & 3)) * 2));
                  const v4i16_t hi = __builtin_amdgcn_ds_read_tr16_b64_v4i16((LAS v4i16_t*)(Vt + (R0 + 16) * VST + (16 * c + 4 * (q & 3)) * 2));
                  va[kk][c] = (bf16x8){lo[0], lo[1], lo[2], lo[3], hi[0], hi[1], hi[2], hi[3]}; } }
#pragma unroll
          for (int kk = 0; kk < 5; ++kk) {
              v4u pw; pw.x = cvtpk(sacc[2 * kk][0], sacc[2 * kk][1]); pw.y = cvtpk(sacc[2 * kk][2], sacc[2 * kk][3]); pw.z = cvtpk(sacc[2 * kk + 1][0], sacc[2 * kk + 1][1]); pw.w = cvtpk(sacc[2 * kk + 1][2], sacc[2 * kk + 1][3]);
              const bf16x8 pb = __builtin_bit_cast(bf16x8, pw);
#pragma unroll
              for (int c = 0; c < 4; ++c) o[c] = __builtin_amdgcn_mfma_f32_16x16x32_bf16(va[kk][c], pb, o[c], 0, 0, 0); } }
        const float inv = 1.0f / sum;
        bf16* op = OBR + ((size_t)br * MP + mq) * DATT + h * 64 + 4 * g;
#pragma unroll
        for (int c = 0; c < 4; ++c) { const unsigned long long w = (unsigned long long)pk2(o[c][0] * inv, o[c][1] * inv) | ((unsigned long long)pk2(o[c][2] * inv, o[c][3] * inv) << 32); *(unsigned long long*)(op + 16 * c) = w; }
        if (g == 0) LSE[((size_t)br * MP + mq) * 16 + h] = mx + __logf(sum);
    }
#undef AT_DECODE
#undef AT_FETCH
}
__device__ __forceinline__ void sample_attn_units(const Args& args, int l, LAS unsigned char* lds, int vcu, int G) {
    int tid_ = threadIdx.x; asm volatile("" : "+v"(tid_)); const int tid = tid_, lane = tid & 63, wave = __builtin_amdgcn_readfirstlane(tid >> 6); const int vskip = (G == 256) ? 64 : 0; if (vcu < vskip) return; const int gw = (vcu - vskip) * NWAVES + wave, NGW = (G - vskip) * NWAVES; (void)tid; (void)lane; (void)wave; (void)gw; (void)NGW;
    unsigned char* ws = args.ws;
    const bf16* QB = (const bf16*)(ws + WS_QB); bf16* MIX = (bf16*)(ws + WS_MIX); const float* BT = (const float*)(ws + WS_BT);
    LAS float* pl = (LAS float*)(lds + 90112) + wave * 448;
    for (int u = gw; u < 128; u += NGW) {
        const int b = u >> 4, h = u & 15, m = MP + b;
        float qv[64];
#pragma unroll
        for (int j = 0; j < 8; ++j) { const v4u w = *(const v4u*)(QB + (size_t)m * DATT + h * 64 + 8 * j);
            qv[8 * j + 0] = bf2f((unsigned short)(w.x & 0xffff)); qv[8 * j + 1] = bf2f((unsigned short)(w.x >> 16)); qv[8 * j + 2] = bf2f((unsigned short)(w.y & 0xffff)); qv[8 * j + 3] = bf2f((unsigned short)(w.y >> 16));
            qv[8 * j + 4] = bf2f((unsigned short)(w.z & 0xffff)); qv[8 * j + 5] = bf2f((unsigned short)(w.z >> 16)); qv[8 * j + 6] = bf2f((unsigned short)(w.w & 0xffff)); qv[8 * j + 7] = bf2f((unsigned short)(w.w >> 16)); }
        const float* knew = args.out + O_KS + ((size_t)l * 8 + b) * DATT + h * 64; const float* vnew = args.out + O_VS + ((size_t)l * 8 + b) * DATT + h * 64;
        const float* kc = args.in[I_CK] + (((size_t)l * 8 + b) * 2048) * 1024 + h * 64; const float* vc = args.in[I_CV] + (((size_t)l * 8 + b) * 2048) * 1024 + h * 64;
        float mx = -INFINITY;
        for (int it = 0; it < 7; ++it) { const int kk = lane + 64 * it;
            if (kk < 387) { const int br = kk / 129, mm = kk % 129; const float* kp = (mm == 0) ? knew : kc + (size_t)(2048 - (mm << (2 * br))) * 1024;
                float d = 0.f;
#pragma unroll
                for (int j = 0; j < 16; ++j) { const f32x4 k4 = *(const f32x4*)(kp + 4 * j); d += (qv[4 * j] * k4.x + qv[4 * j + 1] * k4.y) + (qv[4 * j + 2] * k4.z + qv[4 * j + 3] * k4.w); }
                const float s = d * ATT_SCALE + BT[(br * 129 + mm) * 16 + h]; pl[kk] = s; mx = fmaxf(mx, s); } }
        mx = wave_max(mx);
        float sum = 0.f;
        for (int it = 0; it < 7; ++it) { const int kk = lane + 64 * it; if (kk < 387) { const float p = __expf(pl[kk] - mx); pl[kk] = p; sum += p; } }
        sum = wave_sum(sum);
        f32x4 o4 = (f32x4){0.f, 0.f, 0.f, 0.f}; const int kg = lane >> 4, dq = lane & 15;
#pragma unroll 8
        for (int i = 0; i < 97; ++i) { const int kk = kg + 4 * i; if (kk < 387) { const int br = kk / 129, mm = kk % 129; const float* vp = (mm == 0) ? vnew : vc + (size_t)(2048 - (mm << (2 * br))) * 1024;
            o4 += *(const f32x4*)(vp + 4 * dq) * pl[kk]; } }
#pragma unroll
        for (int e = 0; e < 4; ++e) { o4[e] += __shfl_xor(o4[e], 16); o4[e] += __shfl_xor(o4[e], 32); }
        if (kg == 0) { const float inv = 1.0f / sum; *(unsigned long long*)(MIX + (size_t)m * DM + h * 64 + 4 * dq) = (unsigned long long)pk2(o4.x * inv, o4.y * inv) | ((unsigned long long)pk2(o4.z * inv, o4.w * inv) << 32); }
    }
}

__device__ __forceinline__ void mx_phase(const Args& args, int l, int vcu, int G) {
    int tid_ = threadIdx.x; asm volatile("" : "+v"(tid_)); const int tid = tid_, lane = tid & 63, wave = __builtin_amdgcn_readfirstlane(tid >> 6); const int gw = vcu * NWAVES + wave, NGW = G * NWAVES; (void)tid; (void)lane; (void)wave; (void)gw; (void)NGW;
    unsigned char* ws = args.ws;
    const bf16* OBR = (const bf16*)(ws + WS_OBR); const float* LSE = (const float*)(ws + WS_LSE); bf16* MIX = (bf16*)(ws + WS_MIX);
    const bf16* Vv = (const bf16*)(ws + WS_V); const bf16* Gg = (const bf16*)(ws + WS_G); const float* Y = (const float*)(ws + WS_Y);
    const int hh = lane >> 2, p = lane & 3, c0 = hh * 64 + p * 16;
    const float* BON = (const float*)(ws + WS_BON);
    f32x4 lng[4], lnb[4];
#pragma unroll
    for (int j = 0; j < 4; ++j) { lng[j] = *(const f32x4*)(args.in[I_LNG] + (size_t)l * DRW + c0 + 4 * j); lnb[j] = *(const f32x4*)(args.in[I_LNB] + (size_t)l * DRW + c0 + 4 * j); }
    struct Raw { float l0, l1, l2, bon; v4u ob[6]; f32x4 y[4]; unsigned long long v[4], g[4]; };
#define MX_LOAD(R, mm) do { if ((mm) < MP) { R.l0 = LSE[((size_t)0 * MP + (mm)) * 16 + hh]; R.l1 = LSE[((size_t)1 * MP + (mm)) * 16 + hh]; R.l2 = LSE[((size_t)2 * MP + (mm)) * 16 + hh]; \
            _Pragma("unroll") for (int br = 0; br < 3; ++br) _Pragma("unroll") for (int j = 0; j < 2; ++j) R.ob[2 * br + j] = *(const v4u*)(OBR + ((size_t)br * MP + (mm)) * DATT + c0 + 8 * j); } \
        { const size_t ro_ = (size_t)(mm) * DRW + c0, rh_ = ((mm) < MP) ? ((size_t)(((mm) >> 11) * 16 + hh) * SEQ + ((mm) & (SEQ - 1))) * 64 + p * 16 : ro_;     \
          R.bon = BON[(size_t)(mm) * 16 + hh]; \
          _Pragma("unroll") for (int j = 0; j < 4; ++j) { R.y[j] = *(const f32x4*)(Y + rh_ + 4 * j); R.v[j] = *(const unsigned long long*)(Vv + rh_ + 4 * j); R.g[j] = *(const unsigned long long*)(Gg + ro_ + 4 * j); } } } while (0)
    Raw cur; if (gw < NROWS) MX_LOAD(cur, gw);
    for (int m = gw; m < NROWS; m += NGW) {
        Raw nxt = cur; const int mn = m + NGW; if (mn < NROWS) MX_LOAD(nxt, mn);
        v4u a0 = (v4u){0u, 0u, 0u, 0u}, a1 = a0;
        if (m < MP) {
            const float l0 = cur.l0, l1 = cur.l1, l2 = cur.l2;
            const float mx = fmaxf(l0, fmaxf(l1, l2)); float e0 = __expf(l0 - mx), e1 = __expf(l1 - mx), e2 = __expf(l2 - mx); const float inv = 1.0f / (e0 + e1 + e2); e0 *= inv; e1 *= inv; e2 *= inv;
            float acc[16];
#pragma unroll
            for (int i = 0; i < 16; ++i) acc[i] = 0.f;
#pragma unroll
            for (int br = 0; br < 3; ++br) { const float al = br == 0 ? e0 : br == 1 ? e1 : e2;
#pragma unroll
                for (int j = 0; j < 2; ++j) { const v4u w = cur.ob[2 * br + j];
                    acc[8 * j + 0] += al * bf2f((unsigned short)(w.x & 0xffff)); acc[8 * j + 1] += al * bf2f((unsigned short)(w.x >> 16)); acc[8 * j + 2] += al * bf2f((unsigned short)(w.y & 0xffff)); acc[8 * j + 3] += al * bf2f((unsigned short)(w.y >> 16));
                    acc[8 * j + 4] += al * bf2f((unsigned short)(w.z & 0xffff)); acc[8 * j + 5] += al * bf2f((unsigned short)(w.z >> 16)); acc[8 * j + 6] += al * bf2f((unsigned short)(w.w & 0xffff)); acc[8 * j + 7] += al * bf2f((unsigned short)(w.w >> 16)); } }
            a0.x = pk2(acc[0], acc[1]); a0.y = pk2(acc[2], acc[3]); a0.z = pk2(acc[4], acc[5]); a0.w = pk2(acc[6], acc[7]); a1.x = pk2(acc[8], acc[9]); a1.y = pk2(acc[10], acc[11]); a1.z = pk2(acc[12], acc[13]); a1.w = pk2(acc[14], acc[15]);
        }
        f32x4 y[4], vv[4], gg[4];
        float s = 0.f; const float bon = cur.bon;
#pragma unroll
        for (int j = 0; j < 4; ++j) { y[j] = cur.y[j]; vv[j] = up4bf(cur.v[j]); gg[j] = up4bf(cur.g[j]);
            s += (y[j].x + y[j].y) + (y[j].z + y[j].w); }
        s += __shfl_xor(s, 1); s += __shfl_xor(s, 2);
        const float mean = s * (1.0f / 64.0f); float qq = 0.f;
#pragma unroll
        for (int j = 0; j < 4; ++j) { y[j] = y[j] - mean; qq += (y[j].x * y[j].x + y[j].y * y[j].y) + (y[j].z * y[j].z + y[j].w * y[j].w); }
        qq += __shfl_xor(qq, 1); qq += __shfl_xor(qq, 2);
        const float rstd = 1.0f / sqrtf(qq * (1.0f / 64.0f) + GN_EPS);
        v4u o0, o1; f32x4 z[4];
#pragma unroll
        for (int j = 0; j < 4; ++j) z[j] = ((y[j] * rstd) * lng[j] + lnb[j] + vv[j] * bon) * gg[j];
        o0.x = pk2(z[0].x, z[0].y); o0.y = pk2(z[0].z, z[0].w); o0.z = pk2(z[1].x, z[1].y); o0.w = pk2(z[1].z, z[1].w); o1.x = pk2(z[2].x, z[2].y); o1.y = pk2(z[2].z, z[2].w); o1.z = pk2(z[3].x, z[3].y); o1.w = pk2(z[3].z, z[3].w);
        if (m < MP) { *(v4u*)(MIX + (size_t)m * DM + c0) = a0; *(v4u*)(MIX + (size_t)m * DM + c0 + 8) = a1; }
        *(v4u*)(MIX + (size_t)m * DM + DATT + c0) = o0; *(v4u*)(MIX + (size_t)m * DM + DATT + c0 + 8) = o1;
        cur = nxt;
    }
#undef MX_LOAD
}

template <int K> __device__ __forceinline__ void sample_proj(const bf16* A, const bf16* Bt, const float* base_s, float* out_s, const float* gate, LAS unsigned char* lds, int vcu, int G) {
    int tid_ = threadIdx.x; asm volatile("" : "+v"(tid_)); const int tid = tid_, lane = tid & 63, wave = __builtin_amdgcn_readfirstlane(tid >> 6);
    constexpr int KW = K / 8, NS = KW / 32; static_assert(KW % 32 == 0, "K split");
    LAS float* part = (LAS float*)lds;
    const int c = lane & 15, g = lane >> 4;
    for (int cg = vcu; cg < DM / 8; cg += G) {
        const int n0 = 8 * cg;
        const bf16* ap = A + (size_t)(MP + (c & 7)) * K + wave * KW + 8 * g; const bf16* bp = Bt + (size_t)(n0 + (c & 7)) * K + wave * KW + 8 * g;
        bf16x8 af[NS], bfr[NS];
#pragma unroll
        for (int s = 0; s < NS; ++s) { af[s] = *(const bf16x8*)(ap + 32 * s); bfr[s] = *(const bf16x8*)(bp + 32 * s); }
        f32x4 acc = (f32x4){0.f, 0.f, 0.f, 0.f};
#pragma unroll
        for (int s = 0; s < NS; ++s) acc = __builtin_amdgcn_mfma_f32_16x16x32_bf16(af[s], bfr[s], acc, 0, 0, 0);
        __syncthreads();
        if (g < 2 && c < 8) {
#pragma unroll
            for (int e = 0; e < 4; ++e) part[(wave * 8 + 4 * g + e) * 8 + c] = acc[e]; }
        __syncthreads();
        if (tid < 64) { const int r = tid >> 3, cc = tid & 7; float s = 0.f;
#pragma unroll
            for (int w = 0; w < 8; ++w) s += part[(w * 8 + r) * 8 + cc];
            const size_t o = (size_t)r * DM + n0 + cc; out_s[o] = base_s[o] + gate[(size_t)(4 + r) * MODW + n0 + cc] * s; }
    }
    __syncthreads();
}

#define NR_LOADX(dst, xrow) do { const GAS f32x4* xr_ = (const GAS f32x4*)(xrow) + lane; _Pragma("unroll") for (int j = 0; j < 8; ++j) dst[j] = xr_[64 * j]; } while (0)
#define NR_ROW(xv, g, sh, sc, hrow, frow) do { \
        f32x4 g4_[8], sh4_[8], sc4_[8]; \
        _Pragma("unroll") for (int j = 0; j < 8; ++j) { g4_[j] = ((const GAS f32x4*)(g))[lane + 64 * j]; sh4_[j] = ((const GAS f32x4*)(sh))[lane + 64 * j]; sc4_[j] = ((const GAS f32x4*)(sc))[lane + 64 * j]; } \
        if (mn < NROWS) NR_LOADX(xn, (mn < MP) ? xp_ + (size_t)mn * DM : xs_ + (size_t)(mn - MP) * DM); \
        float s_ = 0.f; _Pragma("unroll") for (int j = 0; j < 8; ++j) s_ += (xv[j].x * xv[j].x + xv[j].y * xv[j].y) + (xv[j].z * xv[j].z + xv[j].w * xv[j].w); \
        const float rstd_ = 1.0f / sqrtf(wave_sum(s_) * (1.0f / DM) + RMS_EPS); \
        GAS unsigned long long* o8_ = (GAS unsigned long long*)(hrow) + lane; float* fr_ = (frow); \
        _Pragma("unroll") for (int j = 0; j < 8; ++j) { const f32x4 h_ = (xv[j] * rstd_ * g4_[j]) * (sc4_[j] + 1.0f) + sh4_[j]; \
            o8_[64 * j] = (unsigned long long)pk2(h_.x, h_.y) | ((unsigned long long)pk2(h_.z, h_.w) << 32); \
            if (fr_) ((GAS f32x4*)fr_)[lane + 64 * j] = h_; } } while (0)
__device__ __forceinline__ void n1_phase(const Args& args, int l, int vcu, int G, const float* Xp, const float* Xs, const float* modl, bf16* HB) {
    int tid_ = threadIdx.x; asm volatile("" : "+v"(tid_)); const int tid = tid_, lane = tid & 63, wave = __builtin_amdgcn_readfirstlane(tid >> 6); const int gw = vcu * NWAVES + wave, NGW = G * NWAVES; (void)tid; (void)lane; (void)wave; (void)gw; (void)NGW;
    if (gw >= NGW - 8) { const int b = NGW - 1 - gw; const float* s = args.in[I_SSH] + ((size_t)l * 8 + b) * DM; GAS unsigned long long* o8 = (GAS unsigned long long*)(HB + (size_t)(NROWS + b) * DM) + lane;
        f32x4 v[8];
#pragma unroll
        for (int j = 0; j < 8; ++j) v[j] = ((const GAS f32x4*)s)[lane + 64 * j];
#pragma unroll
        for (int j = 0; j < 8; ++j) o8[64 * j] = (unsigned long long)pk2(v[j].x, v[j].y) | ((unsigned long long)pk2(v[j].z, v[j].w) << 32); }
    const float* xp_ = Xp; const float* xs_ = Xs; const float* g1 = args.in[I_N1G] + (size_t)l * DM;
    f32x4 xc[8], xn[8];
    if (gw < NROWS) NR_LOADX(xc, (gw < MP) ? xp_ + (size_t)gw * DM : xs_ + (size_t)(gw - MP) * DM);
#pragma unroll 1
    for (int m = gw; m < NROWS; m += NGW) { const int mn = m + NGW;
        const int bb = (m < MP) ? (m >> 11) : 4 + (m - MP);
        float* fo = nullptr;
        if (m < MP) { if ((m & (SEQ - 1)) == SEQ - 1) fo = args.out + O_SP + ((size_t)l * PBATCH + (m >> 11)) * DM; } else fo = args.out + O_SS + ((size_t)l * 8 + (m - MP)) * DM;
        NR_ROW(xc, g1, modl + (size_t)bb * MODW, modl + (size_t)bb * MODW + DM, HB + (size_t)m * DM, fo);
#pragma unroll
        for (int j = 0; j < 8; ++j) xc[j] = xn[j]; }
}
__device__ __forceinline__ void n2_phase(const Args& args, int l, int vcu, int G, const float* XB, const float* modl, bf16* HB) {
    int tid_ = threadIdx.x; asm volatile("" : "+v"(tid_)); const int tid = tid_, lane = tid & 63, wave = __builtin_amdgcn_readfirstlane(tid >> 6); const int gw = vcu * NWAVES + wave, NGW = G * NWAVES; (void)tid; (void)lane; (void)wave; (void)gw; (void)NGW;
    const float* xp_ = XB; const float* xs_ = XB + (size_t)MP * DM; const float* g2 = args.in[I_N2G] + (size_t)l * DM;
    f32x4 xc[8], xn[8];
    if (gw < NROWS) NR_LOADX(xc, xp_ + (size_t)gw * DM);
#pragma unroll 1
    for (int m = gw; m < NROWS; m += NGW) { const int mn = m + NGW; const int bb = (m < MP) ? (m >> 11) : 4 + (m - MP);
        NR_ROW(xc, g2, modl + (size_t)bb * MODW + 3 * DM, modl + (size_t)bb * MODW + 4 * DM, HB + (size_t)m * DM, (float*)nullptr);
#pragma unroll
        for (int j = 0; j < 8; ++j) xc[j] = xn[j]; }
}
#undef NR_LOADX
#undef NR_ROW

__global__ void __launch_bounds__(NTHR, 2) fwd(Args args) {
    extern __shared__ __attribute__((aligned(16))) unsigned char lds_raw[];
    LAS unsigned char* lds = (LAS unsigned char*)lds_raw;
    volatile LAS unsigned* MISC = (volatile LAS unsigned*)(lds + MISC_OFF);
    const int G = gridDim.x; const int bx = blockIdx.x; const int vcu = (G % 8 == 0) ? (bx % 8) * (G / 8) + bx / 8 : bx;
    unsigned char* ws = args.ws;
    for (int u = threadIdx.x; u < (LDS_BYTES - LDSCTL_OFF) / 4; u += NTHR) ((LAS unsigned*)(lds + LDSCTL_OFF))[u] = 0u;
    __syncthreads();
    const int lo = args.ph_lo, hi = args.ph_hi;
    XcdBarrier bar; bar.bar = (unsigned*)(ws + WS_CTL) + CW_BAR; bar.x = 0; bar.st = nullptr;
    if (hi - lo > 1) bar = xcd_barrier_post((unsigned*)(ws + WS_CTL) + CW_BAR, MISC + 8);
#define IN(k) (lo <= (k) && (k) < hi)
#define SEAM(k) do { if (IN(k) && IN((k) + 1)) { for (int repb = 0; repb < REP_BAR; ++repb) xcd_barrier(bar); } } while (0)

    if (IN(0)) { for (int rep = 0; rep < REP_P0; ++rep) { __syncthreads(); p0_prologue(args, lds, vcu, G, MISC + 16); } }
    SEAM(0);

    float* MOD = (float*)(ws + WS_MOD);
    bf16* HB = (bf16*)(ws + WS_HB); bf16* MIX = (bf16*)(ws + WS_MIX); float* XB = (float*)(ws + WS_XB); bf16* ACT = (bf16*)(ws + WS_ACT);
    for (int l = 0; l < DEPTH; ++l) {
        const int pb = 1 + PH_PER_LAYER * l;
        const float* modl = MOD + (size_t)l * 12 * MODW;
        const float* Xp = (l == 0) ? args.in[I_XP] : XB; const float* Xs = (l == 0) ? args.in[I_XS] : XB + (size_t)MP * DM;
        if (IN(pb + 0)) { for (int rep = 0; rep < REP_N1; ++rep) { __syncthreads(); n1_phase(args, l, vcu, G, Xp, Xs, modl, HB); } }
        SEAM(pb + 0);
        if (IN(pb + 1)) {
            __syncthreads();
            pg8::Gemm g{(const pg8::bf16_t*)HB, (const pg8::bf16_t*)(ws + WS_WIN) + (size_t)l * N1 * DM, MH, N1, DM}; pg8::StaticOrder S; S.init(MH, N1, G, bx);
            pg8::EpiG1 E{(pg8::bf16_t*)(ws + WS_QB), (size_t)(WS_KB - WS_QB) / 2, (pg8::bf16_t*)(ws + WS_RKV), (float*)(ws + WS_P),
                         args.out + O_KP + (size_t)l * MP * DATT, args.out + O_KS + (size_t)l * 8 * DATT, (size_t)(O_VP - O_KP), (size_t)(O_VS - O_KS), args.in[I_QG] + l * 64, args.in[I_KG] + l * 64};
            for (int rep = 0; rep < REP_G1; ++rep) pg8::gemm_phase<pg8::EpiG1, pg8::StaticOrder, true, true>(lds, g, S, E);
            if (l + 1 < DEPTH && bx >= (MH / 256) * (N1 / 256) % G && G == 256) conv_pull(args, l + 1, TAIL_PULLS + 2, false, lds, MISC + 16);
        }
        SEAM(pb + 1);
        if (IN(pb + 2)) { for (int rep = 0; rep < REP_PW; ++rep) { __syncthreads(); pw_phase(args, l, lds, vcu, G, vcu, (G == 256) ? 256 : 257); } }
        SEAM(pb + 2);
        if (IN(pb + 3)) {
            __syncthreads();
            for (int rep = 0; rep < REP_SCAN; ++rep) { __syncthreads(); scan_units(args, l, lds, vcu, G); }
            if (G == 256 && vcu == 80) {
                __syncthreads(); pw_phase(args, l, lds, vcu, G, 256, 257);
                asm volatile("s_waitcnt vmcnt(0)" ::: "memory"); __syncthreads();
                if (threadIdx.x == 0) { __builtin_amdgcn_fence(__ATOMIC_RELEASE, "agent"); asm volatile("s_waitcnt vmcnt(0)" ::: "memory"); xb_add((unsigned*)(ws + WS_CTL) + CW_PWF + 64 * l, 1u); }
                __syncthreads(); }
            __syncthreads();
            for (int rep = 0; rep < REP_ATT; ++rep) { __syncthreads(); attn_units(args, l, lds, vcu, G); }
            __syncthreads();
            sample_wkv_units(args, l, vcu, G);
            __syncthreads();
            for (int rep = 0; rep < REP_SATT; ++rep) { __syncthreads(); sample_attn_units(args, l, lds, vcu, G); }
            if (l + 1 < DEPTH && (vcu >= 64 || G != 256)) { prep_layer_pull(args, l + 1, 1, 1 << 30, lds, MISC + 16); prep_layer_pull(args, l + 1, 2, 1 << 30, lds, MISC + 16); conv_pull(args, l + 1, CONV_GS, true, lds, MISC + 16); }
        }
        SEAM(pb + 3);
        if (IN(pb + 4)) { for (int rep = 0; rep < REP_MX; ++rep) mx_phase(args, l, vcu, G); }
        SEAM(pb + 4);
        if (IN(pb + 5)) {
            __syncthreads();
            sample_proj<DM>(MIX, (const bf16*)(ws + WS_WOUT) + (size_t)l * DM * DM, Xs, XB + (size_t)MP * DM, modl + 2 * DM, lds, vcu, G);
            pg8::Gemm g{(const pg8::bf16_t*)MIX, (const pg8::bf16_t*)(ws + WS_WOUT) + (size_t)l * DM * DM, MP, DM, DM}; pg8::StaticOrder S; S.init(MP, DM, G, bx);
            for (int rep = 0; rep < REP_G2; ++rep) { float* dst = (rep + 1 < REP_G2) ? (float*)(ws + WS_END + 16 * MiB) : XB;
            pg8::EpiResid E{Xp, Xs, dst, dst + (size_t)MP * DM, modl + 2 * DM};
            pg8::gemm_phase<pg8::EpiResid, pg8::StaticOrder, true, true>(lds, g, S, E); }
        }
        SEAM(pb + 5);
        if (IN(pb + 6)) { for (int rep = 0; rep < REP_N2; ++rep) { __syncthreads(); n2_phase(args, l, vcu, G, XB, modl, HB); } }
        SEAM(pb + 6);
        if (IN(pb + 7)) {
            __syncthreads();
            pg8::Gemm g{(const pg8::bf16_t*)HB, (const pg8::bf16_t*)(ws + WS_WGU) + (size_t)l * 2 * FF * DM, MH, 2 * FF, DM}; pg8::StaticOrder S; S.init(MH, 2 * FF, G, bx);
            for (int rep = 0; rep < REP_G3; ++rep) { pg8::bf16_t* dst = (rep + 1 < REP_G3) ? (pg8::bf16_t*)(ws + WS_END + 16 * MiB) : (pg8::bf16_t*)ACT;
            pg8::EpiSwiGLU E{dst, FF};
            pg8::gemm_phase<pg8::EpiSwiGLU, pg8::StaticOrder, true, true>(lds, g, S, E); }
            if (l + 1 < DEPTH && bx >= (MH / 256) * (2 * FF / 256) % G && G == 256) conv_pull(args, l + 1, TAIL_PULLS, false, lds, MISC + 16);
        }
        SEAM(pb + 7);
        if (IN(pb + 8)) {
            __syncthreads();
            float* op = (l == DEPTH - 1) ? args.out + O_YP : XB; float* os = (l == DEPTH - 1) ? args.out + O_YS : XB + (size_t)MP * DM;
            sample_proj<FF>(ACT, (const bf16*)(ws + WS_WDN) + (size_t)l * DM * FF, XB + (size_t)MP * DM, os, modl + 5 * DM, lds, vcu, G);
            pg8::Gemm g{(const pg8::bf16_t*)ACT, (const pg8::bf16_t*)(ws + WS_WDN) + (size_t)l * DM * FF, MP, DM, FF}; pg8::StaticOrder S; S.init(MP, DM, G, bx);
            for (int rep = 0; rep < REP_G4; ++rep) { float* dst = (rep + 1 < REP_G4) ? (float*)(ws + WS_END + 16 * MiB) : op;
            pg8::EpiResid E{XB, XB + (size_t)MP * DM, dst, os, modl + 5 * DM};
            pg8::gemm_phase<pg8::EpiResid, pg8::StaticOrder, true, true>(lds, g, S, E); }
        }
        SEAM(pb + 8);
    }
#undef IN
#undef SEAM
}

extern "C" void kernel_launch(void* const* d_in, const int* in_sizes, int n_in, void* d_out, int out_size, void* d_ws, size_t ws_size, hipStream_t stream) {
    static int grid = 0;
    if (grid == 0) {
        if (n_in != N_IN || (size_t)out_size != O_END || ws_size < WS_END) { fprintf(stderr, "kernel_launch: unexpected shapes: n_in %d, out %d, ws %zu (need %zu)\n", n_in, out_size, ws_size, (size_t)WS_END); grid = -1; return; }
        int dev = 0, cus = 0;
        if (hipGetDevice(&dev) != hipSuccess || hipDeviceGetAttribute(&cus, hipDeviceAttributeMultiprocessorCount, dev) != hipSuccess) { grid = -1; return; }
        if (hipFuncSetAttribute((const void*)fwd, hipFuncAttributeMaxDynamicSharedMemorySize, LDS_BYTES) != hipSuccess) { fprintf(stderr, "kernel_launch: hipFuncSetAttribute failed\n"); grid = -1; return; }
        int per_cu = 0;
        if (hipOccupancyMaxActiveBlocksPerMultiprocessor(&per_cu, (const void*)fwd, NTHR, LDS_BYTES) != hipSuccess || per_cu < 1) fprintf(stderr, "kernel_launch: occupancy query says %d blocks per CU\n", per_cu);
        (void)hipGetLastError();
        grid = cus;
    }
    if (grid < 0) return;
    if (hipMemsetAsync((char*)d_ws + WS_CTL, 0, CTL_ZERO_BYTES, stream) != hipSuccess) return;
    Args a{};
    for (int i = 0; i < N_IN; ++i) a.in[i] = (const float*)d_in[i];
    a.out = (float*)d_out; a.ws = (unsigned char*)d_ws;
#if MK_N_LAUNCHES == 1
    a.ph_lo = 0; a.ph_hi = N_PHASES;
    hipLaunchKernelGGL(fwd, dim3(grid), dim3(NTHR), LDS_BYTES, stream, a);
#else
    for (int li = 0; li < N_PHASES; ++li) { a.ph_lo = li; a.ph_hi = li + 1; hipLaunchKernelGGL(fwd, dim3(grid), dim3(NTHR), LDS_BYTES, stream, a); }
#endif
}
```
